# Optimizing an MI355X kernel written in HIP

```python
import math
import jax, jax.numpy as jnp
from jax import lax
import numpy as np

D_MODEL = 2048
BATCH = 4
SEQ = 2048
DEPTH = 1
DEC_BATCH = 128
DEC_SEQ = 1
PAST_LEN = 16384
PAGE_SIZE = 128

RET_HEADS = 8
RET_DK = 128
RET_DV = 256
RET_QK = RET_HEADS * RET_DK
RET_V = RET_HEADS * RET_DV
RET_CHUNK = 128
ROPE_BASE = 10000.0
HG_HEADS = 8
HG_DK = 128
HG_DV = 128
HG_K = HG_HEADS * HG_DK
HG_V = HG_HEADS * HG_DV
HG_CHUNK = 16
D_FF = -(-8 * D_MODEL // (3 * 256)) * 256
EPS = 1e-6

IN_SIZES = [RET_QK, RET_QK, RET_V, RET_V, HG_K, HG_K, HG_V, HG_V, D_MODEL, D_MODEL]
IN_TOTAL = int(sum(IN_SIZES))
IN_OFFSETS = [int(o) for o in np.cumsum(IN_SIZES)[:-1]]

kernel_name = 'hybrid_retnet_hgrn2_step'


def rms_norm(x, g):
    xf = x.astype(jnp.float32)
    y = xf * lax.rsqrt(jnp.mean(xf * xf, axis=-1, keepdims=True) + EPS)
    return (y * g.astype(jnp.float32)).astype(x.dtype)


def head_rms(o):
    return o * lax.rsqrt(jnp.mean(o * o, axis=-1, keepdims=True) + EPS)


def to_heads(a, n_heads):
    B, T, _ = a.shape
    return a.reshape(B, T, n_heads, -1).transpose(0, 2, 1, 3).astype(jnp.float32)


def from_heads(a):
    B, H, T, d = a.shape
    return a.transpose(0, 2, 1, 3).reshape(B, T, H * d)


def rotary(x, pos):
    half = x.shape[-1] // 2
    inv_freq = ROPE_BASE ** (-jnp.arange(half, dtype=jnp.float32) / half)
    ang = pos.astype(jnp.float32)[:, None] * inv_freq[None, :]
    cos, sin = jnp.cos(ang), jnp.sin(ang)
    x1, x2 = x[..., :half], x[..., half:]
    return jnp.concatenate([x1 * cos - x2 * sin, x2 * cos + x1 * sin], axis=-1)


def split_chunks(a, n_chunks, c):
    B, H, T, d = a.shape
    return a.reshape(B, H, n_chunks, c, d).transpose(2, 0, 1, 3, 4)


def merge_chunks(a):
    N, B, H, C, d = a.shape
    return a.transpose(1, 2, 0, 3, 4).reshape(B, H, N * C, d)


def retention_chunkwise(q, k, v, s0, log_gamma):
    B, H, T, _ = q.shape
    C = math.gcd(T, RET_CHUNK)
    N = T // C
    idx = jnp.arange(C, dtype=jnp.float32)
    diff = idx[:, None] - idx[None, :]
    lg = log_gamma[:, None, None]
    decay_mask = jnp.where(diff >= 0, jnp.exp(jnp.maximum(diff, 0.0) * lg), 0.0)
    q_decay = jnp.exp((idx + 1.0)[None, :] * log_gamma[:, None])[..., None]
    k_decay = jnp.exp((C - 1.0 - idx)[None, :] * log_gamma[:, None])[..., None]
    chunk_decay = jnp.exp(C * log_gamma)[:, None, None]

    def step(S, blk):
        qc, kc, vc = blk
        scores = jnp.einsum('bhnd,bhmd->bhnm', qc, kc) * decay_mask
        o = (jnp.einsum('bhnm,bhme->bhne', scores, vc)
             + jnp.einsum('bhnd,bhde->bhne', qc * q_decay, S))
        S = chunk_decay * S + jnp.einsum('bhmd,bhme->bhde', kc * k_decay, vc)
        return S, o

    S, o = lax.scan(step, s0, (split_chunks(q, N, C), split_chunks(k, N, C), split_chunks(v, N, C)))
    return merge_chunks(o), S


def hgrn2_chunkwise(q, k, logf, v, s0):
    B, H, T, _ = q.shape
    C = math.gcd(T, HG_CHUNK)
    N = T // C
    pos = jnp.arange(C)
    causal = (pos[:, None] >= pos[None, :])[:, :, None]

    def step(S, blk):
        qc, kc, lfc, vc = blk
        b = jnp.cumsum(lfc, axis=-2)
        rel = jnp.where(causal, b[:, :, :, None, :] - b[:, :, None, :, :], -jnp.inf)
        A = jnp.einsum('bhnd,bhmd,bhnmd->bhnm', qc, kc, jnp.exp(rel))
        o = (jnp.einsum('bhnm,bhme->bhne', A, vc)
             + jnp.einsum('bhnd,bhde->bhne', qc * jnp.exp(b), S))
        b_last = b[:, :, -1:, :]
        S = (jnp.exp(b_last[:, :, 0, :])[..., None] * S
             + jnp.einsum('bhmd,bhme->bhde', kc * jnp.exp(b_last - b), vc))
        return S, o

    blocks = (split_chunks(q, N, C), split_chunks(k, N, C), split_chunks(logf, N, C), split_chunks(v, N, C))
    S, o = lax.scan(step, s0, blocks)
    return merge_chunks(o), S


def decoder_layer(x, pos, s_ret, s_hg, lb, w_in, w_ret_out, w_hgrn_out, w_out,
                  norm_mix, norm_ffn, hgrn_norm, w_ffn_in, w_ffn_out):
    h = rms_norm(x, norm_mix)
    proj = h @ w_in
    rq, rk, rv, rg, hq, hf, hi, hg, ga, gb = jnp.split(proj, IN_OFFSETS, axis=-1)

    log_gamma = jnp.log(1.0 - 2.0 ** (-5.0 - jnp.arange(RET_HEADS, dtype=jnp.float32)))
    q = rotary(to_heads(rq, RET_HEADS), pos)
    k = rotary(to_heads(rk, RET_HEADS), pos) * (RET_DK ** -0.5)
    v = to_heads(rv, RET_HEADS)
    o_r, s_ret_new = retention_chunkwise(q, k, v, s_ret.astype(jnp.float32), log_gamma)
    o_r = from_heads(head_rms(o_r)) * jax.nn.silu(rg.astype(jnp.float32))
    y_a = o_r.astype(x.dtype) @ w_ret_out

    lbh = lb.reshape(HG_HEADS, 1, HG_DK)
    z = to_heads(hf, HG_HEADS)
    logf = jnp.logaddexp(jnp.log(lbh), jnp.log1p(-lbh) + jax.nn.log_sigmoid(z))
    k_in = (1.0 - lbh) * jax.nn.sigmoid(-z)
    qh = jax.nn.silu(to_heads(hq, HG_HEADS))
    o_h, s_hg_new = hgrn2_chunkwise(qh, k_in, logf, to_heads(hi, HG_HEADS), s_hg.astype(jnp.float32))
    o_h = head_rms(o_h) * hgrn_norm.astype(jnp.float32)
    o_h = from_heads(o_h) * jax.nn.silu(hg.astype(jnp.float32))
    y_b = o_h.astype(x.dtype) @ w_hgrn_out

    merged = jax.nn.sigmoid(ga) * y_a + jax.nn.sigmoid(gb) * y_b
    x = x + merged @ w_out

    h2 = rms_norm(x, norm_ffn)
    g, u = jnp.split(h2 @ w_ffn_in, [D_FF], axis=-1)
    x = x + (jax.nn.silu(g) * u) @ w_ffn_out
    return x, s_ret_new, s_hg_new


def setup_inputs(seed: int = 0) -> dict:
    key = jax.random.key(seed)
    ks = jax.random.split(key, 16)
    f32 = jnp.float32
    nrm = lambda k, shape, s: (jax.random.normal(k, shape, f32) * s)
    return {
        'x_prompt': nrm(ks[0], (BATCH, SEQ, D_MODEL), 1.0),
        'x_sample': nrm(ks[1], (DEC_BATCH, DEC_SEQ, D_MODEL), 1.0),
        'state_ret': nrm(ks[2], (DEPTH, DEC_BATCH, RET_HEADS, RET_DK, RET_DV), 0.5),
        'state_hgrn': nrm(ks[3], (DEPTH, DEC_BATCH, HG_HEADS, HG_DK, HG_DV), 0.5),
        'w_in': nrm(ks[4], (DEPTH, D_MODEL, IN_TOTAL), D_MODEL ** -0.5),
        'w_ret_out': nrm(ks[5], (DEPTH, RET_V, D_MODEL), RET_V ** -0.5),
        'w_hgrn_out': nrm(ks[6], (DEPTH, HG_V, D_MODEL), HG_V ** -0.5),
        'w_out': nrm(ks[7], (DEPTH, D_MODEL, D_MODEL), D_MODEL ** -0.5),
        'norm_mix': 1.0 + nrm(ks[8], (DEPTH, D_MODEL), 0.02),
        'norm_ffn': 1.0 + nrm(ks[9], (DEPTH, D_MODEL), 0.02),
        'hgrn_norm': 1.0 + nrm(ks[10], (DEPTH, HG_DV), 0.02),
        'hgrn_lb_logits': nrm(ks[11], (DEPTH + 1, HG_K), 0.5),
        'w_ffn_in': nrm(ks[12], (DEPTH, D_MODEL, 2 * D_FF), D_MODEL ** -0.5),
        'w_ffn_out': nrm(ks[13], (DEPTH, D_FF, D_MODEL), D_FF ** -0.5),
        'norm_final': 1.0 + nrm(ks[14], (D_MODEL,), 0.02),
    }


def reference(x_prompt, x_sample, state_ret, state_hgrn, w_in, w_ret_out, w_hgrn_out, w_out,
              norm_mix, norm_ffn, hgrn_norm, hgrn_lb_logits, w_ffn_in, w_ffn_out, norm_final):
    lower_bounds = jnp.cumsum(jax.nn.softmax(hgrn_lb_logits.astype(jnp.float32), axis=0), axis=0)

    pos_prompt = jnp.arange(x_prompt.shape[1])
    pos_sample = PAST_LEN + jnp.arange(x_sample.shape[1])
    b_prompt = x_prompt.shape[0]

    xp, xs = x_prompt, x_sample
    ret_p, hg_p, ret_s, hg_s = [], [], [], []
    for l in range(DEPTH):
        lw = (w_in[l], w_ret_out[l], w_hgrn_out[l], w_out[l], norm_mix[l], norm_ffn[l],
              hgrn_norm[l], w_ffn_in[l], w_ffn_out[l])
        zr = jnp.zeros((b_prompt, RET_HEADS, RET_DK, RET_DV), jnp.float32)
        zh = jnp.zeros((b_prompt, HG_HEADS, HG_DK, HG_DV), jnp.float32)
        xp, sr, sh = decoder_layer(xp, pos_prompt, zr, zh, lower_bounds[l], *lw)
        ret_p.append(sr.astype(state_ret.dtype))
        hg_p.append(sh.astype(state_hgrn.dtype))
        xs, sr, sh = decoder_layer(xs, pos_sample, state_ret[l], state_hgrn[l], lower_bounds[l], *lw)
        ret_s.append(sr.astype(state_ret.dtype))
        hg_s.append(sh.astype(state_hgrn.dtype))

    y_prompt = rms_norm(xp, norm_final)
    y_sample = rms_norm(xs, norm_final)
    return (y_prompt, y_sample, jnp.stack(ret_p), jnp.stack(hg_p), jnp.stack(ret_s), jnp.stack(hg_s))
```

```cpp
#include <hip/hip_runtime.h>
namespace nv {
constexpr int DM = 2048, NIN = 14336, DFF = 5632;
constexpr float EPS = 1e-6f;
__device__ __forceinline__ float sigmoidf_(float x) { return 1.f / (1.f + __expf(-x)); }
__device__ __forceinline__ float siluf_(float x) { return x / (1.f + __expf(-x)); }

__global__ void rmsnorm_k(const float* x, const float* g, float* out) {
    __shared__ float red[4];
    const float* xr = x + (size_t)blockIdx.x * DM; float* o = out + (size_t)blockIdx.x * DM;
    float v[8]; float s = 0.f;
    for (int i = 0; i < 8; ++i) { v[i] = xr[threadIdx.x + 256 * i]; s += v[i] * v[i]; }
    for (int o2 = 32; o2 >= 1; o2 >>= 1) s += __shfl_xor(s, o2);
    if ((threadIdx.x & 63) == 0) red[threadIdx.x >> 6] = s;
    __syncthreads();
    const float tot = red[0] + red[1] + red[2] + red[3];
    const float r = 1.0f / sqrtf(tot * (1.f / DM) + EPS);
    for (int i = 0; i < 8; ++i) o[threadIdx.x + 256 * i] = v[i] * r * g[threadIdx.x + 256 * i];
}
__global__ __launch_bounds__(256) void gemm_k(const float* A, int lda, const float* B, int ldb, float* C, int ldc, int K) {
    __shared__ float As[16][68]; __shared__ float Bs[16][68];
    const int tid = threadIdx.x, tx = tid & 15, ty = tid >> 4;
    const int m0 = blockIdx.y * 64, n0 = blockIdx.x * 64;
    float acc[4][4]; for (int i = 0; i < 4; ++i) for (int j = 0; j < 4; ++j) acc[i][j] = 0.f;
    const int ar = tid >> 2, ak = (tid & 3) * 4, bk = tid >> 4, bc = (tid & 15) * 4;
    for (int k0 = 0; k0 < K; k0 += 16) {
        const float4 av = *(const float4*)(A + (size_t)(m0 + ar) * lda + k0 + ak);
        const float4 bv = *(const float4*)(B + (size_t)(k0 + bk) * ldb + n0 + bc);
        __syncthreads();
        As[ak + 0][ar] = av.x; As[ak + 1][ar] = av.y; As[ak + 2][ar] = av.z; As[ak + 3][ar] = av.w;
        *(float4*)&Bs[bk][bc] = bv;
        __syncthreads();
#pragma unroll
        for (int k = 0; k < 16; ++k) {
            const float4 a = *(const float4*)&As[k][ty * 4]; const float4 b = *(const float4*)&Bs[k][tx * 4];
            const float aa[4] = {a.x, a.y, a.z, a.w}, bb[4] = {b.x, b.y, b.z, b.w};
#pragma unroll
            for (int i = 0; i < 4; ++i)
#pragma unroll
                for (int j = 0; j < 4; ++j) acc[i][j] += aa[i] * bb[j];
        }
    }
    for (int i = 0; i < 4; ++i) *(float4*)(C + (size_t)(m0 + ty * 4 + i) * ldc + n0 + tx * 4) = make_float4(acc[i][0], acc[i][1], acc[i][2], acc[i][3]);
}
__global__ void postproj_k(float* proj, int R, int pos0, const float* lb_logits) {
    const size_t idx = (size_t)blockIdx.x * blockDim.x + threadIdx.x; if (idx >= (size_t)R * NIN) return;
    const int r = (int)(idx / NIN), c = (int)(idx % NIN); float* p = proj + (size_t)r * NIN;
    if (c < 2048) {
        const int j = c & 127; if (j >= 64) return;
        const int pos = pos0 >= 0 ? pos0 : (r % 2048);
        const float inv = powf(10000.0f, -(float)j / 64.0f); const float ang = (float)pos * inv;
        float sn, cs; sincosf(ang, &sn, &cs);
        const float x1 = p[c], x2 = p[c + 64]; float o1 = x1 * cs - x2 * sn, o2 = x2 * cs + x1 * sn;
        if (c >= 1024) { o1 *= 0.08838834764831845f; o2 *= 0.08838834764831845f; }
        p[c] = o1; p[c + 64] = o2;
    } else if (c < 4096) {
    } else if (c < 6144) { p[c] = siluf_(p[c]);
    } else if (c < 7168) { p[c] = siluf_(p[c]);
    } else if (c < 8192) {
        const int ch = c - 7168; const float l0 = lb_logits[ch], l1 = lb_logits[1024 + ch];
        const float lb = 1.f / (1.f + expf(l1 - l0));
        p[c] = lb + (1.f - lb) * (1.f / (1.f + expf(-p[c])));
    } else if (c < 9216) {
    } else if (c < 10240) { p[c] = siluf_(p[c]);
    } else { p[c] = 1.f / (1.f + expf(-p[c])); }
}
__global__ __launch_bounds__(256) void ret_rec_k(const float* proj, int T, const float* S0, float* O, float* Sout) {
    const int e = threadIdx.x, h = blockIdx.x & 7, b = blockIdx.x >> 3;
    const float gamma = 1.0f - exp2f(-5.0f - (float)h);
    float S[128];
    const float* s0 = S0 ? S0 + ((size_t)(b * 8 + h) * 128) * 256 + e : nullptr;
#pragma unroll
    for (int d = 0; d < 128; ++d) S[d] = s0 ? s0[(size_t)d * 256] : 0.f;
    for (int t = 0; t < T; ++t) {
        const float* p = proj + (size_t)(b * T + t) * NIN; const float* q = p + h * 128; const float* k = p + 1024 + h * 128; const float v = p[2048 + h * 256 + e];
        float o = 0.f;
#pragma unroll
        for (int d = 0; d < 128; ++d) { S[d] = gamma * S[d] + k[d] * v; o += q[d] * S[d]; }
        O[(size_t)(b * T + t) * 2048 + h * 256 + e] = o;
    }
    float* so = Sout + ((size_t)(b * 8 + h) * 128) * 256 + e;
#pragma unroll
    for (int d = 0; d < 128; ++d) so[(size_t)d * 256] = S[d];
}
__global__ __launch_bounds__(128) void hg_rec_k(const float* proj, int T, const float* S0, float* O, float* Sout) {
    const int e = threadIdx.x, h = blockIdx.x & 7, b = blockIdx.x >> 3;
    float S[128];
    const float* s0 = S0 ? S0 + ((size_t)(b * 8 + h) * 128) * 128 + e : nullptr;
#pragma unroll
    for (int d = 0; d < 128; ++d) S[d] = s0 ? s0[(size_t)d * 128] : 0.f;
    for (int t = 0; t < T; ++t) {
        const float* p = proj + (size_t)(b * T + t) * NIN; const float* q = p + 6144 + h * 128; const float* f = p + 7168 + h * 128; const float v = p[8192 + h * 128 + e];
        float o = 0.f;
#pragma unroll
        for (int d = 0; d < 128; ++d) { const float ff = f[d]; S[d] = ff * S[d] + (1.f - ff) * v; o += q[d] * S[d]; }
        O[(size_t)(b * T + t) * 1024 + h * 128 + e] = o;
    }
    float* so = Sout + ((size_t)(b * 8 + h) * 128) * 128 + e;
#pragma unroll
    for (int d = 0; d < 128; ++d) so[(size_t)d * 128] = S[d];
}
__global__ void headnorm_k(float* Or, float* Oh, const float* proj, const float* hgrn_norm) {
    const int r = blockIdx.x >> 3, h = blockIdx.x & 7, l = threadIdx.x; const float* p = proj + (size_t)r * NIN;
    { float* o = Or + (size_t)r * 2048 + h * 256; float v[4]; float s = 0.f; for (int i = 0; i < 4; ++i) { v[i] = o[l + 64 * i]; s += v[i] * v[i]; }
      for (int o2 = 32; o2 >= 1; o2 >>= 1) s += __shfl_xor(s, o2); const float rr = 1.0f / sqrtf(s * (1.f / 256.f) + EPS);
      for (int i = 0; i < 4; ++i) o[l + 64 * i] = v[i] * rr * p[4096 + h * 256 + l + 64 * i]; }
    { float* o = Oh + (size_t)r * 1024 + h * 128; float v[2]; float s = 0.f; for (int i = 0; i < 2; ++i) { v[i] = o[l + 64 * i]; s += v[i] * v[i]; }
      for (int o2 = 32; o2 >= 1; o2 >>= 1) s += __shfl_xor(s, o2); const float rr = 1.0f / sqrtf(s * (1.f / 128.f) + EPS);
      for (int i = 0; i < 2; ++i) o[l + 64 * i] = v[i] * rr * hgrn_norm[l + 64 * i] * p[9216 + h * 128 + l + 64 * i]; }
}
__global__ void merge_k(float* ya, const float* yb, const float* proj, int R) {
    const size_t idx = (size_t)blockIdx.x * blockDim.x + threadIdx.x; if (idx >= (size_t)R * 2048) return;
    const int r = (int)(idx / 2048), c = (int)(idx % 2048); const float* p = proj + (size_t)r * NIN;
    ya[idx] = p[10240 + c] * ya[idx] + p[12288 + c] * yb[idx];
}
__global__ void add_k(const float* a, const float* b, float* o, size_t n) { const size_t i = (size_t)blockIdx.x * blockDim.x + threadIdx.x; if (i < n) o[i] = a[i] + b[i]; }
__global__ void swiglu_k(const float* gu, float* act, int R) {
    const size_t idx = (size_t)blockIdx.x * blockDim.x + threadIdx.x; if (idx >= (size_t)R * DFF) return;
    const int r = (int)(idx / DFF), c = (int)(idx % DFF); act[idx] = siluf_(gu[(size_t)r * 2 * DFF + c]) * gu[(size_t)r * 2 * DFF + DFF + c];
}
}

static void naive_forward(void* const* d_in, float* out, unsigned char* ws, hipStream_t st) {
    using namespace nv;
    const float* x_prompt = (const float*)d_in[0]; const float* x_sample = (const float*)d_in[1];
    const float* state_ret = (const float*)d_in[2]; const float* state_hg = (const float*)d_in[3];
    const float* w_in = (const float*)d_in[4]; const float* w_ro = (const float*)d_in[5]; const float* w_ho = (const float*)d_in[6]; const float* w_out = (const float*)d_in[7];
    const float* norm_mix = (const float*)d_in[8]; const float* norm_ffn = (const float*)d_in[9]; const float* hgrn_norm = (const float*)d_in[10]; const float* lb_logits = (const float*)d_in[11];
    const float* w_fi = (const float*)d_in[12]; const float* w_fo = (const float*)d_in[13]; const float* norm_final = (const float*)d_in[14];
    float* y_prompt = out; float* y_sample = out + (size_t)8192 * 2048;
    float* srp = y_sample + (size_t)128 * 2048; float* shp = srp + (size_t)4 * 8 * 128 * 256; float* srs = shp + (size_t)4 * 8 * 128 * 128; float* shs = srs + (size_t)128 * 8 * 128 * 256;
    float* proj = (float*)ws;
    float* h    = proj + (size_t)2048 * NIN;
    float* Or   = h + (size_t)2048 * 2048;
    float* Oh   = Or + (size_t)2048 * 2048;
    float* ya   = Oh + (size_t)2048 * 1024;
    float* yb   = ya + (size_t)2048 * 2048;
    float* x1   = yb + (size_t)2048 * 2048;
    float* act  = x1 + (size_t)2048 * 2048;
    for (int g = 0; g < 5; ++g) {
        const int R = g < 4 ? 2048 : 128, T = g < 4 ? 2048 : 1, B = g < 4 ? 1 : 128;
        const float* x = g < 4 ? x_prompt + (size_t)g * 2048 * 2048 : x_sample;
        float* y = g < 4 ? y_prompt + (size_t)g * 2048 * 2048 : y_sample;
        rmsnorm_k<<<R, 256, 0, st>>>(x, norm_mix, h);
        gemm_k<<<dim3(NIN / 64, R / 64), 256, 0, st>>>(h, 2048, w_in, NIN, proj, NIN, 2048);
        { const size_t n = (size_t)R * NIN; postproj_k<<<(unsigned)((n + 255) / 256), 256, 0, st>>>(proj, R, g < 4 ? -1 : 16384, lb_logits); }
        ret_rec_k<<<B * 8, 256, 0, st>>>(proj, T, g < 4 ? nullptr : state_ret, Or, g < 4 ? srp + (size_t)g * 8 * 128 * 256 : srs);
        hg_rec_k<<<B * 8, 128, 0, st>>>(proj, T, g < 4 ? nullptr : state_hg, Oh, g < 4 ? shp + (size_t)g * 8 * 128 * 128 : shs);
        headnorm_k<<<R * 8, 64, 0, st>>>(Or, Oh, proj, hgrn_norm);
        gemm_k<<<dim3(2048 / 64, R / 64), 256, 0, st>>>(Or, 2048, w_ro, 2048, ya, 2048, 2048);
        gemm_k<<<dim3(2048 / 64, R / 64), 256, 0, st>>>(Oh, 1024, w_ho, 2048, yb, 2048, 1024);
        { const size_t n = (size_t)R * 2048; merge_k<<<(unsigned)((n + 255) / 256), 256, 0, st>>>(ya, yb, proj, R); }
        gemm_k<<<dim3(2048 / 64, R / 64), 256, 0, st>>>(ya, 2048, w_out, 2048, yb, 2048, 2048);
        { const size_t n = (size_t)R * 2048; add_k<<<(unsigned)((n + 255) / 256), 256, 0, st>>>(x, yb, x1, n); }
        rmsnorm_k<<<R, 256, 0, st>>>(x1, norm_ffn, h);
        gemm_k<<<dim3(2 * DFF / 64, R / 64), 256, 0, st>>>(h, 2048, w_fi, 2 * DFF, proj, 2 * DFF, 2048);
        { const size_t n = (size_t)R * DFF; swiglu_k<<<(unsigned)((n + 255) / 256), 256, 0, st>>>(proj, act, R); }
        gemm_k<<<dim3(2048 / 64, R / 64), 256, 0, st>>>(act, DFF, w_fo, 2048, yb, 2048, DFF);
        { const size_t n = (size_t)R * 2048; add_k<<<(unsigned)((n + 255) / 256), 256, 0, st>>>(x1, yb, ya, n); }
        rmsnorm_k<<<R, 256, 0, st>>>(ya, norm_final, y);
    }
}
extern "C" void kernel_launch(void* const* d_in, const int* in_sizes, int n_in, void* d_out, int out_size, void* d_ws, size_t ws_size, hipStream_t stream) {
    naive_forward(d_in, (float*)d_out, (unsigned char*)d_ws, stream);
}
```

```cpp
#define HYBRID_LEVEL 7
#define FAST_PHASES 10
#define NAIVE_WS_OFF WS_KVLOC
#include <hip/hip_runtime.h>
#include <cstdio>
#include <cstdint>
constexpr int DMODEL = 2048, MROWS = 8320, MPAD = 8448, NIN = 14336, DFF = 5632, NWAVES = 8;
constexpr float EPS = 1e-6f;
constexpr size_t MiB = 1u << 20;
constexpr size_t WS_CTL = 0, CTL_ZERO_BYTES = 1 * MiB;
constexpr size_t WS_WRO = 1 * MiB, WS_WHO = 9 * MiB, WS_WOUT = 13 * MiB, WS_WFI = 21 * MiB, WS_WFO = 65 * MiB, WS_WIN = 87 * MiB;
constexpr size_t WS_XB = 143 * MiB;
constexpr size_t WS_Q = 176 * MiB, WS_K = WS_Q + 8448ull * 1024 * 2, WS_V = 209 * MiB, WS_RG = 242 * MiB, WS_HQ = 275 * MiB, WS_LOGF = WS_HQ + 8448ull * 1024 * 2;
constexpr size_t WS_HI = WS_LOGF + 8448ull * 1024 * 4, WS_HG = WS_HI + 8448ull * 1024 * 2, WS_GA = WS_HG + 8448ull * 1024 * 2, WS_GB = WS_GA + 8448ull * 2048 * 2;
constexpr size_t WS_KVLOC = WS_GB + 8448ull * 2048 * 2;
constexpr size_t WS_HSLOC = WS_KVLOC + 64 * MiB;
constexpr size_t WS_OH = WS_HSLOC + 32 * MiB;
constexpr size_t WS_MISC = WS_OH + 8448ull * 1024 * 2;
constexpr size_t WS_RR1 = WS_MISC, WS_COS = WS_RR1 + 64 * 1024, WS_SIN = WS_COS + 2049 * 64 * 4 + 256, WS_LB = WS_SIN + 2049 * 64 * 4 + 256, WS_BTOT = WS_LB + 4096, WS_END = WS_BTOT + 512 * 128 * 4;
constexpr size_t WS_OR = WS_XB;
constexpr size_t WS_SRT = WS_WIN, WS_SHT = WS_WIN + 32 * MiB;
constexpr size_t WS_YT = WS_KVLOC;
constexpr size_t WS_MG = WS_Q;
constexpr size_t WS_X1B = WS_V;
constexpr size_t WS_ACT = WS_RG;
static_assert(WS_GB + 8448ull * 2048 * 2 == WS_KVLOC && WS_K + 8448ull * 1024 * 2 == WS_V && WS_V + 8448ull * 2048 * 2 == WS_RG && WS_RG + 8448ull * 2048 * 2 == WS_HQ, "map");
static_assert(WS_YT + 8448ull * 2048 * 4 <= WS_OH && WS_ACT + 8448ull * 5632 * 2 <= WS_GA && WS_END <= 541 * MiB, "map2");
constexpr int CW_BAR = 4096;
constexpr int CW_SS1 = 16384, CW_SS2 = 16384 + 8448;
static_assert((CW_SS2 + 8448) * 4 <= (int)CTL_ZERO_BYTES, "ctl");
constexpr int RING_BYTES = 131072, LDSCTL_OFF = RING_BYTES, MISC_OFF = LDSCTL_OFF + 320, LDS_BYTES = 147456;

#define GAS __attribute__((address_space(1)))
#define LAS __attribute__((address_space(3)))
typedef unsigned short bf16;
typedef unsigned v4u __attribute__((ext_vector_type(4)));
typedef unsigned v2u __attribute__((ext_vector_type(2)));
typedef float f32x4 __attribute__((ext_vector_type(4)));
typedef short bf16x8 __attribute__((ext_vector_type(8)));
typedef GAS unsigned gu32;
#define RLX_AGENT __ATOMIC_RELAXED, __HIP_MEMORY_SCOPE_AGENT
#define LDS_WAIT() asm volatile("s_waitcnt lgkmcnt(0)" ::: "memory")
#define VM_WAIT() asm volatile("s_waitcnt vmcnt(0)" ::: "memory")
__device__ __forceinline__ unsigned f2bf(float f) { unsigned u = __builtin_bit_cast(unsigned, f); return (u + 0x7fffu + ((u >> 16) & 1u)) >> 16; }
__device__ __forceinline__ unsigned pk2(float lo, float hi) { return f2bf(lo) | (f2bf(hi) << 16); }
__device__ __forceinline__ float bf2f(unsigned short b) { return __uint_as_float(((unsigned)b) << 16); }
namespace pg8 {
#define PG8_LAS __attribute__((address_space(3)))
typedef unsigned short bf16_t;
typedef short bf16x8 __attribute__((ext_vector_type(8)));
typedef float f32x4 __attribute__((ext_vector_type(4)));
typedef unsigned u32x4 __attribute__((ext_vector_type(4)));
constexpr int BM = 256, BK = 64, HALF = 128, HTB = HALF * BK * 2  , STAGE_BYTES = 8 * HTB, NXCD = 8, WGM = 8;

__host__ __device__ __forceinline__ int lds_byte(int r, int c) { const int st = (r >> 4) * 2 + (c >> 5), rr = r & 15, cc = c & 31, ob = rr * 64 + cc * 2; return st * 1024 + (ob ^ (((ob >> 9) & 1) << 5)); }
__host__ __device__ __forceinline__ void stage_rc(int b, int& R, int& C) { const int st = b / 1024, sb = b % 1024, swz = sb ^ (((sb >> 9) & 1) << 5); R = (st >> 1) * 16 + swz / 64; C = (st & 1) * 32 + (swz % 64) / 2; }
__host__ __device__ __forceinline__ int perm32(int rho) { const int n = rho >> 4, i = rho & 15; return 8 * (i >> 2) + 4 * n + (i & 3); }

struct Unit { int pm, pn; };
struct Gemm { const bf16_t* A; const bf16_t* Bt; int M, N, K; };

struct StaticOrder {
    int nM, nN, nwg, G, c;
    __host__ __device__ void init(int M, int N, int G_, int c_) { nM = M / BM; nN = N / BM; nwg = nM * nN; G = G_; c = c_; }
    __host__ __device__ bool next(int i, Unit& u) const {
        const long L = (long)i * G + c; if (L >= nwg) return false;
        int wgid = (int)L; { const int q = nwg / NXCD, r = nwg % NXCD, xcd = wgid % NXCD, off = wgid / NXCD; wgid = (xcd < r ? xcd * (q + 1) : r * (q + 1) + (xcd - r) * q) + off; }
        const int nig = WGM * nN, gid = wgid / nig, fm = gid * WGM, gsz = (nM - fm) < WGM ? (nM - fm) : WGM;
        u.pm = fm + ((wgid % nig) % gsz); u.pn = (wgid % nig) / gsz; return true;
    }
    __device__ __forceinline__ void a_ready(const Unit&) const {}
    __device__ __forceinline__ void done(const Unit&) const {}
};

__device__ __forceinline__ unsigned cvt_pk_bf16(float lo, float hi) { unsigned r; asm volatile("v_cvt_pk_bf16_f32 %0, %1, %2" : "=v"(r) : "v"(lo), "v"(hi)); return r; }
typedef float f32x2 __attribute__((ext_vector_type(2)));
typedef unsigned u32x2 __attribute__((ext_vector_type(2)));
__device__ __forceinline__ float sigm(float x) { return 1.0f / (1.0f + __expf(-x)); }
__device__ __forceinline__ f32x4 silu4(f32x4 v) { f32x4 o; o[0] = v[0] * sigm(v[0]); o[1] = v[1] * sigm(v[1]); o[2] = v[2] * sigm(v[2]); o[3] = v[3] * sigm(v[3]); return o; }
__device__ __forceinline__ f32x4 sigm4(f32x4 v) { f32x4 o; o[0] = sigm(v[0]); o[1] = sigm(v[1]); o[2] = sigm(v[2]); o[3] = sigm(v[3]); return o; }
__device__ __forceinline__ u32x4 pack8(f32x4 v0, f32x4 v1) { u32x4 w; w.x = cvt_pk_bf16(v0[0], v0[1]); w.y = cvt_pk_bf16(v0[2], v0[3]); w.z = cvt_pk_bf16(v1[0], v1[1]); w.w = cvt_pk_bf16(v1[2], v1[3]); return w; }
__device__ __forceinline__ u32x2 pack4(f32x4 v) { u32x2 w; w.x = cvt_pk_bf16(v[0], v[1]); w.y = cvt_pk_bf16(v[2], v[3]); return w; }
__device__ __forceinline__ f32x4 unpack4(u32x2 w) { f32x4 o; o[0] = __uint_as_float(w.x << 16); o[1] = __uint_as_float(w.x & 0xffff0000u); o[2] = __uint_as_float(w.y << 16); o[3] = __uint_as_float(w.y & 0xffff0000u); return o; }

struct EpiInProj {
    static constexpr bool PERM = true, AFTER_DRAIN = false;
    unsigned char* ws;
    __device__ __forceinline__ void operator()(const f32x4 (&acc)[2][2][4][2], const Unit& u, int wr, int wc, int fr, int fq) const {
        const int pn = u.pn, row0 = u.pm * BM + wr * 64 + fr;
        if (pn >= 28 && pn < 32) {
            float* Z = (float*)(ws + WS_LOGF); const int cs = (pn - 28) * 256 + wc * 32 + 8 * fq;
#pragma unroll
            for (int ai = 0; ai < 2; ++ai)
#pragma unroll
                for (int m = 0; m < 4; ++m) { const int r = row0 + ai * HALF + m * 16;
#pragma unroll
                    for (int bj = 0; bj < 2; ++bj)
#pragma unroll
                        for (int n = 0; n < 2; ++n) *(f32x4*)(Z + (size_t)r * 1024 + cs + bj * HALF + 4 * n) = acc[ai][bj][m][n]; }
        } else {
            size_t od; int pitch, p0, act; float sc = 1.0f;
            if (pn < 4) { od = WS_Q; pitch = 1024; p0 = 0; act = 0; } else if (pn < 8) { od = WS_K; pitch = 1024; p0 = 4; act = 0; sc = 0.08838834764831845f; }
            else if (pn < 16) { od = WS_V; pitch = 2048; p0 = 8; act = 0; } else if (pn < 24) { od = WS_RG; pitch = 2048; p0 = 16; act = 1; } else if (pn < 28) { od = WS_HQ; pitch = 1024; p0 = 24; act = 1; }
            else if (pn < 36) { od = WS_HI; pitch = 1024; p0 = 32; act = 0; } else if (pn < 40) { od = WS_HG; pitch = 1024; p0 = 36; act = 1; } else if (pn < 48) { od = WS_GA; pitch = 2048; p0 = 40; act = 2; } else { od = WS_GB; pitch = 2048; p0 = 48; act = 2; }
            bf16_t* dst = (bf16_t*)(ws + od);
            const int cs = (pn - p0) * 256 + wc * 32 + 8 * fq;
#pragma unroll
            for (int ai = 0; ai < 2; ++ai)
#pragma unroll
                for (int m = 0; m < 4; ++m) { const int r = row0 + ai * HALF + m * 16; bf16_t* rowp = dst + (size_t)r * pitch + cs;
#pragma unroll
                    for (int bj = 0; bj < 2; ++bj) { f32x4 v0 = acc[ai][bj][m][0] * sc, v1 = acc[ai][bj][m][1] * sc;
                        if (act == 1) { v0 = silu4(v0); v1 = silu4(v1); } else if (act == 2) { v0 = sigm4(v0); v1 = sigm4(v1); }
                        *(u32x4*)(rowp + bj * HALF) = pack8(v0, v1); } }
        }
    }
};
template <int SECOND> struct EpiGate {
    static constexpr bool PERM = true, AFTER_DRAIN = false;
    const bf16_t* G; float* YT; bf16_t* MG;
    __device__ __forceinline__ void operator()(const f32x4 (&acc)[2][2][4][2], const Unit& u, int wr, int wc, int fr, int fq) const {
        const int row0 = u.pm * BM + wr * 64 + fr, col0 = u.pn * BM + wc * 32 + 8 * fq;
#pragma unroll
        for (int ai = 0; ai < 2; ++ai)
#pragma unroll
            for (int m = 0; m < 4; ++m) { const size_t off = (size_t)(row0 + ai * HALF + m * 16) * 2048 + col0;
#pragma unroll
                for (int bj = 0; bj < 2; ++bj) { const u32x4 gw = *(const u32x4*)(G + off + bj * HALF);
                    f32x4 v0 = acc[ai][bj][m][0] * unpack4((u32x2){gw.x, gw.y}), v1 = acc[ai][bj][m][1] * unpack4((u32x2){gw.z, gw.w});
                    float* yp = YT + off + bj * HALF;
                    if (SECOND) { v0 += *(const f32x4*)yp; v1 += *(const f32x4*)(yp + 4); *(u32x4*)(MG + off + bj * HALF) = pack8(v0, v1); }
                    else { *(f32x4*)yp = v0; *(f32x4*)(yp + 4) = v1; } } }
        __builtin_amdgcn_s_waitcnt(0x0F70);
    }
};
struct EpiResid {
    static constexpr bool PERM = true, AFTER_DRAIN = false;
    const float* XP; const float* XS; float* OUT; bf16_t* XB; float* SS;
    __device__ __forceinline__ void operator()(const f32x4 (&acc)[2][2][4][2], const Unit& u, int wr, int wc, int fr, int fq) const {
        const int row0 = u.pm * BM + wr * 64 + fr, col0 = u.pn * BM + wc * 32 + 8 * fq;
#pragma unroll
        for (int ai = 0; ai < 2; ++ai)
#pragma unroll
            for (int m = 0; m < 4; ++m) { const int r = row0 + ai * HALF + m * 16; const bool live = r < 8320;
                const float* xi = (r < 8192 ? XP + (size_t)r * 2048 : XS + (size_t)(r - 8192) * 2048) + col0; float ss = 0.f;
#pragma unroll
                for (int bj = 0; bj < 2; ++bj) { f32x4 v0 = acc[ai][bj][m][0], v1 = acc[ai][bj][m][1];
                    if (live) { v0 += *(const f32x4*)(xi + bj * HALF); v1 += *(const f32x4*)(xi + bj * HALF + 4);
                        float* op = OUT + (size_t)r * 2048 + col0 + bj * HALF; *(f32x4*)op = v0; *(f32x4*)(op + 4) = v1; }
                    if (XB) *(u32x4*)(XB + (size_t)r * 2048 + col0 + bj * HALF) = pack8(v0, v1);
                    ss += (v0[0] * v0[0] + v0[1] * v0[1]) + (v0[2] * v0[2] + v0[3] * v0[3]) + (v1[0] * v1[0] + v1[1] * v1[1]) + (v1[2] * v1[2] + v1[3] * v1[3]); }
                ss += __shfl_xor(ss, 16); ss += __shfl_xor(ss, 32);
                if (fq == 0) atomicAdd(SS + r, ss); }
        __builtin_amdgcn_s_waitcnt(0x0F70);
    }
};
struct EpiSwiglu {
    static constexpr bool PERM = true, AFTER_DRAIN = false;
    const float* SS; bf16_t* ACT;
    __device__ __forceinline__ void operator()(const f32x4 (&acc)[2][2][4][2], const Unit& u, int wr, int wc, int fr, int fq) const {
        const int row0 = u.pm * BM + wr * 64 + fr, col0 = u.pn * HALF + wc * 32 + 8 * fq;
        float ssv[2][4];
#pragma unroll
        for (int ai = 0; ai < 2; ++ai)
#pragma unroll
            for (int m = 0; m < 4; ++m) ssv[ai][m] = SS[row0 + ai * HALF + m * 16];
        __builtin_amdgcn_s_waitcnt(0x0F70);
#pragma unroll
        for (int ai = 0; ai < 2; ++ai)
#pragma unroll
            for (int m = 0; m < 4; ++m) { const int r = row0 + ai * HALF + m * 16; const float r2 = 1.0f / sqrtf(ssv[ai][m] * (1.0f / 2048.0f) + 1e-6f);
                const f32x4 g0 = acc[ai][0][m][0] * r2, g1 = acc[ai][0][m][1] * r2, u0 = acc[ai][1][m][0] * r2, u1 = acc[ai][1][m][1] * r2;
                *(u32x4*)(ACT + (size_t)r * 5632 + col0) = pack8(silu4(g0) * u0, silu4(g1) * u1); }
    }
};
template <class Epi, class Sched, bool ALIGN_EPI = false, bool SP2 = false>
__device__ __forceinline__ void gemm_phase(PG8_LAS unsigned char* lds, const Gemm g, const Sched& S, const Epi& E) {
    const int tid = threadIdx.x, wid = __builtin_amdgcn_readfirstlane(tid >> 6), lane = tid & 63, wr = wid >> 2, wc = wid & 3, fr = lane & 15, fq = lane >> 4;
    const int K = g.K, nt = K / BK;
    unsigned voffA[2], voffB[2];
#pragma unroll
    for (int i = 0; i < 2; ++i) { int R, C; stage_rc(tid * 16 + i * 8192, R, C); const int Rb = Epi::PERM ? ((R & ~31) + perm32(R & 31)) : R;
        voffA[i] = (unsigned)(R * K + C) * 2u; voffB[i] = (unsigned)(Rb * K + C) * 2u; }
    const size_t kstep = (size_t)(BK * 2);
    const size_t hstep = (size_t)HALF * K * 2;
    const size_t tstep = 2 * hstep;
    const unsigned ldsw = (unsigned)wid * 1024u;
    const int aoff = lds_byte(wr * 64 + fr, fq * 8), boff = lds_byte(wc * 32 + fr, fq * 8);
#define PG8_SA(b, h) (((b) * 2 + (h)) * HTB)
#define PG8_SB(b, h) ((4 + (b) * 2 + (h)) * HTB)
#define PG8_STAGE(bufoff, gbase, voff) do { _Pragma("unroll") for (int _i = 0; _i < 2; ++_i) \
        __builtin_amdgcn_global_load_lds((const unsigned*)((const char*)(gbase) + (voff)[_i]), (PG8_LAS unsigned*)(lds + (bufoff) + ldsw + _i * 8192), 16, 0, 0); } while (0)
#define PG8_LDA(dst, b, h) do { _Pragma("unroll") for (int m = 0; m < 4; ++m) _Pragma("unroll") for (int k = 0; k < 2; ++k) dst[m][k] = *(const PG8_LAS bf16x8*)(lds + PG8_SA(b, h) + aoff + m * 2048 + k * 1024); } while (0)
#define PG8_LDB(dst, b, h) do { _Pragma("unroll") for (int n = 0; n < 2; ++n) _Pragma("unroll") for (int k = 0; k < 2; ++k) dst[n][k] = *(const PG8_LAS bf16x8*)(lds + PG8_SB(b, h) + boff + n * 2048 + k * 1024); } while (0)
#define PG8_MMA(ai, bj, At, Bt) do { __builtin_amdgcn_s_setprio(1); _Pragma("unroll") for (int m = 0; m < 4; ++m) _Pragma("unroll") for (int n = 0; n < 2; ++n) _Pragma("unroll") for (int k = 0; k < 2; ++k) \
        acc[ai][bj][m][n] = __builtin_amdgcn_mfma_f32_16x16x32_bf16(Bt[n][k], At[m][k], acc[ai][bj][m][n], 0, 0, 0); __builtin_amdgcn_s_setprio(0); } while (0)
#define PG8_WAIT_V(n) asm volatile("s_waitcnt vmcnt(" #n ")" ::: "memory")
#define PG8_WAIT_L(n) asm volatile("s_waitcnt lgkmcnt(" #n ")" ::: "memory")
#define PG8_BAR __builtin_amdgcn_s_barrier()
#define PG8_SCHED __builtin_amdgcn_sched_barrier(0)
    Unit cur, nxt; int ui = 0;
    if (!S.next(0, cur)) return;
    f32x4 acc[2][2][4][2];
#pragma unroll
    for (int a = 0; a < 2; ++a)
#pragma unroll
        for (int b = 0; b < 2; ++b)
#pragma unroll
            for (int m = 0; m < 4; ++m)
#pragma unroll
                for (int n = 0; n < 2; ++n) acc[a][b][m][n] = (f32x4){0.f, 0.f, 0.f, 0.f};
    bf16x8 At[4][2], B0[2][2], B1[2][2];
    const char* cA = (const char*)g.A + (size_t)cur.pm * tstep; const char* cB = (const char*)g.Bt + (size_t)cur.pn * tstep;
    S.a_ready(cur);
    if constexpr (SP2) {
        PG8_STAGE(PG8_SB(0, 0), cB, voffB); PG8_STAGE(PG8_SB(0, 1), cB + hstep, voffB); PG8_STAGE(PG8_SA(0, 0), cA, voffA); PG8_STAGE(PG8_SA(0, 1), cA + hstep, voffA);
        if (wr == 1) PG8_BAR;
        PG8_WAIT_V(2); PG8_BAR;
        PG8_STAGE(PG8_SB(1, 0), cB + kstep, voffB); PG8_STAGE(PG8_SA(1, 0), cA + kstep, voffA); PG8_STAGE(PG8_SB(1, 1), cB + hstep + kstep, voffB);
        PG8_WAIT_V(6); PG8_BAR;
    } else {
        PG8_STAGE(PG8_SB(0, 0), cB, voffB); PG8_STAGE(PG8_SA(0, 0), cA, voffA); PG8_STAGE(PG8_SB(0, 1), cB + hstep, voffB); PG8_STAGE(PG8_SA(0, 1), cA + hstep, voffA);
        if (wr == 1) PG8_BAR;
        PG8_WAIT_V(4); PG8_BAR;
        PG8_STAGE(PG8_SB(1, 0), cB + kstep, voffB); PG8_STAGE(PG8_SA(1, 0), cA + kstep, voffA); PG8_STAGE(PG8_SB(1, 1), cB + hstep + kstep, voffB);
        PG8_WAIT_V(6); PG8_BAR;
    }
    for (;;) {
        const bool has_next = S.next(ui + 1, nxt);
        const char* nA = has_next ? (const char*)g.A + (size_t)nxt.pm * tstep : cA; const char* nB = has_next ? (const char*)g.Bt + (size_t)nxt.pn * tstep : cB;
        for (int t = 0; t < nt; t += 2) {
            const bool last = (t == nt - 2);
            const char* a1 = cA + (size_t)(t + 1) * kstep;
            const char* a2 = last ? nA : cA + (size_t)(t + 2) * kstep; const char* b2 = last ? nB : cB + (size_t)(t + 2) * kstep;
            const char* a3 = a2 + kstep; const char* b3 = b2 + kstep;
            if (last && has_next) S.a_ready(nxt);
            if constexpr (SP2) {
            PG8_LDB(B0, 0, 0); PG8_LDB(B1, 0, 1); PG8_SCHED; PG8_LDA(At, 0, 0); PG8_STAGE(PG8_SA(1, 1), a1 + hstep, voffA);
            PG8_WAIT_V(8); PG8_WAIT_L(0); PG8_BAR; PG8_MMA(0, 0, At, B0); PG8_MMA(0, 1, At, B1); PG8_BAR; PG8_SCHED;
            PG8_LDA(At, 0, 1); PG8_STAGE(PG8_SB(0, 0), b2, voffB); PG8_STAGE(PG8_SB(0, 1), b2 + hstep, voffB); PG8_STAGE(PG8_SA(0, 0), a2, voffA);
            PG8_WAIT_V(8); PG8_WAIT_L(0); PG8_BAR; PG8_MMA(1, 0, At, B0); PG8_MMA(1, 1, At, B1); PG8_BAR; PG8_SCHED;
            PG8_LDB(B0, 1, 0); PG8_LDB(B1, 1, 1); PG8_SCHED; PG8_LDA(At, 1, 0); PG8_STAGE(PG8_SA(0, 1), a2 + hstep, voffA);
            PG8_WAIT_V(8); PG8_WAIT_L(0); PG8_BAR; PG8_MMA(0, 0, At, B0); PG8_MMA(0, 1, At, B1); PG8_BAR; PG8_SCHED;
            PG8_LDA(At, 1, 1); PG8_STAGE(PG8_SB(1, 0), b3, voffB); PG8_STAGE(PG8_SB(1, 1), b3 + hstep, voffB); PG8_STAGE(PG8_SA(1, 0), a3, voffA);
            PG8_WAIT_V(8); PG8_WAIT_L(0); PG8_BAR; PG8_MMA(1, 0, At, B0); PG8_MMA(1, 1, At, B1); PG8_BAR; PG8_SCHED;
            } else {
            PG8_LDB(B0, 0, 0); PG8_SCHED; PG8_LDA(At, 0, 0); PG8_STAGE(PG8_SA(1, 1), a1 + hstep, voffA);
            PG8_WAIT_L(8); PG8_BAR; PG8_WAIT_L(0); PG8_MMA(0, 0, At, B0); PG8_BAR; PG8_SCHED;
            PG8_LDB(B1, 0, 1); PG8_STAGE(PG8_SB(0, 0), b2, voffB);
            PG8_BAR; PG8_WAIT_L(0); PG8_MMA(0, 1, At, B1); PG8_BAR;
            PG8_LDA(At, 0, 1); PG8_STAGE(PG8_SA(0, 0), a2, voffA);
            PG8_BAR; PG8_WAIT_L(0); PG8_MMA(1, 0, At, B0); PG8_BAR; PG8_SCHED;
            PG8_STAGE(PG8_SB(0, 1), b2 + hstep, voffB);
            PG8_WAIT_V(6); PG8_BAR; PG8_MMA(1, 1, At, B1); PG8_BAR;
            PG8_LDB(B0, 1, 0); PG8_SCHED; PG8_LDA(At, 1, 0); PG8_STAGE(PG8_SA(0, 1), a2 + hstep, voffA);
            PG8_WAIT_L(8); PG8_BAR; PG8_WAIT_L(0); PG8_MMA(0, 0, At, B0); PG8_BAR; PG8_SCHED;
            PG8_LDB(B1, 1, 1); PG8_STAGE(PG8_SB(1, 0), b3, voffB);
            PG8_BAR; PG8_WAIT_L(0); PG8_MMA(0, 1, At, B1); PG8_BAR;
            PG8_LDA(At, 1, 1); PG8_STAGE(PG8_SA(1, 0), a3, voffA);
            PG8_BAR; PG8_WAIT_L(0); PG8_MMA(1, 0, At, B0); PG8_BAR; PG8_SCHED;
            PG8_STAGE(PG8_SB(1, 1), b3 + hstep, voffB);
            PG8_WAIT_V(6); PG8_BAR; PG8_MMA(1, 1, At, B1); PG8_BAR;
            }
        }
        if constexpr (ALIGN_EPI) { if (wr == 0) PG8_BAR; }
        if constexpr (!Epi::AFTER_DRAIN) { E(acc, cur, wr, wc, fr, fq); S.done(cur); }
        if (!has_next) break;
#pragma unroll
        for (int a = 0; a < 2; ++a)
#pragma unroll
            for (int b = 0; b < 2; ++b)
#pragma unroll
                for (int m = 0; m < 4; ++m)
#pragma unroll
                    for (int n = 0; n < 2; ++n) acc[a][b][m][n] = (f32x4){0.f, 0.f, 0.f, 0.f};
        cur = nxt; cA = nA; cB = nB; ++ui;
        if constexpr (ALIGN_EPI) { if (wr == 1) PG8_BAR; }
    }
    PG8_WAIT_V(0);
    if constexpr (!ALIGN_EPI) { if (wr == 0) PG8_BAR; }
    PG8_BAR;
    if constexpr (Epi::AFTER_DRAIN) { E.fused(acc, cur, wr, wc, fr, fq, lds, wid, lane); S.done(cur); }
#undef PG8_SA
#undef PG8_SB
#undef PG8_STAGE
#undef PG8_LDA
#undef PG8_LDB
#undef PG8_MMA
#undef PG8_WAIT_V
#undef PG8_WAIT_L
#undef PG8_BAR
#undef PG8_SCHED
}
}
#define XB_TMO      128
#define XB_XCNT(j)  (256  + 64 * (j))
#define XB_XSUB(j)  (1280 + 64 * (j))
#define XB_XGEN(j)  (2304 + 64 * (j))
#define XB_TOP      3328
#define XB_TOPGEN   3392
#define XCD_BAR_WORDS 3456
#define XB_SPIN_CAP (1u << 18)

__device__ __forceinline__ unsigned xb_ld(unsigned* p)              { return __hip_atomic_load(p, __ATOMIC_RELAXED, __HIP_MEMORY_SCOPE_AGENT); }
__device__ __forceinline__ unsigned xb_add(unsigned* p, unsigned v) { return __hip_atomic_fetch_add(p, v, __ATOMIC_RELAXED, __HIP_MEMORY_SCOPE_AGENT); }
__device__ __forceinline__ unsigned xb_xcc_id() { return (unsigned)__builtin_amdgcn_s_getreg((3 << 11) | 20) & 0xFu; }
#define XB_SPIN(cond, bar) do { unsigned _sp = 0; while (cond) { __builtin_amdgcn_s_sleep(1); \
    if ((++_sp & 255u) == 0u) { if (xb_ld(&(bar)[XB_TMO])) break; if (_sp > XB_SPIN_CAP) { atomicAdd(&(bar)[XB_TMO], 1u); break; } } } } while (0)

struct XcdBarrier {
    unsigned* bar; unsigned x;
    volatile LAS unsigned* st;
};

__device__ __forceinline__ XcdBarrier xcd_barrier_post(unsigned* bar, volatile LAS unsigned* st) {
    XcdBarrier b; b.bar = bar; b.x = xb_xcc_id(); b.st = st;
    if (threadIdx.x == 0) (void)xb_add(&bar[XB_XCNT(b.x)], 1u);
    return b;
}
__device__ __forceinline__ void xcd_barrier_complete(unsigned* bar, unsigned x, unsigned& nloc, unsigned& nx) {
    const unsigned G = gridDim.x * gridDim.y * gridDim.z;
    unsigned sum, cnt, mine, sp = 0u;
    for (;;) {
        sum = 0u; cnt = 0u; mine = 0u;
#pragma unroll
        for (unsigned j = 0; j < 16; ++j) { const unsigned c = xb_ld(&bar[XB_XCNT(j)]); sum += c; cnt += (c > 0u) ? 1u : 0u; mine = (j == x) ? c : mine; }
        if (sum == G) break;
        __builtin_amdgcn_s_sleep(1);
        if ((++sp & 255u) == 0u) { if (xb_ld(&bar[XB_TMO])) break; if (sp > XB_SPIN_CAP) { atomicAdd(&bar[XB_TMO], 1u); break; } }
    }
    nloc = mine > 0u ? mine : 1u; nx = cnt > 0u ? cnt : 1u;
}

__device__ __forceinline__ void xcd_barrier(const XcdBarrier& b) {
    asm volatile("s_waitcnt vmcnt(0)" ::: "memory");
    __syncthreads();
    if (threadIdx.x == 0) {
        unsigned* bar = b.bar;
        __builtin_amdgcn_s_waitcnt(0);
        unsigned nloc = b.st[0], nx = b.st[1];
        if (nloc == 0u) { xcd_barrier_complete(bar, b.x, nloc, nx); b.st[0] = nloc; b.st[1] = nx; }
        const unsigned old = xb_add(&bar[XB_XSUB(b.x)], 1u);
        const unsigned gen = old / nloc;
        if (old + 1u == (gen + 1u) * nloc) {
            __builtin_amdgcn_fence(__ATOMIC_RELEASE, "agent");
            asm volatile("s_waitcnt vmcnt(0)" ::: "memory");
            const unsigned og = xb_add(&bar[XB_TOP], 1u);
            const unsigned tg = og / nx;
            if (og + 1u == (tg + 1u) * nx) xb_add(&bar[XB_TOPGEN], 1u);
            else XB_SPIN(xb_ld(&bar[XB_TOPGEN]) == tg, bar);
            __builtin_amdgcn_fence(__ATOMIC_ACQUIRE, "agent");
            xb_add(&bar[XB_XGEN(b.x)], 1u);
            asm volatile("s_waitcnt vmcnt(0)" ::: "memory");
        } else {
            XB_SPIN(xb_ld(&bar[XB_XGEN(b.x)]) == gen, bar);
            __builtin_amdgcn_fence(__ATOMIC_ACQUIRE, "agent");
            asm volatile("s_waitcnt vmcnt(0)" ::: "memory");
        }
    }
    __syncthreads();
}
struct Frame {
    LAS unsigned char* lds; volatile LAS unsigned* MISC; gu32* ctl;
    int tid, lane, wave, vcu, G;
    float* out; unsigned char* ws;
};
__device__ __forceinline__ float wave_sum(float v) {
#pragma unroll
    for (int o = 1; o < 64; o <<= 1) v += __shfl_xor(v, o);
    return v;
}
template <int MODE> __device__ __forceinline__ int rowmap(int n) {
    if (MODE == 1) { if (n >= 2048) return n; const int j = n & 127, hb = n & ~127; return hb + (j < 64 ? 8 * (j >> 2) + (j & 3) : 8 * ((j - 64) >> 2) + 4 + (j & 3)); }
    if (MODE == 2) { return n < DFF ? (n >> 7) * 256 + (n & 127) : ((n - DFF) >> 7) * 256 + 128 + ((n - DFF) & 127); }
    return n;
}
template <int MODE> __device__ __forceinline__ void p0_transpose_item(const float* W, int K, int N, bf16* WT, const float* g, LAS float* scr, int item, int lane) {
    const int nblk = N / 32, kb = item / nblk, nb = item % nblk, k0 = 64 * kb, n0 = 32 * nb;
#pragma unroll 8
    for (int i = 0; i < 32; ++i) { const int kk = 2 * i + (lane >> 5); float w = W[(size_t)(k0 + kk) * N + n0 + (lane & 31)]; if (g) w *= g[k0 + kk]; scr[kk * 33 + (lane & 31)] = w; }
    LDS_WAIT(); asm volatile("" ::: "memory");
    const int c = lane & 7;
#pragma unroll
    for (int j = 0; j < 4; ++j) { const int n = (lane >> 3) + 8 * j; const LAS float* s = scr + (8 * c) * 33 + n;
        v4u o; o.x = pk2(s[0 * 33], s[1 * 33]); o.y = pk2(s[2 * 33], s[3 * 33]); o.z = pk2(s[4 * 33], s[5 * 33]); o.w = pk2(s[6 * 33], s[7 * 33]);
        *(GAS v4u*)(WT + (size_t)rowmap<MODE>(n0 + n) * K + k0 + 8 * c) = o; }
    LDS_WAIT(); asm volatile("" ::: "memory");
}
struct Args { const float* in[15]; float* out; unsigned char* ws; int ph_lo, ph_hi, use_bar, pad; };
__device__ __forceinline__ void p0_prologue(Frame& F, const Args& A) {
    LAS float* scr = (LAS float*)(F.lds + F.wave * 16384);
    const int gw = F.vcu * NWAVES + F.wave, NGW = F.G * NWAVES;
    unsigned char* ws = F.ws;
    constexpr int I_IN = 32 * (NIN / 32), I_RO = 32 * 64, I_HO = 16 * 64, I_OUT = 32 * 64, I_FI = 32 * (2 * DFF / 32), I_FO = (DFF / 64) * 64;
    constexpr int NITEMS = I_IN + I_RO + I_HO + I_OUT + I_FI + I_FO;
    for (int it = gw; it < NITEMS; it += NGW) {
        int r = it;
        if (r < I_IN) { p0_transpose_item<0>(A.in[4], 2048, NIN, (bf16*)(ws + WS_WIN), A.in[8], scr, r, F.lane); continue; } r -= I_IN;
        if (r < I_RO) { p0_transpose_item<0>(A.in[5], 2048, 2048, (bf16*)(ws + WS_WRO), nullptr, scr, r, F.lane); continue; } r -= I_RO;
        if (r < I_HO) { p0_transpose_item<0>(A.in[6], 1024, 2048, (bf16*)(ws + WS_WHO), nullptr, scr, r, F.lane); continue; } r -= I_HO;
        if (r < I_OUT) { p0_transpose_item<0>(A.in[7], 2048, 2048, (bf16*)(ws + WS_WOUT), nullptr, scr, r, F.lane); continue; } r -= I_OUT;
        if (r < I_FI) { p0_transpose_item<2>(A.in[12], 2048, 2 * DFF, (bf16*)(ws + WS_WFI), A.in[9], scr, r, F.lane); continue; } r -= I_FI;
        p0_transpose_item<0>(A.in[13], DFF, 2048, (bf16*)(ws + WS_WFO), nullptr, scr, r, F.lane);
    }
    bf16* XB = (bf16*)(ws + WS_XB);
    for (int m = gw; m < MPAD; m += NGW) {
        GAS unsigned long long* o8 = (GAS unsigned long long*)(XB + (size_t)m * 2048) + F.lane;
        if (m < MROWS) {
            const float* xrow = m < 8192 ? A.in[0] + (size_t)m * 2048 : A.in[1] + (size_t)(m - 8192) * 2048;
            const GAS f32x4* xr = (const GAS f32x4*)xrow + F.lane;
            f32x4 v[8]; float s = 0.f;
#pragma unroll
            for (int j = 0; j < 8; ++j) { v[j] = xr[64 * j]; s += (v[j].x * v[j].x + v[j].y * v[j].y) + (v[j].z * v[j].z + v[j].w * v[j].w); }
            const float rr = 1.0f / sqrtf(wave_sum(s) * (1.0f / 2048.0f) + EPS);
#pragma unroll
            for (int j = 0; j < 8; ++j) o8[64 * j] = (unsigned long long)pk2(v[j].x * rr, v[j].y * rr) | ((unsigned long long)pk2(v[j].z * rr, v[j].w * rr) << 32);
        } else {
#pragma unroll
            for (int j = 0; j < 8; ++j) o8[64 * j] = 0ull;
        }
    }
    { float* COS = (float*)(ws + WS_COS); float* SIN = (float*)(ws + WS_SIN);
      for (int i = (F.vcu * NWAVES + F.wave) * 64 + F.lane; i < 2049 * 64; i += F.G * NWAVES * 64) { const int p = i >> 6, j = i & 63; const int pos = p < 2048 ? p : 16384;
          const float inv = powf(10000.0f, -(float)j / 64.0f); const float ang = (float)pos * inv; float sn, cs; sincosf(ang, &sn, &cs); COS[i] = cs; SIN[i] = sn; } }
    { float* LB = (float*)(ws + WS_LB); const int i = (F.vcu * NWAVES + F.wave) * 64 + F.lane; if (i < 1024) { const float l0 = A.in[11][i], l1 = A.in[11][1024 + i]; LB[i] = 1.0f / (1.0f + expf(l1 - l0)); } }
}
typedef short bf16x4v __attribute__((ext_vector_type(4)));
#define MFMA16(a, b, c) __builtin_amdgcn_mfma_f32_16x16x32_bf16((a), (b), (c), 0, 0, 0)
constexpr int TP = 136;
constexpr size_t OUT_YS = 8192ull * 2048, OUT_SRP = 8320ull * 2048, OUT_SHP = OUT_SRP + 4ull * 8 * 128 * 256, OUT_SRS = OUT_SHP + 4ull * 8 * 128 * 128, OUT_SHS = OUT_SRS + 128ull * 8 * 128 * 256;
__device__ __forceinline__ float lg2gamma(int h) { return log2f(1.0f - exp2f(-5.0f - (float)h)); }
__device__ __forceinline__ float bfe(const v4u& w, int j) { const unsigned x = w[j >> 1]; return __uint_as_float((j & 1) ? (x & 0xffff0000u) : (x << 16)); }
__device__ __forceinline__ bf16x8 pack_f8(const float* v) { v4u w; w.x = pk2(v[0], v[1]); w.y = pk2(v[2], v[3]); w.z = pk2(v[4], v[5]); w.w = pk2(v[6], v[7]); return __builtin_bit_cast(bf16x8, w); }

__device__ __forceinline__ void p2_ret_item(Frame& F, int item) {
    unsigned char* ws = F.ws;
    const int c = item & 15, h = (item >> 4) & 7, b = item >> 7, r0 = b * 2048 + c * 128;
    const int w = F.wave, l15 = F.lane & 15, g = F.lane >> 4;
    LAS bf16* KT = (LAS bf16*)F.lds; LAS bf16* VT = KT + 128 * TP;
    const bf16* Kg = (const bf16*)(ws + WS_K); const bf16* Vg = (const bf16*)(ws + WS_V);
    const float* COS = (const float*)(ws + WS_COS); const float* SIN = (const float*)(ws + WS_SIN);
    const float lg = lg2gamma(h);
    __syncthreads();
#pragma unroll
    for (int i = 0; i < 2; ++i) { const int u = F.tid + 512 * i, m = u & 127, d0 = (u >> 7) * 8;
        const bf16* kp = Kg + (size_t)(r0 + m) * 1024 + h * 128 + d0; const v4u a = *(const v4u*)kp, bb = *(const v4u*)(kp + 64);
        const int pos = c * 128 + m; const f32x4 c0 = *(const f32x4*)(COS + pos * 64 + d0), c1 = *(const f32x4*)(COS + pos * 64 + d0 + 4), s0 = *(const f32x4*)(SIN + pos * 64 + d0), s1 = *(const f32x4*)(SIN + pos * 64 + d0 + 4);
        const float dec = exp2f((float)(127 - m) * lg);
#pragma unroll
        for (int j = 0; j < 8; ++j) { const float x1 = bfe(a, j), x2 = bfe(bb, j), cj = j < 4 ? c0[j & 3] : c1[j & 3], sj = j < 4 ? s0[j & 3] : s1[j & 3];
            KT[(d0 + j) * TP + m] = (bf16)f2bf((x1 * cj - x2 * sj) * dec); KT[(64 + d0 + j) * TP + m] = (bf16)f2bf((x2 * cj + x1 * sj) * dec); } }
#pragma unroll
    for (int i = 0; i < 8; ++i) { const int u = F.tid + 512 * i, m = u & 127, e0 = (u >> 7) * 8;
        const v4u a = *(const v4u*)(Vg + (size_t)(r0 + m) * 2048 + h * 256 + e0);
#pragma unroll
        for (int j = 0; j < 8; ++j) VT[(e0 + j) * TP + m] = (bf16)((a[j >> 1] >> (16 * (j & 1))) & 0xffffu); }
    __syncthreads();
    f32x4 acc[8][2];
#pragma unroll
    for (int dt = 0; dt < 8; ++dt) { acc[dt][0] = (f32x4){0.f, 0.f, 0.f, 0.f}; acc[dt][1] = (f32x4){0.f, 0.f, 0.f, 0.f}; }
#pragma unroll
    for (int ks = 0; ks < 4; ++ks) {
        const bf16x8 b0 = *(const LAS bf16x8*)&VT[(32 * w + l15) * TP + 32 * ks + 8 * g], b1 = *(const LAS bf16x8*)&VT[(32 * w + 16 + l15) * TP + 32 * ks + 8 * g];
#pragma unroll
        for (int dt = 0; dt < 8; ++dt) { const bf16x8 af = *(const LAS bf16x8*)&KT[(16 * dt + l15) * TP + 32 * ks + 8 * g];
            acc[dt][0] = MFMA16(af, b0, acc[dt][0]); acc[dt][1] = MFMA16(af, b1, acc[dt][1]); } }
    float* out = (float*)(ws + WS_KVLOC) + (size_t)item * 256 * 128;
#pragma unroll
    for (int dt = 0; dt < 8; ++dt)
#pragma unroll
        for (int et = 0; et < 2; ++et) *(f32x4*)(out + (32 * w + 16 * et + l15) * 128 + 16 * dt + 4 * g) = acc[dt][et];
}
__device__ __forceinline__ void p2_hg_item(Frame& F, int item) {
    unsigned char* ws = F.ws;
    const int sc = item & 15, h = (item >> 4) & 7, b = item >> 7, r0 = b * 2048 + sc * 128;
    const int w = F.wave, l15 = F.lane & 15, g = F.lane >> 4;
    LAS bf16* KT = (LAS bf16*)F.lds; LAS bf16* VT = KT + 128 * TP; LAS float* LQ = (LAS float*)(VT + 128 * TP);
    const float* Z = (const float*)(ws + WS_LOGF); const bf16* HI = (const bf16*)(ws + WS_HI); const float* LB = (const float*)(ws + WS_LB);
    __syncthreads();
    const int d = F.tid & 127, q = F.tid >> 7; const float oml = 1.0f - LB[h * 128 + d];
    float lf[32], kin[32]; float L = 0.f;
#pragma unroll
    for (int i = 0; i < 32; ++i) { const float z = Z[(size_t)(r0 + 32 * q + i) * 1024 + h * 128 + d]; kin[i] = oml / (1.0f + __expf(z)); lf[i] = log1pf(-kin[i]); L += lf[i]; }
    LQ[q * 128 + d] = L;
#pragma unroll
    for (int i = 0; i < 4; ++i) { const int u = F.tid + 512 * i, m = u & 127, e0 = (u >> 7) * 8;
        const v4u a = *(const v4u*)(HI + (size_t)(r0 + m) * 1024 + h * 128 + e0);
#pragma unroll
        for (int j = 0; j < 8; ++j) VT[(e0 + j) * TP + m] = (bf16)((a[j >> 1] >> (16 * (j & 1))) & 0xffffu); }
    __syncthreads();
    float run = 0.f;
#pragma unroll
    for (int q2 = 1; q2 < 4; ++q2) if (q2 > q) run += LQ[q2 * 128 + d];
#pragma unroll
    for (int blk = 3; blk >= 0; --blk) { float v[8];
#pragma unroll
        for (int jj = 7; jj >= 0; --jj) { const int i = 8 * blk + jj; v[jj] = kin[i] * __expf(run); run += lf[i]; }
        *(LAS bf16x8*)&KT[d * TP + 32 * q + 8 * blk] = pack_f8(v); }
    if (q == 0) ((float*)(ws + WS_BTOT))[item * 128 + d] = run;
    __syncthreads();
    f32x4 acc[8];
#pragma unroll
    for (int dt = 0; dt < 8; ++dt) acc[dt] = (f32x4){0.f, 0.f, 0.f, 0.f};
#pragma unroll
    for (int ks = 0; ks < 4; ++ks) { const bf16x8 b0 = *(const LAS bf16x8*)&VT[(16 * w + l15) * TP + 32 * ks + 8 * g];
#pragma unroll
        for (int dt = 0; dt < 8; ++dt) { const bf16x8 af = *(const LAS bf16x8*)&KT[(16 * dt + l15) * TP + 32 * ks + 8 * g]; acc[dt] = MFMA16(af, b0, acc[dt]); } }
    float* out = (float*)(ws + WS_HSLOC) + (size_t)item * 128 * 128;
#pragma unroll
    for (int dt = 0; dt < 8; ++dt) *(f32x4*)(out + (16 * w + l15) * 128 + 16 * dt + 4 * g) = acc[dt];
}
__device__ __forceinline__ void p2_sret_item(Frame& F, const Args& A, int it) {
    unsigned char* ws = F.ws; const int h = it & 7, b = it >> 3, r = 8192 + b;
    LAS float* qs = (LAS float*)F.lds; LAS float* ks = qs + 128; LAS float* vs = ks + 128; LAS float* ored = vs + 256;
    const bf16* Q = (const bf16*)(ws + WS_Q); const bf16* K = (const bf16*)(ws + WS_K); const bf16* V = (const bf16*)(ws + WS_V);
    __syncthreads();
    if (F.tid < 64) { const int d = F.tid; const float cs = ((const float*)(ws + WS_COS))[2048 * 64 + d], sn = ((const float*)(ws + WS_SIN))[2048 * 64 + d];
        const float q1 = bf2f(Q[(size_t)r * 1024 + h * 128 + d]), q2 = bf2f(Q[(size_t)r * 1024 + h * 128 + 64 + d]), k1 = bf2f(K[(size_t)r * 1024 + h * 128 + d]), k2 = bf2f(K[(size_t)r * 1024 + h * 128 + 64 + d]);
        qs[d] = q1 * cs - q2 * sn; qs[d + 64] = q2 * cs + q1 * sn; ks[d] = k1 * cs - k2 * sn; ks[d + 64] = k2 * cs + k1 * sn; }
    else if (F.tid >= 256) { const int e = F.tid - 256; vs[e] = bf2f(V[(size_t)r * 2048 + h * 256 + e]); }
    __syncthreads();
    const float gam = 1.0f - exp2f(-5.0f - (float)h);
    const int e4 = F.tid & 63, dq = F.tid >> 6;
    const float* Sin = A.in[2] + ((size_t)(b * 8 + h) * 128) * 256; float* Sout = F.out + OUT_SRS + ((size_t)(b * 8 + h) * 128) * 256;
    const f32x4 v4 = *(const LAS f32x4*)&vs[4 * e4]; f32x4 o = (f32x4){0.f, 0.f, 0.f, 0.f};
    f32x4 s[16];
#pragma unroll
    for (int i = 0; i < 16; ++i) s[i] = *(const f32x4*)(Sin + (size_t)(16 * dq + i) * 256 + 4 * e4);
#pragma unroll
    for (int i = 0; i < 16; ++i) { const int d = 16 * dq + i; s[i] = s[i] * gam + v4 * ks[d]; *(f32x4*)(Sout + (size_t)d * 256 + 4 * e4) = s[i]; o += s[i] * qs[d]; }
    *(LAS f32x4*)&ored[dq * 256 + 4 * e4] = o;
    __syncthreads();
    if (F.wave == 0) { float oo[4]; float ss = 0.f;
#pragma unroll
        for (int k = 0; k < 4; ++k) { const int e = F.lane + 64 * k; float t = 0.f;
#pragma unroll
            for (int j = 0; j < 8; ++j) t += ored[j * 256 + e];
            oo[k] = t; ss += t * t; }
        const float rr = 1.0f / sqrtf(wave_sum(ss) * (1.0f / 256.0f) + EPS);
        const bf16* RG = (const bf16*)(ws + WS_RG); bf16* OR = (bf16*)(ws + WS_OR);
#pragma unroll
        for (int k = 0; k < 4; ++k) { const size_t ix = (size_t)r * 2048 + h * 256 + F.lane + 64 * k; OR[ix] = (bf16)f2bf(oo[k] * rr * bf2f(RG[ix])); } }
}
__device__ __forceinline__ void p2_shg_item(Frame& F, const Args& A, int it) {
    unsigned char* ws = F.ws; const int h = it & 7, b = it >> 3, r = 8192 + b;
    LAS float* qs = (LAS float*)F.lds; LAS float* fs = qs + 128; LAS float* kn = fs + 128; LAS float* vs = kn + 128; LAS float* ored = vs + 128;
    __syncthreads();
    if (F.tid < 128) { const int d = F.tid; const size_t ix = (size_t)r * 1024 + h * 128 + d; const float z = ((const float*)(ws + WS_LOGF))[ix]; const float lb = ((const float*)(ws + WS_LB))[h * 128 + d];
        const float kin = (1.0f - lb) / (1.0f + __expf(z)); kn[d] = kin; fs[d] = 1.0f - kin; qs[d] = bf2f(((const bf16*)(ws + WS_HQ))[ix]); vs[d] = bf2f(((const bf16*)(ws + WS_HI))[ix]); }
    __syncthreads();
    const int e4 = F.tid & 31, dq = F.tid >> 5;
    const float* Sin = A.in[3] + ((size_t)(b * 8 + h) * 128) * 128; float* Sout = F.out + OUT_SHS + ((size_t)(b * 8 + h) * 128) * 128;
    const f32x4 v4 = *(const LAS f32x4*)&vs[4 * e4]; f32x4 o = (f32x4){0.f, 0.f, 0.f, 0.f};
    f32x4 s[8];
#pragma unroll
    for (int i = 0; i < 8; ++i) s[i] = *(const f32x4*)(Sin + (size_t)(8 * dq + i) * 128 + 4 * e4);
#pragma unroll
    for (int i = 0; i < 8; ++i) { const int d = 8 * dq + i; s[i] = s[i] * fs[d] + v4 * kn[d]; *(f32x4*)(Sout + (size_t)d * 128 + 4 * e4) = s[i]; o += s[i] * qs[d]; }
    *(LAS f32x4*)&ored[dq * 128 + 4 * e4] = o;
    __syncthreads();
    if (F.wave == 0) { float oo[2]; float ss = 0.f;
#pragma unroll
        for (int k = 0; k < 2; ++k) { const int e = F.lane + 64 * k; float t = 0.f;
#pragma unroll
            for (int j = 0; j < 16; ++j) t += ored[j * 128 + e];
            oo[k] = t; ss += t * t; }
        const float rr = 1.0f / sqrtf(wave_sum(ss) * (1.0f / 128.0f) + EPS);
        const bf16* HG = (const bf16*)(ws + WS_HG); bf16* OH = (bf16*)(ws + WS_OH);
#pragma unroll
        for (int k = 0; k < 2; ++k) { const int e = F.lane + 64 * k; const size_t ix = (size_t)r * 1024 + h * 128 + e; OH[ix] = (bf16)f2bf(oo[k] * rr * A.in[10][e] * bf2f(HG[ix])); } }
}
__device__ __forceinline__ void p2_phase(Frame& F, const Args& A) {
    for (int it = F.vcu; it < 512; it += F.G) p2_ret_item(F, it);
    for (int it = F.vcu; it < 512; it += F.G) p2_hg_item(F, it);
    for (int it = F.vcu; it < 1024; it += F.G) p2_sret_item(F, A, it);
    for (int it = F.vcu; it < 1024; it += F.G) p2_shg_item(F, A, it);
}
__device__ __forceinline__ void p3_phase(Frame& F) {
    unsigned char* ws = F.ws;
    const int gt = F.vcu * 512 + F.tid, NT = F.G * 512;
    for (int gid = gt; gid < 32 * 256 * 32; gid += NT) {
        const int bh = gid >> 13, e = (gid >> 5) & 255, d4 = gid & 31; const float cd = exp2f(128.0f * lg2gamma(bh & 7));
        const float* kv = (const float*)(ws + WS_KVLOC) + ((size_t)bh * 16 * 256 + e) * 128 + 4 * d4; bf16* st = (bf16*)(ws + WS_SRT) + ((size_t)bh * 16 * 256 + e) * 128 + 4 * d4;
        f32x4 x[16];
#pragma unroll
        for (int c = 0; c < 16; ++c) x[c] = *(const f32x4*)(kv + (size_t)c * 256 * 128);
        f32x4 S = (f32x4){0.f, 0.f, 0.f, 0.f};
#pragma unroll
        for (int c = 0; c < 16; ++c) { v2u p; p.x = pk2(S[0], S[1]); p.y = pk2(S[2], S[3]); *(v2u*)(st + (size_t)c * 256 * 128) = p; S = S * cd + x[c]; }
        float* fo = F.out + OUT_SRP + ((size_t)bh * 128 + 4 * d4) * 256 + e;
#pragma unroll
        for (int i = 0; i < 4; ++i) fo[(size_t)i * 256] = S[i];
    }
    for (int gid = gt; gid < 32 * 128 * 32; gid += NT) {
        const int bh = gid >> 12, e = (gid >> 5) & 127, d4 = gid & 31;
        const float* hs = (const float*)(ws + WS_HSLOC) + ((size_t)bh * 16 * 128 + e) * 128 + 4 * d4; bf16* st = (bf16*)(ws + WS_SHT) + ((size_t)bh * 16 * 128 + e) * 128 + 4 * d4;
        const float* bt = (const float*)(ws + WS_BTOT) + (size_t)bh * 16 * 128 + 4 * d4;
        f32x4 S = (f32x4){0.f, 0.f, 0.f, 0.f};
#pragma unroll 4
        for (int c = 0; c < 16; ++c) { const f32x4 x = *(const f32x4*)(hs + (size_t)c * 128 * 128); const f32x4 bb = *(const f32x4*)(bt + c * 128);
            v2u p; p.x = pk2(S[0], S[1]); p.y = pk2(S[2], S[3]); *(v2u*)(st + (size_t)c * 128 * 128) = p;
            S[0] = S[0] * __expf(bb[0]) + x[0]; S[1] = S[1] * __expf(bb[1]) + x[1]; S[2] = S[2] * __expf(bb[2]) + x[2]; S[3] = S[3] * __expf(bb[3]) + x[3]; }
        float* fo = F.out + OUT_SHP + ((size_t)bh * 128 + 4 * d4) * 128 + e;
#pragma unroll
        for (int i = 0; i < 4; ++i) fo[(size_t)i * 128] = S[i];
    }
}
__device__ __forceinline__ void p4_ret_item(Frame& F, int item) {
    unsigned char* ws = F.ws;
    const int c = item & 15, h = (item >> 4) & 7, b = item >> 7, r0 = b * 2048 + c * 128;
    const int w = F.wave, l15 = F.lane & 15, g = F.lane >> 4;
    LAS bf16* KS = (LAS bf16*)F.lds; LAS bf16* VT = KS + 128 * TP;
    const bf16* Qg = (const bf16*)(ws + WS_Q); const bf16* Kg = (const bf16*)(ws + WS_K); const bf16* Vg = (const bf16*)(ws + WS_V);
    const float* COS = (const float*)(ws + WS_COS); const float* SIN = (const float*)(ws + WS_SIN);
    const float lg = lg2gamma(h);
    __syncthreads();
#pragma unroll
    for (int i = 0; i < 2; ++i) { const int u = F.tid + 512 * i, d0 = (u & 7) * 8, m = u >> 3;
        const bf16* kp = Kg + (size_t)(r0 + m) * 1024 + h * 128 + d0; const v4u a = *(const v4u*)kp, bb = *(const v4u*)(kp + 64);
        const int pos = c * 128 + m; const f32x4 c0 = *(const f32x4*)(COS + pos * 64 + d0), c1 = *(const f32x4*)(COS + pos * 64 + d0 + 4), s0 = *(const f32x4*)(SIN + pos * 64 + d0), s1 = *(const f32x4*)(SIN + pos * 64 + d0 + 4);
        float o1[8], o2[8];
#pragma unroll
        for (int j = 0; j < 8; ++j) { const float x1 = bfe(a, j), x2 = bfe(bb, j), cj = j < 4 ? c0[j & 3] : c1[j & 3], sj = j < 4 ? s0[j & 3] : s1[j & 3]; o1[j] = x1 * cj - x2 * sj; o2[j] = x2 * cj + x1 * sj; }
        *(LAS bf16x8*)&KS[m * TP + d0] = pack_f8(o1); *(LAS bf16x8*)&KS[m * TP + 64 + d0] = pack_f8(o2); }
#pragma unroll
    for (int i = 0; i < 8; ++i) { const int u = F.tid + 512 * i, m = u & 127, e0 = (u >> 7) * 8;
        const v4u a = *(const v4u*)(Vg + (size_t)(r0 + m) * 2048 + h * 256 + e0);
#pragma unroll
        for (int j = 0; j < 8; ++j) VT[(e0 + j) * TP + m] = (bf16)((a[j >> 1] >> (16 * (j & 1))) & 0xffffu); }
    bf16x8 qf[4];
    { const int n = 16 * w + l15, pos = c * 128 + n; const bf16* qp = Qg + (size_t)(r0 + n) * 1024 + h * 128 + 8 * g;
      const v4u a0 = *(const v4u*)qp, a1 = *(const v4u*)(qp + 32), a2 = *(const v4u*)(qp + 64), a3 = *(const v4u*)(qp + 96);
      float r0v[8], r1v[8], r2v[8], r3v[8];
#pragma unroll
      for (int hlf = 0; hlf < 2; ++hlf) { const int dd = 32 * hlf + 8 * g;
          const f32x4 c0 = *(const f32x4*)(COS + pos * 64 + dd), c1 = *(const f32x4*)(COS + pos * 64 + dd + 4), s0 = *(const f32x4*)(SIN + pos * 64 + dd), s1 = *(const f32x4*)(SIN + pos * 64 + dd + 4);
#pragma unroll
          for (int j = 0; j < 8; ++j) { const float cj = j < 4 ? c0[j & 3] : c1[j & 3], sj = j < 4 ? s0[j & 3] : s1[j & 3];
              const float x1 = hlf == 0 ? bfe(a0, j) : bfe(a1, j), x2 = hlf == 0 ? bfe(a2, j) : bfe(a3, j);
              if (hlf == 0) { r0v[j] = x1 * cj - x2 * sj; r2v[j] = x2 * cj + x1 * sj; } else { r1v[j] = x1 * cj - x2 * sj; r3v[j] = x2 * cj + x1 * sj; } } }
      qf[0] = pack_f8(r0v); qf[1] = pack_f8(r1v); qf[2] = pack_f8(r2v); qf[3] = pack_f8(r3v); }
    __syncthreads();
    f32x4 O[16];
    { const bf16* st = (const bf16*)(ws + WS_SRT) + (size_t)item * 256 * 128 + 8 * g;
#pragma unroll
      for (int et = 0; et < 16; ++et) { f32x4 t = (f32x4){0.f, 0.f, 0.f, 0.f};
#pragma unroll
          for (int ks = 0; ks < 4; ++ks) { const bf16x8 sf = *(const bf16x8*)(st + (size_t)(16 * et + l15) * 128 + 32 * ks); t = MFMA16(qf[ks], sf, t); }
          O[et] = t; }
      float rs[4];
#pragma unroll
      for (int reg = 0; reg < 4; ++reg) rs[reg] = exp2f((float)(16 * w + 4 * g + reg + 1) * lg);
#pragma unroll
      for (int et = 0; et < 16; ++et)
#pragma unroll
          for (int reg = 0; reg < 4; ++reg) O[et][reg] *= rs[reg]; }
    bf16x8 pf[4];
#pragma unroll
    for (int s = 0; s < 4; ++s) { float pv[8];
#pragma unroll
        for (int hf = 0; hf < 2; ++hf) { const int mt = 2 * s + hf; f32x4 dd = (f32x4){0.f, 0.f, 0.f, 0.f};
            if (mt <= w) {
#pragma unroll
                for (int ks = 0; ks < 4; ++ks) { const bf16x8 kf = *(const LAS bf16x8*)&KS[(16 * mt + l15) * TP + 32 * ks + 8 * g]; dd = MFMA16(kf, qf[ks], dd); }
#pragma unroll
                for (int reg = 0; reg < 4; ++reg) { const int m = 16 * mt + 4 * g + reg, n = 16 * w + l15; dd[reg] = n >= m ? dd[reg] * exp2f((float)(n - m) * lg) : 0.f; } }
#pragma unroll
            for (int reg = 0; reg < 4; ++reg) pv[4 * hf + reg] = dd[reg]; }
        pf[s] = pack_f8(pv); }
#pragma unroll
    for (int s = 0; s < 4; ++s) if (2 * s <= w) {
#pragma unroll
        for (int et = 0; et < 16; ++et) { const LAS bf16* vp = &VT[(16 * et + l15) * TP + 32 * s + 4 * g];
            const bf16x4v lo = *(const LAS bf16x4v*)vp, hi = *(const LAS bf16x4v*)(vp + 16);
            const bf16x8 vf = __builtin_shufflevector(lo, hi, 0, 1, 2, 3, 4, 5, 6, 7); O[et] = MFMA16(pf[s], vf, O[et]); } }
    float ss[4] = {0.f, 0.f, 0.f, 0.f};
#pragma unroll
    for (int et = 0; et < 16; ++et)
#pragma unroll
        for (int reg = 0; reg < 4; ++reg) ss[reg] += O[et][reg] * O[et][reg];
#pragma unroll
    for (int reg = 0; reg < 4; ++reg) { float v = ss[reg]; v += __shfl_xor(v, 1); v += __shfl_xor(v, 2); v += __shfl_xor(v, 4); v += __shfl_xor(v, 8); ss[reg] = 1.0f / sqrtf(v * (1.0f / 256.0f) + EPS); }
    const bf16* RG = (const bf16*)(ws + WS_RG); bf16* OR = (bf16*)(ws + WS_OR);
#pragma unroll
    for (int reg = 0; reg < 4; ++reg) { const size_t rb = (size_t)(r0 + 16 * w + 4 * g + reg) * 2048 + h * 256 + l15;
#pragma unroll
        for (int et = 0; et < 16; ++et) OR[rb + 16 * et] = (bf16)f2bf(O[et][reg] * ss[reg] * bf2f(RG[rb + 16 * et])); }
}
__device__ __forceinline__ void p4_hg_item(Frame& F, const Args& A, int item) {
    unsigned char* ws = F.ws;
    const int sc = item & 15, h = (item >> 4) & 7, b = item >> 7, r0 = b * 2048 + sc * 128;
    const int w = F.wave, l15 = F.lane & 15, g = F.lane >> 4;
    LAS bf16* QP = (LAS bf16*)F.lds;
    LAS bf16* KP = QP + 64 * TP;
    LAS bf16* KU = KP + 64 * TP;
    LAS bf16* VT = KU + 128 * 72;
    LAS float* E15 = (LAS float*)(VT + 128 * 72);
    LAS float* OB = E15 + 4 * 128;
    const float* Z = (const float*)(ws + WS_LOGF); const bf16* HQ = (const bf16*)(ws + WS_HQ); const bf16* HI = (const bf16*)(ws + WS_HI); const float* LB = (const float*)(ws + WS_LB);
    f32x4 S[8];
    { const bf16* st = (const bf16*)(ws + WS_SHT) + (size_t)item * 128 * 128 + (size_t)(16 * w + l15) * 128 + 4 * g;
#pragma unroll
      for (int dt = 0; dt < 8; ++dt) { const v2u p = *(const v2u*)(st + 16 * dt); S[dt][0] = __uint_as_float(p.x << 16); S[dt][1] = __uint_as_float(p.x & 0xffff0000u); S[dt][2] = __uint_as_float(p.y << 16); S[dt][3] = __uint_as_float(p.y & 0xffff0000u); } }
    for (int hf = 0; hf < 2; ++hf) {
        const int rh = r0 + 64 * hf;
        __syncthreads();
        { const int d = F.tid & 127, sq = F.tid >> 7; const float oml = 1.0f - LB[h * 128 + d];
          float kin[16], bcum[16]; float bb = 0.f;
#pragma unroll
          for (int t = 0; t < 16; ++t) { const size_t ix = (size_t)(rh + 16 * sq + t) * 1024 + h * 128 + d; const float z = Z[ix]; const float q = bf2f(HQ[ix]);
              kin[t] = oml / (1.0f + __expf(z)); bb += log1pf(-kin[t]); bcum[t] = bb;
              QP[(16 * sq + t) * TP + d] = (bf16)f2bf(q * __expf(bb)); KP[(16 * sq + t) * TP + d] = (bf16)f2bf(kin[t] * __expf(fminf(-bb, 80.0f))); }
          E15[sq * 128 + d] = __expf(bb);
          float v[8];
#pragma unroll
          for (int t = 0; t < 8; ++t) v[t] = kin[t] * __expf(bb - bcum[t]);
          *(LAS bf16x8*)&KU[d * 72 + 16 * sq] = pack_f8(v);
#pragma unroll
          for (int t = 0; t < 8; ++t) v[t] = kin[8 + t] * __expf(bb - bcum[8 + t]);
          *(LAS bf16x8*)&KU[d * 72 + 16 * sq + 8] = pack_f8(v); }
#pragma unroll
        for (int i = 0; i < 2; ++i) { const int u = F.tid + 512 * i, m = u & 63, e0 = (u >> 6) * 8;
            const v4u a = *(const v4u*)(HI + (size_t)(rh + m) * 1024 + h * 128 + e0);
#pragma unroll
            for (int j = 0; j < 8; ++j) VT[(e0 + j) * 72 + m] = (bf16)((a[j >> 1] >> (16 * (j & 1))) & 0xffffu); }
        __syncthreads();
        const bf16x8 zero8 = (bf16x8){0, 0, 0, 0, 0, 0, 0, 0};
#pragma unroll
        for (int sq = 0; sq < 4; ++sq) {
            f32x4 at = (f32x4){0.f, 0.f, 0.f, 0.f};
#pragma unroll
            for (int ks = 0; ks < 4; ++ks) { const bf16x8 kf = *(const LAS bf16x8*)&KP[(16 * sq + l15) * TP + 32 * ks + 8 * g], qf = *(const LAS bf16x8*)&QP[(16 * sq + l15) * TP + 32 * ks + 8 * g]; at = MFMA16(kf, qf, at); }
            float pv[8];
#pragma unroll
            for (int reg = 0; reg < 4; ++reg) { pv[reg] = (4 * g + reg) <= l15 ? at[reg] : 0.f; pv[4 + reg] = 0.f; }
            const bf16x8 pfr = pack_f8(pv);
            f32x4 o;
            { const bf16x4v lo = *(const LAS bf16x4v*)&VT[(16 * w + l15) * 72 + 16 * sq + 4 * g]; const bf16x8 vf = __builtin_shufflevector(lo, (bf16x4v){0, 0, 0, 0}, 0, 1, 2, 3, 4, 5, 6, 7);
              const f32x4 z4 = {0.f, 0.f, 0.f, 0.f}; o = MFMA16(pfr, vf, z4); }
#pragma unroll
            for (int ks = 0; ks < 4; ++ks) { float sv[8];
#pragma unroll
                for (int jj = 0; jj < 8; ++jj) sv[jj] = S[2 * ks + (jj >> 2)][jj & 3];
                const bf16x8 sf = pack_f8(sv);
                const LAS bf16* qp = &QP[(16 * sq + l15) * TP + 32 * ks + 4 * g]; const bf16x4v lo = *(const LAS bf16x4v*)qp, hi = *(const LAS bf16x4v*)(qp + 16);
                const bf16x8 qf = __builtin_shufflevector(lo, hi, 0, 1, 2, 3, 4, 5, 6, 7); o = MFMA16(qf, sf, o); }
#pragma unroll
            for (int reg = 0; reg < 4; ++reg) OB[(16 * sq + 4 * g + reg) * 132 + 16 * w + l15] = o[reg];
            const bf16x8 vu = g < 2 ? *(const LAS bf16x8*)&VT[(16 * w + l15) * 72 + 16 * sq + 8 * g] : zero8;
#pragma unroll
            for (int dt = 0; dt < 8; ++dt) { const f32x4 ed = *(const LAS f32x4*)&E15[sq * 128 + 16 * dt + 4 * g];
                const bf16x8 kf = g < 2 ? *(const LAS bf16x8*)&KU[(16 * dt + l15) * 72 + 16 * sq + 8 * g] : zero8;
                S[dt] = MFMA16(kf, vu, S[dt] * ed); }
        }
        __syncthreads();
        { const bf16* HG = (const bf16*)(ws + WS_HG); bf16* OH = (bf16*)(ws + WS_OH);
#pragma unroll
          for (int i = 0; i < 8; ++i) { const int t = 8 * w + i; const float v0 = OB[t * 132 + F.lane], v1 = OB[t * 132 + 64 + F.lane];
              const float rr = 1.0f / sqrtf(wave_sum(v0 * v0 + v1 * v1) * (1.0f / 128.0f) + EPS); const size_t ix = (size_t)(rh + t) * 1024 + h * 128 + F.lane;
              OH[ix] = (bf16)f2bf(v0 * rr * A.in[10][F.lane] * bf2f(HG[ix])); OH[ix + 64] = (bf16)f2bf(v1 * rr * A.in[10][64 + F.lane] * bf2f(HG[ix + 64])); } }
    }
}
__device__ __forceinline__ void p4_phase(Frame& F, const Args& A) {
    for (int it = F.vcu; it < 512; it += F.G) p4_ret_item(F, it);
    for (int it = F.vcu; it < 512; it += F.G) p4_hg_item(F, A, it);
}
__global__ void __launch_bounds__(NWAVES * 64, 2) mk_fwd(Args args) {
    extern __shared__ __attribute__((aligned(16))) unsigned char lds[];
    Frame F;
    F.lds = (LAS unsigned char*)lds; F.MISC = (volatile LAS unsigned*)(F.lds + MISC_OFF);
    F.tid = threadIdx.x; F.lane = F.tid & 63; F.wave = __builtin_amdgcn_readfirstlane(F.tid >> 6);
    F.G = gridDim.x; { const int bx = blockIdx.x; F.vcu = (F.G % 8 == 0) ? (bx % 8) * (F.G / 8) + bx / 8 : bx; }
    F.ws = args.ws; F.out = args.out; F.ctl = (gu32*)(args.ws + WS_CTL);
    for (int u = F.tid; u < (LDS_BYTES - LDSCTL_OFF) / 4; u += NWAVES * 64) ((LAS unsigned*)(F.lds + LDSCTL_OFF))[u] = 0u;
    __syncthreads();
    XcdBarrier bar; bar.bar = (unsigned*)(F.ctl + CW_BAR); bar.x = 0; bar.st = nullptr;
    if (args.use_bar) bar = xcd_barrier_post((unsigned*)(F.ctl + CW_BAR), F.MISC + 8);
    const int lo = args.ph_lo, hi = args.ph_hi;
#define IN(k) (lo <= (k) && (k) < hi)
#define SEAM(k) do { if (IN(k) && IN((k) + 1)) xcd_barrier(bar); } while (0)
    unsigned char* ws = args.ws;
    if (IN(0)) { p0_prologue(F, args); } SEAM(0);
    if (IN(1)) {
        pg8::Gemm g{(const pg8::bf16_t*)(ws + WS_XB), (const pg8::bf16_t*)(ws + WS_WIN), MPAD, NIN, 2048}; pg8::StaticOrder S; S.init(MPAD, NIN, F.G, (int)blockIdx.x);
        pg8::EpiInProj E{ws};
        pg8::gemm_phase<pg8::EpiInProj, pg8::StaticOrder, true, true>(F.lds, g, S, E);
    } SEAM(1);
    if (IN(2)) { p2_phase(F, args); } SEAM(2);
    if (IN(3)) { p3_phase(F); } SEAM(3);
    if (IN(4)) { p4_phase(F, args); } SEAM(4);
    if (IN(5)) {
        { pg8::Gemm g{(const pg8::bf16_t*)(ws + WS_OR), (const pg8::bf16_t*)(ws + WS_WRO), MPAD, 2048, 2048}; pg8::StaticOrder S; S.init(MPAD, 2048, F.G, (int)blockIdx.x);
          pg8::EpiGate<0> E{(const pg8::bf16_t*)(ws + WS_GA), (float*)(ws + WS_YT), (pg8::bf16_t*)(ws + WS_MG)};
          pg8::gemm_phase<pg8::EpiGate<0>, pg8::StaticOrder, true, true>(F.lds, g, S, E); }
        { pg8::Gemm g{(const pg8::bf16_t*)(ws + WS_OH), (const pg8::bf16_t*)(ws + WS_WHO), MPAD, 2048, 1024}; pg8::StaticOrder S; S.init(MPAD, 2048, F.G, (int)blockIdx.x);
          pg8::EpiGate<1> E{(const pg8::bf16_t*)(ws + WS_GB), (float*)(ws + WS_YT), (pg8::bf16_t*)(ws + WS_MG)};
          pg8::gemm_phase<pg8::EpiGate<1>, pg8::StaticOrder, true, true>(F.lds, g, S, E); }
    } SEAM(5);
    if (IN(6)) {
        pg8::Gemm g{(const pg8::bf16_t*)(ws + WS_MG), (const pg8::bf16_t*)(ws + WS_WOUT), MPAD, 2048, 2048}; pg8::StaticOrder S; S.init(MPAD, 2048, F.G, (int)blockIdx.x);
        pg8::EpiResid E{args.in[0], args.in[1], args.out, (pg8::bf16_t*)(ws + WS_X1B), (float*)(F.ctl + CW_SS1)};
        pg8::gemm_phase<pg8::EpiResid, pg8::StaticOrder, true, true>(F.lds, g, S, E);
    } SEAM(6);
    if (IN(7)) {
        pg8::Gemm g{(const pg8::bf16_t*)(ws + WS_X1B), (const pg8::bf16_t*)(ws + WS_WFI), MPAD, 2 * DFF, 2048}; pg8::StaticOrder S; S.init(MPAD, 2 * DFF, F.G, (int)blockIdx.x);
        pg8::EpiSwiglu E{(const float*)(F.ctl + CW_SS1), (pg8::bf16_t*)(ws + WS_ACT)};
        pg8::gemm_phase<pg8::EpiSwiglu, pg8::StaticOrder, true, true>(F.lds, g, S, E);
    } SEAM(7);
    if (IN(8)) {
        pg8::Gemm g{(const pg8::bf16_t*)(ws + WS_ACT), (const pg8::bf16_t*)(ws + WS_WFO), MPAD, 2048, DFF}; pg8::StaticOrder S; S.init(MPAD, 2048, F.G, (int)blockIdx.x);
        pg8::EpiResid E{args.out, args.out + OUT_YS, args.out, nullptr, (float*)(F.ctl + CW_SS2)};
        pg8::gemm_phase<pg8::EpiResid, pg8::StaticOrder, true, true>(F.lds, g, S, E);
    } SEAM(8);
    if (IN(9)) {
        const int gw = F.vcu * NWAVES + F.wave, NGW = F.G * NWAVES; const float* SS2 = (const float*)(F.ctl + CW_SS2);
        for (int m = gw; m < MROWS; m += NGW) { f32x4* xr = (f32x4*)(args.out + (size_t)m * 2048) + F.lane; const f32x4* gn = (const f32x4*)args.in[14] + F.lane;
            const float rr = 1.0f / sqrtf(SS2[m] * (1.0f / 2048.0f) + EPS);
#pragma unroll
            for (int j = 0; j < 8; ++j) xr[64 * j] = xr[64 * j] * rr * gn[64 * j]; }
    }
#undef IN
#undef SEAM
}
namespace hy {
__device__ __forceinline__ float b2f(unsigned short b) { return __uint_as_float(((unsigned)b) << 16); }
__global__ void unpack_proj_k(float* proj, int R, int row0, const unsigned char* ws, const float* lb_logits) {
    const size_t idx = (size_t)blockIdx.x * blockDim.x + threadIdx.x; if (idx >= (size_t)R * 14336) return;
    const int r = (int)(idx / 14336), c = (int)(idx % 14336); const size_t g = (size_t)(row0 + r);
    const unsigned short* Q = (const unsigned short*)(ws + WS_Q); const unsigned short* K = (const unsigned short*)(ws + WS_K); const unsigned short* V = (const unsigned short*)(ws + WS_V);
    const unsigned short* RG = (const unsigned short*)(ws + WS_RG); const unsigned short* HQ = (const unsigned short*)(ws + WS_HQ); const float* Z = (const float*)(ws + WS_LOGF);
    const unsigned short* HI = (const unsigned short*)(ws + WS_HI); const unsigned short* HG = (const unsigned short*)(ws + WS_HG); const unsigned short* GA = (const unsigned short*)(ws + WS_GA); const unsigned short* GB = (const unsigned short*)(ws + WS_GB);
    float v;
    if (c < 2048) { const int j = c & 127; if (j >= 64) return; const unsigned short* S = c < 1024 ? Q : K; const int cc = c & 1023;
        const int pos = row0 + r < 8192 ? ((row0 + r) & 2047) : 16384; const float inv = powf(10000.0f, -(float)j / 64.0f); const float ang = (float)pos * inv; float sn, cs; sincosf(ang, &sn, &cs);
        const float x1 = b2f(S[g * 1024 + cc]), x2 = b2f(S[g * 1024 + cc + 64]); proj[idx] = x1 * cs - x2 * sn; proj[idx + 64] = x2 * cs + x1 * sn; return; }
    else if (c < 4096) v = b2f(V[g * 2048 + c - 2048]); else if (c < 6144) v = b2f(RG[g * 2048 + c - 4096]);
    else if (c < 7168) v = b2f(HQ[g * 1024 + c - 6144]);
    else if (c < 8192) { const int ch = c - 7168; const float lb = 1.f / (1.f + expf(lb_logits[1024 + ch] - lb_logits[ch])); v = lb + (1.f - lb) / (1.f + expf(-Z[g * 1024 + ch])); }
    else if (c < 9216) v = b2f(HI[g * 1024 + c - 8192]); else if (c < 10240) v = b2f(HG[g * 1024 + c - 9216]);
    else if (c < 12288) v = b2f(GA[g * 2048 + c - 10240]); else v = b2f(GB[g * 2048 + c - 12288]);
    proj[idx] = v;
}
}
namespace nv {
constexpr int DM = 2048;
constexpr float EPSN = 1e-6f;
__device__ __forceinline__ float sigmoidf_(float x) { return 1.f / (1.f + __expf(-x)); }
__device__ __forceinline__ float siluf_(float x) { return x / (1.f + __expf(-x)); }

__global__ void rmsnorm_k(const float* x, const float* g, float* out) {
    __shared__ float red[4];
    const float* xr = x + (size_t)blockIdx.x * DM; float* o = out + (size_t)blockIdx.x * DM;
    float v[8]; float s = 0.f;
    for (int i = 0; i < 8; ++i) { v[i] = xr[threadIdx.x + 256 * i]; s += v[i] * v[i]; }
    for (int o2 = 32; o2 >= 1; o2 >>= 1) s += __shfl_xor(s, o2);
    if ((threadIdx.x & 63) == 0) red[threadIdx.x >> 6] = s;
    __syncthreads();
    const float tot = red[0] + red[1] + red[2] + red[3];
    const float r = 1.0f / sqrtf(tot * (1.f / DM) + EPSN);
    for (int i = 0; i < 8; ++i) o[threadIdx.x + 256 * i] = v[i] * r * g[threadIdx.x + 256 * i];
}
__global__ __launch_bounds__(256) void gemm_k(const float* A, int lda, const float* B, int ldb, float* C, int ldc, int K) {
    __shared__ float As[16][68]; __shared__ float Bs[16][68];
    const int tid = threadIdx.x, tx = tid & 15, ty = tid >> 4;
    const int m0 = blockIdx.y * 64, n0 = blockIdx.x * 64;
    float acc[4][4]; for (int i = 0; i < 4; ++i) for (int j = 0; j < 4; ++j) acc[i][j] = 0.f;
    const int ar = tid >> 2, ak = (tid & 3) * 4, bk = tid >> 4, bc = (tid & 15) * 4;
    for (int k0 = 0; k0 < K; k0 += 16) {
        const float4 av = *(const float4*)(A + (size_t)(m0 + ar) * lda + k0 + ak);
        const float4 bv = *(const float4*)(B + (size_t)(k0 + bk) * ldb + n0 + bc);
        __syncthreads();
        As[ak + 0][ar] = av.x; As[ak + 1][ar] = av.y; As[ak + 2][ar] = av.z; As[ak + 3][ar] = av.w;
        *(float4*)&Bs[bk][bc] = bv;
        __syncthreads();
#pragma unroll
        for (int k = 0; k < 16; ++k) {
            const float4 a = *(const float4*)&As[k][ty * 4]; const float4 b = *(const float4*)&Bs[k][tx * 4];
            const float aa[4] = {a.x, a.y, a.z, a.w}, bb[4] = {b.x, b.y, b.z, b.w};
#pragma unroll
            for (int i = 0; i < 4; ++i)
#pragma unroll
                for (int j = 0; j < 4; ++j) acc[i][j] += aa[i] * bb[j];
        }
    }
    for (int i = 0; i < 4; ++i) *(float4*)(C + (size_t)(m0 + ty * 4 + i) * ldc + n0 + tx * 4) = make_float4(acc[i][0], acc[i][1], acc[i][2], acc[i][3]);
}
__global__ void postproj_k(float* proj, int R, int pos0, const float* lb_logits) {
    const size_t idx = (size_t)blockIdx.x * blockDim.x + threadIdx.x; if (idx >= (size_t)R * NIN) return;
    const int r = (int)(idx / NIN), c = (int)(idx % NIN); float* p = proj + (size_t)r * NIN;
    if (c < 2048) {
        const int j = c & 127; if (j >= 64) return;
        const int pos = pos0 >= 0 ? pos0 : (-1 - pos0) + r;
        const float inv = powf(10000.0f, -(float)j / 64.0f); const float ang = (float)pos * inv;
        float sn, cs; sincosf(ang, &sn, &cs);
        const float x1 = p[c], x2 = p[c + 64]; float o1 = x1 * cs - x2 * sn, o2 = x2 * cs + x1 * sn;
        if (c >= 1024) { o1 *= 0.08838834764831845f; o2 *= 0.08838834764831845f; }
        p[c] = o1; p[c + 64] = o2;
    } else if (c < 4096) {
    } else if (c < 6144) { p[c] = siluf_(p[c]);
    } else if (c < 7168) { p[c] = siluf_(p[c]);
    } else if (c < 8192) {
        const int ch = c - 7168; const float l0 = lb_logits[ch], l1 = lb_logits[1024 + ch];
        const float lb = 1.f / (1.f + expf(l1 - l0));
        p[c] = lb + (1.f - lb) * (1.f / (1.f + expf(-p[c])));
    } else if (c < 9216) {
    } else if (c < 10240) { p[c] = siluf_(p[c]);
    } else { p[c] = 1.f / (1.f + expf(-p[c])); }
}
__global__ __launch_bounds__(256) void ret_rec_k(const float* proj, int T, const float* S0, float* O, float* Sout) {
    const int e = threadIdx.x, h = blockIdx.x & 7, b = blockIdx.x >> 3;
    const float gamma = 1.0f - exp2f(-5.0f - (float)h);
    float S[128];
    const float* s0 = S0 ? S0 + ((size_t)(b * 8 + h) * 128) * 256 + e : nullptr;
#pragma unroll
    for (int d = 0; d < 128; ++d) S[d] = s0 ? s0[(size_t)d * 256] : 0.f;
    for (int t = 0; t < T; ++t) {
        const float* p = proj + (size_t)(b * T + t) * NIN; const float* q = p + h * 128; const float* k = p + 1024 + h * 128; const float v = p[2048 + h * 256 + e];
        float o = 0.f;
#pragma unroll
        for (int d = 0; d < 128; ++d) { S[d] = gamma * S[d] + k[d] * v; o += q[d] * S[d]; }
        O[(size_t)(b * T + t) * 2048 + h * 256 + e] = o;
    }
    float* so = Sout + ((size_t)(b * 8 + h) * 128) * 256 + e;
#pragma unroll
    for (int d = 0; d < 128; ++d) so[(size_t)d * 256] = S[d];
}
__global__ __launch_bounds__(128) void hg_rec_k(const float* proj, int T, const float* S0, float* O, float* Sout) {
    const int e = threadIdx.x, h = blockIdx.x & 7, b = blockIdx.x >> 3;
    float S[128];
    const float* s0 = S0 ? S0 + ((size_t)(b * 8 + h) * 128) * 128 + e : nullptr;
#pragma unroll
    for (int d = 0; d < 128; ++d) S[d] = s0 ? s0[(size_t)d * 128] : 0.f;
    for (int t = 0; t < T; ++t) {
        const float* p = proj + (size_t)(b * T + t) * NIN; const float* q = p + 6144 + h * 128; const float* f = p + 7168 + h * 128; const float v = p[8192 + h * 128 + e];
        float o = 0.f;
#pragma unroll
        for (int d = 0; d < 128; ++d) { const float ff = f[d]; S[d] = ff * S[d] + (1.f - ff) * v; o += q[d] * S[d]; }
        O[(size_t)(b * T + t) * 1024 + h * 128 + e] = o;
    }
    float* so = Sout + ((size_t)(b * 8 + h) * 128) * 128 + e;
#pragma unroll
    for (int d = 0; d < 128; ++d) so[(size_t)d * 128] = S[d];
}
__global__ void headnorm_k(float* Or, float* Oh, const float* proj, const float* hgrn_norm) {
    const int r = blockIdx.x >> 3, h = blockIdx.x & 7, l = threadIdx.x; const float* p = proj + (size_t)r * NIN;
    { float* o = Or + (size_t)r * 2048 + h * 256; float v[4]; float s = 0.f; for (int i = 0; i < 4; ++i) { v[i] = o[l + 64 * i]; s += v[i] * v[i]; }
      for (int o2 = 32; o2 >= 1; o2 >>= 1) s += __shfl_xor(s, o2); const float rr = 1.0f / sqrtf(s * (1.f / 256.f) + EPSN);
      for (int i = 0; i < 4; ++i) o[l + 64 * i] = v[i] * rr * p[4096 + h * 256 + l + 64 * i]; }
    { float* o = Oh + (size_t)r * 1024 + h * 128; float v[2]; float s = 0.f; for (int i = 0; i < 2; ++i) { v[i] = o[l + 64 * i]; s += v[i] * v[i]; }
      for (int o2 = 32; o2 >= 1; o2 >>= 1) s += __shfl_xor(s, o2); const float rr = 1.0f / sqrtf(s * (1.f / 128.f) + EPSN);
      for (int i = 0; i < 2; ++i) o[l + 64 * i] = v[i] * rr * hgrn_norm[l + 64 * i] * p[9216 + h * 128 + l + 64 * i]; }
}
__global__ void merge_k(float* ya, const float* yb, const float* proj, int R) {
    const size_t idx = (size_t)blockIdx.x * blockDim.x + threadIdx.x; if (idx >= (size_t)R * 2048) return;
    const int r = (int)(idx / 2048), c = (int)(idx % 2048); const float* p = proj + (size_t)r * NIN;
    ya[idx] = p[10240 + c] * ya[idx] + p[12288 + c] * yb[idx];
}
__global__ void add_k(const float* a, const float* b, float* o, size_t n) { const size_t i = (size_t)blockIdx.x * blockDim.x + threadIdx.x; if (i < n) o[i] = a[i] + b[i]; }
__global__ void swiglu_k(const float* gu, float* act, int R) {
    const size_t idx = (size_t)blockIdx.x * blockDim.x + threadIdx.x; if (idx >= (size_t)R * DFF) return;
    const int r = (int)(idx / DFF), c = (int)(idx % DFF); act[idx] = siluf_(gu[(size_t)r * 2 * DFF + c]) * gu[(size_t)r * 2 * DFF + DFF + c];
}
}


#ifndef HYBRID_LEVEL
#define HYBRID_LEVEL 0
#endif
namespace hy {
__global__ void unpack_rows_k(float* dst, const unsigned short* src, int pitch, int row0, int R, int C) {
    const size_t idx = (size_t)blockIdx.x * blockDim.x + threadIdx.x; if (idx >= (size_t)R * C) return;
    const int r = (int)(idx / C), c = (int)(idx % C); dst[idx] = __uint_as_float(((unsigned)src[(size_t)(row0 + r) * pitch + c]) << 16);
}
__global__ void copy_rows_k(float* dst, const float* src, size_t n) { const size_t i = (size_t)blockIdx.x * blockDim.x + threadIdx.x; if (i < n) dst[i] = src[i]; }
}
static void naive_forward(void* const* d_in, float* out, unsigned char* ws, const unsigned char* wsf, int level, hipStream_t st) {
    using namespace nv;
    const float* x_prompt = (const float*)d_in[0]; const float* x_sample = (const float*)d_in[1];
    const float* state_ret = (const float*)d_in[2]; const float* state_hg = (const float*)d_in[3];
    const float* w_in = (const float*)d_in[4]; const float* w_ro = (const float*)d_in[5]; const float* w_ho = (const float*)d_in[6]; const float* w_out = (const float*)d_in[7];
    const float* norm_mix = (const float*)d_in[8]; const float* norm_ffn = (const float*)d_in[9]; const float* hgrn_norm = (const float*)d_in[10]; const float* lb_logits = (const float*)d_in[11];
    const float* w_fi = (const float*)d_in[12]; const float* w_fo = (const float*)d_in[13]; const float* norm_final = (const float*)d_in[14];
    float* y_prompt = out; float* y_sample = out + (size_t)8192 * 2048;
    float* srp = y_sample + (size_t)128 * 2048; float* shp = srp + (size_t)4 * 8 * 128 * 256; float* srs = shp + (size_t)4 * 8 * 128 * 128; float* shs = srs + (size_t)128 * 8 * 128 * 256;
    constexpr int RC = 512;
    float* proj = (float*)ws;
    float* h    = proj + (size_t)RC * NIN;
    float* Or   = h + (size_t)RC * 2048;
    float* Oh   = Or + (size_t)RC * 2048;
    float* ya   = Oh + (size_t)RC * 1024;
    float* yb   = ya + (size_t)RC * 2048;
    float* x1   = yb + (size_t)RC * 2048;
    float* act  = x1 + (size_t)RC * 2048;
    for (int ci = 0; ci < 17; ++ci) {
        const bool smp = ci == 16; const int R = smp ? 128 : RC, T = smp ? 1 : RC, B = smp ? 128 : 1, row0 = ci * RC;
        const int b = ci / 4, t0 = (ci % 4) * RC;
        const float* x = smp ? x_sample : x_prompt + (size_t)row0 * 2048;
        float* y = smp ? y_sample : y_prompt + (size_t)row0 * 2048;
        if (level < 2) {
            if (level < 1) {
                rmsnorm_k<<<R, 256, 0, st>>>(x, norm_mix, h);
                gemm_k<<<dim3(NIN / 64, R / 64), 256, 0, st>>>(h, 2048, w_in, NIN, proj, NIN, 2048);
                { const size_t n = (size_t)R * NIN; postproj_k<<<(unsigned)((n + 255) / 256), 256, 0, st>>>(proj, R, smp ? 16384 : -1 - t0, lb_logits); }
            } else {
                const size_t n = (size_t)R * NIN; hy::unpack_proj_k<<<(unsigned)((n + 255) / 256), 256, 0, st>>>(proj, R, row0, wsf, lb_logits);
            }
            float* sr = smp ? srs : srp + (size_t)b * 8 * 128 * 256; float* sh = smp ? shs : shp + (size_t)b * 8 * 128 * 128;
            ret_rec_k<<<B * 8, 256, 0, st>>>(proj, T, smp ? state_ret : (t0 ? sr : nullptr), Or, sr);
            hg_rec_k<<<B * 8, 128, 0, st>>>(proj, T, smp ? state_hg : (t0 ? sh : nullptr), Oh, sh);
            headnorm_k<<<R * 8, 64, 0, st>>>(Or, Oh, proj, hgrn_norm);
        } else if (level < 3) {
            { const size_t n = (size_t)R * 2048; hy::unpack_rows_k<<<(unsigned)((n + 255) / 256), 256, 0, st>>>(Or, (const unsigned short*)(wsf + WS_OR), 2048, row0, R, 2048); }
            { const size_t n = (size_t)R * 1024; hy::unpack_rows_k<<<(unsigned)((n + 255) / 256), 256, 0, st>>>(Oh, (const unsigned short*)(wsf + WS_OH), 1024, row0, R, 1024); }
            { const size_t n = (size_t)R * NIN; hy::unpack_proj_k<<<(unsigned)((n + 255) / 256), 256, 0, st>>>(proj, R, row0, wsf, lb_logits); }
        }
        if (level < 3) {
            gemm_k<<<dim3(2048 / 64, R / 64), 256, 0, st>>>(Or, 2048, w_ro, 2048, ya, 2048, 2048);
            gemm_k<<<dim3(2048 / 64, R / 64), 256, 0, st>>>(Oh, 1024, w_ho, 2048, yb, 2048, 1024);
            { const size_t n = (size_t)R * 2048; merge_k<<<(unsigned)((n + 255) / 256), 256, 0, st>>>(ya, yb, proj, R); }
        } else if (level < 4) {
            const size_t n = (size_t)R * 2048; hy::unpack_rows_k<<<(unsigned)((n + 255) / 256), 256, 0, st>>>(ya, (const unsigned short*)(wsf + WS_MG), 2048, row0, R, 2048);
        }
        if (level < 4) {
            gemm_k<<<dim3(2048 / 64, R / 64), 256, 0, st>>>(ya, 2048, w_out, 2048, yb, 2048, 2048);
            { const size_t n = (size_t)R * 2048; add_k<<<(unsigned)((n + 255) / 256), 256, 0, st>>>(x, yb, x1, n); }
        } else if (level < 6) {
            const size_t n = (size_t)R * 2048; hy::copy_rows_k<<<(unsigned)((n + 255) / 256), 256, 0, st>>>(x1, y, n);
        }
        if (level < 5) {
            rmsnorm_k<<<R, 256, 0, st>>>(x1, norm_ffn, h);
            gemm_k<<<dim3(2 * DFF / 64, R / 64), 256, 0, st>>>(h, 2048, w_fi, 2 * DFF, proj, 2 * DFF, 2048);
            { const size_t n = (size_t)R * DFF; swiglu_k<<<(unsigned)((n + 255) / 256), 256, 0, st>>>(proj, act, R); }
        } else if (level < 6) {
            const size_t n = (size_t)R * DFF; hy::unpack_rows_k<<<(unsigned)((n + 255) / 256), 256, 0, st>>>(act, (const unsigned short*)(wsf + WS_ACT), DFF, row0, R, DFF);
        }
        if (level < 6) {
            gemm_k<<<dim3(2048 / 64, R / 64), 256, 0, st>>>(act, DFF, w_fo, 2048, yb, 2048, DFF);
            { const size_t n = (size_t)R * 2048; add_k<<<(unsigned)((n + 255) / 256), 256, 0, st>>>(x1, yb, ya, n); }
        } else if (level < 7) {
            const size_t n = (size_t)R * 2048; hy::copy_rows_k<<<(unsigned)((n + 255) / 256), 256, 0, st>>>(ya, y, n);
        }
        if (level < 7) rmsnorm_k<<<R, 256, 0, st>>>(ya, norm_final, y);
    }
}
#ifndef FAST_PHASES
#define FAST_PHASES 2
#endif
extern "C" void kernel_launch(void* const* d_in, const int* in_sizes, int n_in, void* d_out, int out_size, void* d_ws, size_t ws_size, hipStream_t stream) {
    static int grid = 0;
    if (grid == 0) {
        int dev = 0, cus = 0;
        if (ws_size < WS_END || n_in != 15) { fprintf(stderr, "kernel_launch: unexpected sizes (ws %zu, n_in %d)\n", ws_size, n_in); grid = -1; return; }
        if (hipGetDevice(&dev) != hipSuccess || hipDeviceGetAttribute(&cus, hipDeviceAttributeMultiprocessorCount, dev) != hipSuccess) { grid = -1; return; }
        if (hipFuncSetAttribute((const void*)mk_fwd, hipFuncAttributeMaxDynamicSharedMemorySize, LDS_BYTES) != hipSuccess) { fprintf(stderr, "kernel_launch: hipFuncSetAttribute failed\n"); grid = -1; return; }
        int per_cu = 0; (void)hipOccupancyMaxActiveBlocksPerMultiprocessor(&per_cu, (const void*)mk_fwd, NWAVES * 64, LDS_BYTES); (void)hipGetLastError();
        if (per_cu < 1) fprintf(stderr, "kernel_launch: occupancy query says %d blocks per CU\n", per_cu);
        grid = cus;
    }
    if (grid < 0) return;
    (void)hipMemsetAsync((char*)d_ws + WS_CTL, 0, CTL_ZERO_BYTES, stream);
    Args a{};
    for (int i = 0; i < 15; ++i) a.in[i] = (const float*)d_in[i];
    a.out = (float*)d_out; a.ws = (unsigned char*)d_ws; a.use_bar = 0;
    for (int ph = 0; ph < FAST_PHASES; ++ph) { a.ph_lo = ph; a.ph_hi = ph + 1; hipLaunchKernelGGL(mk_fwd, dim3(grid), dim3(NWAVES * 64), LDS_BYTES, stream, a); }
    naive_forward(d_in, (float*)d_out, (unsigned char*)d_ws + NAIVE_WS_OFF, (const unsigned char*)d_ws, HYBRID_LEVEL, stream);
}
```

```cpp
#include <hip/hip_runtime.h>
#include <cstdio>
#include <cstdint>
constexpr int DMODEL = 2048, MROWS = 8320, MPAD = 8448, NIN = 14336, DFF = 5632, NWAVES = 8;
constexpr float EPS = 1e-6f;
constexpr size_t MiB = 1u << 20;
constexpr size_t WS_CTL = 0, CTL_ZERO_BYTES = 1 * MiB;
constexpr size_t WS_WRO = 1 * MiB, WS_WHO = 9 * MiB, WS_WOUT = 13 * MiB, WS_WFI = 21 * MiB, WS_WFO = 65 * MiB, WS_WIN = 87 * MiB;
constexpr size_t WS_XB = 143 * MiB;
constexpr size_t WS_Q = 176 * MiB, WS_K = WS_Q + 8448ull * 1024 * 2, WS_V = 209 * MiB, WS_RG = 242 * MiB, WS_HQ = 275 * MiB, WS_LOGF = WS_HQ + 8448ull * 1024 * 2;
constexpr size_t WS_HI = WS_LOGF + 8448ull * 1024 * 4, WS_HG = WS_HI + 8448ull * 1024 * 2, WS_GA = WS_HG + 8448ull * 1024 * 2, WS_GB = WS_GA + 8448ull * 2048 * 2;
constexpr size_t WS_KVLOC = WS_GB + 8448ull * 2048 * 2;
constexpr size_t WS_HSLOC = WS_KVLOC + 64 * MiB;
constexpr size_t WS_OH = WS_HSLOC + 32 * MiB;
constexpr size_t WS_MISC = WS_OH + 8448ull * 1024 * 2;
constexpr size_t WS_RR1 = WS_MISC, WS_COS = WS_RR1 + 64 * 1024, WS_SIN = WS_COS + 2049 * 64 * 4 + 256, WS_LB = WS_SIN + 2049 * 64 * 4 + 256, WS_BTOT = WS_LB + 4096, WS_END = WS_BTOT + 512 * 128 * 4;
constexpr size_t WS_OR = WS_XB;
constexpr size_t WS_SRT = WS_WIN, WS_SHT = WS_WIN + 32 * MiB;
constexpr size_t WS_YT = WS_KVLOC;
constexpr size_t WS_MG = WS_Q;
constexpr size_t WS_X1B = WS_V;
constexpr size_t WS_ACT = WS_RG;
static_assert(WS_GB + 8448ull * 2048 * 2 == WS_KVLOC && WS_K + 8448ull * 1024 * 2 == WS_V && WS_V + 8448ull * 2048 * 2 == WS_RG && WS_RG + 8448ull * 2048 * 2 == WS_HQ, "map");
static_assert(WS_YT + 8448ull * 2048 * 4 <= WS_OH && WS_ACT + 8448ull * 5632 * 2 <= WS_GA && WS_END <= 541 * MiB, "map2");
constexpr int CW_BAR = 4096;
constexpr int CW_SS1 = 16384, CW_SS2 = 16384 + 8448;
static_assert((CW_SS2 + 8448) * 4 <= (int)CTL_ZERO_BYTES, "ctl");
constexpr int RING_BYTES = 131072, LDSCTL_OFF = RING_BYTES, MISC_OFF = LDSCTL_OFF + 320, LDS_BYTES = 147456;

#define GAS __attribute__((address_space(1)))
#define LAS __attribute__((address_space(3)))
typedef unsigned short bf16;
typedef unsigned v4u __attribute__((ext_vector_type(4)));
typedef unsigned v2u __attribute__((ext_vector_type(2)));
typedef float f32x4 __attribute__((ext_vector_type(4)));
typedef short bf16x8 __attribute__((ext_vector_type(8)));
typedef GAS unsigned gu32;
#define RLX_AGENT __ATOMIC_RELAXED, __HIP_MEMORY_SCOPE_AGENT
#define LDS_WAIT() asm volatile("s_waitcnt lgkmcnt(0)" ::: "memory")
#define VM_WAIT() asm volatile("s_waitcnt vmcnt(0)" ::: "memory")
__device__ __forceinline__ unsigned f2bf(float f) { unsigned u = __builtin_bit_cast(unsigned, f); return (u + 0x7fffu + ((u >> 16) & 1u)) >> 16; }
__device__ __forceinline__ unsigned pk2(float lo, float hi) { return f2bf(lo) | (f2bf(hi) << 16); }
__device__ __forceinline__ float bf2f(unsigned short b) { return __uint_as_float(((unsigned)b) << 16); }
namespace pg8 {
#define PG8_LAS __attribute__((address_space(3)))
typedef unsigned short bf16_t;
typedef short bf16x8 __attribute__((ext_vector_type(8)));
typedef float f32x4 __attribute__((ext_vector_type(4)));
typedef unsigned u32x4 __attribute__((ext_vector_type(4)));
constexpr int BM = 256, BK = 64, HALF = 128, HTB = HALF * BK * 2  , STAGE_BYTES = 8 * HTB, NXCD = 8, WGM = 8;

__host__ __device__ __forceinline__ int lds_byte(int r, int c) { const int st = (r >> 4) * 2 + (c >> 5), rr = r & 15, cc = c & 31, ob = rr * 64 + cc * 2; return st * 1024 + (ob ^ (((ob >> 9) & 1) << 5)); }
__host__ __device__ __forceinline__ void stage_rc(int b, int& R, int& C) { const int st = b / 1024, sb = b % 1024, swz = sb ^ (((sb >> 9) & 1) << 5); R = (st >> 1) * 16 + swz / 64; C = (st & 1) * 32 + (swz % 64) / 2; }
__host__ __device__ __forceinline__ int perm32(int rho) { const int n = rho >> 4, i = rho & 15; return 8 * (i >> 2) + 4 * n + (i & 3); }

struct Unit { int pm, pn; };
struct Gemm { const bf16_t* A; const bf16_t* Bt; int M, N, K; };

struct StaticOrder {
    int nM, nN, nwg, G, c;
    __host__ __device__ void init(int M, int N, int G_, int c_) { nM = M / BM; nN = N / BM; nwg = nM * nN; G = G_; c = c_; }
    __host__ __device__ bool next(int i, Unit& u) const {
        const long L = (long)i * G + c; if (L >= nwg) return false;
        int wgid = (int)L; { const int q = nwg / NXCD, r = nwg % NXCD, xcd = wgid % NXCD, off = wgid / NXCD; wgid = (xcd < r ? xcd * (q + 1) : r * (q + 1) + (xcd - r) * q) + off; }
        const int nig = WGM * nN, gid = wgid / nig, fm = gid * WGM, gsz = (nM - fm) < WGM ? (nM - fm) : WGM;
        u.pm = fm + ((wgid % nig) % gsz); u.pn = (wgid % nig) / gsz; return true;
    }
    __device__ __forceinline__ void a_ready(const Unit&) const {}
    __device__ __forceinline__ void done(const Unit&) const {}
};

__device__ __forceinline__ unsigned cvt_pk_bf16(float lo, float hi) { unsigned r; asm volatile("v_cvt_pk_bf16_f32 %0, %1, %2" : "=v"(r) : "v"(lo), "v"(hi)); return r; }
typedef float f32x2 __attribute__((ext_vector_type(2)));
typedef unsigned u32x2 __attribute__((ext_vector_type(2)));
__device__ __forceinline__ float sigm(float x) { return 1.0f / (1.0f + __expf(-x)); }
__device__ __forceinline__ f32x4 silu4(f32x4 v) { f32x4 o; o[0] = v[0] * sigm(v[0]); o[1] = v[1] * sigm(v[1]); o[2] = v[2] * sigm(v[2]); o[3] = v[3] * sigm(v[3]); return o; }
__device__ __forceinline__ f32x4 sigm4(f32x4 v) { f32x4 o; o[0] = sigm(v[0]); o[1] = sigm(v[1]); o[2] = sigm(v[2]); o[3] = sigm(v[3]); return o; }
__device__ __forceinline__ u32x4 pack8(f32x4 v0, f32x4 v1) { u32x4 w; w.x = cvt_pk_bf16(v0[0], v0[1]); w.y = cvt_pk_bf16(v0[2], v0[3]); w.z = cvt_pk_bf16(v1[0], v1[1]); w.w = cvt_pk_bf16(v1[2], v1[3]); return w; }
__device__ __forceinline__ u32x2 pack4(f32x4 v) { u32x2 w; w.x = cvt_pk_bf16(v[0], v[1]); w.y = cvt_pk_bf16(v[2], v[3]); return w; }
__device__ __forceinline__ f32x4 unpack4(u32x2 w) { f32x4 o; o[0] = __uint_as_float(w.x << 16); o[1] = __uint_as_float(w.x & 0xffff0000u); o[2] = __uint_as_float(w.y << 16); o[3] = __uint_as_float(w.y & 0xffff0000u); return o; }

struct EpiInProj {
    static constexpr bool PERM = true, AFTER_DRAIN = false;
    unsigned char* ws;
    __device__ __forceinline__ void operator()(const f32x4 (&acc)[2][2][4][2], const Unit& u, int wr, int wc, int fr, int fq) const {
        const int pn = u.pn, row0 = u.pm * BM + wr * 64 + fr;
        if (pn >= 28 && pn < 32) {
            float* Z = (float*)(ws + WS_LOGF); const int cs = (pn - 28) * 256 + wc * 32 + 8 * fq;
#pragma unroll
            for (int ai = 0; ai < 2; ++ai)
#pragma unroll
                for (int m = 0; m < 4; ++m) { const int r = row0 + ai * HALF + m * 16;
#pragma unroll
                    for (int bj = 0; bj < 2; ++bj)
#pragma unroll
                        for (int n = 0; n < 2; ++n) *(f32x4*)(Z + (size_t)r * 1024 + cs + bj * HALF + 4 * n) = acc[ai][bj][m][n]; }
        } else {
            size_t od; int pitch, p0, act; float sc = 1.0f;
            if (pn < 4) { od = WS_Q; pitch = 1024; p0 = 0; act = 0; } else if (pn < 8) { od = WS_K; pitch = 1024; p0 = 4; act = 0; sc = 0.08838834764831845f; }
            else if (pn < 16) { od = WS_V; pitch = 2048; p0 = 8; act = 0; } else if (pn < 24) { od = WS_RG; pitch = 2048; p0 = 16; act = 1; } else if (pn < 28) { od = WS_HQ; pitch = 1024; p0 = 24; act = 1; }
            else if (pn < 36) { od = WS_HI; pitch = 1024; p0 = 32; act = 0; } else if (pn < 40) { od = WS_HG; pitch = 1024; p0 = 36; act = 1; } else if (pn < 48) { od = WS_GA; pitch = 2048; p0 = 40; act = 2; } else { od = WS_GB; pitch = 2048; p0 = 48; act = 2; }
            bf16_t* dst = (bf16_t*)(ws + od);
            const int cs = (pn - p0) * 256 + wc * 32 + 8 * fq;
#pragma unroll
            for (int ai = 0; ai < 2; ++ai)
#pragma unroll
                for (int m = 0; m < 4; ++m) { const int r = row0 + ai * HALF + m * 16; bf16_t* rowp = dst + (size_t)r * pitch + cs;
#pragma unroll
                    for (int bj = 0; bj < 2; ++bj) { f32x4 v0 = acc[ai][bj][m][0] * sc, v1 = acc[ai][bj][m][1] * sc;
                        if (act == 1) { v0 = silu4(v0); v1 = silu4(v1); } else if (act == 2) { v0 = sigm4(v0); v1 = sigm4(v1); }
                        *(u32x4*)(rowp + bj * HALF) = pack8(v0, v1); } }
        }
    }
};
template <int SECOND> struct EpiGate {
    static constexpr bool PERM = true, AFTER_DRAIN = false;
    const bf16_t* G; float* YT; bf16_t* MG;
    __device__ __forceinline__ void operator()(const f32x4 (&acc)[2][2][4][2], const Unit& u, int wr, int wc, int fr, int fq) const {
        const int row0 = u.pm * BM + wr * 64 + fr, col0 = u.pn * BM + wc * 32 + 8 * fq;
#pragma unroll
        for (int ai = 0; ai < 2; ++ai)
#pragma unroll
            for (int m = 0; m < 4; ++m) { const size_t off = (size_t)(row0 + ai * HALF + m * 16) * 2048 + col0;
#pragma unroll
                for (int bj = 0; bj < 2; ++bj) { const u32x4 gw = *(const u32x4*)(G + off + bj * HALF);
                    f32x4 v0 = acc[ai][bj][m][0] * unpack4((u32x2){gw.x, gw.y}), v1 = acc[ai][bj][m][1] * unpack4((u32x2){gw.z, gw.w});
                    float* yp = YT + off + bj * HALF;
                    if (SECOND) { v0 += *(const f32x4*)yp; v1 += *(const f32x4*)(yp + 4); *(u32x4*)(MG + off + bj * HALF) = pack8(v0, v1); }
                    else { *(f32x4*)yp = v0; *(f32x4*)(yp + 4) = v1; } } }
        __builtin_amdgcn_s_waitcnt(0x0F70);
    }
};
struct EpiResid {
    static constexpr bool PERM = true, AFTER_DRAIN = false;
    const float* XP; const float* XS; float* OUT; bf16_t* XB; float* SS;
    __device__ __forceinline__ void operator()(const f32x4 (&acc)[2][2][4][2], const Unit& u, int wr, int wc, int fr, int fq) const {
        const int row0 = u.pm * BM + wr * 64 + fr, col0 = u.pn * BM + wc * 32 + 8 * fq;
#pragma unroll
        for (int ai = 0; ai < 2; ++ai)
#pragma unroll
            for (int m = 0; m < 4; ++m) { const int r = row0 + ai * HALF + m * 16; const bool live = r < 8320;
                const float* xi = (r < 8192 ? XP + (size_t)r * 2048 : XS + (size_t)(r - 8192) * 2048) + col0; float ss = 0.f;
#pragma unroll
                for (int bj = 0; bj < 2; ++bj) { f32x4 v0 = acc[ai][bj][m][0], v1 = acc[ai][bj][m][1];
                    if (live) { v0 += *(const f32x4*)(xi + bj * HALF); v1 += *(const f32x4*)(xi + bj * HALF + 4);
                        float* op = OUT + (size_t)r * 2048 + col0 + bj * HALF; *(f32x4*)op = v0; *(f32x4*)(op + 4) = v1; }
                    if (XB) *(u32x4*)(XB + (size_t)r * 2048 + col0 + bj * HALF) = pack8(v0, v1);
                    ss += (v0[0] * v0[0] + v0[1] * v0[1]) + (v0[2] * v0[2] + v0[3] * v0[3]) + (v1[0] * v1[0] + v1[1] * v1[1]) + (v1[2] * v1[2] + v1[3] * v1[3]); }
                ss += __shfl_xor(ss, 16); ss += __shfl_xor(ss, 32);
                if (fq == 0) atomicAdd(SS + r, ss); }
        __builtin_amdgcn_s_waitcnt(0x0F70);
    }
};
struct EpiSwiglu {
    static constexpr bool PERM = true, AFTER_DRAIN = false;
    const float* SS; bf16_t* ACT;
    __device__ __forceinline__ void operator()(const f32x4 (&acc)[2][2][4][2], const Unit& u, int wr, int wc, int fr, int fq) const {
        const int row0 = u.pm * BM + wr * 64 + fr, col0 = u.pn * HALF + wc * 32 + 8 * fq;
        float ssv[2][4];
#pragma unroll
        for (int ai = 0; ai < 2; ++ai)
#pragma unroll
            for (int m = 0; m < 4; ++m) ssv[ai][m] = SS[row0 + ai * HALF + m * 16];
        __builtin_amdgcn_s_waitcnt(0x0F70);
#pragma unroll
        for (int ai = 0; ai < 2; ++ai)
#pragma unroll
            for (int m = 0; m < 4; ++m) { const int r = row0 + ai * HALF + m * 16; const float r2 = 1.0f / sqrtf(ssv[ai][m] * (1.0f / 2048.0f) + 1e-6f);
                const f32x4 g0 = acc[ai][0][m][0] * r2, g1 = acc[ai][0][m][1] * r2, u0 = acc[ai][1][m][0] * r2, u1 = acc[ai][1][m][1] * r2;
                *(u32x4*)(ACT + (size_t)r * 5632 + col0) = pack8(silu4(g0) * u0, silu4(g1) * u1); }
    }
};
template <class Epi, class Sched, bool ALIGN_EPI = false, bool SP2 = false>
__device__ __forceinline__ void gemm_phase(PG8_LAS unsigned char* lds, const Gemm g, const Sched& S, const Epi& E) {
    const int tid = threadIdx.x, wid = __builtin_amdgcn_readfirstlane(tid >> 6), lane = tid & 63, wr = wid >> 2, wc = wid & 3, fr = lane & 15, fq = lane >> 4;
    const int K = g.K, nt = K / BK;
    unsigned voffA[2], voffB[2];
#pragma unroll
    for (int i = 0; i < 2; ++i) { int R, C; stage_rc(tid * 16 + i * 8192, R, C); const int Rb = Epi::PERM ? ((R & ~31) + perm32(R & 31)) : R;
        voffA[i] = (unsigned)(R * K + C) * 2u; voffB[i] = (unsigned)(Rb * K + C) * 2u; }
    const size_t kstep = (size_t)(BK * 2);
    const size_t hstep = (size_t)HALF * K * 2;
    const size_t tstep = 2 * hstep;
    const unsigned ldsw = (unsigned)wid * 1024u;
    const int aoff = lds_byte(wr * 64 + fr, fq * 8), boff = lds_byte(wc * 32 + fr, fq * 8);
#define PG8_SA(b, h) (((b) * 2 + (h)) * HTB)
#define PG8_SB(b, h) ((4 + (b) * 2 + (h)) * HTB)
#define PG8_STAGE(bufoff, gbase, voff) do { _Pragma("unroll") for (int _i = 0; _i < 2; ++_i) \
        __builtin_amdgcn_global_load_lds((const unsigned*)((const char*)(gbase) + (voff)[_i]), (PG8_LAS unsigned*)(lds + (bufoff) + ldsw + _i * 8192), 16, 0, 0); } while (0)
#define PG8_LDA(dst, b, h) do { _Pragma("unroll") for (int m = 0; m < 4; ++m) _Pragma("unroll") for (int k = 0; k < 2; ++k) dst[m][k] = *(const PG8_LAS bf16x8*)(lds + PG8_SA(b, h) + aoff + m * 2048 + k * 1024); } while (0)
#define PG8_LDB(dst, b, h) do { _Pragma("unroll") for (int n = 0; n < 2; ++n) _Pragma("unroll") for (int k = 0; k < 2; ++k) dst[n][k] = *(const PG8_LAS bf16x8*)(lds + PG8_SB(b, h) + boff + n * 2048 + k * 1024); } while (0)
#define PG8_MMA(ai, bj, At, Bt) do { __builtin_amdgcn_s_setprio(1); _Pragma("unroll") for (int m = 0; m < 4; ++m) _Pragma("unroll") for (int n = 0; n < 2; ++n) _Pragma("unroll") for (int k = 0; k < 2; ++k) \
        acc[ai][bj][m][n] = __builtin_amdgcn_mfma_f32_16x16x32_bf16(Bt[n][k], At[m][k], acc[ai][bj][m][n], 0, 0, 0); __builtin_amdgcn_s_setprio(0); } while (0)
#define PG8_WAIT_V(n) asm volatile("s_waitcnt vmcnt(" #n ")" ::: "memory")
#define PG8_WAIT_L(n) asm volatile("s_waitcnt lgkmcnt(" #n ")" ::: "memory")
#define PG8_BAR __builtin_amdgcn_s_barrier()
#define PG8_SCHED __builtin_amdgcn_sched_barrier(0)
    Unit cur, nxt; int ui = 0;
    if (!S.next(0, cur)) return;
    f32x4 acc[2][2][4][2];
#pragma unroll
    for (int a = 0; a < 2; ++a)
#pragma unroll
        for (int b = 0; b < 2; ++b)
#pragma unroll
            for (int m = 0; m < 4; ++m)
#pragma unroll
                for (int n = 0; n < 2; ++n) acc[a][b][m][n] = (f32x4){0.f, 0.f, 0.f, 0.f};
    bf16x8 At[4][2], B0[2][2], B1[2][2];
    const char* cA = (const char*)g.A + (size_t)cur.pm * tstep; const char* cB = (const char*)g.Bt + (size_t)cur.pn * tstep;
    S.a_ready(cur);
    if constexpr (SP2) {
        PG8_STAGE(PG8_SB(0, 0), cB, voffB); PG8_STAGE(PG8_SB(0, 1), cB + hstep, voffB); PG8_STAGE(PG8_SA(0, 0), cA, voffA); PG8_STAGE(PG8_SA(0, 1), cA + hstep, voffA);
        if (wr == 1) PG8_BAR;
        PG8_WAIT_V(2); PG8_BAR;
        PG8_STAGE(PG8_SB(1, 0), cB + kstep, voffB); PG8_STAGE(PG8_SA(1, 0), cA + kstep, voffA); PG8_STAGE(PG8_SB(1, 1), cB + hstep + kstep, voffB);
        PG8_WAIT_V(6); PG8_BAR;
    } else {
        PG8_STAGE(PG8_SB(0, 0), cB, voffB); PG8_STAGE(PG8_SA(0, 0), cA, voffA); PG8_STAGE(PG8_SB(0, 1), cB + hstep, voffB); PG8_STAGE(PG8_SA(0, 1), cA + hstep, voffA);
        if (wr == 1) PG8_BAR;
        PG8_WAIT_V(4); PG8_BAR;
        PG8_STAGE(PG8_SB(1, 0), cB + kstep, voffB); PG8_STAGE(PG8_SA(1, 0), cA + kstep, voffA); PG8_STAGE(PG8_SB(1, 1), cB + hstep + kstep, voffB);
        PG8_WAIT_V(6); PG8_BAR;
    }
    for (;;) {
        const bool has_next = S.next(ui + 1, nxt);
        const char* nA = has_next ? (const char*)g.A + (size_t)nxt.pm * tstep : cA; const char* nB = has_next ? (const char*)g.Bt + (size_t)nxt.pn * tstep : cB;
        for (int t = 0; t < nt; t += 2) {
            const bool last = (t == nt - 2);
            const char* a1 = cA + (size_t)(t + 1) * kstep;
            const char* a2 = last ? nA : cA + (size_t)(t + 2) * kstep; const char* b2 = last ? nB : cB + (size_t)(t + 2) * kstep;
            const char* a3 = a2 + kstep; const char* b3 = b2 + kstep;
            if (last && has_next) S.a_ready(nxt);
            if constexpr (SP2) {
            PG8_LDB(B0, 0, 0); PG8_LDB(B1, 0, 1); PG8_SCHED; PG8_LDA(At, 0, 0); PG8_STAGE(PG8_SA(1, 1), a1 + hstep, voffA);
            PG8_WAIT_V(8); PG8_WAIT_L(0); PG8_BAR; PG8_MMA(0, 0, At, B0); PG8_MMA(0, 1, At, B1); PG8_BAR; PG8_SCHED;
            PG8_LDA(At, 0, 1); PG8_STAGE(PG8_SB(0, 0), b2, voffB); PG8_STAGE(PG8_SB(0, 1), b2 + hstep, voffB); PG8_STAGE(PG8_SA(0, 0), a2, voffA);
            PG8_WAIT_V(8); PG8_WAIT_L(0); PG8_BAR; PG8_MMA(1, 0, At, B0); PG8_MMA(1, 1, At, B1); PG8_BAR; PG8_SCHED;
            PG8_LDB(B0, 1, 0); PG8_LDB(B1, 1, 1); PG8_SCHED; PG8_LDA(At, 1, 0); PG8_STAGE(PG8_SA(0, 1), a2 + hstep, voffA);
            PG8_WAIT_V(8); PG8_WAIT_L(0); PG8_BAR; PG8_MMA(0, 0, At, B0); PG8_MMA(0, 1, At, B1); PG8_BAR; PG8_SCHED;
            PG8_LDA(At, 1, 1); PG8_STAGE(PG8_SB(1, 0), b3, voffB); PG8_STAGE(PG8_SB(1, 1), b3 + hstep, voffB); PG8_STAGE(PG8_SA(1, 0), a3, voffA);
            PG8_WAIT_V(8); PG8_WAIT_L(0); PG8_BAR; PG8_MMA(1, 0, At, B0); PG8_MMA(1, 1, At, B1); PG8_BAR; PG8_SCHED;
            } else {
            PG8_LDB(B0, 0, 0); PG8_SCHED; PG8_LDA(At, 0, 0); PG8_STAGE(PG8_SA(1, 1), a1 + hstep, voffA);
            PG8_WAIT_L(8); PG8_BAR; PG8_WAIT_L(0); PG8_MMA(0, 0, At, B0); PG8_BAR; PG8_SCHED;
            PG8_LDB(B1, 0, 1); PG8_STAGE(PG8_SB(0, 0), b2, voffB);
            PG8_BAR; PG8_WAIT_L(0); PG8_MMA(0, 1, At, B1); PG8_BAR;
            PG8_LDA(At, 0, 1); PG8_STAGE(PG8_SA(0, 0), a2, voffA);
            PG8_BAR; PG8_WAIT_L(0); PG8_MMA(1, 0, At, B0); PG8_BAR; PG8_SCHED;
            PG8_STAGE(PG8_SB(0, 1), b2 + hstep, voffB);
            PG8_WAIT_V(6); PG8_BAR; PG8_MMA(1, 1, At, B1); PG8_BAR;
            PG8_LDB(B0, 1, 0); PG8_SCHED; PG8_LDA(At, 1, 0); PG8_STAGE(PG8_SA(0, 1), a2 + hstep, voffA);
            PG8_WAIT_L(8); PG8_BAR; PG8_WAIT_L(0); PG8_MMA(0, 0, At, B0); PG8_BAR; PG8_SCHED;
            PG8_LDB(B1, 1, 1); PG8_STAGE(PG8_SB(1, 0), b3, voffB);
            PG8_BAR; PG8_WAIT_L(0); PG8_MMA(0, 1, At, B1); PG8_BAR;
            PG8_LDA(At, 1, 1); PG8_STAGE(PG8_SA(1, 0), a3, voffA);
            PG8_BAR; PG8_WAIT_L(0); PG8_MMA(1, 0, At, B0); PG8_BAR; PG8_SCHED;
            PG8_STAGE(PG8_SB(1, 1), b3 + hstep, voffB);
            PG8_WAIT_V(6); PG8_BAR; PG8_MMA(1, 1, At, B1); PG8_BAR;
            }
        }
        if constexpr (ALIGN_EPI) { if (wr == 0) PG8_BAR; }
        if constexpr (!Epi::AFTER_DRAIN) { E(acc, cur, wr, wc, fr, fq); S.done(cur); }
        if (!has_next) break;
#pragma unroll
        for (int a = 0; a < 2; ++a)
#pragma unroll
            for (int b = 0; b < 2; ++b)
#pragma unroll
                for (int m = 0; m < 4; ++m)
#pragma unroll
                    for (int n = 0; n < 2; ++n) acc[a][b][m][n] = (f32x4){0.f, 0.f, 0.f, 0.f};
        cur = nxt; cA = nA; cB = nB; ++ui;
        if constexpr (ALIGN_EPI) { if (wr == 1) PG8_BAR; }
    }
    PG8_WAIT_V(0);
    if constexpr (!ALIGN_EPI) { if (wr == 0) PG8_BAR; }
    PG8_BAR;
    if constexpr (Epi::AFTER_DRAIN) { E.fused(acc, cur, wr, wc, fr, fq, lds, wid, lane); S.done(cur); }
#undef PG8_SA
#undef PG8_SB
#undef PG8_STAGE
#undef PG8_LDA
#undef PG8_LDB
#undef PG8_MMA
#undef PG8_WAIT_V
#undef PG8_WAIT_L
#undef PG8_BAR
#undef PG8_SCHED
}
}
#define XB_TMO      128
#define XB_XCNT(j)  (256  + 64 * (j))
#define XB_XSUB(j)  (1280 + 64 * (j))
#define XB_XGEN(j)  (2304 + 64 * (j))
#define XB_TOP      3328
#define XB_TOPGEN   3392
#define XCD_BAR_WORDS 3456
#define XB_SPIN_CAP (1u << 18)

__device__ __forceinline__ unsigned xb_ld(unsigned* p)              { return __hip_atomic_load(p, __ATOMIC_RELAXED, __HIP_MEMORY_SCOPE_AGENT); }
__device__ __forceinline__ unsigned xb_add(unsigned* p, unsigned v) { return __hip_atomic_fetch_add(p, v, __ATOMIC_RELAXED, __HIP_MEMORY_SCOPE_AGENT); }
__device__ __forceinline__ unsigned xb_xcc_id() { return (unsigned)__builtin_amdgcn_s_getreg((3 << 11) | 20) & 0xFu; }
#define XB_SPIN(cond, bar) do { unsigned _sp = 0; while (cond) { __builtin_amdgcn_s_sleep(1); \
    if ((++_sp & 255u) == 0u) { if (xb_ld(&(bar)[XB_TMO])) break; if (_sp > XB_SPIN_CAP) { atomicAdd(&(bar)[XB_TMO], 1u); break; } } } } while (0)

struct XcdBarrier {
    unsigned* bar; unsigned x;
    volatile LAS unsigned* st;
};

__device__ __forceinline__ XcdBarrier xcd_barrier_post(unsigned* bar, volatile LAS unsigned* st) {
    XcdBarrier b; b.bar = bar; b.x = xb_xcc_id(); b.st = st;
    if (threadIdx.x == 0) (void)xb_add(&bar[XB_XCNT(b.x)], 1u);
    return b;
}
__device__ __forceinline__ void xcd_barrier_complete(unsigned* bar, unsigned x, unsigned& nloc, unsigned& nx) {
    const unsigned G = gridDim.x * gridDim.y * gridDim.z;
    unsigned sum, cnt, mine, sp = 0u;
    for (;;) {
        sum = 0u; cnt = 0u; mine = 0u;
#pragma unroll
        for (unsigned j = 0; j < 16; ++j) { const unsigned c = xb_ld(&bar[XB_XCNT(j)]); sum += c; cnt += (c > 0u) ? 1u : 0u; mine = (j == x) ? c : mine; }
        if (sum == G) break;
        __builtin_amdgcn_s_sleep(1);
        if ((++sp & 255u) == 0u) { if (xb_ld(&bar[XB_TMO])) break; if (sp > XB_SPIN_CAP) { atomicAdd(&bar[XB_TMO], 1u); break; } }
    }
    nloc = mine > 0u ? mine : 1u; nx = cnt > 0u ? cnt : 1u;
}

__device__ __forceinline__ void xcd_barrier(const XcdBarrier& b) {
    asm volatile("s_waitcnt vmcnt(0)" ::: "memory");
    __syncthreads();
    if (threadIdx.x == 0) {
        unsigned* bar = b.bar;
        __builtin_amdgcn_s_waitcnt(0);
        unsigned nloc = b.st[0], nx = b.st[1];
        if (nloc == 0u) { xcd_barrier_complete(bar, b.x, nloc, nx); b.st[0] = nloc; b.st[1] = nx; }
        const unsigned old = xb_add(&bar[XB_XSUB(b.x)], 1u);
        const unsigned gen = old / nloc;
        if (old + 1u == (gen + 1u) * nloc) {
            __builtin_amdgcn_fence(__ATOMIC_RELEASE, "agent");
            asm volatile("s_waitcnt vmcnt(0)" ::: "memory");
            const unsigned og = xb_add(&bar[XB_TOP], 1u);
            const unsigned tg = og / nx;
            if (og + 1u == (tg + 1u) * nx) xb_add(&bar[XB_TOPGEN], 1u);
            else XB_SPIN(xb_ld(&bar[XB_TOPGEN]) == tg, bar);
            __builtin_amdgcn_fence(__ATOMIC_ACQUIRE, "agent");
            xb_add(&bar[XB_XGEN(b.x)], 1u);
            asm volatile("s_waitcnt vmcnt(0)" ::: "memory");
        } else {
            XB_SPIN(xb_ld(&bar[XB_XGEN(b.x)]) == gen, bar);
            __builtin_amdgcn_fence(__ATOMIC_ACQUIRE, "agent");
            asm volatile("s_waitcnt vmcnt(0)" ::: "memory");
        }
    }
    __syncthreads();
}
struct Frame {
    LAS unsigned char* lds; volatile LAS unsigned* MISC; gu32* ctl;
    int tid, lane, wave, vcu, G;
    float* out; unsigned char* ws;
};
__device__ __forceinline__ float wave_sum(float v) {
#pragma unroll
    for (int o = 1; o < 64; o <<= 1) v += __shfl_xor(v, o);
    return v;
}
template <int MODE> __device__ __forceinline__ int rowmap(int n) {
    if (MODE == 1) { if (n >= 2048) return n; const int j = n & 127, hb = n & ~127; return hb + (j < 64 ? 8 * (j >> 2) + (j & 3) : 8 * ((j - 64) >> 2) + 4 + (j & 3)); }
    if (MODE == 2) { return n < DFF ? (n >> 7) * 256 + (n & 127) : ((n - DFF) >> 7) * 256 + 128 + ((n - DFF) & 127); }
    return n;
}
template <int MODE> __device__ __forceinline__ void p0_transpose_item(const float* W, int K, int N, bf16* WT, const float* g, LAS float* scr, int item, int lane) {
    const int nblk = N / 32, kb = item / nblk, nb = item % nblk, k0 = 64 * kb, n0 = 32 * nb;
#pragma unroll 8
    for (int i = 0; i < 32; ++i) { const int kk = 2 * i + (lane >> 5); float w = W[(size_t)(k0 + kk) * N + n0 + (lane & 31)]; if (g) w *= g[k0 + kk]; scr[kk * 33 + (lane & 31)] = w; }
    LDS_WAIT(); asm volatile("" ::: "memory");
    const int c = lane & 7;
#pragma unroll
    for (int j = 0; j < 4; ++j) { const int n = (lane >> 3) + 8 * j; const LAS float* s = scr + (8 * c) * 33 + n;
        v4u o; o.x = pk2(s[0 * 33], s[1 * 33]); o.y = pk2(s[2 * 33], s[3 * 33]); o.z = pk2(s[4 * 33], s[5 * 33]); o.w = pk2(s[6 * 33], s[7 * 33]);
        *(GAS v4u*)(WT + (size_t)rowmap<MODE>(n0 + n) * K + k0 + 8 * c) = o; }
    LDS_WAIT(); asm volatile("" ::: "memory");
}
struct Args { const float* in[15]; float* out; unsigned char* ws; int ph_lo, ph_hi, use_bar, pad; };
__device__ __forceinline__ void p0_prologue(Frame& F, const Args& A) {
    LAS float* scr = (LAS float*)(F.lds + F.wave * 16384);
    const int gw = F.vcu * NWAVES + F.wave, NGW = F.G * NWAVES;
    unsigned char* ws = F.ws;
    constexpr int I_IN = 32 * (NIN / 32), I_RO = 32 * 64, I_HO = 16 * 64, I_OUT = 32 * 64, I_FI = 32 * (2 * DFF / 32), I_FO = (DFF / 64) * 64;
    constexpr int NITEMS = I_IN + I_RO + I_HO + I_OUT + I_FI + I_FO;
    for (int it = gw; it < NITEMS; it += NGW) {
        int r = it;
        if (r < I_IN) { p0_transpose_item<0>(A.in[4], 2048, NIN, (bf16*)(ws + WS_WIN), A.in[8], scr, r, F.lane); continue; } r -= I_IN;
        if (r < I_RO) { p0_transpose_item<0>(A.in[5], 2048, 2048, (bf16*)(ws + WS_WRO), nullptr, scr, r, F.lane); continue; } r -= I_RO;
        if (r < I_HO) { p0_transpose_item<0>(A.in[6], 1024, 2048, (bf16*)(ws + WS_WHO), nullptr, scr, r, F.lane); continue; } r -= I_HO;
        if (r < I_OUT) { p0_transpose_item<0>(A.in[7], 2048, 2048, (bf16*)(ws + WS_WOUT), nullptr, scr, r, F.lane); continue; } r -= I_OUT;
        if (r < I_FI) { p0_transpose_item<2>(A.in[12], 2048, 2 * DFF, (bf16*)(ws + WS_WFI), A.in[9], scr, r, F.lane); continue; } r -= I_FI;
        p0_transpose_item<0>(A.in[13], DFF, 2048, (bf16*)(ws + WS_WFO), nullptr, scr, r, F.lane);
    }
    bf16* XB = (bf16*)(ws + WS_XB);
    for (int m = gw; m < MPAD; m += NGW) {
        GAS unsigned long long* o8 = (GAS unsigned long long*)(XB + (size_t)m * 2048) + F.lane;
        if (m < MROWS) {
            const float* xrow = m < 8192 ? A.in[0] + (size_t)m * 2048 : A.in[1] + (size_t)(m - 8192) * 2048;
            const GAS f32x4* xr = (const GAS f32x4*)xrow + F.lane;
            f32x4 v[8]; float s = 0.f;
#pragma unroll
            for (int j = 0; j < 8; ++j) { v[j] = xr[64 * j]; s += (v[j].x * v[j].x + v[j].y * v[j].y) + (v[j].z * v[j].z + v[j].w * v[j].w); }
            const float rr = 1.0f / sqrtf(wave_sum(s) * (1.0f / 2048.0f) + EPS);
#pragma unroll
            for (int j = 0; j < 8; ++j) o8[64 * j] = (unsigned long long)pk2(v[j].x * rr, v[j].y * rr) | ((unsigned long long)pk2(v[j].z * rr, v[j].w * rr) << 32);
        } else {
#pragma unroll
            for (int j = 0; j < 8; ++j) o8[64 * j] = 0ull;
        }
    }
    { float* COS = (float*)(ws + WS_COS); float* SIN = (float*)(ws + WS_SIN);
      for (int i = (F.vcu * NWAVES + F.wave) * 64 + F.lane; i < 2049 * 64; i += F.G * NWAVES * 64) { const int p = i >> 6, j = i & 63; const int pos = p < 2048 ? p : 16384;
          const float inv = powf(10000.0f, -(float)j / 64.0f); const float ang = (float)pos * inv; float sn, cs; sincosf(ang, &sn, &cs); COS[i] = cs; SIN[i] = sn; } }
    { float* LB = (float*)(ws + WS_LB); const int i = (F.vcu * NWAVES + F.wave) * 64 + F.lane; if (i < 1024) { const float l0 = A.in[11][i], l1 = A.in[11][1024 + i]; LB[i] = 1.0f / (1.0f + expf(l1 - l0)); } }
}
typedef short bf16x4v __attribute__((ext_vector_type(4)));
#define MFMA16(a, b, c) __builtin_amdgcn_mfma_f32_16x16x32_bf16((a), (b), (c), 0, 0, 0)
constexpr int TP = 136;
constexpr size_t OUT_YS = 8192ull * 2048, OUT_SRP = 8320ull * 2048, OUT_SHP = OUT_SRP + 4ull * 8 * 128 * 256, OUT_SRS = OUT_SHP + 4ull * 8 * 128 * 128, OUT_SHS = OUT_SRS + 128ull * 8 * 128 * 256;
__device__ __forceinline__ float lg2gamma(int h) { return log2f(1.0f - exp2f(-5.0f - (float)h)); }
__device__ __forceinline__ float bfe(const v4u& w, int j) { const unsigned x = w[j >> 1]; return __uint_as_float((j & 1) ? (x & 0xffff0000u) : (x << 16)); }
__device__ __forceinline__ bf16x8 pack_f8(const float* v) { v4u w; w.x = pk2(v[0], v[1]); w.y = pk2(v[2], v[3]); w.z = pk2(v[4], v[5]); w.w = pk2(v[6], v[7]); return __builtin_bit_cast(bf16x8, w); }

__device__ __forceinline__ void p2_ret_item(Frame& F, int item) {
    unsigned char* ws = F.ws;
    const int c = item & 15, h = (item >> 4) & 7, b = item >> 7, r0 = b * 2048 + c * 128;
    const int w = F.wave, l15 = F.lane & 15, g = F.lane >> 4;
    LAS bf16* KT = (LAS bf16*)F.lds; LAS bf16* VT = KT + 128 * TP;
    const bf16* Kg = (const bf16*)(ws + WS_K); const bf16* Vg = (const bf16*)(ws + WS_V);
    const float* COS = (const float*)(ws + WS_COS); const float* SIN = (const float*)(ws + WS_SIN);
    const float lg = lg2gamma(h);
    __syncthreads();
#pragma unroll
    for (int i = 0; i < 2; ++i) { const int u = F.tid + 512 * i, m = u & 127, d0 = (u >> 7) * 8;
        const bf16* kp = Kg + (size_t)(r0 + m) * 1024 + h * 128 + d0; const v4u a = *(const v4u*)kp, bb = *(const v4u*)(kp + 64);
        const int pos = c * 128 + m; const f32x4 c0 = *(const f32x4*)(COS + pos * 64 + d0), c1 = *(const f32x4*)(COS + pos * 64 + d0 + 4), s0 = *(const f32x4*)(SIN + pos * 64 + d0), s1 = *(const f32x4*)(SIN + pos * 64 + d0 + 4);
        const float dec = exp2f((float)(127 - m) * lg);
#pragma unroll
        for (int j = 0; j < 8; ++j) { const float x1 = bfe(a, j), x2 = bfe(bb, j), cj = j < 4 ? c0[j & 3] : c1[j & 3], sj = j < 4 ? s0[j & 3] : s1[j & 3];
            KT[(d0 + j) * TP + m] = (bf16)f2bf((x1 * cj - x2 * sj) * dec); KT[(64 + d0 + j) * TP + m] = (bf16)f2bf((x2 * cj + x1 * sj) * dec); } }
#pragma unroll
    for (int i = 0; i < 8; ++i) { const int u = F.tid + 512 * i, m = u & 127, e0 = (u >> 7) * 8;
        const v4u a = *(const v4u*)(Vg + (size_t)(r0 + m) * 2048 + h * 256 + e0);
#pragma unroll
        for (int j = 0; j < 8; ++j) VT[(e0 + j) * TP + m] = (bf16)((a[j >> 1] >> (16 * (j & 1))) & 0xffffu); }
    __syncthreads();
    f32x4 acc[8][2];
#pragma unroll
    for (int dt = 0; dt < 8; ++dt) { acc[dt][0] = (f32x4){0.f, 0.f, 0.f, 0.f}; acc[dt][1] = (f32x4){0.f, 0.f, 0.f, 0.f}; }
#pragma unroll
    for (int ks = 0; ks < 4; ++ks) {
        const bf16x8 b0 = *(const LAS bf16x8*)&VT[(32 * w + l15) * TP + 32 * ks + 8 * g], b1 = *(const LAS bf16x8*)&VT[(32 * w + 16 + l15) * TP + 32 * ks + 8 * g];
#pragma unroll
        for (int dt = 0; dt < 8; ++dt) { const bf16x8 af = *(const LAS bf16x8*)&KT[(16 * dt + l15) * TP + 32 * ks + 8 * g];
            acc[dt][0] = MFMA16(af, b0, acc[dt][0]); acc[dt][1] = MFMA16(af, b1, acc[dt][1]); } }
    float* out = (float*)(ws + WS_KVLOC) + (size_t)item * 256 * 128;
#pragma unroll
    for (int dt = 0; dt < 8; ++dt)
#pragma unroll
        for (int et = 0; et < 2; ++et) *(f32x4*)(out + (32 * w + 16 * et + l15) * 128 + 16 * dt + 4 * g) = acc[dt][et];
}
__device__ __forceinline__ void p2_hg_item(Frame& F, int item) {
    unsigned char* ws = F.ws;
    const int sc = item & 15, h = (item >> 4) & 7, b = item >> 7, r0 = b * 2048 + sc * 128;
    const int w = F.wave, l15 = F.lane & 15, g = F.lane >> 4;
    LAS bf16* KT = (LAS bf16*)F.lds; LAS bf16* VT = KT + 128 * TP; LAS float* LQ = (LAS float*)(VT + 128 * TP);
    const float* Z = (const float*)(ws + WS_LOGF); const bf16* HI = (const bf16*)(ws + WS_HI); const float* LB = (const float*)(ws + WS_LB);
    __syncthreads();
    const int d = F.tid & 127, q = F.tid >> 7; const float oml = 1.0f - LB[h * 128 + d];
    float lf[32], kin[32]; float L = 0.f;
#pragma unroll
    for (int i = 0; i < 32; ++i) { const float z = Z[(size_t)(r0 + 32 * q + i) * 1024 + h * 128 + d]; kin[i] = oml / (1.0f + __expf(z)); lf[i] = log1pf(-kin[i]); L += lf[i]; }
    LQ[q * 128 + d] = L;
#pragma unroll
    for (int i = 0; i < 4; ++i) { const int u = F.tid + 512 * i, m = u & 127, e0 = (u >> 7) * 8;
        const v4u a = *(const v4u*)(HI + (size_t)(r0 + m) * 1024 + h * 128 + e0);
#pragma unroll
        for (int j = 0; j < 8; ++j) VT[(e0 + j) * TP + m] = (bf16)((a[j >> 1] >> (16 * (j & 1))) & 0xffffu); }
    __syncthreads();
    float run = 0.f;
#pragma unroll
    for (int q2 = 1; q2 < 4; ++q2) if (q2 > q) run += LQ[q2 * 128 + d];
#pragma unroll
    for (int blk = 3; blk >= 0; --blk) { float v[8];
#pragma unroll
        for (int jj = 7; jj >= 0; --jj) { const int i = 8 * blk + jj; v[jj] = kin[i] * __expf(run); run += lf[i]; }
        *(LAS bf16x8*)&KT[d * TP + 32 * q + 8 * blk] = pack_f8(v); }
    if (q == 0) ((float*)(ws + WS_BTOT))[item * 128 + d] = run;
    __syncthreads();
    f32x4 acc[8];
#pragma unroll
    for (int dt = 0; dt < 8; ++dt) acc[dt] = (f32x4){0.f, 0.f, 0.f, 0.f};
#pragma unroll
    for (int ks = 0; ks < 4; ++ks) { const bf16x8 b0 = *(const LAS bf16x8*)&VT[(16 * w + l15) * TP + 32 * ks + 8 * g];
#pragma unroll
        for (int dt = 0; dt < 8; ++dt) { const bf16x8 af = *(const LAS bf16x8*)&KT[(16 * dt + l15) * TP + 32 * ks + 8 * g]; acc[dt] = MFMA16(af, b0, acc[dt]); } }
    float* out = (float*)(ws + WS_HSLOC) + (size_t)item * 128 * 128;
#pragma unroll
    for (int dt = 0; dt < 8; ++dt) *(f32x4*)(out + (16 * w + l15) * 128 + 16 * dt + 4 * g) = acc[dt];
}
__device__ __forceinline__ void p2_sret_item(Frame& F, const Args& A, int it) {
    unsigned char* ws = F.ws; const int h = it & 7, b = it >> 3, r = 8192 + b;
    LAS float* qs = (LAS float*)F.lds; LAS float* ks = qs + 128; LAS float* vs = ks + 128; LAS float* ored = vs + 256;
    const bf16* Q = (const bf16*)(ws + WS_Q); const bf16* K = (const bf16*)(ws + WS_K); const bf16* V = (const bf16*)(ws + WS_V);
    __syncthreads();
    if (F.tid < 64) { const int d = F.tid; const float cs = ((const float*)(ws + WS_COS))[2048 * 64 + d], sn = ((const float*)(ws + WS_SIN))[2048 * 64 + d];
        const float q1 = bf2f(Q[(size_t)r * 1024 + h * 128 + d]), q2 = bf2f(Q[(size_t)r * 1024 + h * 128 + 64 + d]), k1 = bf2f(K[(size_t)r * 1024 + h * 128 + d]), k2 = bf2f(K[(size_t)r * 1024 + h * 128 + 64 + d]);
        qs[d] = q1 * cs - q2 * sn; qs[d + 64] = q2 * cs + q1 * sn; ks[d] = k1 * cs - k2 * sn; ks[d + 64] = k2 * cs + k1 * sn; }
    else if (F.tid >= 256) { const int e = F.tid - 256; vs[e] = bf2f(V[(size_t)r * 2048 + h * 256 + e]); }
    __syncthreads();
    const float gam = 1.0f - exp2f(-5.0f - (float)h);
    const int e4 = F.tid & 63, dq = F.tid >> 6;
    const float* Sin = A.in[2] + ((size_t)(b * 8 + h) * 128) * 256; float* Sout = F.out + OUT_SRS + ((size_t)(b * 8 + h) * 128) * 256;
    const f32x4 v4 = *(const LAS f32x4*)&vs[4 * e4]; f32x4 o = (f32x4){0.f, 0.f, 0.f, 0.f};
    f32x4 s[16];
#pragma unroll
    for (int i = 0; i < 16; ++i) s[i] = *(const f32x4*)(Sin + (size_t)(16 * dq + i) * 256 + 4 * e4);
#pragma unroll
    for (int i = 0; i < 16; ++i) { const int d = 16 * dq + i; s[i] = s[i] * gam + v4 * ks[d]; *(f32x4*)(Sout + (size_t)d * 256 + 4 * e4) = s[i]; o += s[i] * qs[d]; }
    *(LAS f32x4*)&ored[dq * 256 + 4 * e4] = o;
    __syncthreads();
    if (F.wave == 0) { float oo[4]; float ss = 0.f;
#pragma unroll
        for (int k = 0; k < 4; ++k) { const int e = F.lane + 64 * k; float t = 0.f;
#pragma unroll
            for (int j = 0; j < 8; ++j) t += ored[j * 256 + e];
            oo[k] = t; ss += t * t; }
        const float rr = 1.0f / sqrtf(wave_sum(ss) * (1.0f / 256.0f) + EPS);
        const bf16* RG = (const bf16*)(ws + WS_RG); bf16* OR = (bf16*)(ws + WS_OR);
#pragma unroll
        for (int k = 0; k < 4; ++k) { const size_t ix = (size_t)r * 2048 + h * 256 + F.lane + 64 * k; OR[ix] = (bf16)f2bf(oo[k] * rr * bf2f(RG[ix])); } }
}
__device__ __forceinline__ void p2_shg_item(Frame& F, const Args& A, int it) {
    unsigned char* ws = F.ws; const int h = it & 7, b = it >> 3, r = 8192 + b;
    LAS float* qs = (LAS float*)F.lds; LAS float* fs = qs + 128; LAS float* kn = fs + 128; LAS float* vs = kn + 128; LAS float* ored = vs + 128;
    __syncthreads();
    if (F.tid < 128) { const int d = F.tid; const size_t ix = (size_t)r * 1024 + h * 128 + d; const float z = ((const float*)(ws + WS_LOGF))[ix]; const float lb = ((const float*)(ws + WS_LB))[h * 128 + d];
        const float kin = (1.0f - lb) / (1.0f + __expf(z)); kn[d] = kin; fs[d] = 1.0f - kin; qs[d] = bf2f(((const bf16*)(ws + WS_HQ))[ix]); vs[d] = bf2f(((const bf16*)(ws + WS_HI))[ix]); }
    __syncthreads();
    const int e4 = F.tid & 31, dq = F.tid >> 5;
    const float* Sin = A.in[3] + ((size_t)(b * 8 + h) * 128) * 128; float* Sout = F.out + OUT_SHS + ((size_t)(b * 8 + h) * 128) * 128;
    const f32x4 v4 = *(const LAS f32x4*)&vs[4 * e4]; f32x4 o = (f32x4){0.f, 0.f, 0.f, 0.f};
    f32x4 s[8];
#pragma unroll
    for (int i = 0; i < 8; ++i) s[i] = *(const f32x4*)(Sin + (size_t)(8 * dq + i) * 128 + 4 * e4);
#pragma unroll
    for (int i = 0; i < 8; ++i) { const int d = 8 * dq + i; s[i] = s[i] * fs[d] + v4 * kn[d]; *(f32x4*)(Sout + (size_t)d * 128 + 4 * e4) = s[i]; o += s[i] * qs[d]; }
    *(LAS f32x4*)&ored[dq * 128 + 4 * e4] = o;
    __syncthreads();
    if (F.wave == 0) { float oo[2]; float ss = 0.f;
#pragma unroll
        for (int k = 0; k < 2; ++k) { const int e = F.lane + 64 * k; float t = 0.f;
#pragma unroll
            for (int j = 0; j < 16; ++j) t += ored[j * 128 + e];
            oo[k] = t; ss += t * t; }
        const float rr = 1.0f / sqrtf(wave_sum(ss) * (1.0f / 128.0f) + EPS);
        const bf16* HG = (const bf16*)(ws + WS_HG); bf16* OH = (bf16*)(ws + WS_OH);
#pragma unroll
        for (int k = 0; k < 2; ++k) { const int e = F.lane + 64 * k; const size_t ix = (size_t)r * 1024 + h * 128 + e; OH[ix] = (bf16)f2bf(oo[k] * rr * A.in[10][e] * bf2f(HG[ix])); } }
}
__device__ __forceinline__ void p2_phase(Frame& F, const Args& A) {
    for (int it = F.vcu; it < 512; it += F.G) p2_ret_item(F, it);
    for (int it = F.vcu; it < 512; it += F.G) p2_hg_item(F, it);
    for (int it = F.vcu; it < 1024; it += F.G) p2_sret_item(F, A, it);
    for (int it = F.vcu; it < 1024; it += F.G) p2_shg_item(F, A, it);
}
__device__ __forceinline__ void p3_phase(Frame& F) {
    unsigned char* ws = F.ws;
    const int gt = F.vcu * 512 + F.tid, NT = F.G * 512;
    for (int gid = gt; gid < 32 * 256 * 32; gid += NT) {
        const int bh = gid >> 13, e = (gid >> 5) & 255, d4 = gid & 31; const float cd = exp2f(128.0f * lg2gamma(bh & 7));
        const float* kv = (const float*)(ws + WS_KVLOC) + ((size_t)bh * 16 * 256 + e) * 128 + 4 * d4; bf16* st = (bf16*)(ws + WS_SRT) + ((size_t)bh * 16 * 256 + e) * 128 + 4 * d4;
        f32x4 x[16];
#pragma unroll
        for (int c = 0; c < 16; ++c) x[c] = *(const f32x4*)(kv + (size_t)c * 256 * 128);
        f32x4 S = (f32x4){0.f, 0.f, 0.f, 0.f};
#pragma unroll
        for (int c = 0; c < 16; ++c) { v2u p; p.x = pk2(S[0], S[1]); p.y = pk2(S[2], S[3]); *(v2u*)(st + (size_t)c * 256 * 128) = p; S = S * cd + x[c]; }
        float* fo = F.out + OUT_SRP + ((size_t)bh * 128 + 4 * d4) * 256 + e;
#pragma unroll
        for (int i = 0; i < 4; ++i) fo[(size_t)i * 256] = S[i];
    }
    for (int gid = gt; gid < 32 * 128 * 32; gid += NT) {
        const int bh = gid >> 12, e = (gid >> 5) & 127, d4 = gid & 31;
        const float* hs = (const float*)(ws + WS_HSLOC) + ((size_t)bh * 16 * 128 + e) * 128 + 4 * d4; bf16* st = (bf16*)(ws + WS_SHT) + ((size_t)bh * 16 * 128 + e) * 128 + 4 * d4;
        const float* bt = (const float*)(ws + WS_BTOT) + (size_t)bh * 16 * 128 + 4 * d4;
        f32x4 S = (f32x4){0.f, 0.f, 0.f, 0.f};
#pragma unroll 4
        for (int c = 0; c < 16; ++c) { const f32x4 x = *(const f32x4*)(hs + (size_t)c * 128 * 128); const f32x4 bb = *(const f32x4*)(bt + c * 128);
            v2u p; p.x = pk2(S[0], S[1]); p.y = pk2(S[2], S[3]); *(v2u*)(st + (size_t)c * 128 * 128) = p;
            S[0] = S[0] * __expf(bb[0]) + x[0]; S[1] = S[1] * __expf(bb[1]) + x[1]; S[2] = S[2] * __expf(bb[2]) + x[2]; S[3] = S[3] * __expf(bb[3]) + x[3]; }
        float* fo = F.out + OUT_SHP + ((size_t)bh * 128 + 4 * d4) * 128 + e;
#pragma unroll
        for (int i = 0; i < 4; ++i) fo[(size_t)i * 128] = S[i];
    }
}
__device__ __forceinline__ void p4_ret_item(Frame& F, int item) {
    unsigned char* ws = F.ws;
    const int c = item & 15, h = (item >> 4) & 7, b = item >> 7, r0 = b * 2048 + c * 128;
    const int w = F.wave, l15 = F.lane & 15, g = F.lane >> 4;
    LAS bf16* KS = (LAS bf16*)F.lds; LAS bf16* VT = KS + 128 * TP;
    const bf16* Qg = (const bf16*)(ws + WS_Q); const bf16* Kg = (const bf16*)(ws + WS_K); const bf16* Vg = (const bf16*)(ws + WS_V);
    const float* COS = (const float*)(ws + WS_COS); const float* SIN = (const float*)(ws + WS_SIN);
    const float lg = lg2gamma(h);
    __syncthreads();
#pragma unroll
    for (int i = 0; i < 2; ++i) { const int u = F.tid + 512 * i, d0 = (u & 7) * 8, m = u >> 3;
        const bf16* kp = Kg + (size_t)(r0 + m) * 1024 + h * 128 + d0; const v4u a = *(const v4u*)kp, bb = *(const v4u*)(kp + 64);
        const int pos = c * 128 + m; const f32x4 c0 = *(const f32x4*)(COS + pos * 64 + d0), c1 = *(const f32x4*)(COS + pos * 64 + d0 + 4), s0 = *(const f32x4*)(SIN + pos * 64 + d0), s1 = *(const f32x4*)(SIN + pos * 64 + d0 + 4);
        float o1[8], o2[8];
#pragma unroll
        for (int j = 0; j < 8; ++j) { const float x1 = bfe(a, j), x2 = bfe(bb, j), cj = j < 4 ? c0[j & 3] : c1[j & 3], sj = j < 4 ? s0[j & 3] : s1[j & 3]; o1[j] = x1 * cj - x2 * sj; o2[j] = x2 * cj + x1 * sj; }
        *(LAS bf16x8*)&KS[m * TP + d0] = pack_f8(o1); *(LAS bf16x8*)&KS[m * TP + 64 + d0] = pack_f8(o2); }
#pragma unroll
    for (int i = 0; i < 8; ++i) { const int u = F.tid + 512 * i, m = u & 127, e0 = (u >> 7) * 8;
        const v4u a = *(const v4u*)(Vg + (size_t)(r0 + m) * 2048 + h * 256 + e0);
#pragma unroll
        for (int j = 0; j < 8; ++j) VT[(e0 + j) * TP + m] = (bf16)((a[j >> 1] >> (16 * (j & 1))) & 0xffffu); }
    bf16x8 qf[4];
    { const int n = 16 * w + l15, pos = c * 128 + n; const bf16* qp = Qg + (size_t)(r0 + n) * 1024 + h * 128 + 8 * g;
      const v4u a0 = *(const v4u*)qp, a1 = *(const v4u*)(qp + 32), a2 = *(const v4u*)(qp + 64), a3 = *(const v4u*)(qp + 96);
      float r0v[8], r1v[8], r2v[8], r3v[8];
#pragma unroll
      for (int hlf = 0; hlf < 2; ++hlf) { const int dd = 32 * hlf + 8 * g;
          const f32x4 c0 = *(const f32x4*)(COS + pos * 64 + dd), c1 = *(const f32x4*)(COS + pos * 64 + dd + 4), s0 = *(const f32x4*)(SIN + pos * 64 + dd), s1 = *(const f32x4*)(SIN + pos * 64 + dd + 4);
#pragma unroll
          for (int j = 0; j < 8; ++j) { const float cj = j < 4 ? c0[j & 3] : c1[j & 3], sj = j < 4 ? s0[j & 3] : s1[j & 3];
              const float x1 = hlf == 0 ? bfe(a0, j) : bfe(a1, j), x2 = hlf == 0 ? bfe(a2, j) : bfe(a3, j);
              if (hlf == 0) { r0v[j] = x1 * cj - x2 * sj; r2v[j] = x2 * cj + x1 * sj; } else { r1v[j] = x1 * cj - x2 * sj; r3v[j] = x2 * cj + x1 * sj; } } }
      qf[0] = pack_f8(r0v); qf[1] = pack_f8(r1v); qf[2] = pack_f8(r2v); qf[3] = pack_f8(r3v); }
    __syncthreads();
    f32x4 O[16];
    { const bf16* st = (const bf16*)(ws + WS_SRT) + (size_t)item * 256 * 128 + 8 * g;
#pragma unroll
      for (int et = 0; et < 16; ++et) { f32x4 t = (f32x4){0.f, 0.f, 0.f, 0.f};
#pragma unroll
          for (int ks = 0; ks < 4; ++ks) { const bf16x8 sf = *(const bf16x8*)(st + (size_t)(16 * et + l15) * 128 + 32 * ks); t = MFMA16(qf[ks], sf, t); }
          O[et] = t; }
      float rs[4];
#pragma unroll
      for (int reg = 0; reg < 4; ++reg) rs[reg] = exp2f((float)(16 * w + 4 * g + reg + 1) * lg);
#pragma unroll
      for (int et = 0; et < 16; ++et)
#pragma unroll
          for (int reg = 0; reg < 4; ++reg) O[et][reg] *= rs[reg]; }
    bf16x8 pf[4];
#pragma unroll
    for (int s = 0; s < 4; ++s) { float pv[8];
#pragma unroll
        for (int hf = 0; hf < 2; ++hf) { const int mt = 2 * s + hf; f32x4 dd = (f32x4){0.f, 0.f, 0.f, 0.f};
            if (mt <= w) {
#pragma unroll
                for (int ks = 0; ks < 4; ++ks) { const bf16x8 kf = *(const LAS bf16x8*)&KS[(16 * mt + l15) * TP + 32 * ks + 8 * g]; dd = MFMA16(kf, qf[ks], dd); }
#pragma unroll
                for (int reg = 0; reg < 4; ++reg) { const int m = 16 * mt + 4 * g + reg, n = 16 * w + l15; dd[reg] = n >= m ? dd[reg] * exp2f((float)(n - m) * lg) : 0.f; } }
#pragma unroll
            for (int reg = 0; reg < 4; ++reg) pv[4 * hf + reg] = dd[reg]; }
        pf[s] = pack_f8(pv); }
#pragma unroll
    for (int s = 0; s < 4; ++s) if (2 * s <= w) {
#pragma unroll
        for (int et = 0; et < 16; ++et) { const LAS bf16* vp = &VT[(16 * et + l15) * TP + 32 * s + 4 * g];
            const bf16x4v lo = *(const LAS bf16x4v*)vp, hi = *(const LAS bf16x4v*)(vp + 16);
            const bf16x8 vf = __builtin_shufflevector(lo, hi, 0, 1, 2, 3, 4, 5, 6, 7); O[et] = MFMA16(pf[s], vf, O[et]); } }
    float ss[4] = {0.f, 0.f, 0.f, 0.f};
#pragma unroll
    for (int et = 0; et < 16; ++et)
#pragma unroll
        for (int reg = 0; reg < 4; ++reg) ss[reg] += O[et][reg] * O[et][reg];
#pragma unroll
    for (int reg = 0; reg < 4; ++reg) { float v = ss[reg]; v += __shfl_xor(v, 1); v += __shfl_xor(v, 2); v += __shfl_xor(v, 4); v += __shfl_xor(v, 8); ss[reg] = 1.0f / sqrtf(v * (1.0f / 256.0f) + EPS); }
    const bf16* RG = (const bf16*)(ws + WS_RG); bf16* OR = (bf16*)(ws + WS_OR);
#pragma unroll
    for (int reg = 0; reg < 4; ++reg) { const size_t rb = (size_t)(r0 + 16 * w + 4 * g + reg) * 2048 + h * 256 + l15;
#pragma unroll
        for (int et = 0; et < 16; ++et) OR[rb + 16 * et] = (bf16)f2bf(O[et][reg] * ss[reg] * bf2f(RG[rb + 16 * et])); }
}
__device__ __forceinline__ void p4_hg_item(Frame& F, const Args& A, int item) {
    unsigned char* ws = F.ws;
    const int sc = item & 15, h = (item >> 4) & 7, b = item >> 7, r0 = b * 2048 + sc * 128;
    const int w = F.wave, l15 = F.lane & 15, g = F.lane >> 4;
    LAS bf16* QP = (LAS bf16*)F.lds;
    LAS bf16* KP = QP + 64 * TP;
    LAS bf16* KU = KP + 64 * TP;
    LAS bf16* VT = KU + 128 * 72;
    LAS float* E15 = (LAS float*)(VT + 128 * 72);
    LAS float* OB = E15 + 4 * 128;
    const float* Z = (const float*)(ws + WS_LOGF); const bf16* HQ = (const bf16*)(ws + WS_HQ); const bf16* HI = (const bf16*)(ws + WS_HI); const float* LB = (const float*)(ws + WS_LB);
    f32x4 S[8];
    { const bf16* st = (const bf16*)(ws + WS_SHT) + (size_t)item * 128 * 128 + (size_t)(16 * w + l15) * 128 + 4 * g;
#pragma unroll
      for (int dt = 0; dt < 8; ++dt) { const v2u p = *(const v2u*)(st + 16 * dt); S[dt][0] = __uint_as_float(p.x << 16); S[dt][1] = __uint_as_float(p.x & 0xffff0000u); S[dt][2] = __uint_as_float(p.y << 16); S[dt][3] = __uint_as_float(p.y & 0xffff0000u); } }
    for (int hf = 0; hf < 2; ++hf) {
        const int rh = r0 + 64 * hf;
        __syncthreads();
        { const int d = F.tid & 127, sq = F.tid >> 7; const float oml = 1.0f - LB[h * 128 + d];
          float kin[16], bcum[16]; float bb = 0.f;
#pragma unroll
          for (int t = 0; t < 16; ++t) { const size_t ix = (size_t)(rh + 16 * sq + t) * 1024 + h * 128 + d; const float z = Z[ix]; const float q = bf2f(HQ[ix]);
              kin[t] = oml / (1.0f + __expf(z)); bb += log1pf(-kin[t]); bcum[t] = bb;
              QP[(16 * sq + t) * TP + d] = (bf16)f2bf(q * __expf(bb)); KP[(16 * sq + t) * TP + d] = (bf16)f2bf(kin[t] * __expf(fminf(-bb, 80.0f))); }
          E15[sq * 128 + d] = __expf(bb);
          float v[8];
#pragma unroll
          for (int t = 0; t < 8; ++t) v[t] = kin[t] * __expf(bb - bcum[t]);
          *(LAS bf16x8*)&KU[d * 72 + 16 * sq] = pack_f8(v);
#pragma unroll
          for (int t = 0; t < 8; ++t) v[t] = kin[8 + t] * __expf(bb - bcum[8 + t]);
          *(LAS bf16x8*)&KU[d * 72 + 16 * sq + 8] = pack_f8(v); }
#pragma unroll
        for (int i = 0; i < 2; ++i) { const int u = F.tid + 512 * i, m = u & 63, e0 = (u >> 6) * 8;
            const v4u a = *(const v4u*)(HI + (size_t)(rh + m) * 1024 + h * 128 + e0);
#pragma unroll
            for (int j = 0; j < 8; ++j) VT[(e0 + j) * 72 + m] = (bf16)((a[j >> 1] >> (16 * (j & 1))) & 0xffffu); }
        __syncthreads();
        const bf16x8 zero8 = (bf16x8){0, 0, 0, 0, 0, 0, 0, 0};
#pragma unroll
        for (int sq = 0; sq < 4; ++sq) {
            f32x4 at = (f32x4){0.f, 0.f, 0.f, 0.f};
#pragma unroll
            for (int ks = 0; ks < 4; ++ks) { const bf16x8 kf = *(const LAS bf16x8*)&KP[(16 * sq + l15) * TP + 32 * ks + 8 * g], qf = *(const LAS bf16x8*)&QP[(16 * sq + l15) * TP + 32 * ks + 8 * g]; at = MFMA16(kf, qf, at); }
            float pv[8];
#pragma unroll
            for (int reg = 0; reg < 4; ++reg) { pv[reg] = (4 * g + reg) <= l15 ? at[reg] : 0.f; pv[4 + reg] = 0.f; }
            const bf16x8 pfr = pack_f8(pv);
            f32x4 o;
            { const bf16x4v lo = *(const LAS bf16x4v*)&VT[(16 * w + l15) * 72 + 16 * sq + 4 * g]; const bf16x8 vf = __builtin_shufflevector(lo, (bf16x4v){0, 0, 0, 0}, 0, 1, 2, 3, 4, 5, 6, 7);
              const f32x4 z4 = {0.f, 0.f, 0.f, 0.f}; o = MFMA16(pfr, vf, z4); }
#pragma unroll
            for (int ks = 0; ks < 4; ++ks) { float sv[8];
#pragma unroll
                for (int jj = 0; jj < 8; ++jj) sv[jj] = S[2 * ks + (jj >> 2)][jj & 3];
                const bf16x8 sf = pack_f8(sv);
                const LAS bf16* qp = &QP[(16 * sq + l15) * TP + 32 * ks + 4 * g]; const bf16x4v lo = *(const LAS bf16x4v*)qp, hi = *(const LAS bf16x4v*)(qp + 16);
                const bf16x8 qf = __builtin_shufflevector(lo, hi, 0, 1, 2, 3, 4, 5, 6, 7); o = MFMA16(qf, sf, o); }
#pragma unroll
            for (int reg = 0; reg < 4; ++reg) OB[(16 * sq + 4 * g + reg) * 132 + 16 * w + l15] = o[reg];
            const bf16x8 vu = g < 2 ? *(const LAS bf16x8*)&VT[(16 * w + l15) * 72 + 16 * sq + 8 * g] : zero8;
#pragma unroll
            for (int dt = 0; dt < 8; ++dt) { const f32x4 ed = *(const LAS f32x4*)&E15[sq * 128 + 16 * dt + 4 * g];
                const bf16x8 kf = g < 2 ? *(const LAS bf16x8*)&KU[(16 * dt + l15) * 72 + 16 * sq + 8 * g] : zero8;
                S[dt] = MFMA16(kf, vu, S[dt] * ed); }
        }
        __syncthreads();
        { const bf16* HG = (const bf16*)(ws + WS_HG); bf16* OH = (bf16*)(ws + WS_OH);
#pragma unroll
          for (int i = 0; i < 8; ++i) { const int t = 8 * w + i; const float v0 = OB[t * 132 + F.lane], v1 = OB[t * 132 + 64 + F.lane];
              const float rr = 1.0f / sqrtf(wave_sum(v0 * v0 + v1 * v1) * (1.0f / 128.0f) + EPS); const size_t ix = (size_t)(rh + t) * 1024 + h * 128 + F.lane;
              OH[ix] = (bf16)f2bf(v0 * rr * A.in[10][F.lane] * bf2f(HG[ix])); OH[ix + 64] = (bf16)f2bf(v1 * rr * A.in[10][64 + F.lane] * bf2f(HG[ix + 64])); } }
    }
}
__device__ __forceinline__ void p4_phase(Frame& F, const Args& A) {
    for (int it = F.vcu; it < 512; it += F.G) p4_ret_item(F, it);
    for (int it = F.vcu; it < 512; it += F.G) p4_hg_item(F, A, it);
}
__global__ void __launch_bounds__(NWAVES * 64, 2) mk_fwd(Args args) {
    extern __shared__ __attribute__((aligned(16))) unsigned char lds[];
    Frame F;
    F.lds = (LAS unsigned char*)lds; F.MISC = (volatile LAS unsigned*)(F.lds + MISC_OFF);
    F.tid = threadIdx.x; F.lane = F.tid & 63; F.wave = __builtin_amdgcn_readfirstlane(F.tid >> 6);
    F.G = gridDim.x; { const int bx = blockIdx.x; F.vcu = (F.G % 8 == 0) ? (bx % 8) * (F.G / 8) + bx / 8 : bx; }
    F.ws = args.ws; F.out = args.out; F.ctl = (gu32*)(args.ws + WS_CTL);
    for (int u = F.tid; u < (LDS_BYTES - LDSCTL_OFF) / 4; u += NWAVES * 64) ((LAS unsigned*)(F.lds + LDSCTL_OFF))[u] = 0u;
    __syncthreads();
    XcdBarrier bar; bar.bar = (unsigned*)(F.ctl + CW_BAR); bar.x = 0; bar.st = nullptr;
    if (args.use_bar) bar = xcd_barrier_post((unsigned*)(F.ctl + CW_BAR), F.MISC + 8);
    const int lo = args.ph_lo, hi = args.ph_hi;
#define IN(k) (lo <= (k) && (k) < hi)
#define SEAM(k) do { if (IN(k) && IN((k) + 1)) xcd_barrier(bar); } while (0)
    unsigned char* ws = args.ws;
    if (IN(0)) { p0_prologue(F, args); } SEAM(0);
    if (IN(1)) {
        pg8::Gemm g{(const pg8::bf16_t*)(ws + WS_XB), (const pg8::bf16_t*)(ws + WS_WIN), MPAD, NIN, 2048}; pg8::StaticOrder S; S.init(MPAD, NIN, F.G, (int)blockIdx.x);
        pg8::EpiInProj E{ws};
        pg8::gemm_phase<pg8::EpiInProj, pg8::StaticOrder, true, true>(F.lds, g, S, E);
    } SEAM(1);
    if (IN(2)) { p2_phase(F, args); } SEAM(2);
    if (IN(3)) { p3_phase(F); } SEAM(3);
    if (IN(4)) { p4_phase(F, args); } SEAM(4);
    if (IN(5)) {
        { pg8::Gemm g{(const pg8::bf16_t*)(ws + WS_OR), (const pg8::bf16_t*)(ws + WS_WRO), MPAD, 2048, 2048}; pg8::StaticOrder S; S.init(MPAD, 2048, F.G, (int)blockIdx.x);
          pg8::EpiGate<0> E{(const pg8::bf16_t*)(ws + WS_GA), (float*)(ws + WS_YT), (pg8::bf16_t*)(ws + WS_MG)};
          pg8::gemm_phase<pg8::EpiGate<0>, pg8::StaticOrder, true, true>(F.lds, g, S, E); }
        { pg8::Gemm g{(const pg8::bf16_t*)(ws + WS_OH), (const pg8::bf16_t*)(ws + WS_WHO), MPAD, 2048, 1024}; pg8::StaticOrder S; S.init(MPAD, 2048, F.G, (int)blockIdx.x);
          pg8::EpiGate<1> E{(const pg8::bf16_t*)(ws + WS_GB), (float*)(ws + WS_YT), (pg8::bf16_t*)(ws + WS_MG)};
          pg8::gemm_phase<pg8::EpiGate<1>, pg8::StaticOrder, true, true>(F.lds, g, S, E); }
    } SEAM(5);
    if (IN(6)) {
        pg8::Gemm g{(const pg8::bf16_t*)(ws + WS_MG), (const pg8::bf16_t*)(ws + WS_WOUT), MPAD, 2048, 2048}; pg8::StaticOrder S; S.init(MPAD, 2048, F.G, (int)blockIdx.x);
        pg8::EpiResid E{args.in[0], args.in[1], args.out, (pg8::bf16_t*)(ws + WS_X1B), (float*)(F.ctl + CW_SS1)};
        pg8::gemm_phase<pg8::EpiResid, pg8::StaticOrder, true, true>(F.lds, g, S, E);
    } SEAM(6);
    if (IN(7)) {
        pg8::Gemm g{(const pg8::bf16_t*)(ws + WS_X1B), (const pg8::bf16_t*)(ws + WS_WFI), MPAD, 2 * DFF, 2048}; pg8::StaticOrder S; S.init(MPAD, 2 * DFF, F.G, (int)blockIdx.x);
        pg8::EpiSwiglu E{(const float*)(F.ctl + CW_SS1), (pg8::bf16_t*)(ws + WS_ACT)};
        pg8::gemm_phase<pg8::EpiSwiglu, pg8::StaticOrder, true, true>(F.lds, g, S, E);
    } SEAM(7);
    if (IN(8)) {
        pg8::Gemm g{(const pg8::bf16_t*)(ws + WS_ACT), (const pg8::bf16_t*)(ws + WS_WFO), MPAD, 2048, DFF}; pg8::StaticOrder S; S.init(MPAD, 2048, F.G, (int)blockIdx.x);
        pg8::EpiResid E{args.out, args.out + OUT_YS, args.out, nullptr, (float*)(F.ctl + CW_SS2)};
        pg8::gemm_phase<pg8::EpiResid, pg8::StaticOrder, true, true>(F.lds, g, S, E);
    } SEAM(8);
    if (IN(9)) {
        const int gw = F.vcu * NWAVES + F.wave, NGW = F.G * NWAVES; const float* SS2 = (const float*)(F.ctl + CW_SS2);
        for (int m = gw; m < MROWS; m += NGW) { f32x4* xr = (f32x4*)(args.out + (size_t)m * 2048) + F.lane; const f32x4* gn = (const f32x4*)args.in[14] + F.lane;
            const float rr = 1.0f / sqrtf(SS2[m] * (1.0f / 2048.0f) + EPS);
#pragma unroll
            for (int j = 0; j < 8; ++j) xr[64 * j] = xr[64 * j] * rr * gn[64 * j]; }
    }
#undef IN
#undef SEAM
}
extern "C" void kernel_launch(void* const* d_in, const int* in_sizes, int n_in, void* d_out, int out_size, void* d_ws, size_t ws_size, hipStream_t stream) {
    static int grid = 0;
    if (grid == 0) {
        int dev = 0, cus = 0;
        if (ws_size < WS_END || n_in != 15) { fprintf(stderr, "kernel_launch: unexpected sizes (ws %zu, n_in %d)\n", ws_size, n_in); grid = -1; return; }
        if (hipGetDevice(&dev) != hipSuccess || hipDeviceGetAttribute(&cus, hipDeviceAttributeMultiprocessorCount, dev) != hipSuccess) { grid = -1; return; }
        if (hipFuncSetAttribute((const void*)mk_fwd, hipFuncAttributeMaxDynamicSharedMemorySize, LDS_BYTES) != hipSuccess) { fprintf(stderr, "kernel_launch: hipFuncSetAttribute failed\n"); grid = -1; return; }
        int per_cu = 0; (void)hipOccupancyMaxActiveBlocksPerMultiprocessor(&per_cu, (const void*)mk_fwd, NWAVES * 64, LDS_BYTES); (void)hipGetLastError();
        if (per_cu < 1) { fprintf(stderr, "kernel_launch: occupancy query says %d blocks per CU; nothing launched\n", per_cu); grid = -1; return; }
        grid = cus;
    }
    if (grid < 0) return;
    (void)hipMemsetAsync((char*)d_ws + WS_CTL, 0, CTL_ZERO_BYTES, stream);
    Args a{};
    for (int i = 0; i < 15; ++i) a.in[i] = (const float*)d_in[i];
    a.out = (float*)d_out; a.ws = (unsigned char*)d_ws; a.use_bar = 1; a.ph_lo = 0; a.ph_hi = 10;
    hipLaunchKernelGGL(mk_fwd, dim3(grid), dim3(NWAVES * 64), LDS_BYTES, stream, a);
}
```

```cpp
#include <hip/hip_runtime.h>
#include <cstdio>
#include <cstdint>
constexpr int DMODEL = 2048, MROWS = 8320, MPAD = 8448, NIN = 14336, DFF = 5632, NWAVES = 8;
constexpr float EPS = 1e-6f;
constexpr size_t MiB = 1u << 20;
constexpr size_t WS_CTL = 0, CTL_ZERO_BYTES = 1 * MiB;
constexpr size_t WS_WRO = 1 * MiB, WS_WHO = 9 * MiB, WS_WOUT = 13 * MiB, WS_WFI = 21 * MiB, WS_WFO = 65 * MiB, WS_WIN = 87 * MiB;
constexpr size_t WS_XB = 143 * MiB;
constexpr size_t WS_Q = 176 * MiB, WS_K = WS_Q + 8448ull * 1024 * 2, WS_V = 209 * MiB, WS_RG = 242 * MiB, WS_HQ = 275 * MiB, WS_LOGF = WS_HQ + 8448ull * 1024 * 2;
constexpr size_t WS_HI = WS_LOGF + 8448ull * 1024 * 4, WS_HG = WS_HI + 8448ull * 1024 * 2, WS_GA = WS_HG + 8448ull * 1024 * 2, WS_GB = WS_GA + 8448ull * 2048 * 2;
constexpr size_t WS_KVLOC = WS_GB + 8448ull * 2048 * 2;
constexpr size_t WS_HSLOC = WS_KVLOC + 64 * MiB;
constexpr size_t WS_OH = WS_HSLOC + 32 * MiB;
constexpr size_t WS_MISC = WS_OH + 8448ull * 1024 * 2;
constexpr size_t WS_RR1 = WS_MISC, WS_COS = WS_RR1 + 64 * 1024, WS_SIN = WS_COS + 2049 * 64 * 4 + 256, WS_LB = WS_SIN + 2049 * 64 * 4 + 256, WS_BTOT = WS_LB + 4096, WS_END = WS_BTOT + 512 * 128 * 4;
constexpr size_t WS_OR = WS_XB;
constexpr size_t WS_SRT = WS_WIN, WS_SHT = WS_WIN + 32 * MiB;
constexpr size_t WS_YT = WS_KVLOC;
constexpr size_t WS_MG = WS_Q;
constexpr size_t WS_X1B = WS_V;
constexpr size_t WS_ACT = WS_RG;
static_assert(WS_GB + 8448ull * 2048 * 2 == WS_KVLOC && WS_K + 8448ull * 1024 * 2 == WS_V && WS_V + 8448ull * 2048 * 2 == WS_RG && WS_RG + 8448ull * 2048 * 2 == WS_HQ, "map");
static_assert(WS_YT + 8448ull * 2048 * 4 <= WS_OH && WS_ACT + 8448ull * 5632 * 2 <= WS_GA && WS_END <= 541 * MiB, "map2");
constexpr int CW_BAR = 4096;
constexpr int CW_SS1 = 16384, CW_SS2 = 16384 + 8448;
static_assert((CW_SS2 + 8448) * 4 <= (int)CTL_ZERO_BYTES, "ctl");
constexpr int RING_BYTES = 131072, LDSCTL_OFF = RING_BYTES, MISC_OFF = LDSCTL_OFF + 320, LDS_BYTES = 147456;

#define GAS __attribute__((address_space(1)))
#define LAS __attribute__((address_space(3)))
typedef unsigned short bf16;
typedef unsigned v4u __attribute__((ext_vector_type(4)));
typedef unsigned v2u __attribute__((ext_vector_type(2)));
typedef float f32x4 __attribute__((ext_vector_type(4)));
typedef short bf16x8 __attribute__((ext_vector_type(8)));
typedef GAS unsigned gu32;
#define RLX_AGENT __ATOMIC_RELAXED, __HIP_MEMORY_SCOPE_AGENT
#define LDS_WAIT() asm volatile("s_waitcnt lgkmcnt(0)" ::: "memory")
#define VM_WAIT() asm volatile("s_waitcnt vmcnt(0)" ::: "memory")
__device__ __forceinline__ unsigned f2bf(float f) { unsigned u = __builtin_bit_cast(unsigned, f); return (u + 0x7fffu + ((u >> 16) & 1u)) >> 16; }
__device__ __forceinline__ unsigned pk2(float lo, float hi) { return f2bf(lo) | (f2bf(hi) << 16); }
__device__ __forceinline__ float bf2f(unsigned short b) { return __uint_as_float(((unsigned)b) << 16); }
namespace pg8 {
#define PG8_LAS __attribute__((address_space(3)))
typedef unsigned short bf16_t;
typedef short bf16x8 __attribute__((ext_vector_type(8)));
typedef float f32x4 __attribute__((ext_vector_type(4)));
typedef unsigned u32x4 __attribute__((ext_vector_type(4)));
constexpr int BM = 256, BK = 64, HALF = 128, HTB = HALF * BK * 2  , STAGE_BYTES = 8 * HTB, NXCD = 8, WGM = 8;

__host__ __device__ __forceinline__ int lds_byte(int r, int c) { const int st = (r >> 4) * 2 + (c >> 5), rr = r & 15, cc = c & 31, ob = rr * 64 + cc * 2; return st * 1024 + (ob ^ (((ob >> 9) & 1) << 5)); }
__host__ __device__ __forceinline__ void stage_rc(int b, int& R, int& C) { const int st = b / 1024, sb = b % 1024, swz = sb ^ (((sb >> 9) & 1) << 5); R = (st >> 1) * 16 + swz / 64; C = (st & 1) * 32 + (swz % 64) / 2; }
__host__ __device__ __forceinline__ int perm32(int rho) { const int n = rho >> 4, i = rho & 15; return 8 * (i >> 2) + 4 * n + (i & 3); }

struct Unit { int pm, pn; };
struct Gemm { const bf16_t* A; const bf16_t* Bt; int M, N, K; };

struct StaticOrder {
    int nM, nN, nwg, G, c;
    __host__ __device__ void init(int M, int N, int G_, int c_) { nM = M / BM; nN = N / BM; nwg = nM * nN; G = G_; c = c_; }
    __host__ __device__ bool next(int i, Unit& u) const {
        const long L = (long)i * G + c; if (L >= nwg) return false;
        int wgid = (int)L; { const int q = nwg / NXCD, r = nwg % NXCD, xcd = wgid % NXCD, off = wgid / NXCD; wgid = (xcd < r ? xcd * (q + 1) : r * (q + 1) + (xcd - r) * q) + off; }
        const int nig = WGM * nN, gid = wgid / nig, fm = gid * WGM, gsz = (nM - fm) < WGM ? (nM - fm) : WGM;
        u.pm = fm + ((wgid % nig) % gsz); u.pn = (wgid % nig) / gsz; return true;
    }
    __device__ __forceinline__ void a_ready(const Unit&) const {}
    __device__ __forceinline__ void done(const Unit&) const {}
};

__device__ __forceinline__ unsigned cvt_pk_bf16(float lo, float hi) { unsigned r; asm volatile("v_cvt_pk_bf16_f32 %0, %1, %2" : "=v"(r) : "v"(lo), "v"(hi)); return r; }
typedef float f32x2 __attribute__((ext_vector_type(2)));
typedef unsigned u32x2 __attribute__((ext_vector_type(2)));
__device__ __forceinline__ float sigm(float x) { return 1.0f / (1.0f + __expf(-x)); }
__device__ __forceinline__ f32x4 silu4(f32x4 v) { f32x4 o; o[0] = v[0] * sigm(v[0]); o[1] = v[1] * sigm(v[1]); o[2] = v[2] * sigm(v[2]); o[3] = v[3] * sigm(v[3]); return o; }
__device__ __forceinline__ f32x4 sigm4(f32x4 v) { f32x4 o; o[0] = sigm(v[0]); o[1] = sigm(v[1]); o[2] = sigm(v[2]); o[3] = sigm(v[3]); return o; }
__device__ __forceinline__ u32x4 pack8(f32x4 v0, f32x4 v1) { u32x4 w; w.x = cvt_pk_bf16(v0[0], v0[1]); w.y = cvt_pk_bf16(v0[2], v0[3]); w.z = cvt_pk_bf16(v1[0], v1[1]); w.w = cvt_pk_bf16(v1[2], v1[3]); return w; }
__device__ __forceinline__ u32x2 pack4(f32x4 v) { u32x2 w; w.x = cvt_pk_bf16(v[0], v[1]); w.y = cvt_pk_bf16(v[2], v[3]); return w; }
__device__ __forceinline__ f32x4 unpack4(u32x2 w) { f32x4 o; o[0] = __uint_as_float(w.x << 16); o[1] = __uint_as_float(w.x & 0xffff0000u); o[2] = __uint_as_float(w.y << 16); o[3] = __uint_as_float(w.y & 0xffff0000u); return o; }

struct EpiInProj {
    static constexpr bool PERM = true, AFTER_DRAIN = false;
    unsigned char* ws;
    __device__ __forceinline__ void operator()(const f32x4 (&acc)[2][2][4][2], const Unit& u, int wr, int wc, int fr, int fq) const {
        const int pn = u.pn, row0 = u.pm * BM + wr * 64 + fr;
        if (pn >= 28 && pn < 32) {
            float* Z = (float*)(ws + WS_LOGF); const int cs = (pn - 28) * 256 + wc * 32 + 8 * fq;
#pragma unroll
            for (int ai = 0; ai < 2; ++ai)
#pragma unroll
                for (int m = 0; m < 4; ++m) { const int r = row0 + ai * HALF + m * 16;
#pragma unroll
                    for (int bj = 0; bj < 2; ++bj)
#pragma unroll
                        for (int n = 0; n < 2; ++n) *(f32x4*)(Z + (size_t)r * 1024 + cs + bj * HALF + 4 * n) = acc[ai][bj][m][n]; }
        } else {
            size_t od; int pitch, p0, act; float sc = 1.0f;
            if (pn < 4) { od = WS_Q; pitch = 1024; p0 = 0; act = 0; } else if (pn < 8) { od = WS_K; pitch = 1024; p0 = 4; act = 0; sc = 0.08838834764831845f; }
            else if (pn < 16) { od = WS_V; pitch = 2048; p0 = 8; act = 0; } else if (pn < 24) { od = WS_RG; pitch = 2048; p0 = 16; act = 1; } else if (pn < 28) { od = WS_HQ; pitch = 1024; p0 = 24; act = 1; }
            else if (pn < 36) { od = WS_HI; pitch = 1024; p0 = 32; act = 0; } else if (pn < 40) { od = WS_HG; pitch = 1024; p0 = 36; act = 1; } else if (pn < 48) { od = WS_GA; pitch = 2048; p0 = 40; act = 2; } else { od = WS_GB; pitch = 2048; p0 = 48; act = 2; }
            bf16_t* dst = (bf16_t*)(ws + od);
            const int cs = (pn - p0) * 256 + wc * 32 + 8 * fq;
#pragma unroll
            for (int ai = 0; ai < 2; ++ai)
#pragma unroll
                for (int m = 0; m < 4; ++m) { const int r = row0 + ai * HALF + m * 16; bf16_t* rowp = dst + (size_t)r * pitch + cs;
#pragma unroll
                    for (int bj = 0; bj < 2; ++bj) { f32x4 v0 = acc[ai][bj][m][0] * sc, v1 = acc[ai][bj][m][1] * sc;
                        if (act == 1) { v0 = silu4(v0); v1 = silu4(v1); } else if (act == 2) { v0 = sigm4(v0); v1 = sigm4(v1); }
                        *(u32x4*)(rowp + bj * HALF) = pack8(v0, v1); } }
        }
    }
};
template <int SECOND> struct EpiGate {
    static constexpr bool PERM = true, AFTER_DRAIN = false;
    const bf16_t* G; float* YT; bf16_t* MG;
    __device__ __forceinline__ void operator()(const f32x4 (&acc)[2][2][4][2], const Unit& u, int wr, int wc, int fr, int fq) const {
        const int row0 = u.pm * BM + wr * 64 + fr, col0 = u.pn * BM + wc * 32 + 8 * fq;
#pragma unroll
        for (int ai = 0; ai < 2; ++ai)
#pragma unroll
            for (int m = 0; m < 4; ++m) { const size_t off = (size_t)(row0 + ai * HALF + m * 16) * 2048 + col0;
#pragma unroll
                for (int bj = 0; bj < 2; ++bj) { const u32x4 gw = *(const u32x4*)(G + off + bj * HALF);
                    f32x4 v0 = acc[ai][bj][m][0] * unpack4((u32x2){gw.x, gw.y}), v1 = acc[ai][bj][m][1] * unpack4((u32x2){gw.z, gw.w});
                    float* yp = YT + off + bj * HALF;
                    if (SECOND) { v0 += *(const f32x4*)yp; v1 += *(const f32x4*)(yp + 4); *(u32x4*)(MG + off + bj * HALF) = pack8(v0, v1); }
                    else { *(f32x4*)yp = v0; *(f32x4*)(yp + 4) = v1; } } }
        __builtin_amdgcn_s_waitcnt(0x0F70);
    }
};
struct EpiResid {
    static constexpr bool PERM = true, AFTER_DRAIN = false;
    const float* XP; const float* XS; float* OUT; bf16_t* XB; float* SS;
    __device__ __forceinline__ void operator()(const f32x4 (&acc)[2][2][4][2], const Unit& u, int wr, int wc, int fr, int fq) const {
        const int row0 = u.pm * BM + wr * 64 + fr, col0 = u.pn * BM + wc * 32 + 8 * fq;
#pragma unroll
        for (int ai = 0; ai < 2; ++ai)
#pragma unroll
            for (int m = 0; m < 4; ++m) { const int r = row0 + ai * HALF + m * 16; const bool live = r < 8320;
                const float* xi = (r < 8192 ? XP + (size_t)r * 2048 : XS + (size_t)(r - 8192) * 2048) + col0; float ss = 0.f;
#pragma unroll
                for (int bj = 0; bj < 2; ++bj) { f32x4 v0 = acc[ai][bj][m][0], v1 = acc[ai][bj][m][1];
                    if (live) { v0 += *(const f32x4*)(xi + bj * HALF); v1 += *(const f32x4*)(xi + bj * HALF + 4);
                        float* op = OUT + (size_t)r * 2048 + col0 + bj * HALF; *(f32x4*)op = v0; *(f32x4*)(op + 4) = v1; }
                    if (XB) *(u32x4*)(XB + (size_t)r * 2048 + col0 + bj * HALF) = pack8(v0, v1);
                    ss += (v0[0] * v0[0] + v0[1] * v0[1]) + (v0[2] * v0[2] + v0[3] * v0[3]) + (v1[0] * v1[0] + v1[1] * v1[1]) + (v1[2] * v1[2] + v1[3] * v1[3]); }
                ss += __shfl_xor(ss, 16); ss += __shfl_xor(ss, 32);
                if (fq == 0) atomicAdd(SS + r, ss); }
        __builtin_amdgcn_s_waitcnt(0x0F70);
    }
};
struct EpiSwiglu {
    static constexpr bool PERM = true, AFTER_DRAIN = false;
    const float* SS; bf16_t* ACT;
    __device__ __forceinline__ void operator()(const f32x4 (&acc)[2][2][4][2], const Unit& u, int wr, int wc, int fr, int fq) const {
        const int row0 = u.pm * BM + wr * 64 + fr, col0 = u.pn * HALF + wc * 32 + 8 * fq;
        float ssv[2][4];
#pragma unroll
        for (int ai = 0; ai < 2; ++ai)
#pragma unroll
            for (int m = 0; m < 4; ++m) ssv[ai][m] = SS[row0 + ai * HALF + m * 16];
        __builtin_amdgcn_s_waitcnt(0x0F70);
#pragma unroll
        for (int ai = 0; ai < 2; ++ai)
#pragma unroll
            for (int m = 0; m < 4; ++m) { const int r = row0 + ai * HALF + m * 16; const float r2 = 1.0f / sqrtf(ssv[ai][m] * (1.0f / 2048.0f) + 1e-6f);
                const f32x4 g0 = acc[ai][0][m][0] * r2, g1 = acc[ai][0][m][1] * r2, u0 = acc[ai][1][m][0] * r2, u1 = acc[ai][1][m][1] * r2;
                *(u32x4*)(ACT + (size_t)r * 5632 + col0) = pack8(silu4(g0) * u0, silu4(g1) * u1); }
    }
};
template <class Epi, class Sched, bool ALIGN_EPI = false, bool SP2 = false>
__device__ __forceinline__ void gemm_phase(PG8_LAS unsigned char* lds, const Gemm g, const Sched& S, const Epi& E) {
    const int tid = threadIdx.x, wid = __builtin_amdgcn_readfirstlane(tid >> 6), lane = tid & 63, wr = wid >> 2, wc = wid & 3, fr = lane & 15, fq = lane >> 4;
    const int K = g.K, nt = K / BK;
    unsigned voffA[2], voffB[2];
#pragma unroll
    for (int i = 0; i < 2; ++i) { int R, C; stage_rc(tid * 16 + i * 8192, R, C); const int Rb = Epi::PERM ? ((R & ~31) + perm32(R & 31)) : R;
        voffA[i] = (unsigned)(R * K + C) * 2u; voffB[i] = (unsigned)(Rb * K + C) * 2u; }
    const size_t kstep = (size_t)(BK * 2);
    const size_t hstep = (size_t)HALF * K * 2;
    const size_t tstep = 2 * hstep;
    const unsigned ldsw = (unsigned)wid * 1024u;
    const int aoff = lds_byte(wr * 64 + fr, fq * 8), boff = lds_byte(wc * 32 + fr, fq * 8);
#define PG8_SA(b, h) (((b) * 2 + (h)) * HTB)
#define PG8_SB(b, h) ((4 + (b) * 2 + (h)) * HTB)
#define PG8_STAGE(bufoff, gbase, voff) do { _Pragma("unroll") for (int _i = 0; _i < 2; ++_i) \
        __builtin_amdgcn_global_load_lds((const unsigned*)((const char*)(gbase) + (voff)[_i]), (PG8_LAS unsigned*)(lds + (bufoff) + ldsw + _i * 8192), 16, 0, 0); } while (0)
#define PG8_LDA(dst, b, h) do { _Pragma("unroll") for (int m = 0; m < 4; ++m) _Pragma("unroll") for (int k = 0; k < 2; ++k) dst[m][k] = *(const PG8_LAS bf16x8*)(lds + PG8_SA(b, h) + aoff + m * 2048 + k * 1024); } while (0)
#define PG8_LDB(dst, b, h) do { _Pragma("unroll") for (int n = 0; n < 2; ++n) _Pragma("unroll") for (int k = 0; k < 2; ++k) dst[n][k] = *(const PG8_LAS bf16x8*)(lds + PG8_SB(b, h) + boff + n * 2048 + k * 1024); } while (0)
#define PG8_MMA(ai, bj, At, Bt) do { __builtin_amdgcn_s_setprio(1); _Pragma("unroll") for (int m = 0; m < 4; ++m) _Pragma("unroll") for (int n = 0; n < 2; ++n) _Pragma("unroll") for (int k = 0; k < 2; ++k) \
        acc[ai][bj][m][n] = __builtin_amdgcn_mfma_f32_16x16x32_bf16(Bt[n][k], At[m][k], acc[ai][bj][m][n], 0, 0, 0); __builtin_amdgcn_s_setprio(0); } while (0)
#define PG8_WAIT_V(n) asm volatile("s_waitcnt vmcnt(" #n ")" ::: "memory")
#define PG8_WAIT_L(n) asm volatile("s_waitcnt lgkmcnt(" #n ")" ::: "memory")
#define PG8_BAR __builtin_amdgcn_s_barrier()
#define PG8_SCHED __builtin_amdgcn_sched_barrier(0)
    Unit cur, nxt; int ui = 0;
    if (!S.next(0, cur)) return;
    f32x4 acc[2][2][4][2];
#pragma unroll
    for (int a = 0; a < 2; ++a)
#pragma unroll
        for (int b = 0; b < 2; ++b)
#pragma unroll
            for (int m = 0; m < 4; ++m)
#pragma unroll
                for (int n = 0; n < 2; ++n) acc[a][b][m][n] = (f32x4){0.f, 0.f, 0.f, 0.f};
    bf16x8 At[4][2], B0[2][2], B1[2][2];
    const char* cA = (const char*)g.A + (size_t)cur.pm * tstep; const char* cB = (const char*)g.Bt + (size_t)cur.pn * tstep;
    S.a_ready(cur);
    if constexpr (SP2) {
        PG8_STAGE(PG8_SB(0, 0), cB, voffB); PG8_STAGE(PG8_SB(0, 1), cB + hstep, voffB); PG8_STAGE(PG8_SA(0, 0), cA, voffA); PG8_STAGE(PG8_SA(0, 1), cA + hstep, voffA);
        if (wr == 1) PG8_BAR;
        PG8_WAIT_V(2); PG8_BAR;
        PG8_STAGE(PG8_SB(1, 0), cB + kstep, voffB); PG8_STAGE(PG8_SA(1, 0), cA + kstep, voffA); PG8_STAGE(PG8_SB(1, 1), cB + hstep + kstep, voffB);
        PG8_WAIT_V(6); PG8_BAR;
    } else {
        PG8_STAGE(PG8_SB(0, 0), cB, voffB); PG8_STAGE(PG8_SA(0, 0), cA, voffA); PG8_STAGE(PG8_SB(0, 1), cB + hstep, voffB); PG8_STAGE(PG8_SA(0, 1), cA + hstep, voffA);
        if (wr == 1) PG8_BAR;
        PG8_WAIT_V(4); PG8_BAR;
        PG8_STAGE(PG8_SB(1, 0), cB + kstep, voffB); PG8_STAGE(PG8_SA(1, 0), cA + kstep, voffA); PG8_STAGE(PG8_SB(1, 1), cB + hstep + kstep, voffB);
        PG8_WAIT_V(6); PG8_BAR;
    }
    for (;;) {
        const bool has_next = S.next(ui + 1, nxt);
        const char* nA = has_next ? (const char*)g.A + (size_t)nxt.pm * tstep : cA; const char* nB = has_next ? (const char*)g.Bt + (size_t)nxt.pn * tstep : cB;
        for (int t = 0; t < nt; t += 2) {
            const bool last = (t == nt - 2);
            const char* a1 = cA + (size_t)(t + 1) * kstep;
            const char* a2 = last ? nA : cA + (size_t)(t + 2) * kstep; const char* b2 = last ? nB : cB + (size_t)(t + 2) * kstep;
            const char* a3 = a2 + kstep; const char* b3 = b2 + kstep;
            if (last && has_next) S.a_ready(nxt);
            if constexpr (SP2) {
            PG8_LDB(B0, 0, 0); PG8_LDB(B1, 0, 1); PG8_SCHED; PG8_LDA(At, 0, 0); PG8_STAGE(PG8_SA(1, 1), a1 + hstep, voffA);
            PG8_WAIT_V(8); PG8_WAIT_L(0); PG8_BAR; PG8_MMA(0, 0, At, B0); PG8_MMA(0, 1, At, B1); PG8_BAR; PG8_SCHED;
            PG8_LDA(At, 0, 1); PG8_STAGE(PG8_SB(0, 0), b2, voffB); PG8_STAGE(PG8_SB(0, 1), b2 + hstep, voffB); PG8_STAGE(PG8_SA(0, 0), a2, voffA);
            PG8_WAIT_V(8); PG8_WAIT_L(0); PG8_BAR; PG8_MMA(1, 0, At, B0); PG8_MMA(1, 1, At, B1); PG8_BAR; PG8_SCHED;
            PG8_LDB(B0, 1, 0); PG8_LDB(B1, 1, 1); PG8_SCHED; PG8_LDA(At, 1, 0); PG8_STAGE(PG8_SA(0, 1), a2 + hstep, voffA);
            PG8_WAIT_V(8); PG8_WAIT_L(0); PG8_BAR; PG8_MMA(0, 0, At, B0); PG8_MMA(0, 1, At, B1); PG8_BAR; PG8_SCHED;
            PG8_LDA(At, 1, 1); PG8_STAGE(PG8_SB(1, 0), b3, voffB); PG8_STAGE(PG8_SB(1, 1), b3 + hstep, voffB); PG8_STAGE(PG8_SA(1, 0), a3, voffA);
            PG8_WAIT_V(8); PG8_WAIT_L(0); PG8_BAR; PG8_MMA(1, 0, At, B0); PG8_MMA(1, 1, At, B1); PG8_BAR; PG8_SCHED;
            } else {
            PG8_LDB(B0, 0, 0); PG8_SCHED; PG8_LDA(At, 0, 0); PG8_STAGE(PG8_SA(1, 1), a1 + hstep, voffA);
            PG8_WAIT_L(8); PG8_BAR; PG8_WAIT_L(0); PG8_MMA(0, 0, At, B0); PG8_BAR; PG8_SCHED;
            PG8_LDB(B1, 0, 1); PG8_STAGE(PG8_SB(0, 0), b2, voffB);
            PG8_BAR; PG8_WAIT_L(0); PG8_MMA(0, 1, At, B1); PG8_BAR;
            PG8_LDA(At, 0, 1); PG8_STAGE(PG8_SA(0, 0), a2, voffA);
            PG8_BAR; PG8_WAIT_L(0); PG8_MMA(1, 0, At, B0); PG8_BAR; PG8_SCHED;
            PG8_STAGE(PG8_SB(0, 1), b2 + hstep, voffB);
            PG8_WAIT_V(6); PG8_BAR; PG8_MMA(1, 1, At, B1); PG8_BAR;
            PG8_LDB(B0, 1, 0); PG8_SCHED; PG8_LDA(At, 1, 0); PG8_STAGE(PG8_SA(0, 1), a2 + hstep, voffA);
            PG8_WAIT_L(8); PG8_BAR; PG8_WAIT_L(0); PG8_MMA(0, 0, At, B0); PG8_BAR; PG8_SCHED;
            PG8_LDB(B1, 1, 1); PG8_STAGE(PG8_SB(1, 0), b3, voffB);
            PG8_BAR; PG8_WAIT_L(0); PG8_MMA(0, 1, At, B1); PG8_BAR;
            PG8_LDA(At, 1, 1); PG8_STAGE(PG8_SA(1, 0), a3, voffA);
            PG8_BAR; PG8_WAIT_L(0); PG8_MMA(1, 0, At, B0); PG8_BAR; PG8_SCHED;
            PG8_STAGE(PG8_SB(1, 1), b3 + hstep, voffB);
            PG8_WAIT_V(6); PG8_BAR; PG8_MMA(1, 1, At, B1); PG8_BAR;
            }
        }
        if constexpr (ALIGN_EPI) { if (wr == 0) PG8_BAR; }
        if constexpr (!Epi::AFTER_DRAIN) { E(acc, cur, wr, wc, fr, fq); S.done(cur); }
        if (!has_next) break;
#pragma unroll
        for (int a = 0; a < 2; ++a)
#pragma unroll
            for (int b = 0; b < 2; ++b)
#pragma unroll
                for (int m = 0; m < 4; ++m)
#pragma unroll
                    for (int n = 0; n < 2; ++n) acc[a][b][m][n] = (f32x4){0.f, 0.f, 0.f, 0.f};
        cur = nxt; cA = nA; cB = nB; ++ui;
        if constexpr (ALIGN_EPI) { if (wr == 1) PG8_BAR; }
    }
    PG8_WAIT_V(0);
    if constexpr (!ALIGN_EPI) { if (wr == 0) PG8_BAR; }
    PG8_BAR;
    if constexpr (Epi::AFTER_DRAIN) { E.fused(acc, cur, wr, wc, fr, fq, lds, wid, lane); S.done(cur); }
#undef PG8_SA
#undef PG8_SB
#undef PG8_STAGE
#undef PG8_LDA
#undef PG8_LDB
#undef PG8_MMA
#undef PG8_WAIT_V
#undef PG8_WAIT_L
#undef PG8_BAR
#undef PG8_SCHED
}
}
#define XB_TMO      128
#define XB_XCNT(j)  (256  + 64 * (j))
#define XB_XSUB(j)  (1280 + 64 * (j))
#define XB_XGEN(j)  (2304 + 64 * (j))
#define XB_TOP      3328
#define XB_TOPGEN   3392
#define XCD_BAR_WORDS 3456
#define XB_SPIN_CAP (1u << 18)

__device__ __forceinline__ unsigned xb_ld(unsigned* p)              { return __hip_atomic_load(p, __ATOMIC_RELAXED, __HIP_MEMORY_SCOPE_AGENT); }
__device__ __forceinline__ unsigned xb_add(unsigned* p, unsigned v) { return __hip_atomic_fetch_add(p, v, __ATOMIC_RELAXED, __HIP_MEMORY_SCOPE_AGENT); }
__device__ __forceinline__ unsigned xb_xcc_id() { return (unsigned)__builtin_amdgcn_s_getreg((3 << 11) | 20) & 0xFu; }
#define XB_SPIN(cond, bar) do { unsigned _sp = 0; while (cond) { __builtin_amdgcn_s_sleep(1); \
    if ((++_sp & 255u) == 0u) { if (xb_ld(&(bar)[XB_TMO])) break; if (_sp > XB_SPIN_CAP) { atomicAdd(&(bar)[XB_TMO], 1u); break; } } } } while (0)

struct XcdBarrier {
    unsigned* bar; unsigned x;
    volatile LAS unsigned* st;
};

__device__ __forceinline__ XcdBarrier xcd_barrier_post(unsigned* bar, volatile LAS unsigned* st) {
    XcdBarrier b; b.bar = bar; b.x = xb_xcc_id(); b.st = st;
    if (threadIdx.x == 0) (void)xb_add(&bar[XB_XCNT(b.x)], 1u);
    return b;
}
__device__ __forceinline__ void xcd_barrier_complete(unsigned* bar, unsigned x, unsigned& nloc, unsigned& nx) {
    const unsigned G = gridDim.x * gridDim.y * gridDim.z;
    unsigned sum, cnt, mine, sp = 0u;
    for (;;) {
        sum = 0u; cnt = 0u; mine = 0u;
#pragma unroll
        for (unsigned j = 0; j < 16; ++j) { const unsigned c = xb_ld(&bar[XB_XCNT(j)]); sum += c; cnt += (c > 0u) ? 1u : 0u; mine = (j == x) ? c : mine; }
        if (sum == G) break;
        __builtin_amdgcn_s_sleep(1);
        if ((++sp & 255u) == 0u) { if (xb_ld(&bar[XB_TMO])) break; if (sp > XB_SPIN_CAP) { atomicAdd(&bar[XB_TMO], 1u); break; } }
    }
    nloc = mine > 0u ? mine : 1u; nx = cnt > 0u ? cnt : 1u;
}

__device__ __forceinline__ void xcd_barrier(const XcdBarrier& b) {
    asm volatile("s_waitcnt vmcnt(0)" ::: "memory");
    __syncthreads();
    if (threadIdx.x == 0) {
        unsigned* bar = b.bar;
        __builtin_amdgcn_s_waitcnt(0);
        unsigned nloc = b.st[0], nx = b.st[1];
        if (nloc == 0u) { xcd_barrier_complete(bar, b.x, nloc, nx); b.st[0] = nloc; b.st[1] = nx; }
        const unsigned old = xb_add(&bar[XB_XSUB(b.x)], 1u);
        const unsigned gen = old / nloc;
        if (old + 1u == (gen + 1u) * nloc) {
            __builtin_amdgcn_fence(__ATOMIC_RELEASE, "agent");
            asm volatile("s_waitcnt vmcnt(0)" ::: "memory");
            const unsigned og = xb_add(&bar[XB_TOP], 1u);
            const unsigned tg = og / nx;
            if (og + 1u == (tg + 1u) * nx) xb_add(&bar[XB_TOPGEN], 1u);
            else XB_SPIN(xb_ld(&bar[XB_TOPGEN]) == tg, bar);
            __builtin_amdgcn_fence(__ATOMIC_ACQUIRE, "agent");
            xb_add(&bar[XB_XGEN(b.x)], 1u);
            asm volatile("s_waitcnt vmcnt(0)" ::: "memory");
        } else {
            XB_SPIN(xb_ld(&bar[XB_XGEN(b.x)]) == gen, bar);
            __builtin_amdgcn_fence(__ATOMIC_ACQUIRE, "agent");
            asm volatile("s_waitcnt vmcnt(0)" ::: "memory");
        }
    }
    __syncthreads();
}
struct Frame {
    LAS unsigned char* lds; volatile LAS unsigned* MISC; gu32* ctl;
    int tid, lane, wave, vcu, G;
    float* out; unsigned char* ws;
};
__device__ __forceinline__ float wave_sum(float v) {
#pragma unroll
    for (int o = 1; o < 64; o <<= 1) v += __shfl_xor(v, o);
    return v;
}
template <int MODE> __device__ __forceinline__ int rowmap(int n) {
    if (MODE == 1) { if (n >= 2048) return n; const int j = n & 127, hb = n & ~127; return hb + (j < 64 ? 8 * (j >> 2) + (j & 3) : 8 * ((j - 64) >> 2) + 4 + (j & 3)); }
    if (MODE == 2) { return n < DFF ? (n >> 7) * 256 + (n & 127) : ((n - DFF) >> 7) * 256 + 128 + ((n - DFF) & 127); }
    return n;
}
template <int MODE> __device__ __forceinline__ void p0_transpose_item(const float* W, int K, int N, bf16* WT, const float* g, LAS unsigned* T, int item, int lane) {
    const int nblk = N / 64, kb = item / nblk, nb = item % nblk, k0 = 64 * kb, n0 = 64 * nb;
    const int l15 = lane & 15, lg = lane >> 4;
    f32x4 v[16];
#pragma unroll
    for (int i = 0; i < 16; ++i) { const int row = 8 * (i >> 1) + 2 * lg + (i & 1); v[i] = *(const f32x4*)(W + (size_t)(k0 + row) * N + n0 + 4 * l15); }
    if (g) {
#pragma unroll
        for (int i = 0; i < 16; ++i) { const int row = 8 * (i >> 1) + 2 * lg + (i & 1); v[i] = v[i] * g[k0 + row]; } }
#pragma unroll
    for (int p = 0; p < 8; ++p)
#pragma unroll
        for (int j = 0; j < 4; ++j) T[(4 * l15 + j) * 33 + 4 * p + lg] = pk2(v[2 * p][j], v[2 * p + 1][j]);
    LDS_WAIT(); asm volatile("" ::: "memory");
    const int c = lane & 7;
#pragma unroll
    for (int i = 0; i < 8; ++i) { const int n = (lane >> 3) + 8 * i; const LAS unsigned* s = T + n * 33 + 4 * c;
        v4u o; o.x = s[0]; o.y = s[1]; o.z = s[2]; o.w = s[3];
        *(GAS v4u*)(WT + (size_t)rowmap<MODE>(n0 + n) * K + k0 + 8 * c) = o; }
    LDS_WAIT(); asm volatile("" ::: "memory");
}
struct Args { const float* in[15]; float* out; unsigned char* ws; int ph_lo, ph_hi, use_bar, pad; };
__device__ __forceinline__ void p0_prologue(Frame& F, const Args& A) {
    LAS unsigned* scr = (LAS unsigned*)(F.lds + F.wave * 16384);
    const int gw = F.vcu * NWAVES + F.wave, NGW = F.G * NWAVES;
    unsigned char* ws = F.ws;
    constexpr int I_IN = 32 * (NIN / 64), I_RO = 32 * 32, I_HO = 16 * 32, I_OUT = 32 * 32, I_FI = 32 * (2 * DFF / 64), I_FO = (DFF / 64) * 32;
    constexpr int NITEMS = I_IN + I_RO + I_HO + I_OUT + I_FI + I_FO;
    for (int it = gw; it < NITEMS; it += NGW) {
        int r = it;
        if (r < I_IN) { p0_transpose_item<0>(A.in[4], 2048, NIN, (bf16*)(ws + WS_WIN), A.in[8], scr, r, F.lane); continue; } r -= I_IN;
        if (r < I_RO) { p0_transpose_item<0>(A.in[5], 2048, 2048, (bf16*)(ws + WS_WRO), nullptr, scr, r, F.lane); continue; } r -= I_RO;
        if (r < I_HO) { p0_transpose_item<0>(A.in[6], 1024, 2048, (bf16*)(ws + WS_WHO), nullptr, scr, r, F.lane); continue; } r -= I_HO;
        if (r < I_OUT) { p0_transpose_item<0>(A.in[7], 2048, 2048, (bf16*)(ws + WS_WOUT), nullptr, scr, r, F.lane); continue; } r -= I_OUT;
        if (r < I_FI) { p0_transpose_item<2>(A.in[12], 2048, 2 * DFF, (bf16*)(ws + WS_WFI), A.in[9], scr, r, F.lane); continue; } r -= I_FI;
        p0_transpose_item<0>(A.in[13], DFF, 2048, (bf16*)(ws + WS_WFO), nullptr, scr, r, F.lane);
    }
    bf16* XB = (bf16*)(ws + WS_XB);
    for (int m = gw; m < MPAD; m += NGW) {
        GAS unsigned long long* o8 = (GAS unsigned long long*)(XB + (size_t)m * 2048) + F.lane;
        if (m < MROWS) {
            const float* xrow = m < 8192 ? A.in[0] + (size_t)m * 2048 : A.in[1] + (size_t)(m - 8192) * 2048;
            const GAS f32x4* xr = (const GAS f32x4*)xrow + F.lane;
            f32x4 v[8]; float s = 0.f;
#pragma unroll
            for (int j = 0; j < 8; ++j) { v[j] = xr[64 * j]; s += (v[j].x * v[j].x + v[j].y * v[j].y) + (v[j].z * v[j].z + v[j].w * v[j].w); }
            const float rr = 1.0f / sqrtf(wave_sum(s) * (1.0f / 2048.0f) + EPS);
#pragma unroll
            for (int j = 0; j < 8; ++j) o8[64 * j] = (unsigned long long)pk2(v[j].x * rr, v[j].y * rr) | ((unsigned long long)pk2(v[j].z * rr, v[j].w * rr) << 32);
        } else {
#pragma unroll
            for (int j = 0; j < 8; ++j) o8[64 * j] = 0ull;
        }
    }
    { float* COS = (float*)(ws + WS_COS); float* SIN = (float*)(ws + WS_SIN);
      for (int i = (F.vcu * NWAVES + F.wave) * 64 + F.lane; i < 2049 * 64; i += F.G * NWAVES * 64) { const int p = i >> 6, j = i & 63; const int pos = p < 2048 ? p : 16384;
          const float inv = powf(10000.0f, -(float)j / 64.0f); const float ang = (float)pos * inv; float sn, cs; sincosf(ang, &sn, &cs); COS[i] = cs; SIN[i] = sn; } }
    { float* LB = (float*)(ws + WS_LB); const int i = (F.vcu * NWAVES + F.wave) * 64 + F.lane; if (i < 1024) { const float l0 = A.in[11][i], l1 = A.in[11][1024 + i]; LB[i] = 1.0f / (1.0f + expf(l1 - l0)); } }
}
typedef short bf16x4v __attribute__((ext_vector_type(4)));
#define MFMA16(a, b, c) __builtin_amdgcn_mfma_f32_16x16x32_bf16((a), (b), (c), 0, 0, 0)
constexpr int TP = 136;
constexpr size_t OUT_YS = 8192ull * 2048, OUT_SRP = 8320ull * 2048, OUT_SHP = OUT_SRP + 4ull * 8 * 128 * 256, OUT_SRS = OUT_SHP + 4ull * 8 * 128 * 128, OUT_SHS = OUT_SRS + 128ull * 8 * 128 * 256;
__device__ __forceinline__ float lg2gamma(int h) { return log2f(1.0f - exp2f(-5.0f - (float)h)); }
__device__ __forceinline__ float bfe(const v4u& w, int j) { const unsigned x = w[j >> 1]; return __uint_as_float((j & 1) ? (x & 0xffff0000u) : (x << 16)); }
__device__ __forceinline__ bf16x8 pack_f8(const float* v) { v4u w; w.x = pk2(v[0], v[1]); w.y = pk2(v[2], v[3]); w.z = pk2(v[4], v[5]); w.w = pk2(v[6], v[7]); return __builtin_bit_cast(bf16x8, w); }

__device__ __forceinline__ void p2_ret_item(Frame& F, int item) {
    unsigned char* ws = F.ws;
    const int c = item & 15, h = (item >> 4) & 7, b = item >> 7, r0 = b * 2048 + c * 128;
    const int w = F.wave, l15 = F.lane & 15, g = F.lane >> 4;
    LAS bf16* KT = (LAS bf16*)F.lds; LAS bf16* VT = KT + 128 * TP;
    const bf16* Kg = (const bf16*)(ws + WS_K); const bf16* Vg = (const bf16*)(ws + WS_V);
    const float* COS = (const float*)(ws + WS_COS); const float* SIN = (const float*)(ws + WS_SIN);
    const float lg = lg2gamma(h);
    __syncthreads();
#pragma unroll
    for (int i = 0; i < 2; ++i) { const int u = F.tid + 512 * i, m = u & 127, d0 = (u >> 7) * 8;
        const bf16* kp = Kg + (size_t)(r0 + m) * 1024 + h * 128 + d0; const v4u a = *(const v4u*)kp, bb = *(const v4u*)(kp + 64);
        const int pos = c * 128 + m; const f32x4 c0 = *(const f32x4*)(COS + pos * 64 + d0), c1 = *(const f32x4*)(COS + pos * 64 + d0 + 4), s0 = *(const f32x4*)(SIN + pos * 64 + d0), s1 = *(const f32x4*)(SIN + pos * 64 + d0 + 4);
        const float dec = exp2f((float)(127 - m) * lg);
#pragma unroll
        for (int j = 0; j < 8; ++j) { const float x1 = bfe(a, j), x2 = bfe(bb, j), cj = j < 4 ? c0[j & 3] : c1[j & 3], sj = j < 4 ? s0[j & 3] : s1[j & 3];
            KT[(d0 + j) * TP + m] = (bf16)f2bf((x1 * cj - x2 * sj) * dec); KT[(64 + d0 + j) * TP + m] = (bf16)f2bf((x2 * cj + x1 * sj) * dec); } }
#pragma unroll
    for (int i = 0; i < 8; ++i) { const int u = F.tid + 512 * i, m = u & 127, e0 = (u >> 7) * 8;
        const v4u a = *(const v4u*)(Vg + (size_t)(r0 + m) * 2048 + h * 256 + e0);
#pragma unroll
        for (int j = 0; j < 8; ++j) VT[(e0 + j) * TP + m] = (bf16)((a[j >> 1] >> (16 * (j & 1))) & 0xffffu); }
    __syncthreads();
    f32x4 acc[8][2];
#pragma unroll
    for (int dt = 0; dt < 8; ++dt) { acc[dt][0] = (f32x4){0.f, 0.f, 0.f, 0.f}; acc[dt][1] = (f32x4){0.f, 0.f, 0.f, 0.f}; }
#pragma unroll
    for (int ks = 0; ks < 4; ++ks) {
        const bf16x8 b0 = *(const LAS bf16x8*)&VT[(32 * w + l15) * TP + 32 * ks + 8 * g], b1 = *(const LAS bf16x8*)&VT[(32 * w + 16 + l15) * TP + 32 * ks + 8 * g];
#pragma unroll
        for (int dt = 0; dt < 8; ++dt) { const bf16x8 af = *(const LAS bf16x8*)&KT[(16 * dt + l15) * TP + 32 * ks + 8 * g];
            acc[dt][0] = MFMA16(af, b0, acc[dt][0]); acc[dt][1] = MFMA16(af, b1, acc[dt][1]); } }
    float* out = (float*)(ws + WS_KVLOC) + (size_t)item * 256 * 128;
#pragma unroll
    for (int dt = 0; dt < 8; ++dt)
#pragma unroll
        for (int et = 0; et < 2; ++et) *(f32x4*)(out + (32 * w + 16 * et + l15) * 128 + 16 * dt + 4 * g) = acc[dt][et];
}
__device__ __forceinline__ void p2_hg_item(Frame& F, int item) {
    unsigned char* ws = F.ws;
    const int sc = item & 15, h = (item >> 4) & 7, b = item >> 7, r0 = b * 2048 + sc * 128;
    const int w = F.wave, l15 = F.lane & 15, g = F.lane >> 4;
    LAS bf16* KT = (LAS bf16*)F.lds; LAS bf16* VT = KT + 128 * TP; LAS float* LQ = (LAS float*)(VT + 128 * TP);
    const float* Z = (const float*)(ws + WS_LOGF); const bf16* HI = (const bf16*)(ws + WS_HI); const float* LB = (const float*)(ws + WS_LB);
    __syncthreads();
    const int d = F.tid & 127, q = F.tid >> 7; const float oml = 1.0f - LB[h * 128 + d];
    float lf[32], kin[32]; float L = 0.f;
#pragma unroll
    for (int i = 0; i < 32; ++i) { const float z = Z[(size_t)(r0 + 32 * q + i) * 1024 + h * 128 + d]; kin[i] = oml / (1.0f + __expf(z)); lf[i] = log1pf(-kin[i]); L += lf[i]; }
    LQ[q * 128 + d] = L;
#pragma unroll
    for (int i = 0; i < 4; ++i) { const int u = F.tid + 512 * i, m = u & 127, e0 = (u >> 7) * 8;
        const v4u a = *(const v4u*)(HI + (size_t)(r0 + m) * 1024 + h * 128 + e0);
#pragma unroll
        for (int j = 0; j < 8; ++j) VT[(e0 + j) * TP + m] = (bf16)((a[j >> 1] >> (16 * (j & 1))) & 0xffffu); }
    __syncthreads();
    float run = 0.f;
#pragma unroll
    for (int q2 = 1; q2 < 4; ++q2) if (q2 > q) run += LQ[q2 * 128 + d];
#pragma unroll
    for (int blk = 3; blk >= 0; --blk) { float v[8];
#pragma unroll
        for (int jj = 7; jj >= 0; --jj) { const int i = 8 * blk + jj; v[jj] = kin[i] * __expf(run); run += lf[i]; }
        *(LAS bf16x8*)&KT[d * TP + 32 * q + 8 * blk] = pack_f8(v); }
    if (q == 0) ((float*)(ws + WS_BTOT))[item * 128 + d] = run;
    __syncthreads();
    f32x4 acc[8];
#pragma unroll
    for (int dt = 0; dt < 8; ++dt) acc[dt] = (f32x4){0.f, 0.f, 0.f, 0.f};
#pragma unroll
    for (int ks = 0; ks < 4; ++ks) { const bf16x8 b0 = *(const LAS bf16x8*)&VT[(16 * w + l15) * TP + 32 * ks + 8 * g];
#pragma unroll
        for (int dt = 0; dt < 8; ++dt) { const bf16x8 af = *(const LAS bf16x8*)&KT[(16 * dt + l15) * TP + 32 * ks + 8 * g]; acc[dt] = MFMA16(af, b0, acc[dt]); } }
    float* out = (float*)(ws + WS_HSLOC) + (size_t)item * 128 * 128;
#pragma unroll
    for (int dt = 0; dt < 8; ++dt) *(f32x4*)(out + (16 * w + l15) * 128 + 16 * dt + 4 * g) = acc[dt];
}
__device__ __forceinline__ void p2_sret_item(Frame& F, const Args& A, int it) {
    unsigned char* ws = F.ws; const int h = it & 7, b = it >> 3, r = 8192 + b;
    LAS float* qs = (LAS float*)F.lds; LAS float* ks = qs + 128; LAS float* vs = ks + 128; LAS float* ored = vs + 256;
    const bf16* Q = (const bf16*)(ws + WS_Q); const bf16* K = (const bf16*)(ws + WS_K); const bf16* V = (const bf16*)(ws + WS_V);
    __syncthreads();
    if (F.tid < 64) { const int d = F.tid; const float cs = ((const float*)(ws + WS_COS))[2048 * 64 + d], sn = ((const float*)(ws + WS_SIN))[2048 * 64 + d];
        const float q1 = bf2f(Q[(size_t)r * 1024 + h * 128 + d]), q2 = bf2f(Q[(size_t)r * 1024 + h * 128 + 64 + d]), k1 = bf2f(K[(size_t)r * 1024 + h * 128 + d]), k2 = bf2f(K[(size_t)r * 1024 + h * 128 + 64 + d]);
        qs[d] = q1 * cs - q2 * sn; qs[d + 64] = q2 * cs + q1 * sn; ks[d] = k1 * cs - k2 * sn; ks[d + 64] = k2 * cs + k1 * sn; }
    else if (F.tid >= 256) { const int e = F.tid - 256; vs[e] = bf2f(V[(size_t)r * 2048 + h * 256 + e]); }
    __syncthreads();
    const float gam = 1.0f - exp2f(-5.0f - (float)h);
    const int e4 = F.tid & 63, dq = F.tid >> 6;
    const float* Sin = A.in[2] + ((size_t)(b * 8 + h) * 128) * 256; float* Sout = F.out + OUT_SRS + ((size_t)(b * 8 + h) * 128) * 256;
    const f32x4 v4 = *(const LAS f32x4*)&vs[4 * e4]; f32x4 o = (f32x4){0.f, 0.f, 0.f, 0.f};
    f32x4 s[16];
#pragma unroll
    for (int i = 0; i < 16; ++i) s[i] = *(const f32x4*)(Sin + (size_t)(16 * dq + i) * 256 + 4 * e4);
#pragma unroll
    for (int i = 0; i < 16; ++i) { const int d = 16 * dq + i; s[i] = s[i] * gam + v4 * ks[d]; *(f32x4*)(Sout + (size_t)d * 256 + 4 * e4) = s[i]; o += s[i] * qs[d]; }
    *(LAS f32x4*)&ored[dq * 256 + 4 * e4] = o;
    __syncthreads();
    if (F.wave == 0) { float oo[4]; float ss = 0.f;
#pragma unroll
        for (int k = 0; k < 4; ++k) { const int e = F.lane + 64 * k; float t = 0.f;
#pragma unroll
            for (int j = 0; j < 8; ++j) t += ored[j * 256 + e];
            oo[k] = t; ss += t * t; }
        const float rr = 1.0f / sqrtf(wave_sum(ss) * (1.0f / 256.0f) + EPS);
        const bf16* RG = (const bf16*)(ws + WS_RG); bf16* OR = (bf16*)(ws + WS_OR);
#pragma unroll
        for (int k = 0; k < 4; ++k) { const size_t ix = (size_t)r * 2048 + h * 256 + F.lane + 64 * k; OR[ix] = (bf16)f2bf(oo[k] * rr * bf2f(RG[ix])); } }
}
__device__ __forceinline__ void p2_shg_item(Frame& F, const Args& A, int it) {
    unsigned char* ws = F.ws; const int h = it & 7, b = it >> 3, r = 8192 + b;
    LAS float* qs = (LAS float*)F.lds; LAS float* fs = qs + 128; LAS float* kn = fs + 128; LAS float* vs = kn + 128; LAS float* ored = vs + 128;
    __syncthreads();
    if (F.tid < 128) { const int d = F.tid; const size_t ix = (size_t)r * 1024 + h * 128 + d; const float z = ((const float*)(ws + WS_LOGF))[ix]; const float lb = ((const float*)(ws + WS_LB))[h * 128 + d];
        const float kin = (1.0f - lb) / (1.0f + __expf(z)); kn[d] = kin; fs[d] = 1.0f - kin; qs[d] = bf2f(((const bf16*)(ws + WS_HQ))[ix]); vs[d] = bf2f(((const bf16*)(ws + WS_HI))[ix]); }
    __syncthreads();
    const int e4 = F.tid & 31, dq = F.tid >> 5;
    const float* Sin = A.in[3] + ((size_t)(b * 8 + h) * 128) * 128; float* Sout = F.out + OUT_SHS + ((size_t)(b * 8 + h) * 128) * 128;
    const f32x4 v4 = *(const LAS f32x4*)&vs[4 * e4]; f32x4 o = (f32x4){0.f, 0.f, 0.f, 0.f};
    f32x4 s[8];
#pragma unroll
    for (int i = 0; i < 8; ++i) s[i] = *(const f32x4*)(Sin + (size_t)(8 * dq + i) * 128 + 4 * e4);
#pragma unroll
    for (int i = 0; i < 8; ++i) { const int d = 8 * dq + i; s[i] = s[i] * fs[d] + v4 * kn[d]; *(f32x4*)(Sout + (size_t)d * 128 + 4 * e4) = s[i]; o += s[i] * qs[d]; }
    *(LAS f32x4*)&ored[dq * 128 + 4 * e4] = o;
    __syncthreads();
    if (F.wave == 0) { float oo[2]; float ss = 0.f;
#pragma unroll
        for (int k = 0; k < 2; ++k) { const int e = F.lane + 64 * k; float t = 0.f;
#pragma unroll
            for (int j = 0; j < 16; ++j) t += ored[j * 128 + e];
            oo[k] = t; ss += t * t; }
        const float rr = 1.0f / sqrtf(wave_sum(ss) * (1.0f / 128.0f) + EPS);
        const bf16* HG = (const bf16*)(ws + WS_HG); bf16* OH = (bf16*)(ws + WS_OH);
#pragma unroll
        for (int k = 0; k < 2; ++k) { const int e = F.lane + 64 * k; const size_t ix = (size_t)r * 1024 + h * 128 + e; OH[ix] = (bf16)f2bf(oo[k] * rr * A.in[10][e] * bf2f(HG[ix])); } }
}
__device__ __forceinline__ void p2_phase(Frame& F, const Args& A) {
    for (int it = F.vcu; it < 512; it += F.G) p2_ret_item(F, it);
    for (int it = F.vcu; it < 512; it += F.G) p2_hg_item(F, it);
    for (int it = F.vcu; it < 1024; it += F.G) p2_sret_item(F, A, it);
    for (int it = F.vcu; it < 1024; it += F.G) p2_shg_item(F, A, it);
}
__device__ __forceinline__ void p3_phase(Frame& F) {
    unsigned char* ws = F.ws;
    const int gt = F.vcu * 512 + F.tid, NT = F.G * 512;
    for (int gid = gt; gid < 32 * 256 * 32; gid += NT) {
        const int bh = gid >> 13, e = (gid >> 5) & 255, d4 = gid & 31; const float cd = exp2f(128.0f * lg2gamma(bh & 7));
        const float* kv = (const float*)(ws + WS_KVLOC) + ((size_t)bh * 16 * 256 + e) * 128 + 4 * d4; bf16* st = (bf16*)(ws + WS_SRT) + ((size_t)bh * 16 * 256 + e) * 128 + 4 * d4;
        f32x4 x[16];
#pragma unroll
        for (int c = 0; c < 16; ++c) x[c] = *(const f32x4*)(kv + (size_t)c * 256 * 128);
        f32x4 S = (f32x4){0.f, 0.f, 0.f, 0.f};
#pragma unroll
        for (int c = 0; c < 16; ++c) { v2u p; p.x = pk2(S[0], S[1]); p.y = pk2(S[2], S[3]); *(v2u*)(st + (size_t)c * 256 * 128) = p; S = S * cd + x[c]; }
        float* fo = F.out + OUT_SRP + ((size_t)bh * 128 + 4 * d4) * 256 + e;
#pragma unroll
        for (int i = 0; i < 4; ++i) fo[(size_t)i * 256] = S[i];
    }
    for (int gid = gt; gid < 32 * 128 * 32; gid += NT) {
        const int bh = gid >> 12, e = (gid >> 5) & 127, d4 = gid & 31;
        const float* hs = (const float*)(ws + WS_HSLOC) + ((size_t)bh * 16 * 128 + e) * 128 + 4 * d4; bf16* st = (bf16*)(ws + WS_SHT) + ((size_t)bh * 16 * 128 + e) * 128 + 4 * d4;
        const float* bt = (const float*)(ws + WS_BTOT) + (size_t)bh * 16 * 128 + 4 * d4;
        f32x4 S = (f32x4){0.f, 0.f, 0.f, 0.f};
#pragma unroll 4
        for (int c = 0; c < 16; ++c) { const f32x4 x = *(const f32x4*)(hs + (size_t)c * 128 * 128); const f32x4 bb = *(const f32x4*)(bt + c * 128);
            v2u p; p.x = pk2(S[0], S[1]); p.y = pk2(S[2], S[3]); *(v2u*)(st + (size_t)c * 128 * 128) = p;
            S[0] = S[0] * __expf(bb[0]) + x[0]; S[1] = S[1] * __expf(bb[1]) + x[1]; S[2] = S[2] * __expf(bb[2]) + x[2]; S[3] = S[3] * __expf(bb[3]) + x[3]; }
        float* fo = F.out + OUT_SHP + ((size_t)bh * 128 + 4 * d4) * 128 + e;
#pragma unroll
        for (int i = 0; i < 4; ++i) fo[(size_t)i * 128] = S[i];
    }
}
__device__ __forceinline__ void p4_ret_item(Frame& F, int item) {
    unsigned char* ws = F.ws;
    const int c = item & 15, h = (item >> 4) & 7, b = item >> 7, r0 = b * 2048 + c * 128;
    const int w = F.wave, l15 = F.lane & 15, g = F.lane >> 4;
    LAS bf16* KS = (LAS bf16*)F.lds; LAS bf16* VT = KS + 128 * TP;
    const bf16* Qg = (const bf16*)(ws + WS_Q); const bf16* Kg = (const bf16*)(ws + WS_K); const bf16* Vg = (const bf16*)(ws + WS_V);
    const float* COS = (const float*)(ws + WS_COS); const float* SIN = (const float*)(ws + WS_SIN);
    const float lg = lg2gamma(h);
    __syncthreads();
#pragma unroll
    for (int i = 0; i < 2; ++i) { const int u = F.tid + 512 * i, d0 = (u & 7) * 8, m = u >> 3;
        const bf16* kp = Kg + (size_t)(r0 + m) * 1024 + h * 128 + d0; const v4u a = *(const v4u*)kp, bb = *(const v4u*)(kp + 64);
        const int pos = c * 128 + m; const f32x4 c0 = *(const f32x4*)(COS + pos * 64 + d0), c1 = *(const f32x4*)(COS + pos * 64 + d0 + 4), s0 = *(const f32x4*)(SIN + pos * 64 + d0), s1 = *(const f32x4*)(SIN + pos * 64 + d0 + 4);
        float o1[8], o2[8];
#pragma unroll
        for (int j = 0; j < 8; ++j) { const float x1 = bfe(a, j), x2 = bfe(bb, j), cj = j < 4 ? c0[j & 3] : c1[j & 3], sj = j < 4 ? s0[j & 3] : s1[j & 3]; o1[j] = x1 * cj - x2 * sj; o2[j] = x2 * cj + x1 * sj; }
        *(LAS bf16x8*)&KS[m * TP + d0] = pack_f8(o1); *(LAS bf16x8*)&KS[m * TP + 64 + d0] = pack_f8(o2); }
#pragma unroll
    for (int i = 0; i < 8; ++i) { const int u = F.tid + 512 * i, m = u & 127, e0 = (u >> 7) * 8;
        const v4u a = *(const v4u*)(Vg + (size_t)(r0 + m) * 2048 + h * 256 + e0);
#pragma unroll
        for (int j = 0; j < 8; ++j) VT[(e0 + j) * TP + m] = (bf16)((a[j >> 1] >> (16 * (j & 1))) & 0xffffu); }
    bf16x8 qf[4];
    { const int n = 16 * w + l15, pos = c * 128 + n; const bf16* qp = Qg + (size_t)(r0 + n) * 1024 + h * 128 + 8 * g;
      const v4u a0 = *(const v4u*)qp, a1 = *(const v4u*)(qp + 32), a2 = *(const v4u*)(qp + 64), a3 = *(const v4u*)(qp + 96);
      float r0v[8], r1v[8], r2v[8], r3v[8];
#pragma unroll
      for (int hlf = 0; hlf < 2; ++hlf) { const int dd = 32 * hlf + 8 * g;
          const f32x4 c0 = *(const f32x4*)(COS + pos * 64 + dd), c1 = *(const f32x4*)(COS + pos * 64 + dd + 4), s0 = *(const f32x4*)(SIN + pos * 64 + dd), s1 = *(const f32x4*)(SIN + pos * 64 + dd + 4);
#pragma unroll
          for (int j = 0; j < 8; ++j) { const float cj = j < 4 ? c0[j & 3] : c1[j & 3], sj = j < 4 ? s0[j & 3] : s1[j & 3];
              const float x1 = hlf == 0 ? bfe(a0, j) : bfe(a1, j), x2 = hlf == 0 ? bfe(a2, j) : bfe(a3, j);
              if (hlf == 0) { r0v[j] = x1 * cj - x2 * sj; r2v[j] = x2 * cj + x1 * sj; } else { r1v[j] = x1 * cj - x2 * sj; r3v[j] = x2 * cj + x1 * sj; } } }
      qf[0] = pack_f8(r0v); qf[1] = pack_f8(r1v); qf[2] = pack_f8(r2v); qf[3] = pack_f8(r3v); }
    __syncthreads();
    f32x4 O[16];
    { const bf16* st = (const bf16*)(ws + WS_SRT) + (size_t)item * 256 * 128 + 8 * g;
#pragma unroll
      for (int et = 0; et < 16; ++et) { f32x4 t = (f32x4){0.f, 0.f, 0.f, 0.f};
#pragma unroll
          for (int ks = 0; ks < 4; ++ks) { const bf16x8 sf = *(const bf16x8*)(st + (size_t)(16 * et + l15) * 128 + 32 * ks); t = MFMA16(qf[ks], sf, t); }
          O[et] = t; }
      float rs[4];
#pragma unroll
      for (int reg = 0; reg < 4; ++reg) rs[reg] = exp2f((float)(16 * w + 4 * g + reg + 1) * lg);
#pragma unroll
      for (int et = 0; et < 16; ++et)
#pragma unroll
          for (int reg = 0; reg < 4; ++reg) O[et][reg] *= rs[reg]; }
    bf16x8 pf[4];
#pragma unroll
    for (int s = 0; s < 4; ++s) { float pv[8];
#pragma unroll
        for (int hf = 0; hf < 2; ++hf) { const int mt = 2 * s + hf; f32x4 dd = (f32x4){0.f, 0.f, 0.f, 0.f};
            if (mt <= w) {
#pragma unroll
                for (int ks = 0; ks < 4; ++ks) { const bf16x8 kf = *(const LAS bf16x8*)&KS[(16 * mt + l15) * TP + 32 * ks + 8 * g]; dd = MFMA16(kf, qf[ks], dd); }
#pragma unroll
                for (int reg = 0; reg < 4; ++reg) { const int m = 16 * mt + 4 * g + reg, n = 16 * w + l15; dd[reg] = n >= m ? dd[reg] * exp2f((float)(n - m) * lg) : 0.f; } }
#pragma unroll
            for (int reg = 0; reg < 4; ++reg) pv[4 * hf + reg] = dd[reg]; }
        pf[s] = pack_f8(pv); }
#pragma unroll
    for (int s = 0; s < 4; ++s) if (2 * s <= w) {
#pragma unroll
        for (int et = 0; et < 16; ++et) { const LAS bf16* vp = &VT[(16 * et + l15) * TP + 32 * s + 4 * g];
            const bf16x4v lo = *(const LAS bf16x4v*)vp, hi = *(const LAS bf16x4v*)(vp + 16);
            const bf16x8 vf = __builtin_shufflevector(lo, hi, 0, 1, 2, 3, 4, 5, 6, 7); O[et] = MFMA16(pf[s], vf, O[et]); } }
    float ss[4] = {0.f, 0.f, 0.f, 0.f};
#pragma unroll
    for (int et = 0; et < 16; ++et)
#pragma unroll
        for (int reg = 0; reg < 4; ++reg) ss[reg] += O[et][reg] * O[et][reg];
#pragma unroll
    for (int reg = 0; reg < 4; ++reg) { float v = ss[reg]; v += __shfl_xor(v, 1); v += __shfl_xor(v, 2); v += __shfl_xor(v, 4); v += __shfl_xor(v, 8); ss[reg] = 1.0f / sqrtf(v * (1.0f / 256.0f) + EPS); }
    const bf16* RG = (const bf16*)(ws + WS_RG); bf16* OR = (bf16*)(ws + WS_OR);
#pragma unroll
    for (int reg = 0; reg < 4; ++reg) { const size_t rb = (size_t)(r0 + 16 * w + 4 * g + reg) * 2048 + h * 256 + l15;
#pragma unroll
        for (int et = 0; et < 16; ++et) OR[rb + 16 * et] = (bf16)f2bf(O[et][reg] * ss[reg] * bf2f(RG[rb + 16 * et])); }
}
__device__ __forceinline__ void p4_hg_item(Frame& F, const Args& A, int item) {
    unsigned char* ws = F.ws;
    const int sc = item & 15, h = (item >> 4) & 7, b = item >> 7, r0 = b * 2048 + sc * 128;
    const int w = F.wave, l15 = F.lane & 15, g = F.lane >> 4;
    LAS bf16* QP = (LAS bf16*)F.lds;
    LAS bf16* KP = QP + 64 * TP;
    LAS bf16* KU = KP + 64 * TP;
    LAS bf16* VT = KU + 128 * 72;
    LAS float* E15 = (LAS float*)(VT + 128 * 72);
    LAS float* OB = E15 + 4 * 128;
    const float* Z = (const float*)(ws + WS_LOGF); const bf16* HQ = (const bf16*)(ws + WS_HQ); const bf16* HI = (const bf16*)(ws + WS_HI); const float* LB = (const float*)(ws + WS_LB);
    f32x4 S[8];
    { const bf16* st = (const bf16*)(ws + WS_SHT) + (size_t)item * 128 * 128 + (size_t)(16 * w + l15) * 128 + 4 * g;
#pragma unroll
      for (int dt = 0; dt < 8; ++dt) { const v2u p = *(const v2u*)(st + 16 * dt); S[dt][0] = __uint_as_float(p.x << 16); S[dt][1] = __uint_as_float(p.x & 0xffff0000u); S[dt][2] = __uint_as_float(p.y << 16); S[dt][3] = __uint_as_float(p.y & 0xffff0000u); } }
    for (int hf = 0; hf < 2; ++hf) {
        const int rh = r0 + 64 * hf;
        __syncthreads();
        { const int d = F.tid & 127, sq = F.tid >> 7; const float oml = 1.0f - LB[h * 128 + d];
          float kin[16], bcum[16]; float bb = 0.f;
#pragma unroll
          for (int t = 0; t < 16; ++t) { const size_t ix = (size_t)(rh + 16 * sq + t) * 1024 + h * 128 + d; const float z = Z[ix]; const float q = bf2f(HQ[ix]);
              kin[t] = oml / (1.0f + __expf(z)); bb += log1pf(-kin[t]); bcum[t] = bb;
              QP[(16 * sq + t) * TP + d] = (bf16)f2bf(q * __expf(bb)); KP[(16 * sq + t) * TP + d] = (bf16)f2bf(kin[t] * __expf(fminf(-bb, 80.0f))); }
          E15[sq * 128 + d] = __expf(bb);
          float v[8];
#pragma unroll
          for (int t = 0; t < 8; ++t) v[t] = kin[t] * __expf(bb - bcum[t]);
          *(LAS bf16x8*)&KU[d * 72 + 16 * sq] = pack_f8(v);
#pragma unroll
          for (int t = 0; t < 8; ++t) v[t] = kin[8 + t] * __expf(bb - bcum[8 + t]);
          *(LAS bf16x8*)&KU[d * 72 + 16 * sq + 8] = pack_f8(v); }
#pragma unroll
        for (int i = 0; i < 2; ++i) { const int u = F.tid + 512 * i, m = u & 63, e0 = (u >> 6) * 8;
            const v4u a = *(const v4u*)(HI + (size_t)(rh + m) * 1024 + h * 128 + e0);
#pragma unroll
            for (int j = 0; j < 8; ++j) VT[(e0 + j) * 72 + m] = (bf16)((a[j >> 1] >> (16 * (j & 1))) & 0xffffu); }
        __syncthreads();
        const bf16x8 zero8 = (bf16x8){0, 0, 0, 0, 0, 0, 0, 0};
#pragma unroll
        for (int sq = 0; sq < 4; ++sq) {
            f32x4 at = (f32x4){0.f, 0.f, 0.f, 0.f};
#pragma unroll
            for (int ks = 0; ks < 4; ++ks) { const bf16x8 kf = *(const LAS bf16x8*)&KP[(16 * sq + l15) * TP + 32 * ks + 8 * g], qf = *(const LAS bf16x8*)&QP[(16 * sq + l15) * TP + 32 * ks + 8 * g]; at = MFMA16(kf, qf, at); }
            float pv[8];
#pragma unroll
            for (int reg = 0; reg < 4; ++reg) { pv[reg] = (4 * g + reg) <= l15 ? at[reg] : 0.f; pv[4 + reg] = 0.f; }
            const bf16x8 pfr = pack_f8(pv);
            f32x4 o;
            { const bf16x4v lo = *(const LAS bf16x4v*)&VT[(16 * w + l15) * 72 + 16 * sq + 4 * g]; const bf16x8 vf = __builtin_shufflevector(lo, (bf16x4v){0, 0, 0, 0}, 0, 1, 2, 3, 4, 5, 6, 7);
              const f32x4 z4 = {0.f, 0.f, 0.f, 0.f}; o = MFMA16(pfr, vf, z4); }
#pragma unroll
            for (int ks = 0; ks < 4; ++ks) { float sv[8];
#pragma unroll
                for (int jj = 0; jj < 8; ++jj) sv[jj] = S[2 * ks + (jj >> 2)][jj & 3];
                const bf16x8 sf = pack_f8(sv);
                const LAS bf16* qp = &QP[(16 * sq + l15) * TP + 32 * ks + 4 * g]; const bf16x4v lo = *(const LAS bf16x4v*)qp, hi = *(const LAS bf16x4v*)(qp + 16);
                const bf16x8 qf = __builtin_shufflevector(lo, hi, 0, 1, 2, 3, 4, 5, 6, 7); o = MFMA16(qf, sf, o); }
#pragma unroll
            for (int reg = 0; reg < 4; ++reg) OB[(16 * sq + 4 * g + reg) * 132 + 16 * w + l15] = o[reg];
            const bf16x8 vu = g < 2 ? *(const LAS bf16x8*)&VT[(16 * w + l15) * 72 + 16 * sq + 8 * g] : zero8;
#pragma unroll
            for (int dt = 0; dt < 8; ++dt) { const f32x4 ed = *(const LAS f32x4*)&E15[sq * 128 + 16 * dt + 4 * g];
                const bf16x8 kf = g < 2 ? *(const LAS bf16x8*)&KU[(16 * dt + l15) * 72 + 16 * sq + 8 * g] : zero8;
                S[dt] = MFMA16(kf, vu, S[dt] * ed); }
        }
        __syncthreads();
        { const bf16* HG = (const bf16*)(ws + WS_HG); bf16* OH = (bf16*)(ws + WS_OH);
#pragma unroll
          for (int i = 0; i < 8; ++i) { const int t = 8 * w + i; const float v0 = OB[t * 132 + F.lane], v1 = OB[t * 132 + 64 + F.lane];
              const float rr = 1.0f / sqrtf(wave_sum(v0 * v0 + v1 * v1) * (1.0f / 128.0f) + EPS); const size_t ix = (size_t)(rh + t) * 1024 + h * 128 + F.lane;
              OH[ix] = (bf16)f2bf(v0 * rr * A.in[10][F.lane] * bf2f(HG[ix])); OH[ix + 64] = (bf16)f2bf(v1 * rr * A.in[10][64 + F.lane] * bf2f(HG[ix + 64])); } }
    }
}
__device__ __forceinline__ void p4_phase(Frame& F, const Args& A) {
    for (int it = F.vcu; it < 512; it += F.G) p4_ret_item(F, it);
    for (int it = F.vcu; it < 512; it += F.G) p4_hg_item(F, A, it);
}
__global__ void __launch_bounds__(NWAVES * 64, 2) mk_fwd(Args args) {
    extern __shared__ __attribute__((aligned(16))) unsigned char lds[];
    Frame F;
    F.lds = (LAS unsigned char*)lds; F.MISC = (volatile LAS unsigned*)(F.lds + MISC_OFF);
    F.tid = threadIdx.x; F.lane = F.tid & 63; F.wave = __builtin_amdgcn_readfirstlane(F.tid >> 6);
    F.G = gridDim.x; { const int bx = blockIdx.x; F.vcu = (F.G % 8 == 0) ? (bx % 8) * (F.G / 8) + bx / 8 : bx; }
    F.ws = args.ws; F.out = args.out; F.ctl = (gu32*)(args.ws + WS_CTL);
    for (int u = F.tid; u < (LDS_BYTES - LDSCTL_OFF) / 4; u += NWAVES * 64) ((LAS unsigned*)(F.lds + LDSCTL_OFF))[u] = 0u;
    __syncthreads();
    XcdBarrier bar; bar.bar = (unsigned*)(F.ctl + CW_BAR); bar.x = 0; bar.st = nullptr;
    if (args.use_bar) bar = xcd_barrier_post((unsigned*)(F.ctl + CW_BAR), F.MISC + 8);
    const int lo = args.ph_lo, hi = args.ph_hi;
#define IN(k) (lo <= (k) && (k) < hi)
#define SEAM(k) do { if (IN(k) && IN((k) + 1)) xcd_barrier(bar); } while (0)
#ifndef PROBE_REPEAT
#define PROBE_REPEAT -1
#endif
#define NREP(k) ((PROBE_REPEAT == (k)) ? 2 : 1)
    unsigned char* ws = args.ws;
    if (PROBE_REPEAT == 0) { p0_prologue(F, args); xcd_barrier(bar); }
    if (IN(0)) { p0_prologue(F, args); } SEAM(0);
#define P1_BODY { \
        pg8::Gemm g{(const pg8::bf16_t*)(ws + WS_XB), (const pg8::bf16_t*)(ws + WS_WIN), MPAD, NIN, 2048}; pg8::StaticOrder S; S.init(MPAD, NIN, F.G, (int)blockIdx.x); \
        pg8::EpiInProj E{ws}; \
        pg8::gemm_phase<pg8::EpiInProj, pg8::StaticOrder, true, true>(F.lds, g, S, E); }
    if (PROBE_REPEAT == 1) { P1_BODY xcd_barrier(bar); }
    if (IN(1)) P1_BODY SEAM(1);
    if (PROBE_REPEAT == 2) { p2_phase(F, args); xcd_barrier(bar); }
    if (IN(2)) { p2_phase(F, args); } SEAM(2);
    if (PROBE_REPEAT == 3) { p3_phase(F); xcd_barrier(bar); }
    if (IN(3)) { p3_phase(F); } SEAM(3);
    if (PROBE_REPEAT == 4) { p4_phase(F, args); xcd_barrier(bar); }
    if (IN(4)) { p4_phase(F, args); } SEAM(4);
    if (IN(5)) {
        { pg8::Gemm g{(const pg8::bf16_t*)(ws + WS_OR), (const pg8::bf16_t*)(ws + WS_WRO), MPAD, 2048, 2048}; pg8::StaticOrder S; S.init(MPAD, 2048, F.G, (int)blockIdx.x);
          pg8::EpiGate<0> E{(const pg8::bf16_t*)(ws + WS_GA), (float*)(ws + WS_YT), (pg8::bf16_t*)(ws + WS_MG)};
          pg8::gemm_phase<pg8::EpiGate<0>, pg8::StaticOrder, true, true>(F.lds, g, S, E); }
        { pg8::Gemm g{(const pg8::bf16_t*)(ws + WS_OH), (const pg8::bf16_t*)(ws + WS_WHO), MPAD, 2048, 1024}; pg8::StaticOrder S; S.init(MPAD, 2048, F.G, (int)blockIdx.x);
          pg8::EpiGate<1> E{(const pg8::bf16_t*)(ws + WS_GB), (float*)(ws + WS_YT), (pg8::bf16_t*)(ws + WS_MG)};
          pg8::gemm_phase<pg8::EpiGate<1>, pg8::StaticOrder, true, true>(F.lds, g, S, E); }
    } SEAM(5);
    if (IN(6)) {
        pg8::Gemm g{(const pg8::bf16_t*)(ws + WS_MG), (const pg8::bf16_t*)(ws + WS_WOUT), MPAD, 2048, 2048}; pg8::StaticOrder S; S.init(MPAD, 2048, F.G, (int)blockIdx.x);
        pg8::EpiResid E{args.in[0], args.in[1], args.out, (pg8::bf16_t*)(ws + WS_X1B), (float*)(F.ctl + CW_SS1)};
        pg8::gemm_phase<pg8::EpiResid, pg8::StaticOrder, true, true>(F.lds, g, S, E);
    } SEAM(6);
    if (IN(7)) {
        pg8::Gemm g{(const pg8::bf16_t*)(ws + WS_X1B), (const pg8::bf16_t*)(ws + WS_WFI), MPAD, 2 * DFF, 2048}; pg8::StaticOrder S; S.init(MPAD, 2 * DFF, F.G, (int)blockIdx.x);
        pg8::EpiSwiglu E{(const float*)(F.ctl + CW_SS1), (pg8::bf16_t*)(ws + WS_ACT)};
        pg8::gemm_phase<pg8::EpiSwiglu, pg8::StaticOrder, true, true>(F.lds, g, S, E);
    } SEAM(7);
    if (IN(8)) {
        pg8::Gemm g{(const pg8::bf16_t*)(ws + WS_ACT), (const pg8::bf16_t*)(ws + WS_WFO), MPAD, 2048, DFF}; pg8::StaticOrder S; S.init(MPAD, 2048, F.G, (int)blockIdx.x);
        pg8::EpiResid E{args.out, args.out + OUT_YS, args.out, nullptr, (float*)(F.ctl + CW_SS2)};
        pg8::gemm_phase<pg8::EpiResid, pg8::StaticOrder, true, true>(F.lds, g, S, E);
    } SEAM(8);
    if (IN(9)) {
        const int gw = F.vcu * NWAVES + F.wave, NGW = F.G * NWAVES; const float* SS2 = (const float*)(F.ctl + CW_SS2);
        for (int m = gw; m < MROWS; m += NGW) { f32x4* xr = (f32x4*)(args.out + (size_t)m * 2048) + F.lane; const f32x4* gn = (const f32x4*)args.in[14] + F.lane;
            const float rr = 1.0f / sqrtf(SS2[m] * (1.0f / 2048.0f) + EPS);
#pragma unroll
            for (int j = 0; j < 8; ++j) xr[64 * j] = xr[64 * j] * rr * gn[64 * j]; }
    }
#undef IN
#undef SEAM
}
extern "C" void kernel_launch(void* const* d_in, const int* in_sizes, int n_in, void* d_out, int out_size, void* d_ws, size_t ws_size, hipStream_t stream) {
    static int grid = 0;
    if (grid == 0) {
        int dev = 0, cus = 0;
        if (ws_size < WS_END || n_in != 15) { fprintf(stderr, "kernel_launch: unexpected sizes (ws %zu, n_in %d)\n", ws_size, n_in); grid = -1; return; }
        if (hipGetDevice(&dev) != hipSuccess || hipDeviceGetAttribute(&cus, hipDeviceAttributeMultiprocessorCount, dev) != hipSuccess) { grid = -1; return; }
        if (hipFuncSetAttribute((const void*)mk_fwd, hipFuncAttributeMaxDynamicSharedMemorySize, LDS_BYTES) != hipSuccess) { fprintf(stderr, "kernel_launch: hipFuncSetAttribute failed\n"); grid = -1; return; }
        int per_cu = 0; (void)hipOccupancyMaxActiveBlocksPerMultiprocessor(&per_cu, (const void*)mk_fwd, NWAVES * 64, LDS_BYTES); (void)hipGetLastError();
        if (per_cu < 1) { fprintf(stderr, "kernel_launch: occupancy query says %d blocks per CU; nothing launched\n", per_cu); grid = -1; return; }
        grid = cus;
    }
    if (grid < 0) return;
    (void)hipMemsetAsync((char*)d_ws + WS_CTL, 0, CTL_ZERO_BYTES, stream);
    Args a{};
    for (int i = 0; i < 15; ++i) a.in[i] = (const float*)d_in[i];
    a.out = (float*)d_out; a.ws = (unsigned char*)d_ws; a.use_bar = 1; a.ph_lo = 0; a.ph_hi = 10;
    hipLaunchKernelGGL(mk_fwd, dim3(grid), dim3(NWAVES * 64), LDS_BYTES, stream, a);
}
```

```cpp
#include <hip/hip_runtime.h>
#include <cstdio>
#include <cstdint>
constexpr int DMODEL = 2048, MROWS = 8320, MPAD = 8448, NIN = 14336, DFF = 5632, NWAVES = 8;
constexpr float EPS = 1e-6f;
constexpr size_t MiB = 1u << 20;
constexpr size_t WS_CTL = 0, CTL_ZERO_BYTES = 1 * MiB;
constexpr size_t WS_WRO = 1 * MiB, WS_WHO = 9 * MiB, WS_WOUT = 13 * MiB, WS_WFI = 21 * MiB, WS_WFO = 65 * MiB, WS_WIN = 87 * MiB;
constexpr size_t WS_XB = 143 * MiB;
constexpr size_t WS_Q = 176 * MiB, WS_K = WS_Q + 8448ull * 1024 * 2, WS_V = 209 * MiB, WS_RG = 242 * MiB, WS_HQ = 275 * MiB, WS_LOGF = WS_HQ + 8448ull * 1024 * 2;
constexpr size_t WS_HI = WS_LOGF + 8448ull * 1024 * 4, WS_HG = WS_HI + 8448ull * 1024 * 2, WS_GA = WS_HG + 8448ull * 1024 * 2, WS_GB = WS_GA + 8448ull * 2048 * 2;
constexpr size_t WS_KVLOC = WS_GB + 8448ull * 2048 * 2;
constexpr size_t WS_HSLOC = WS_KVLOC + 64 * MiB;
constexpr size_t WS_OH = WS_HSLOC + 32 * MiB;
constexpr size_t WS_MISC = WS_OH + 8448ull * 1024 * 2;
constexpr size_t WS_RR1 = WS_MISC, WS_COS = WS_RR1 + 64 * 1024, WS_SIN = WS_COS + 2049 * 64 * 4 + 256, WS_LB = WS_SIN + 2049 * 64 * 4 + 256, WS_BTOT = WS_LB + 4096, WS_END = WS_BTOT + 512 * 128 * 4;
constexpr size_t WS_OR = WS_XB;
constexpr size_t WS_SRT = WS_WIN, WS_SHT = WS_WIN + 32 * MiB;
constexpr size_t WS_YT = WS_KVLOC;
constexpr size_t WS_MG = WS_Q;
constexpr size_t WS_X1B = WS_V;
constexpr size_t WS_ACT = WS_RG;
static_assert(WS_GB + 8448ull * 2048 * 2 == WS_KVLOC && WS_K + 8448ull * 1024 * 2 == WS_V && WS_V + 8448ull * 2048 * 2 == WS_RG && WS_RG + 8448ull * 2048 * 2 == WS_HQ, "map");
static_assert(WS_YT + 8448ull * 2048 * 4 <= WS_OH && WS_ACT + 8448ull * 5632 * 2 <= WS_GA && WS_END <= 541 * MiB, "map2");
constexpr int CW_BAR = 4096;
constexpr int CW_SS1 = 16384, CW_SS2 = 16384 + 8448;
static_assert((CW_SS2 + 8448) * 4 <= (int)CTL_ZERO_BYTES, "ctl");
constexpr int RING_BYTES = 131072, LDSCTL_OFF = RING_BYTES, MISC_OFF = LDSCTL_OFF + 320, LDS_BYTES = 147456;

#define GAS __attribute__((address_space(1)))
#define LAS __attribute__((address_space(3)))
typedef unsigned short bf16;
typedef unsigned v4u __attribute__((ext_vector_type(4)));
typedef unsigned v2u __attribute__((ext_vector_type(2)));
typedef float f32x4 __attribute__((ext_vector_type(4)));
typedef short bf16x8 __attribute__((ext_vector_type(8)));
typedef GAS unsigned gu32;
#define RLX_AGENT __ATOMIC_RELAXED, __HIP_MEMORY_SCOPE_AGENT
#define LDS_WAIT() asm volatile("s_waitcnt lgkmcnt(0)" ::: "memory")
#define VM_WAIT() asm volatile("s_waitcnt vmcnt(0)" ::: "memory")
__device__ __forceinline__ unsigned f2bf(float f) { unsigned u = __builtin_bit_cast(unsigned, f); return (u + 0x7fffu + ((u >> 16) & 1u)) >> 16; }
__device__ __forceinline__ unsigned pk2(float lo, float hi) { return f2bf(lo) | (f2bf(hi) << 16); }
__device__ __forceinline__ float bf2f(unsigned short b) { return __uint_as_float(((unsigned)b) << 16); }
namespace pg8 {
#define PG8_LAS __attribute__((address_space(3)))
typedef unsigned short bf16_t;
typedef short bf16x8 __attribute__((ext_vector_type(8)));
typedef float f32x4 __attribute__((ext_vector_type(4)));
typedef unsigned u32x4 __attribute__((ext_vector_type(4)));
constexpr int BM = 256, BK = 64, HALF = 128, HTB = HALF * BK * 2  , STAGE_BYTES = 8 * HTB, NXCD = 8, WGM = 8;

__host__ __device__ __forceinline__ int lds_byte(int r, int c) { const int st = (r >> 4) * 2 + (c >> 5), rr = r & 15, cc = c & 31, ob = rr * 64 + cc * 2; return st * 1024 + (ob ^ (((ob >> 9) & 1) << 5)); }
__host__ __device__ __forceinline__ void stage_rc(int b, int& R, int& C) { const int st = b / 1024, sb = b % 1024, swz = sb ^ (((sb >> 9) & 1) << 5); R = (st >> 1) * 16 + swz / 64; C = (st & 1) * 32 + (swz % 64) / 2; }
__host__ __device__ __forceinline__ int perm32(int rho) { const int n = rho >> 4, i = rho & 15; return 8 * (i >> 2) + 4 * n + (i & 3); }

struct Unit { int pm, pn; };
struct Gemm { const bf16_t* A; const bf16_t* Bt; int M, N, K; };

struct StaticOrder {
    int nM, nN, nwg, G, c;
    __host__ __device__ void init(int M, int N, int G_, int c_) { nM = M / BM; nN = N / BM; nwg = nM * nN; G = G_; c = c_; }
    __host__ __device__ bool next(int i, Unit& u) const {
        const long L = (long)i * G + c; if (L >= nwg) return false;
        int wgid = (int)L; { const int q = nwg / NXCD, r = nwg % NXCD, xcd = wgid % NXCD, off = wgid / NXCD; wgid = (xcd < r ? xcd * (q + 1) : r * (q + 1) + (xcd - r) * q) + off; }
        const int nig = WGM * nN, gid = wgid / nig, fm = gid * WGM, gsz = (nM - fm) < WGM ? (nM - fm) : WGM;
        u.pm = fm + ((wgid % nig) % gsz); u.pn = (wgid % nig) / gsz; return true;
    }
    __device__ __forceinline__ void a_ready(const Unit&) const {}
    __device__ __forceinline__ void done(const Unit&) const {}
};

__device__ __forceinline__ unsigned cvt_pk_bf16(float lo, float hi) { unsigned r; asm volatile("v_cvt_pk_bf16_f32 %0, %1, %2" : "=v"(r) : "v"(lo), "v"(hi)); return r; }
typedef float f32x2 __attribute__((ext_vector_type(2)));
typedef unsigned u32x2 __attribute__((ext_vector_type(2)));
__device__ __forceinline__ float sigm(float x) { return 1.0f / (1.0f + __expf(-x)); }
__device__ __forceinline__ f32x4 silu4(f32x4 v) { f32x4 o; o[0] = v[0] * sigm(v[0]); o[1] = v[1] * sigm(v[1]); o[2] = v[2] * sigm(v[2]); o[3] = v[3] * sigm(v[3]); return o; }
__device__ __forceinline__ f32x4 sigm4(f32x4 v) { f32x4 o; o[0] = sigm(v[0]); o[1] = sigm(v[1]); o[2] = sigm(v[2]); o[3] = sigm(v[3]); return o; }
__device__ __forceinline__ u32x4 pack8(f32x4 v0, f32x4 v1) { u32x4 w; w.x = cvt_pk_bf16(v0[0], v0[1]); w.y = cvt_pk_bf16(v0[2], v0[3]); w.z = cvt_pk_bf16(v1[0], v1[1]); w.w = cvt_pk_bf16(v1[2], v1[3]); return w; }
__device__ __forceinline__ u32x2 pack4(f32x4 v) { u32x2 w; w.x = cvt_pk_bf16(v[0], v[1]); w.y = cvt_pk_bf16(v[2], v[3]); return w; }
__device__ __forceinline__ f32x4 unpack4(u32x2 w) { f32x4 o; o[0] = __uint_as_float(w.x << 16); o[1] = __uint_as_float(w.x & 0xffff0000u); o[2] = __uint_as_float(w.y << 16); o[3] = __uint_as_float(w.y & 0xffff0000u); return o; }

struct EpiInProj {
    static constexpr bool PERM = true, AFTER_DRAIN = false;
    unsigned char* ws;
    __device__ __forceinline__ void operator()(const f32x4 (&acc)[2][2][4][2], const Unit& u, int wr, int wc, int fr, int fq) const {
        const int pn = u.pn, row0 = u.pm * BM + wr * 64 + fr;
        if (pn >= 28 && pn < 32) {
            float* Z = (float*)(ws + WS_LOGF); const int cs = (pn - 28) * 256 + wc * 32 + 8 * fq;
#pragma unroll
            for (int ai = 0; ai < 2; ++ai)
#pragma unroll
                for (int m = 0; m < 4; ++m) { const int r = row0 + ai * HALF + m * 16;
#pragma unroll
                    for (int bj = 0; bj < 2; ++bj)
#pragma unroll
                        for (int n = 0; n < 2; ++n) *(f32x4*)(Z + (size_t)r * 1024 + cs + bj * HALF + 4 * n) = acc[ai][bj][m][n]; }
        } else {
            size_t od; int pitch, p0, act; float sc = 1.0f;
            if (pn < 4) { od = WS_Q; pitch = 1024; p0 = 0; act = 0; } else if (pn < 8) { od = WS_K; pitch = 1024; p0 = 4; act = 0; sc = 0.08838834764831845f; }
            else if (pn < 16) { od = WS_V; pitch = 2048; p0 = 8; act = 0; } else if (pn < 24) { od = WS_RG; pitch = 2048; p0 = 16; act = 1; } else if (pn < 28) { od = WS_HQ; pitch = 1024; p0 = 24; act = 1; }
            else if (pn < 36) { od = WS_HI; pitch = 1024; p0 = 32; act = 0; } else if (pn < 40) { od = WS_HG; pitch = 1024; p0 = 36; act = 1; } else if (pn < 48) { od = WS_GA; pitch = 2048; p0 = 40; act = 2; } else { od = WS_GB; pitch = 2048; p0 = 48; act = 2; }
            bf16_t* dst = (bf16_t*)(ws + od);
            const int cs = (pn - p0) * 256 + wc * 32 + 8 * fq;
#pragma unroll
            for (int ai = 0; ai < 2; ++ai)
#pragma unroll
                for (int m = 0; m < 4; ++m) { const int r = row0 + ai * HALF + m * 16; bf16_t* rowp = dst + (size_t)r * pitch + cs;
#pragma unroll
                    for (int bj = 0; bj < 2; ++bj) { f32x4 v0 = acc[ai][bj][m][0] * sc, v1 = acc[ai][bj][m][1] * sc;
                        if (act == 1) { v0 = silu4(v0); v1 = silu4(v1); } else if (act == 2) { v0 = sigm4(v0); v1 = sigm4(v1); }
                        *(u32x4*)(rowp + bj * HALF) = pack8(v0, v1); } }
        }
    }
};
template <int SECOND> struct EpiGate {
    static constexpr bool PERM = true, AFTER_DRAIN = false;
    const bf16_t* G; float* YT; bf16_t* MG;
    __device__ __forceinline__ void operator()(const f32x4 (&acc)[2][2][4][2], const Unit& u, int wr, int wc, int fr, int fq) const {
        const int row0 = u.pm * BM + wr * 64 + fr, col0 = u.pn * BM + wc * 32 + 8 * fq;
#pragma unroll
        for (int ai = 0; ai < 2; ++ai)
#pragma unroll
            for (int m = 0; m < 4; ++m) { const size_t off = (size_t)(row0 + ai * HALF + m * 16) * 2048 + col0;
#pragma unroll
                for (int bj = 0; bj < 2; ++bj) { const u32x4 gw = *(const u32x4*)(G + off + bj * HALF);
                    f32x4 v0 = acc[ai][bj][m][0] * unpack4((u32x2){gw.x, gw.y}), v1 = acc[ai][bj][m][1] * unpack4((u32x2){gw.z, gw.w});
                    float* yp = YT + off + bj * HALF;
                    if (SECOND) { v0 += *(const f32x4*)yp; v1 += *(const f32x4*)(yp + 4); *(u32x4*)(MG + off + bj * HALF) = pack8(v0, v1); }
                    else { *(f32x4*)yp = v0; *(f32x4*)(yp + 4) = v1; } } }
        __builtin_amdgcn_s_waitcnt(0x0F70);
    }
};
struct EpiResid {
    static constexpr bool PERM = true, AFTER_DRAIN = false;
    const float* XP; const float* XS; float* OUT; bf16_t* XB; float* SS;
    __device__ __forceinline__ void operator()(const f32x4 (&acc)[2][2][4][2], const Unit& u, int wr, int wc, int fr, int fq) const {
        const int row0 = u.pm * BM + wr * 64 + fr, col0 = u.pn * BM + wc * 32 + 8 * fq;
#pragma unroll
        for (int ai = 0; ai < 2; ++ai)
#pragma unroll
            for (int m = 0; m < 4; ++m) { const int r = row0 + ai * HALF + m * 16; const bool live = r < 8320;
                const float* xi = (r < 8192 ? XP + (size_t)r * 2048 : XS + (size_t)(r - 8192) * 2048) + col0; float ss = 0.f;
#pragma unroll
                for (int bj = 0; bj < 2; ++bj) { f32x4 v0 = acc[ai][bj][m][0], v1 = acc[ai][bj][m][1];
                    if (live) { v0 += *(const f32x4*)(xi + bj * HALF); v1 += *(const f32x4*)(xi + bj * HALF + 4);
                        float* op = OUT + (size_t)r * 2048 + col0 + bj * HALF; *(f32x4*)op = v0; *(f32x4*)(op + 4) = v1; }
                    if (XB) *(u32x4*)(XB + (size_t)r * 2048 + col0 + bj * HALF) = pack8(v0, v1);
                    ss += (v0[0] * v0[0] + v0[1] * v0[1]) + (v0[2] * v0[2] + v0[3] * v0[3]) + (v1[0] * v1[0] + v1[1] * v1[1]) + (v1[2] * v1[2] + v1[3] * v1[3]); }
                ss += __shfl_xor(ss, 16); ss += __shfl_xor(ss, 32);
                if (fq == 0) atomicAdd(SS + r, ss); }
        __builtin_amdgcn_s_waitcnt(0x0F70);
    }
};
struct EpiSwiglu {
    static constexpr bool PERM = true, AFTER_DRAIN = false;
    const float* SS; bf16_t* ACT;
    __device__ __forceinline__ void operator()(const f32x4 (&acc)[2][2][4][2], const Unit& u, int wr, int wc, int fr, int fq) const {
        const int row0 = u.pm * BM + wr * 64 + fr, col0 = u.pn * HALF + wc * 32 + 8 * fq;
        float ssv[2][4];
#pragma unroll
        for (int ai = 0; ai < 2; ++ai)
#pragma unroll
            for (int m = 0; m < 4; ++m) ssv[ai][m] = SS[row0 + ai * HALF + m * 16];
        __builtin_amdgcn_s_waitcnt(0x0F70);
#pragma unroll
        for (int ai = 0; ai < 2; ++ai)
#pragma unroll
            for (int m = 0; m < 4; ++m) { const int r = row0 + ai * HALF + m * 16; const float r2 = 1.0f / sqrtf(ssv[ai][m] * (1.0f / 2048.0f) + 1e-6f);
                const f32x4 g0 = acc[ai][0][m][0] * r2, g1 = acc[ai][0][m][1] * r2, u0 = acc[ai][1][m][0] * r2, u1 = acc[ai][1][m][1] * r2;
                *(u32x4*)(ACT + (size_t)r * 5632 + col0) = pack8(silu4(g0) * u0, silu4(g1) * u1); }
    }
};
template <class Epi, class Sched, bool ALIGN_EPI = false, bool SP2 = false>
__device__ __forceinline__ void gemm_phase(PG8_LAS unsigned char* lds, const Gemm g, const Sched& S, const Epi& E) {
    const int tid = threadIdx.x, wid = __builtin_amdgcn_readfirstlane(tid >> 6), lane = tid & 63, wr = wid >> 2, wc = wid & 3, fr = lane & 15, fq = lane >> 4;
    const int K = g.K, nt = K / BK;
    unsigned voffA[2], voffB[2];
#pragma unroll
    for (int i = 0; i < 2; ++i) { int R, C; stage_rc(tid * 16 + i * 8192, R, C); const int Rb = Epi::PERM ? ((R & ~31) + perm32(R & 31)) : R;
        voffA[i] = (unsigned)(R * K + C) * 2u; voffB[i] = (unsigned)(Rb * K + C) * 2u; }
    const size_t kstep = (size_t)(BK * 2);
    const size_t hstep = (size_t)HALF * K * 2;
    const size_t tstep = 2 * hstep;
    const unsigned ldsw = (unsigned)wid * 1024u;
    const int aoff = lds_byte(wr * 64 + fr, fq * 8), boff = lds_byte(wc * 32 + fr, fq * 8);
#define PG8_SA(b, h) (((b) * 2 + (h)) * HTB)
#define PG8_SB(b, h) ((4 + (b) * 2 + (h)) * HTB)
#define PG8_STAGE(bufoff, gbase, voff) do { _Pragma("unroll") for (int _i = 0; _i < 2; ++_i) \
        __builtin_amdgcn_global_load_lds((const unsigned*)((const char*)(gbase) + (voff)[_i]), (PG8_LAS unsigned*)(lds + (bufoff) + ldsw + _i * 8192), 16, 0, 0); } while (0)
#define PG8_LDA(dst, b, h) do { _Pragma("unroll") for (int m = 0; m < 4; ++m) _Pragma("unroll") for (int k = 0; k < 2; ++k) dst[m][k] = *(const PG8_LAS bf16x8*)(lds + PG8_SA(b, h) + aoff + m * 2048 + k * 1024); } while (0)
#define PG8_LDB(dst, b, h) do { _Pragma("unroll") for (int n = 0; n < 2; ++n) _Pragma("unroll") for (int k = 0; k < 2; ++k) dst[n][k] = *(const PG8_LAS bf16x8*)(lds + PG8_SB(b, h) + boff + n * 2048 + k * 1024); } while (0)
#define PG8_MMA(ai, bj, At, Bt) do { __builtin_amdgcn_s_setprio(1); _Pragma("unroll") for (int m = 0; m < 4; ++m) _Pragma("unroll") for (int n = 0; n < 2; ++n) _Pragma("unroll") for (int k = 0; k < 2; ++k) \
        acc[ai][bj][m][n] = __builtin_amdgcn_mfma_f32_16x16x32_bf16(Bt[n][k], At[m][k], acc[ai][bj][m][n], 0, 0, 0); __builtin_amdgcn_s_setprio(0); } while (0)
#define PG8_WAIT_V(n) asm volatile("s_waitcnt vmcnt(" #n ")" ::: "memory")
#define PG8_WAIT_L(n) asm volatile("s_waitcnt lgkmcnt(" #n ")" ::: "memory")
#define PG8_BAR __builtin_amdgcn_s_barrier()
#define PG8_SCHED __builtin_amdgcn_sched_barrier(0)
    Unit cur, nxt; int ui = 0;
    if (!S.next(0, cur)) return;
    f32x4 acc[2][2][4][2];
#pragma unroll
    for (int a = 0; a < 2; ++a)
#pragma unroll
        for (int b = 0; b < 2; ++b)
#pragma unroll
            for (int m = 0; m < 4; ++m)
#pragma unroll
                for (int n = 0; n < 2; ++n) acc[a][b][m][n] = (f32x4){0.f, 0.f, 0.f, 0.f};
    bf16x8 At[4][2], B0[2][2], B1[2][2];
    const char* cA = (const char*)g.A + (size_t)cur.pm * tstep; const char* cB = (const char*)g.Bt + (size_t)cur.pn * tstep;
    S.a_ready(cur);
    if constexpr (SP2) {
        PG8_STAGE(PG8_SB(0, 0), cB, voffB); PG8_STAGE(PG8_SB(0, 1), cB + hstep, voffB); PG8_STAGE(PG8_SA(0, 0), cA, voffA); PG8_STAGE(PG8_SA(0, 1), cA + hstep, voffA);
        if (wr == 1) PG8_BAR;
        PG8_WAIT_V(2); PG8_BAR;
        PG8_STAGE(PG8_SB(1, 0), cB + kstep, voffB); PG8_STAGE(PG8_SA(1, 0), cA + kstep, voffA); PG8_STAGE(PG8_SB(1, 1), cB + hstep + kstep, voffB);
        PG8_WAIT_V(6); PG8_BAR;
    } else {
        PG8_STAGE(PG8_SB(0, 0), cB, voffB); PG8_STAGE(PG8_SA(0, 0), cA, voffA); PG8_STAGE(PG8_SB(0, 1), cB + hstep, voffB); PG8_STAGE(PG8_SA(0, 1), cA + hstep, voffA);
        if (wr == 1) PG8_BAR;
        PG8_WAIT_V(4); PG8_BAR;
        PG8_STAGE(PG8_SB(1, 0), cB + kstep, voffB); PG8_STAGE(PG8_SA(1, 0), cA + kstep, voffA); PG8_STAGE(PG8_SB(1, 1), cB + hstep + kstep, voffB);
        PG8_WAIT_V(6); PG8_BAR;
    }
    for (;;) {
        const bool has_next = S.next(ui + 1, nxt);
        const char* nA = has_next ? (const char*)g.A + (size_t)nxt.pm * tstep : cA; const char* nB = has_next ? (const char*)g.Bt + (size_t)nxt.pn * tstep : cB;
        for (int t = 0; t < nt; t += 2) {
            const bool last = (t == nt - 2);
            const char* a1 = cA + (size_t)(t + 1) * kstep;
            const char* a2 = last ? nA : cA + (size_t)(t + 2) * kstep; const char* b2 = last ? nB : cB + (size_t)(t + 2) * kstep;
            const char* a3 = a2 + kstep; const char* b3 = b2 + kstep;
            if (last && has_next) S.a_ready(nxt);
            if constexpr (SP2) {
            PG8_LDB(B0, 0, 0); PG8_LDB(B1, 0, 1); PG8_SCHED; PG8_LDA(At, 0, 0); PG8_STAGE(PG8_SA(1, 1), a1 + hstep, voffA);
            PG8_WAIT_V(8); PG8_WAIT_L(0); PG8_BAR; PG8_MMA(0, 0, At, B0); PG8_MMA(0, 1, At, B1); PG8_BAR; PG8_SCHED;
            PG8_LDA(At, 0, 1); PG8_STAGE(PG8_SB(0, 0), b2, voffB); PG8_STAGE(PG8_SB(0, 1), b2 + hstep, voffB); PG8_STAGE(PG8_SA(0, 0), a2, voffA);
            PG8_WAIT_V(8); PG8_WAIT_L(0); PG8_BAR; PG8_MMA(1, 0, At, B0); PG8_MMA(1, 1, At, B1); PG8_BAR; PG8_SCHED;
            PG8_LDB(B0, 1, 0); PG8_LDB(B1, 1, 1); PG8_SCHED; PG8_LDA(At, 1, 0); PG8_STAGE(PG8_SA(0, 1), a2 + hstep, voffA);
            PG8_WAIT_V(8); PG8_WAIT_L(0); PG8_BAR; PG8_MMA(0, 0, At, B0); PG8_MMA(0, 1, At, B1); PG8_BAR; PG8_SCHED;
            PG8_LDA(At, 1, 1); PG8_STAGE(PG8_SB(1, 0), b3, voffB); PG8_STAGE(PG8_SB(1, 1), b3 + hstep, voffB); PG8_STAGE(PG8_SA(1, 0), a3, voffA);
            PG8_WAIT_V(8); PG8_WAIT_L(0); PG8_BAR; PG8_MMA(1, 0, At, B0); PG8_MMA(1, 1, At, B1); PG8_BAR; PG8_SCHED;
            } else {
            PG8_LDB(B0, 0, 0); PG8_SCHED; PG8_LDA(At, 0, 0); PG8_STAGE(PG8_SA(1, 1), a1 + hstep, voffA);
            PG8_WAIT_L(8); PG8_BAR; PG8_WAIT_L(0); PG8_MMA(0, 0, At, B0); PG8_BAR; PG8_SCHED;
            PG8_LDB(B1, 0, 1); PG8_STAGE(PG8_SB(0, 0), b2, voffB);
            PG8_BAR; PG8_WAIT_L(0); PG8_MMA(0, 1, At, B1); PG8_BAR;
            PG8_LDA(At, 0, 1); PG8_STAGE(PG8_SA(0, 0), a2, voffA);
            PG8_BAR; PG8_WAIT_L(0); PG8_MMA(1, 0, At, B0); PG8_BAR; PG8_SCHED;
            PG8_STAGE(PG8_SB(0, 1), b2 + hstep, voffB);
            PG8_WAIT_V(6); PG8_BAR; PG8_MMA(1, 1, At, B1); PG8_BAR;
            PG8_LDB(B0, 1, 0); PG8_SCHED; PG8_LDA(At, 1, 0); PG8_STAGE(PG8_SA(0, 1), a2 + hstep, voffA);
            PG8_WAIT_L(8); PG8_BAR; PG8_WAIT_L(0); PG8_MMA(0, 0, At, B0); PG8_BAR; PG8_SCHED;
            PG8_LDB(B1, 1, 1); PG8_STAGE(PG8_SB(1, 0), b3, voffB);
            PG8_BAR; PG8_WAIT_L(0); PG8_MMA(0, 1, At, B1); PG8_BAR;
            PG8_LDA(At, 1, 1); PG8_STAGE(PG8_SA(1, 0), a3, voffA);
            PG8_BAR; PG8_WAIT_L(0); PG8_MMA(1, 0, At, B0); PG8_BAR; PG8_SCHED;
            PG8_STAGE(PG8_SB(1, 1), b3 + hstep, voffB);
            PG8_WAIT_V(6); PG8_BAR; PG8_MMA(1, 1, At, B1); PG8_BAR;
            }
        }
        if constexpr (ALIGN_EPI) { if (wr == 0) PG8_BAR; }
        if constexpr (!Epi::AFTER_DRAIN) { E(acc, cur, wr, wc, fr, fq); S.done(cur); }
        if (!has_next) break;
#pragma unroll
        for (int a = 0; a < 2; ++a)
#pragma unroll
            for (int b = 0; b < 2; ++b)
#pragma unroll
                for (int m = 0; m < 4; ++m)
#pragma unroll
                    for (int n = 0; n < 2; ++n) acc[a][b][m][n] = (f32x4){0.f, 0.f, 0.f, 0.f};
        cur = nxt; cA = nA; cB = nB; ++ui;
        if constexpr (ALIGN_EPI) { if (wr == 1) PG8_BAR; }
    }
    PG8_WAIT_V(0);
    if constexpr (!ALIGN_EPI) { if (wr == 0) PG8_BAR; }
    PG8_BAR;
    if constexpr (Epi::AFTER_DRAIN) { E.fused(acc, cur, wr, wc, fr, fq, lds, wid, lane); S.done(cur); }
#undef PG8_SA
#undef PG8_SB
#undef PG8_STAGE
#undef PG8_LDA
#undef PG8_LDB
#undef PG8_MMA
#undef PG8_WAIT_V
#undef PG8_WAIT_L
#undef PG8_BAR
#undef PG8_SCHED
}
}
#define XB_TMO      128
#define XB_XCNT(j)  (256  + 64 * (j))
#define XB_XSUB(j)  (1280 + 64 * (j))
#define XB_XGEN(j)  (2304 + 64 * (j))
#define XB_TOP      3328
#define XB_TOPGEN   3392
#define XCD_BAR_WORDS 3456
#define XB_SPIN_CAP (1u << 18)

__device__ __forceinline__ unsigned xb_ld(unsigned* p)              { return __hip_atomic_load(p, __ATOMIC_RELAXED, __HIP_MEMORY_SCOPE_AGENT); }
__device__ __forceinline__ unsigned xb_add(unsigned* p, unsigned v) { return __hip_atomic_fetch_add(p, v, __ATOMIC_RELAXED, __HIP_MEMORY_SCOPE_AGENT); }
__device__ __forceinline__ unsigned xb_xcc_id() { return (unsigned)__builtin_amdgcn_s_getreg((3 << 11) | 20) & 0xFu; }
#define XB_SPIN(cond, bar) do { unsigned _sp = 0; while (cond) { __builtin_amdgcn_s_sleep(1); \
    if ((++_sp & 255u) == 0u) { if (xb_ld(&(bar)[XB_TMO])) break; if (_sp > XB_SPIN_CAP) { atomicAdd(&(bar)[XB_TMO], 1u); break; } } } } while (0)

struct XcdBarrier {
    unsigned* bar; unsigned x;
    volatile LAS unsigned* st;
};

__device__ __forceinline__ XcdBarrier xcd_barrier_post(unsigned* bar, volatile LAS unsigned* st) {
    XcdBarrier b; b.bar = bar; b.x = xb_xcc_id(); b.st = st;
    if (threadIdx.x == 0) (void)xb_add(&bar[XB_XCNT(b.x)], 1u);
    return b;
}
__device__ __forceinline__ void xcd_barrier_complete(unsigned* bar, unsigned x, unsigned& nloc, unsigned& nx) {
    const unsigned G = gridDim.x * gridDim.y * gridDim.z;
    unsigned sum, cnt, mine, sp = 0u;
    for (;;) {
        sum = 0u; cnt = 0u; mine = 0u;
#pragma unroll
        for (unsigned j = 0; j < 16; ++j) { const unsigned c = xb_ld(&bar[XB_XCNT(j)]); sum += c; cnt += (c > 0u) ? 1u : 0u; mine = (j == x) ? c : mine; }
        if (sum == G) break;
        __builtin_amdgcn_s_sleep(1);
        if ((++sp & 255u) == 0u) { if (xb_ld(&bar[XB_TMO])) break; if (sp > XB_SPIN_CAP) { atomicAdd(&bar[XB_TMO], 1u); break; } }
    }
    nloc = mine > 0u ? mine : 1u; nx = cnt > 0u ? cnt : 1u;
}

__device__ __forceinline__ void xcd_barrier(const XcdBarrier& b) {
    asm volatile("s_waitcnt vmcnt(0)" ::: "memory");
    __syncthreads();
    if (threadIdx.x == 0) {
        unsigned* bar = b.bar;
        __builtin_amdgcn_s_waitcnt(0);
        unsigned nloc = b.st[0], nx = b.st[1];
        if (nloc == 0u) { xcd_barrier_complete(bar, b.x, nloc, nx); b.st[0] = nloc; b.st[1] = nx; }
        const unsigned old = xb_add(&bar[XB_XSUB(b.x)], 1u);
        const unsigned gen = old / nloc;
        if (old + 1u == (gen + 1u) * nloc) {
            __builtin_amdgcn_fence(__ATOMIC_RELEASE, "agent");
            asm volatile("s_waitcnt vmcnt(0)" ::: "memory");
            const unsigned og = xb_add(&bar[XB_TOP], 1u);
            const unsigned tg = og / nx;
            if (og + 1u == (tg + 1u) * nx) xb_add(&bar[XB_TOPGEN], 1u);
            else XB_SPIN(xb_ld(&bar[XB_TOPGEN]) == tg, bar);
            __builtin_amdgcn_fence(__ATOMIC_ACQUIRE, "agent");
            xb_add(&bar[XB_XGEN(b.x)], 1u);
            asm volatile("s_waitcnt vmcnt(0)" ::: "memory");
        } else {
            XB_SPIN(xb_ld(&bar[XB_XGEN(b.x)]) == gen, bar);
            __builtin_amdgcn_fence(__ATOMIC_ACQUIRE, "agent");
            asm volatile("s_waitcnt vmcnt(0)" ::: "memory");
        }
    }
    __syncthreads();
}
struct Frame {
    LAS unsigned char* lds; volatile LAS unsigned* MISC; gu32* ctl;
    int tid, lane, wave, vcu, G;
    float* out; unsigned char* ws;
};
__device__ __forceinline__ float wave_sum(float v) {
#pragma unroll
    for (int o = 1; o < 64; o <<= 1) v += __shfl_xor(v, o);
    return v;
}
template <int MODE> __device__ __forceinline__ int rowmap(int n) {
    if (MODE == 1) { if (n >= 2048) return n; const int j = n & 127, hb = n & ~127; return hb + (j < 64 ? 8 * (j >> 2) + (j & 3) : 8 * ((j - 64) >> 2) + 4 + (j & 3)); }
    if (MODE == 2) { return n < DFF ? (n >> 7) * 256 + (n & 127) : ((n - DFF) >> 7) * 256 + 128 + ((n - DFF) & 127); }
    return n;
}
template <int MODE> __device__ __forceinline__ void p0_transpose_item(const float* W, int K, int N, bf16* WT, const float* g, LAS unsigned* T, int item, int lane) {
    const int nblk = N / 64, kb = item / nblk, nb = item % nblk, k0 = 64 * kb, n0 = 64 * nb;
    const int l15 = lane & 15, lg = lane >> 4;
    f32x4 v[16];
#pragma unroll
    for (int i = 0; i < 16; ++i) { const int row = 8 * (i >> 1) + 2 * lg + (i & 1); v[i] = *(const f32x4*)(W + (size_t)(k0 + row) * N + n0 + 4 * l15); }
    if (g) {
#pragma unroll
        for (int i = 0; i < 16; ++i) { const int row = 8 * (i >> 1) + 2 * lg + (i & 1); v[i] = v[i] * g[k0 + row]; } }
#pragma unroll
    for (int p = 0; p < 8; ++p)
#pragma unroll
        for (int j = 0; j < 4; ++j) T[(4 * l15 + j) * 33 + 4 * p + lg] = pk2(v[2 * p][j], v[2 * p + 1][j]);
    LDS_WAIT(); asm volatile("" ::: "memory");
    const int c = lane & 7;
#pragma unroll
    for (int i = 0; i < 8; ++i) { const int n = (lane >> 3) + 8 * i; const LAS unsigned* s = T + n * 33 + 4 * c;
        v4u o; o.x = s[0]; o.y = s[1]; o.z = s[2]; o.w = s[3];
        *(GAS v4u*)(WT + (size_t)rowmap<MODE>(n0 + n) * K + k0 + 8 * c) = o; }
    LDS_WAIT(); asm volatile("" ::: "memory");
}
struct Args { const float* in[15]; float* out; unsigned char* ws; int ph_lo, ph_hi, use_bar, pad; };
__device__ __forceinline__ void p0_prologue(Frame& F, const Args& A) {
    LAS unsigned* scr = (LAS unsigned*)(F.lds + F.wave * 16384);
    const int gw = F.vcu * NWAVES + F.wave, NGW = F.G * NWAVES;
    unsigned char* ws = F.ws;
    constexpr int I_IN = 32 * (NIN / 64), I_RO = 32 * 32, I_HO = 16 * 32, I_OUT = 32 * 32, I_FI = 32 * (2 * DFF / 64), I_FO = (DFF / 64) * 32;
    constexpr int NITEMS = I_IN + I_RO + I_HO + I_OUT + I_FI + I_FO;
    for (int it = gw; it < NITEMS; it += NGW) {
        int r = it;
        if (r < I_IN) { p0_transpose_item<0>(A.in[4], 2048, NIN, (bf16*)(ws + WS_WIN), A.in[8], scr, r, F.lane); continue; } r -= I_IN;
        if (r < I_RO) { p0_transpose_item<0>(A.in[5], 2048, 2048, (bf16*)(ws + WS_WRO), nullptr, scr, r, F.lane); continue; } r -= I_RO;
        if (r < I_HO) { p0_transpose_item<0>(A.in[6], 1024, 2048, (bf16*)(ws + WS_WHO), nullptr, scr, r, F.lane); continue; } r -= I_HO;
        if (r < I_OUT) { p0_transpose_item<0>(A.in[7], 2048, 2048, (bf16*)(ws + WS_WOUT), nullptr, scr, r, F.lane); continue; } r -= I_OUT;
        if (r < I_FI) { p0_transpose_item<2>(A.in[12], 2048, 2 * DFF, (bf16*)(ws + WS_WFI), A.in[9], scr, r, F.lane); continue; } r -= I_FI;
        p0_transpose_item<0>(A.in[13], DFF, 2048, (bf16*)(ws + WS_WFO), nullptr, scr, r, F.lane);
    }
    bf16* XB = (bf16*)(ws + WS_XB);
    for (int m = gw; m < MPAD; m += NGW) {
        GAS unsigned long long* o8 = (GAS unsigned long long*)(XB + (size_t)m * 2048) + F.lane;
        if (m < MROWS) {
            const float* xrow = m < 8192 ? A.in[0] + (size_t)m * 2048 : A.in[1] + (size_t)(m - 8192) * 2048;
            const GAS f32x4* xr = (const GAS f32x4*)xrow + F.lane;
            f32x4 v[8]; float s = 0.f;
#pragma unroll
            for (int j = 0; j < 8; ++j) { v[j] = xr[64 * j]; s += (v[j].x * v[j].x + v[j].y * v[j].y) + (v[j].z * v[j].z + v[j].w * v[j].w); }
            const float rr = 1.0f / sqrtf(wave_sum(s) * (1.0f / 2048.0f) + EPS);
#pragma unroll
            for (int j = 0; j < 8; ++j) o8[64 * j] = (unsigned long long)pk2(v[j].x * rr, v[j].y * rr) | ((unsigned long long)pk2(v[j].z * rr, v[j].w * rr) << 32);
        } else {
#pragma unroll
            for (int j = 0; j < 8; ++j) o8[64 * j] = 0ull;
        }
    }
    { float* COS = (float*)(ws + WS_COS); float* SIN = (float*)(ws + WS_SIN);
      for (int i = (F.vcu * NWAVES + F.wave) * 64 + F.lane; i < 2049 * 64; i += F.G * NWAVES * 64) { const int p = i >> 6, j = i & 63; const int pos = p < 2048 ? p : 16384;
          const float inv = powf(10000.0f, -(float)j / 64.0f); const float ang = (float)pos * inv; float sn, cs; sincosf(ang, &sn, &cs); COS[i] = cs; SIN[i] = sn; } }
    { float* LB = (float*)(ws + WS_LB); const int i = (F.vcu * NWAVES + F.wave) * 64 + F.lane; if (i < 1024) { const float l0 = A.in[11][i], l1 = A.in[11][1024 + i]; LB[i] = 1.0f / (1.0f + expf(l1 - l0)); } }
}
typedef short bf16x4v __attribute__((ext_vector_type(4)));
#define MFMA16(a, b, c) __builtin_amdgcn_mfma_f32_16x16x32_bf16((a), (b), (c), 0, 0, 0)
constexpr int TP = 136;
constexpr size_t OUT_YS = 8192ull * 2048, OUT_SRP = 8320ull * 2048, OUT_SHP = OUT_SRP + 4ull * 8 * 128 * 256, OUT_SRS = OUT_SHP + 4ull * 8 * 128 * 128, OUT_SHS = OUT_SRS + 128ull * 8 * 128 * 256;
__device__ __forceinline__ float lg2gamma(int h) { return log2f(1.0f - exp2f(-5.0f - (float)h)); }
__device__ __forceinline__ float bfe(const v4u& w, int j) { const unsigned x = w[j >> 1]; return __uint_as_float((j & 1) ? (x & 0xffff0000u) : (x << 16)); }
__device__ __forceinline__ bf16x8 pack_f8(const float* v) { v4u w; w.x = pk2(v[0], v[1]); w.y = pk2(v[2], v[3]); w.z = pk2(v[4], v[5]); w.w = pk2(v[6], v[7]); return __builtin_bit_cast(bf16x8, w); }

__device__ __forceinline__ void p2_ret_item(Frame& F, int item) {
    unsigned char* ws = F.ws;
    const int c = item & 15, h = (item >> 4) & 7, b = item >> 7, r0 = b * 2048 + c * 128;
    const int w = F.wave, l15 = F.lane & 15, g = F.lane >> 4;
    LAS bf16* KT = (LAS bf16*)F.lds; LAS bf16* VT = KT + 128 * TP;
    const bf16* Kg = (const bf16*)(ws + WS_K); const bf16* Vg = (const bf16*)(ws + WS_V);
    const float* COS = (const float*)(ws + WS_COS); const float* SIN = (const float*)(ws + WS_SIN);
    const float lg = lg2gamma(h);
    __syncthreads();
#pragma unroll
    for (int i = 0; i < 2; ++i) { const int u = F.tid + 512 * i, m = u & 127, d0 = (u >> 7) * 8;
        const bf16* kp = Kg + (size_t)(r0 + m) * 1024 + h * 128 + d0; const v4u a = *(const v4u*)kp, bb = *(const v4u*)(kp + 64);
        const int pos = c * 128 + m; const f32x4 c0 = *(const f32x4*)(COS + pos * 64 + d0), c1 = *(const f32x4*)(COS + pos * 64 + d0 + 4), s0 = *(const f32x4*)(SIN + pos * 64 + d0), s1 = *(const f32x4*)(SIN + pos * 64 + d0 + 4);
        const float dec = exp2f((float)(127 - m) * lg);
#pragma unroll
        for (int j = 0; j < 8; ++j) { const float x1 = bfe(a, j), x2 = bfe(bb, j), cj = j < 4 ? c0[j & 3] : c1[j & 3], sj = j < 4 ? s0[j & 3] : s1[j & 3];
            KT[(d0 + j) * TP + m] = (bf16)f2bf((x1 * cj - x2 * sj) * dec); KT[(64 + d0 + j) * TP + m] = (bf16)f2bf((x2 * cj + x1 * sj) * dec); } }
#pragma unroll
    for (int i = 0; i < 8; ++i) { const int u = F.tid + 512 * i, m = u & 127, e0 = (u >> 7) * 8;
        const v4u a = *(const v4u*)(Vg + (size_t)(r0 + m) * 2048 + h * 256 + e0);
#pragma unroll
        for (int j = 0; j < 8; ++j) VT[(e0 + j) * TP + m] = (bf16)((a[j >> 1] >> (16 * (j & 1))) & 0xffffu); }
    __syncthreads();
    f32x4 acc[8][2];
#pragma unroll
    for (int dt = 0; dt < 8; ++dt) { acc[dt][0] = (f32x4){0.f, 0.f, 0.f, 0.f}; acc[dt][1] = (f32x4){0.f, 0.f, 0.f, 0.f}; }
#pragma unroll
    for (int ks = 0; ks < 4; ++ks) {
        const bf16x8 b0 = *(const LAS bf16x8*)&VT[(32 * w + l15) * TP + 32 * ks + 8 * g], b1 = *(const LAS bf16x8*)&VT[(32 * w + 16 + l15) * TP + 32 * ks + 8 * g];
#pragma unroll
        for (int dt = 0; dt < 8; ++dt) { const bf16x8 af = *(const LAS bf16x8*)&KT[(16 * dt + l15) * TP + 32 * ks + 8 * g];
            acc[dt][0] = MFMA16(af, b0, acc[dt][0]); acc[dt][1] = MFMA16(af, b1, acc[dt][1]); } }
    float* out = (float*)(ws + WS_KVLOC) + (size_t)item * 256 * 128;
#pragma unroll
    for (int dt = 0; dt < 8; ++dt)
#pragma unroll
        for (int et = 0; et < 2; ++et) *(f32x4*)(out + (32 * w + 16 * et + l15) * 128 + 16 * dt + 4 * g) = acc[dt][et];
}
__device__ __forceinline__ void p2_hg_item(Frame& F, int item) {
    unsigned char* ws = F.ws;
    const int sc = item & 15, h = (item >> 4) & 7, b = item >> 7, r0 = b * 2048 + sc * 128;
    const int w = F.wave, l15 = F.lane & 15, g = F.lane >> 4;
    LAS bf16* KT = (LAS bf16*)F.lds; LAS bf16* VT = KT + 128 * TP; LAS float* LQ = (LAS float*)(VT + 128 * TP);
    const float* Z = (const float*)(ws + WS_LOGF); const bf16* HI = (const bf16*)(ws + WS_HI); const float* LB = (const float*)(ws + WS_LB);
    __syncthreads();
    const int d = F.tid & 127, q = F.tid >> 7; const float oml = 1.0f - LB[h * 128 + d];
    float lf[32], kin[32]; float L = 0.f;
#pragma unroll
    for (int i = 0; i < 32; ++i) { const float z = Z[(size_t)(r0 + 32 * q + i) * 1024 + h * 128 + d]; kin[i] = oml / (1.0f + __expf(z)); lf[i] = log1pf(-kin[i]); L += lf[i]; }
    LQ[q * 128 + d] = L;
#pragma unroll
    for (int i = 0; i < 4; ++i) { const int u = F.tid + 512 * i, m = u & 127, e0 = (u >> 7) * 8;
        const v4u a = *(const v4u*)(HI + (size_t)(r0 + m) * 1024 + h * 128 + e0);
#pragma unroll
        for (int j = 0; j < 8; ++j) VT[(e0 + j) * TP + m] = (bf16)((a[j >> 1] >> (16 * (j & 1))) & 0xffffu); }
    __syncthreads();
    float run = 0.f;
#pragma unroll
    for (int q2 = 1; q2 < 4; ++q2) if (q2 > q) run += LQ[q2 * 128 + d];
#pragma unroll
    for (int blk = 3; blk >= 0; --blk) { float v[8];
#pragma unroll
        for (int jj = 7; jj >= 0; --jj) { const int i = 8 * blk + jj; v[jj] = kin[i] * __expf(run); run += lf[i]; }
        *(LAS bf16x8*)&KT[d * TP + 32 * q + 8 * blk] = pack_f8(v); }
    if (q == 0) ((float*)(ws + WS_BTOT))[item * 128 + d] = run;
    __syncthreads();
    f32x4 acc[8];
#pragma unroll
    for (int dt = 0; dt < 8; ++dt) acc[dt] = (f32x4){0.f, 0.f, 0.f, 0.f};
#pragma unroll
    for (int ks = 0; ks < 4; ++ks) { const bf16x8 b0 = *(const LAS bf16x8*)&VT[(16 * w + l15) * TP + 32 * ks + 8 * g];
#pragma unroll
        for (int dt = 0; dt < 8; ++dt) { const bf16x8 af = *(const LAS bf16x8*)&KT[(16 * dt + l15) * TP + 32 * ks + 8 * g]; acc[dt] = MFMA16(af, b0, acc[dt]); } }
    float* out = (float*)(ws + WS_HSLOC) + (size_t)item * 128 * 128;
#pragma unroll
    for (int dt = 0; dt < 8; ++dt) *(f32x4*)(out + (16 * w + l15) * 128 + 16 * dt + 4 * g) = acc[dt];
}
__device__ __forceinline__ void p2_sret_item(Frame& F, const Args& A, int it) {
    unsigned char* ws = F.ws; const int h = it & 7, b = it >> 3, r = 8192 + b;
    LAS float* qs = (LAS float*)F.lds; LAS float* ks = qs + 128; LAS float* vs = ks + 128; LAS float* ored = vs + 256;
    const bf16* Q = (const bf16*)(ws + WS_Q); const bf16* K = (const bf16*)(ws + WS_K); const bf16* V = (const bf16*)(ws + WS_V);
    __syncthreads();
    if (F.tid < 64) { const int d = F.tid; const float cs = ((const float*)(ws + WS_COS))[2048 * 64 + d], sn = ((const float*)(ws + WS_SIN))[2048 * 64 + d];
        const float q1 = bf2f(Q[(size_t)r * 1024 + h * 128 + d]), q2 = bf2f(Q[(size_t)r * 1024 + h * 128 + 64 + d]), k1 = bf2f(K[(size_t)r * 1024 + h * 128 + d]), k2 = bf2f(K[(size_t)r * 1024 + h * 128 + 64 + d]);
        qs[d] = q1 * cs - q2 * sn; qs[d + 64] = q2 * cs + q1 * sn; ks[d] = k1 * cs - k2 * sn; ks[d + 64] = k2 * cs + k1 * sn; }
    else if (F.tid >= 256) { const int e = F.tid - 256; vs[e] = bf2f(V[(size_t)r * 2048 + h * 256 + e]); }
    __syncthreads();
    const float gam = 1.0f - exp2f(-5.0f - (float)h);
    const int e4 = F.tid & 63, dq = F.tid >> 6;
    const float* Sin = A.in[2] + ((size_t)(b * 8 + h) * 128) * 256; float* Sout = F.out + OUT_SRS + ((size_t)(b * 8 + h) * 128) * 256;
    const f32x4 v4 = *(const LAS f32x4*)&vs[4 * e4]; f32x4 o = (f32x4){0.f, 0.f, 0.f, 0.f};
    f32x4 s[16];
#pragma unroll
    for (int i = 0; i < 16; ++i) s[i] = *(const f32x4*)(Sin + (size_t)(16 * dq + i) * 256 + 4 * e4);
#pragma unroll
    for (int i = 0; i < 16; ++i) { const int d = 16 * dq + i; s[i] = s[i] * gam + v4 * ks[d]; *(f32x4*)(Sout + (size_t)d * 256 + 4 * e4) = s[i]; o += s[i] * qs[d]; }
    *(LAS f32x4*)&ored[dq * 256 + 4 * e4] = o;
    __syncthreads();
    if (F.wave == 0) { float oo[4]; float ss = 0.f;
#pragma unroll
        for (int k = 0; k < 4; ++k) { const int e = F.lane + 64 * k; float t = 0.f;
#pragma unroll
            for (int j = 0; j < 8; ++j) t += ored[j * 256 + e];
            oo[k] = t; ss += t * t; }
        const float rr = 1.0f / sqrtf(wave_sum(ss) * (1.0f / 256.0f) + EPS);
        const bf16* RG = (const bf16*)(ws + WS_RG); bf16* OR = (bf16*)(ws + WS_OR);
#pragma unroll
        for (int k = 0; k < 4; ++k) { const size_t ix = (size_t)r * 2048 + h * 256 + F.lane + 64 * k; OR[ix] = (bf16)f2bf(oo[k] * rr * bf2f(RG[ix])); } }
}
__device__ __forceinline__ void p2_shg_item(Frame& F, const Args& A, int it) {
    unsigned char* ws = F.ws; const int h = it & 7, b = it >> 3, r = 8192 + b;
    LAS float* qs = (LAS float*)F.lds; LAS float* fs = qs + 128; LAS float* kn = fs + 128; LAS float* vs = kn + 128; LAS float* ored = vs + 128;
    __syncthreads();
    if (F.tid < 128) { const int d = F.tid; const size_t ix = (size_t)r * 1024 + h * 128 + d; const float z = ((const float*)(ws + WS_LOGF))[ix]; const float lb = ((const float*)(ws + WS_LB))[h * 128 + d];
        const float kin = (1.0f - lb) / (1.0f + __expf(z)); kn[d] = kin; fs[d] = 1.0f - kin; qs[d] = bf2f(((const bf16*)(ws + WS_HQ))[ix]); vs[d] = bf2f(((const bf16*)(ws + WS_HI))[ix]); }
    __syncthreads();
    const int e4 = F.tid & 31, dq = F.tid >> 5;
    const float* Sin = A.in[3] + ((size_t)(b * 8 + h) * 128) * 128; float* Sout = F.out + OUT_SHS + ((size_t)(b * 8 + h) * 128) * 128;
    const f32x4 v4 = *(const LAS f32x4*)&vs[4 * e4]; f32x4 o = (f32x4){0.f, 0.f, 0.f, 0.f};
    f32x4 s[8];
#pragma unroll
    for (int i = 0; i < 8; ++i) s[i] = *(const f32x4*)(Sin + (size_t)(8 * dq + i) * 128 + 4 * e4);
#pragma unroll
    for (int i = 0; i < 8; ++i) { const int d = 8 * dq + i; s[i] = s[i] * fs[d] + v4 * kn[d]; *(f32x4*)(Sout + (size_t)d * 128 + 4 * e4) = s[i]; o += s[i] * qs[d]; }
    *(LAS f32x4*)&ored[dq * 128 + 4 * e4] = o;
    __syncthreads();
    if (F.wave == 0) { float oo[2]; float ss = 0.f;
#pragma unroll
        for (int k = 0; k < 2; ++k) { const int e = F.lane + 64 * k; float t = 0.f;
#pragma unroll
            for (int j = 0; j < 16; ++j) t += ored[j * 128 + e];
            oo[k] = t; ss += t * t; }
        const float rr = 1.0f / sqrtf(wave_sum(ss) * (1.0f / 128.0f) + EPS);
        const bf16* HG = (const bf16*)(ws + WS_HG); bf16* OH = (bf16*)(ws + WS_OH);
#pragma unroll
        for (int k = 0; k < 2; ++k) { const int e = F.lane + 64 * k; const size_t ix = (size_t)r * 1024 + h * 128 + e; OH[ix] = (bf16)f2bf(oo[k] * rr * A.in[10][e] * bf2f(HG[ix])); } }
}
__device__ __forceinline__ void p2_phase(Frame& F, const Args& A) {
    for (int it = F.vcu; it < 512; it += F.G) p2_ret_item(F, it);
    for (int it = F.vcu; it < 512; it += F.G) p2_hg_item(F, it);
    for (int it = F.vcu; it < 1024; it += F.G) p2_sret_item(F, A, it);
    for (int it = F.vcu; it < 1024; it += F.G) p2_shg_item(F, A, it);
}
__device__ __forceinline__ void p3_phase(Frame& F) {
    unsigned char* ws = F.ws;
    const int gt = F.vcu * 512 + F.tid, NT = F.G * 512;
    for (int gid = gt; gid < 32 * 256 * 32; gid += NT) {
        const int bh = gid >> 13, e = (gid >> 5) & 255, d4 = gid & 31; const float cd = exp2f(128.0f * lg2gamma(bh & 7));
        const float* kv = (const float*)(ws + WS_KVLOC) + ((size_t)bh * 16 * 256 + e) * 128 + 4 * d4; bf16* st = (bf16*)(ws + WS_SRT) + ((size_t)bh * 16 * 256 + e) * 128 + 4 * d4;
        f32x4 x[16];
#pragma unroll
        for (int c = 0; c < 16; ++c) x[c] = *(const f32x4*)(kv + (size_t)c * 256 * 128);
        f32x4 S = (f32x4){0.f, 0.f, 0.f, 0.f};
#pragma unroll
        for (int c = 0; c < 16; ++c) { v2u p; p.x = pk2(S[0], S[1]); p.y = pk2(S[2], S[3]); *(v2u*)(st + (size_t)c * 256 * 128) = p; S = S * cd + x[c]; }
        float* fo = F.out + OUT_SRP + ((size_t)bh * 128 + 4 * d4) * 256 + e;
#pragma unroll
        for (int i = 0; i < 4; ++i) fo[(size_t)i * 256] = S[i];
    }
    for (int gid = gt; gid < 32 * 128 * 32; gid += NT) {
        const int bh = gid >> 12, e = (gid >> 5) & 127, d4 = gid & 31;
        const float* hs = (const float*)(ws + WS_HSLOC) + ((size_t)bh * 16 * 128 + e) * 128 + 4 * d4; bf16* st = (bf16*)(ws + WS_SHT) + ((size_t)bh * 16 * 128 + e) * 128 + 4 * d4;
        const float* bt = (const float*)(ws + WS_BTOT) + (size_t)bh * 16 * 128 + 4 * d4;
        f32x4 S = (f32x4){0.f, 0.f, 0.f, 0.f};
#pragma unroll 4
        for (int c = 0; c < 16; ++c) { const f32x4 x = *(const f32x4*)(hs + (size_t)c * 128 * 128); const f32x4 bb = *(const f32x4*)(bt + c * 128);
            v2u p; p.x = pk2(S[0], S[1]); p.y = pk2(S[2], S[3]); *(v2u*)(st + (size_t)c * 128 * 128) = p;
            S[0] = S[0] * __expf(bb[0]) + x[0]; S[1] = S[1] * __expf(bb[1]) + x[1]; S[2] = S[2] * __expf(bb[2]) + x[2]; S[3] = S[3] * __expf(bb[3]) + x[3]; }
        float* fo = F.out + OUT_SHP + ((size_t)bh * 128 + 4 * d4) * 128 + e;
#pragma unroll
        for (int i = 0; i < 4; ++i) fo[(size_t)i * 128] = S[i];
    }
}
__device__ __forceinline__ void p4_ret_item(Frame& F, int item) {
    unsigned char* ws = F.ws;
    const int c = item & 15, h = (item >> 4) & 7, b = item >> 7, r0 = b * 2048 + c * 128;
    const int w = F.wave, l15 = F.lane & 15, g = F.lane >> 4;
    LAS bf16* KS = (LAS bf16*)F.lds; LAS bf16* VT = KS + 128 * TP;
    const bf16* Qg = (const bf16*)(ws + WS_Q); const bf16* Kg = (const bf16*)(ws + WS_K); const bf16* Vg = (const bf16*)(ws + WS_V);
    const float* COS = (const float*)(ws + WS_COS); const float* SIN = (const float*)(ws + WS_SIN);
    const float lg = lg2gamma(h);
    __syncthreads();
#pragma unroll
    for (int i = 0; i < 2; ++i) { const int u = F.tid + 512 * i, d0 = (u & 7) * 8, m = u >> 3;
        const bf16* kp = Kg + (size_t)(r0 + m) * 1024 + h * 128 + d0; const v4u a = *(const v4u*)kp, bb = *(const v4u*)(kp + 64);
        const int pos = c * 128 + m; const f32x4 c0 = *(const f32x4*)(COS + pos * 64 + d0), c1 = *(const f32x4*)(COS + pos * 64 + d0 + 4), s0 = *(const f32x4*)(SIN + pos * 64 + d0), s1 = *(const f32x4*)(SIN + pos * 64 + d0 + 4);
        float o1[8], o2[8];
#pragma unroll
        for (int j = 0; j < 8; ++j) { const float x1 = bfe(a, j), x2 = bfe(bb, j), cj = j < 4 ? c0[j & 3] : c1[j & 3], sj = j < 4 ? s0[j & 3] : s1[j & 3]; o1[j] = x1 * cj - x2 * sj; o2[j] = x2 * cj + x1 * sj; }
        *(LAS bf16x8*)&KS[m * TP + d0] = pack_f8(o1); *(LAS bf16x8*)&KS[m * TP + 64 + d0] = pack_f8(o2); }
#pragma unroll
    for (int i = 0; i < 8; ++i) { const int u = F.tid + 512 * i, m = u & 127, e0 = (u >> 7) * 8;
        const v4u a = *(const v4u*)(Vg + (size_t)(r0 + m) * 2048 + h * 256 + e0);
#pragma unroll
        for (int j = 0; j < 8; ++j) VT[(e0 + j) * TP + m] = (bf16)((a[j >> 1] >> (16 * (j & 1))) & 0xffffu); }
    bf16x8 qf[4];
    { const int n = 16 * w + l15, pos = c * 128 + n; const bf16* qp = Qg + (size_t)(r0 + n) * 1024 + h * 128 + 8 * g;
      const v4u a0 = *(const v4u*)qp, a1 = *(const v4u*)(qp + 32), a2 = *(const v4u*)(qp + 64), a3 = *(const v4u*)(qp + 96);
      float r0v[8], r1v[8], r2v[8], r3v[8];
#pragma unroll
      for (int hlf = 0; hlf < 2; ++hlf) { const int dd = 32 * hlf + 8 * g;
          const f32x4 c0 = *(const f32x4*)(COS + pos * 64 + dd), c1 = *(const f32x4*)(COS + pos * 64 + dd + 4), s0 = *(const f32x4*)(SIN + pos * 64 + dd), s1 = *(const f32x4*)(SIN + pos * 64 + dd + 4);
#pragma unroll
          for (int j = 0; j < 8; ++j) { const float cj = j < 4 ? c0[j & 3] : c1[j & 3], sj = j < 4 ? s0[j & 3] : s1[j & 3];
              const float x1 = hlf == 0 ? bfe(a0, j) : bfe(a1, j), x2 = hlf == 0 ? bfe(a2, j) : bfe(a3, j);
              if (hlf == 0) { r0v[j] = x1 * cj - x2 * sj; r2v[j] = x2 * cj + x1 * sj; } else { r1v[j] = x1 * cj - x2 * sj; r3v[j] = x2 * cj + x1 * sj; } } }
      qf[0] = pack_f8(r0v); qf[1] = pack_f8(r1v); qf[2] = pack_f8(r2v); qf[3] = pack_f8(r3v); }
    __syncthreads();
    f32x4 O[16];
    { const bf16* st = (const bf16*)(ws + WS_SRT) + (size_t)item * 256 * 128 + 8 * g;
#pragma unroll
      for (int et = 0; et < 16; ++et) { f32x4 t = (f32x4){0.f, 0.f, 0.f, 0.f};
#pragma unroll
          for (int ks = 0; ks < 4; ++ks) { const bf16x8 sf = *(const bf16x8*)(st + (size_t)(16 * et + l15) * 128 + 32 * ks); t = MFMA16(qf[ks], sf, t); }
          O[et] = t; }
      float rs[4];
#pragma unroll
      for (int reg = 0; reg < 4; ++reg) rs[reg] = exp2f((float)(16 * w + 4 * g + reg + 1) * lg);
#pragma unroll
      for (int et = 0; et < 16; ++et)
#pragma unroll
          for (int reg = 0; reg < 4; ++reg) O[et][reg] *= rs[reg]; }
    bf16x8 pf[4];
#pragma unroll
    for (int s = 0; s < 4; ++s) { float pv[8];
#pragma unroll
        for (int hf = 0; hf < 2; ++hf) { const int mt = 2 * s + hf; f32x4 dd = (f32x4){0.f, 0.f, 0.f, 0.f};
            if (mt <= w) {
#pragma unroll
                for (int ks = 0; ks < 4; ++ks) { const bf16x8 kf = *(const LAS bf16x8*)&KS[(16 * mt + l15) * TP + 32 * ks + 8 * g]; dd = MFMA16(kf, qf[ks], dd); }
#pragma unroll
                for (int reg = 0; reg < 4; ++reg) { const int m = 16 * mt + 4 * g + reg, n = 16 * w + l15; dd[reg] = n >= m ? dd[reg] * exp2f((float)(n - m) * lg) : 0.f; } }
#pragma unroll
            for (int reg = 0; reg < 4; ++reg) pv[4 * hf + reg] = dd[reg]; }
        pf[s] = pack_f8(pv); }
#pragma unroll
    for (int s = 0; s < 4; ++s) if (2 * s <= w) {
#pragma unroll
        for (int et = 0; et < 16; ++et) { const LAS bf16* vp = &VT[(16 * et + l15) * TP + 32 * s + 4 * g];
            const bf16x4v lo = *(const LAS bf16x4v*)vp, hi = *(const LAS bf16x4v*)(vp + 16);
            const bf16x8 vf = __builtin_shufflevector(lo, hi, 0, 1, 2, 3, 4, 5, 6, 7); O[et] = MFMA16(pf[s], vf, O[et]); } }
    float ss[4] = {0.f, 0.f, 0.f, 0.f};
#pragma unroll
    for (int et = 0; et < 16; ++et)
#pragma unroll
        for (int reg = 0; reg < 4; ++reg) ss[reg] += O[et][reg] * O[et][reg];
#pragma unroll
    for (int reg = 0; reg < 4; ++reg) { float v = ss[reg]; v += __shfl_xor(v, 1); v += __shfl_xor(v, 2); v += __shfl_xor(v, 4); v += __shfl_xor(v, 8); ss[reg] = 1.0f / sqrtf(v * (1.0f / 256.0f) + EPS); }
    const bf16* RG = (const bf16*)(ws + WS_RG); bf16* OR = (bf16*)(ws + WS_OR);
#pragma unroll
    for (int reg = 0; reg < 4; ++reg) { const size_t rb = (size_t)(r0 + 16 * w + 4 * g + reg) * 2048 + h * 256 + l15;
#pragma unroll
        for (int et = 0; et < 16; ++et) OR[rb + 16 * et] = (bf16)f2bf(O[et][reg] * ss[reg] * bf2f(RG[rb + 16 * et])); }
}
__device__ __forceinline__ void p4_hg_item(Frame& F, const Args& A, int item) {
    unsigned char* ws = F.ws;
    const int sc = item & 15, h = (item >> 4) & 7, b = item >> 7, r0 = b * 2048 + sc * 128;
    const int w = F.wave, l15 = F.lane & 15, g = F.lane >> 4;
    LAS bf16* QP = (LAS bf16*)F.lds;
    LAS bf16* KP = QP + 64 * TP;
    LAS bf16* KU = KP + 64 * TP;
    LAS bf16* VT = KU + 128 * 72;
    LAS float* E15 = (LAS float*)(VT + 128 * 72);
    LAS float* OB = E15 + 4 * 128;
    const float* Z = (const float*)(ws + WS_LOGF); const bf16* HQ = (const bf16*)(ws + WS_HQ); const bf16* HI = (const bf16*)(ws + WS_HI); const float* LB = (const float*)(ws + WS_LB);
    f32x4 S[8];
    { const bf16* st = (const bf16*)(ws + WS_SHT) + (size_t)item * 128 * 128 + (size_t)(16 * w + l15) * 128 + 4 * g;
#pragma unroll
      for (int dt = 0; dt < 8; ++dt) { const v2u p = *(const v2u*)(st + 16 * dt); S[dt][0] = __uint_as_float(p.x << 16); S[dt][1] = __uint_as_float(p.x & 0xffff0000u); S[dt][2] = __uint_as_float(p.y << 16); S[dt][3] = __uint_as_float(p.y & 0xffff0000u); } }
    for (int hf = 0; hf < 2; ++hf) {
        const int rh = r0 + 64 * hf;
        __syncthreads();
        { const int d = F.tid & 127, sq = F.tid >> 7; const float oml = 1.0f - LB[h * 128 + d];
          float kin[16], bcum[16]; float bb = 0.f;
#pragma unroll
          for (int t = 0; t < 16; ++t) { const size_t ix = (size_t)(rh + 16 * sq + t) * 1024 + h * 128 + d; const float z = Z[ix]; const float q = bf2f(HQ[ix]);
              kin[t] = oml / (1.0f + __expf(z)); bb += log1pf(-kin[t]); bcum[t] = bb;
              QP[(16 * sq + t) * TP + d] = (bf16)f2bf(q * __expf(bb)); KP[(16 * sq + t) * TP + d] = (bf16)f2bf(kin[t] * __expf(fminf(-bb, 80.0f))); }
          E15[sq * 128 + d] = __expf(bb);
          float v[8];
#pragma unroll
          for (int t = 0; t < 8; ++t) v[t] = kin[t] * __expf(bb - bcum[t]);
          *(LAS bf16x8*)&KU[d * 72 + 16 * sq] = pack_f8(v);
#pragma unroll
          for (int t = 0; t < 8; ++t) v[t] = kin[8 + t] * __expf(bb - bcum[8 + t]);
          *(LAS bf16x8*)&KU[d * 72 + 16 * sq + 8] = pack_f8(v); }
#pragma unroll
        for (int i = 0; i < 2; ++i) { const int u = F.tid + 512 * i, m = u & 63, e0 = (u >> 6) * 8;
            const v4u a = *(const v4u*)(HI + (size_t)(rh + m) * 1024 + h * 128 + e0);
#pragma unroll
            for (int j = 0; j < 8; ++j) VT[(e0 + j) * 72 + m] = (bf16)((a[j >> 1] >> (16 * (j & 1))) & 0xffffu); }
        __syncthreads();
        const bf16x8 zero8 = (bf16x8){0, 0, 0, 0, 0, 0, 0, 0};
#pragma unroll
        for (int sq = 0; sq < 4; ++sq) {
            f32x4 at = (f32x4){0.f, 0.f, 0.f, 0.f};
#pragma unroll
            for (int ks = 0; ks < 4; ++ks) { const bf16x8 kf = *(const LAS bf16x8*)&KP[(16 * sq + l15) * TP + 32 * ks + 8 * g], qf = *(const LAS bf16x8*)&QP[(16 * sq + l15) * TP + 32 * ks + 8 * g]; at = MFMA16(kf, qf, at); }
            float pv[8];
#pragma unroll
            for (int reg = 0; reg < 4; ++reg) { pv[reg] = (4 * g + reg) <= l15 ? at[reg] : 0.f; pv[4 + reg] = 0.f; }
            const bf16x8 pfr = pack_f8(pv);
            f32x4 o;
            { const bf16x4v lo = *(const LAS bf16x4v*)&VT[(16 * w + l15) * 72 + 16 * sq + 4 * g]; const bf16x8 vf = __builtin_shufflevector(lo, (bf16x4v){0, 0, 0, 0}, 0, 1, 2, 3, 4, 5, 6, 7);
              const f32x4 z4 = {0.f, 0.f, 0.f, 0.f}; o = MFMA16(pfr, vf, z4); }
#pragma unroll
            for (int ks = 0; ks < 4; ++ks) { float sv[8];
#pragma unroll
                for (int jj = 0; jj < 8; ++jj) sv[jj] = S[2 * ks + (jj >> 2)][jj & 3];
                const bf16x8 sf = pack_f8(sv);
                const LAS bf16* qp = &QP[(16 * sq + l15) * TP + 32 * ks + 4 * g]; const bf16x4v lo = *(const LAS bf16x4v*)qp, hi = *(const LAS bf16x4v*)(qp + 16);
                const bf16x8 qf = __builtin_shufflevector(lo, hi, 0, 1, 2, 3, 4, 5, 6, 7); o = MFMA16(qf, sf, o); }
#pragma unroll
            for (int reg = 0; reg < 4; ++reg) OB[(16 * sq + 4 * g + reg) * 132 + 16 * w + l15] = o[reg];
            const bf16x8 vu = g < 2 ? *(const LAS bf16x8*)&VT[(16 * w + l15) * 72 + 16 * sq + 8 * g] : zero8;
#pragma unroll
            for (int dt = 0; dt < 8; ++dt) { const f32x4 ed = *(const LAS f32x4*)&E15[sq * 128 + 16 * dt + 4 * g];
                const bf16x8 kf = g < 2 ? *(const LAS bf16x8*)&KU[(16 * dt + l15) * 72 + 16 * sq + 8 * g] : zero8;
                S[dt] = MFMA16(kf, vu, S[dt] * ed); }
        }
        __syncthreads();
        { const bf16* HG = (const bf16*)(ws + WS_HG); bf16* OH = (bf16*)(ws + WS_OH);
#pragma unroll
          for (int i = 0; i < 8; ++i) { const int t = 8 * w + i; const float v0 = OB[t * 132 + F.lane], v1 = OB[t * 132 + 64 + F.lane];
              const float rr = 1.0f / sqrtf(wave_sum(v0 * v0 + v1 * v1) * (1.0f / 128.0f) + EPS); const size_t ix = (size_t)(rh + t) * 1024 + h * 128 + F.lane;
              OH[ix] = (bf16)f2bf(v0 * rr * A.in[10][F.lane] * bf2f(HG[ix])); OH[ix + 64] = (bf16)f2bf(v1 * rr * A.in[10][64 + F.lane] * bf2f(HG[ix + 64])); } }
    }
}
__device__ __forceinline__ void p4_phase(Frame& F, const Args& A) {
    for (int it = F.vcu; it < 512; it += F.G) p4_ret_item(F, it);
    for (int it = F.vcu; it < 512; it += F.G) p4_hg_item(F, A, it);
}
namespace mini {
using pg8::bf16_t; using pg8::u32x2; using pg8::silu4; using pg8::sigm4; using pg8::pack4; using pg8::unpack4;
constexpr int AP = 136;
template <bool TWO> __device__ __forceinline__ void core(Frame& F, const bf16_t* A, int lda, int K, const bf16_t* bp0, const bf16_t* bp1, f32x4 (&acc0)[8], f32x4 (&acc1)[8]) {
    LAS bf16* AS = (LAS bf16*)F.lds; const int l15 = F.lane & 15, g = F.lane >> 4; const int nch = K >> 7; int cc = F.vcu % nch;
    v4u pre[4]; bf16x8 b0[4], b1[4];
    const int prow = F.tid >> 4, pc = (F.tid & 15) * 8;
#pragma unroll
    for (int i = 0; i < 4; ++i) pre[i] = *(const v4u*)(A + (size_t)(prow + 32 * i) * lda + cc * 128 + pc);
    if (bp0) {
#pragma unroll
        for (int u = 0; u < 4; ++u) { b0[u] = *(const bf16x8*)(bp0 + cc * 128 + 32 * u); if (TWO) b1[u] = *(const bf16x8*)(bp1 + cc * 128 + 32 * u); } }
    __syncthreads();
    for (int c = 0; c < nch; ++c) {
        LAS bf16* buf = AS + (c & 1) * (128 * AP);
#pragma unroll
        for (int i = 0; i < 4; ++i) *(LAS v4u*)&buf[(prow + 32 * i) * AP + pc] = pre[i];
        bf16x8 c0[4], c1[4];
#pragma unroll
        for (int u = 0; u < 4; ++u) { c0[u] = b0[u]; if (TWO) c1[u] = b1[u]; }
        cc = cc + 1 == nch ? 0 : cc + 1;
        if (c + 1 < nch) {
#pragma unroll
            for (int i = 0; i < 4; ++i) pre[i] = *(const v4u*)(A + (size_t)(prow + 32 * i) * lda + cc * 128 + pc);
            if (bp0) {
#pragma unroll
                for (int u = 0; u < 4; ++u) { b0[u] = *(const bf16x8*)(bp0 + cc * 128 + 32 * u); if (TWO) b1[u] = *(const bf16x8*)(bp1 + cc * 128 + 32 * u); } } }
        __syncthreads();
        if (bp0) {
#pragma unroll
            for (int u = 0; u < 4; ++u)
#pragma unroll
                for (int rt = 0; rt < 8; ++rt) { const bf16x8 a = *(const LAS bf16x8*)&buf[(16 * rt + l15) * AP + 32 * u + 8 * g];
                    acc0[rt] = __builtin_amdgcn_mfma_f32_16x16x32_bf16(c0[u], a, acc0[rt], 0, 0, 0); if (TWO) acc1[rt] = __builtin_amdgcn_mfma_f32_16x16x32_bf16(c1[u], a, acc1[rt], 0, 0, 0); } }
    }
}
#define MINI_ZERO(acc) _Pragma("unroll") for (int _i = 0; _i < 8; ++_i) acc[_i] = (f32x4){0.f, 0.f, 0.f, 0.f}
__device__ __forceinline__ void inproj(Frame& F) {
    unsigned char* ws = F.ws; const int l15 = F.lane & 15, g = F.lane >> 4;
    if (F.vcu >= NIN / 16) return;
    const int t = F.vcu + F.G * F.wave; const bool has = t < NIN / 16; const int n0 = 16 * t;
    f32x4 acc[8]; MINI_ZERO(acc);
    core<false>(F, (const bf16_t*)(ws + WS_XB) + 8192ull * 2048, 2048, 2048, has ? (const bf16_t*)(ws + WS_WIN) + (size_t)(n0 + l15) * 2048 + 8 * g : nullptr, nullptr, acc, acc);
    if (!has) return;
    const int c = n0 + 4 * g;
    if (c >= 7168 && c < 8192) {
#pragma unroll
        for (int rt = 0; rt < 8; ++rt) *(f32x4*)((float*)(ws + WS_LOGF) + (size_t)(8192 + 16 * rt + l15) * 1024 + (c - 7168)) = acc[rt];
        return; }
    size_t od; int pitch, c0, act; float sc = 1.0f;
    if (c < 1024) { od = WS_Q; pitch = 1024; c0 = 0; act = 0; } else if (c < 2048) { od = WS_K; pitch = 1024; c0 = 1024; act = 0; sc = 0.08838834764831845f; }
    else if (c < 4096) { od = WS_V; pitch = 2048; c0 = 2048; act = 0; } else if (c < 6144) { od = WS_RG; pitch = 2048; c0 = 4096; act = 1; } else if (c < 7168) { od = WS_HQ; pitch = 1024; c0 = 6144; act = 1; }
    else if (c < 9216) { od = WS_HI; pitch = 1024; c0 = 8192; act = 0; } else if (c < 10240) { od = WS_HG; pitch = 1024; c0 = 9216; act = 1; } else if (c < 12288) { od = WS_GA; pitch = 2048; c0 = 10240; act = 2; } else { od = WS_GB; pitch = 2048; c0 = 12288; act = 2; }
#pragma unroll
    for (int rt = 0; rt < 8; ++rt) { f32x4 v = acc[rt] * sc; if (act == 1) v = silu4(v); else if (act == 2) v = sigm4(v);
        *(u32x2*)((bf16_t*)(ws + od) + (size_t)(8192 + 16 * rt + l15) * pitch + (c - c0)) = pack4(v); }
}
__device__ __forceinline__ void outproj(Frame& F) {
    unsigned char* ws = F.ws; const int l15 = F.lane & 15, g = F.lane >> 4;
    if (F.vcu >= 128) return;
    const int t = F.vcu + F.G * F.wave; const bool has = t < 128; const int n0 = 16 * t;
    f32x4 ya[8], yb[8]; MINI_ZERO(ya); MINI_ZERO(yb);
    core<false>(F, (const bf16_t*)(ws + WS_OR) + 8192ull * 2048, 2048, 2048, has ? (const bf16_t*)(ws + WS_WRO) + (size_t)(n0 + l15) * 2048 + 8 * g : nullptr, nullptr, ya, ya);
    core<false>(F, (const bf16_t*)(ws + WS_OH) + 8192ull * 1024, 1024, 1024, has ? (const bf16_t*)(ws + WS_WHO) + (size_t)(n0 + l15) * 1024 + 8 * g : nullptr, nullptr, yb, yb);
    if (!has) return;
#pragma unroll
    for (int rt = 0; rt < 8; ++rt) { const size_t ix = (size_t)(8192 + 16 * rt + l15) * 2048 + n0 + 4 * g;
        const f32x4 ga = unpack4(*(const u32x2*)((const bf16_t*)(ws + WS_GA) + ix)), gb = unpack4(*(const u32x2*)((const bf16_t*)(ws + WS_GB) + ix));
        *(u32x2*)((bf16_t*)(ws + WS_MG) + ix) = pack4(ga * ya[rt] + gb * yb[rt]); }
}
__device__ __forceinline__ void resid(Frame& F, const bf16_t* Arows  , const bf16_t* Bt, int K, const float* XI  , float* XO  , bf16_t* XBo  , float* SS  ) {
    const int l15 = F.lane & 15, g = F.lane >> 4;
    if (F.vcu >= 128) return;
    const int t = F.vcu + F.G * F.wave; const bool has = t < 128; const int n0 = 16 * t;
    f32x4 acc[8]; MINI_ZERO(acc);
    core<false>(F, Arows, K, K, has ? Bt + (size_t)(n0 + l15) * K + 8 * g : nullptr, nullptr, acc, acc);
    if (!has) return;
#pragma unroll
    for (int rt = 0; rt < 8; ++rt) { const int rl = 16 * rt + l15; const size_t ix = (size_t)rl * 2048 + n0 + 4 * g;
        f32x4 v = acc[rt] + *(const f32x4*)(XI + ix); *(f32x4*)(XO + ix) = v;
        if (XBo) *(u32x2*)(XBo + ix) = pack4(v);
        float ss = (v[0] * v[0] + v[1] * v[1]) + (v[2] * v[2] + v[3] * v[3]); ss += __shfl_xor(ss, 16); ss += __shfl_xor(ss, 32);
        if (g == 0) atomicAdd(SS + rl, ss); }
}
__device__ __forceinline__ void swiglu(Frame& F) {
    unsigned char* ws = F.ws; const int l15 = F.lane & 15, g = F.lane >> 4;
    const int t = F.vcu + F.G * F.wave; const bool has = t < DFF / 16; const int ng = ((16 * t) >> 7) * 256 + ((16 * t) & 127);
    f32x4 ag[8], au[8]; MINI_ZERO(ag); MINI_ZERO(au);
    const bf16_t* A = (const bf16_t*)(ws + WS_X1B) + 8192ull * 2048;
    const bf16_t* bg = has ? (const bf16_t*)(ws + WS_WFI) + (size_t)(ng + l15) * 2048 + 8 * g : nullptr;
    core<true>(F, A, 2048, 2048, bg, has ? bg + 128 * 2048 : nullptr, ag, au);
    if (!has) return;
    const float* SS1 = (const float*)(F.ctl + CW_SS1);
#pragma unroll
    for (int rt = 0; rt < 8; ++rt) { const int r = 8192 + 16 * rt + l15; const float r2 = 1.0f / sqrtf(SS1[r] * (1.0f / 2048.0f) + EPS);
        *(u32x2*)((bf16_t*)(ws + WS_ACT) + (size_t)r * DFF + 16 * t + 4 * g) = pack4(silu4(ag[rt] * r2) * (au[rt] * r2)); }
}
}
__global__ void __launch_bounds__(NWAVES * 64, 2) mk_fwd(Args args) {
    extern __shared__ __attribute__((aligned(16))) unsigned char lds[];
    Frame F;
    F.lds = (LAS unsigned char*)lds; F.MISC = (volatile LAS unsigned*)(F.lds + MISC_OFF);
    F.tid = threadIdx.x; F.lane = F.tid & 63; F.wave = __builtin_amdgcn_readfirstlane(F.tid >> 6);
    F.G = gridDim.x; { const int bx = blockIdx.x; F.vcu = (F.G % 8 == 0) ? (bx % 8) * (F.G / 8) + bx / 8 : bx; }
    F.ws = args.ws; F.out = args.out; F.ctl = (gu32*)(args.ws + WS_CTL);
    for (int u = F.tid; u < (LDS_BYTES - LDSCTL_OFF) / 4; u += NWAVES * 64) ((LAS unsigned*)(F.lds + LDSCTL_OFF))[u] = 0u;
    __syncthreads();
    XcdBarrier bar; bar.bar = (unsigned*)(F.ctl + CW_BAR); bar.x = 0; bar.st = nullptr;
    if (args.use_bar) bar = xcd_barrier_post((unsigned*)(F.ctl + CW_BAR), F.MISC + 8);
    const int lo = args.ph_lo, hi = args.ph_hi;
#define IN(k) (lo <= (k) && (k) < hi)
#define SEAM(k) do { if (IN(k) && IN((k) + 1)) xcd_barrier(bar); } while (0)
#ifndef PROBE_REPEAT
#define PROBE_REPEAT -1
#endif
#define NREP(k) ((PROBE_REPEAT == (k)) ? 2 : 1)
    unsigned char* ws = args.ws;
    if (PROBE_REPEAT == 0) { p0_prologue(F, args); xcd_barrier(bar); }
    if (IN(0)) { p0_prologue(F, args); } SEAM(0);
#define P1_BODY { \
        pg8::Gemm g{(const pg8::bf16_t*)(ws + WS_XB), (const pg8::bf16_t*)(ws + WS_WIN), 8192, NIN, 2048}; pg8::StaticOrder S; S.init(8192, NIN, F.G, (int)blockIdx.x); \
        pg8::EpiInProj E{ws}; \
        pg8::gemm_phase<pg8::EpiInProj, pg8::StaticOrder, true, true>(F.lds, g, S, E); mini::inproj(F); }
    if (PROBE_REPEAT == 1) { P1_BODY xcd_barrier(bar); }
    if (IN(1)) P1_BODY SEAM(1);
    if (PROBE_REPEAT == 2) { p2_phase(F, args); xcd_barrier(bar); }
    if (IN(2)) { p2_phase(F, args); } SEAM(2);
    if (PROBE_REPEAT == 3) { p3_phase(F); xcd_barrier(bar); }
    if (IN(3)) { p3_phase(F); } SEAM(3);
    if (PROBE_REPEAT == 4) { p4_phase(F, args); xcd_barrier(bar); }
    if (IN(4)) { p4_phase(F, args); } SEAM(4);
    if (IN(5)) {
        { pg8::Gemm g{(const pg8::bf16_t*)(ws + WS_OR), (const pg8::bf16_t*)(ws + WS_WRO), 8192, 2048, 2048}; pg8::StaticOrder S; S.init(8192, 2048, F.G, (int)blockIdx.x);
          pg8::EpiGate<0> E{(const pg8::bf16_t*)(ws + WS_GA), (float*)(ws + WS_YT), (pg8::bf16_t*)(ws + WS_MG)};
          pg8::gemm_phase<pg8::EpiGate<0>, pg8::StaticOrder, true, true>(F.lds, g, S, E); }
        { pg8::Gemm g{(const pg8::bf16_t*)(ws + WS_OH), (const pg8::bf16_t*)(ws + WS_WHO), 8192, 2048, 1024}; pg8::StaticOrder S; S.init(8192, 2048, F.G, (int)blockIdx.x);
          pg8::EpiGate<1> E{(const pg8::bf16_t*)(ws + WS_GB), (float*)(ws + WS_YT), (pg8::bf16_t*)(ws + WS_MG)};
          pg8::gemm_phase<pg8::EpiGate<1>, pg8::StaticOrder, true, true>(F.lds, g, S, E); }
        mini::outproj(F);
    } SEAM(5);
    if (IN(6)) {
        pg8::Gemm g{(const pg8::bf16_t*)(ws + WS_MG), (const pg8::bf16_t*)(ws + WS_WOUT), 8192, 2048, 2048}; pg8::StaticOrder S; S.init(8192, 2048, F.G, (int)blockIdx.x);
        pg8::EpiResid E{args.in[0], args.in[1], args.out, (pg8::bf16_t*)(ws + WS_X1B), (float*)(F.ctl + CW_SS1)};
        pg8::gemm_phase<pg8::EpiResid, pg8::StaticOrder, true, true>(F.lds, g, S, E);
        mini::resid(F, (const pg8::bf16_t*)(ws + WS_MG) + 8192ull * 2048, (const pg8::bf16_t*)(ws + WS_WOUT), 2048, args.in[1], args.out + OUT_YS, (pg8::bf16_t*)(ws + WS_X1B) + 8192ull * 2048, (float*)(F.ctl + CW_SS1) + 8192);
    } SEAM(6);
    if (IN(7)) {
        pg8::Gemm g{(const pg8::bf16_t*)(ws + WS_X1B), (const pg8::bf16_t*)(ws + WS_WFI), 8192, 2 * DFF, 2048}; pg8::StaticOrder S; S.init(8192, 2 * DFF, F.G, (int)blockIdx.x);
        pg8::EpiSwiglu E{(const float*)(F.ctl + CW_SS1), (pg8::bf16_t*)(ws + WS_ACT)};
        pg8::gemm_phase<pg8::EpiSwiglu, pg8::StaticOrder, true, true>(F.lds, g, S, E);
        mini::swiglu(F);
    } SEAM(7);
    if (IN(8)) {
        pg8::Gemm g{(const pg8::bf16_t*)(ws + WS_ACT), (const pg8::bf16_t*)(ws + WS_WFO), 8192, 2048, DFF}; pg8::StaticOrder S; S.init(8192, 2048, F.G, (int)blockIdx.x);
        pg8::EpiResid E{args.out, args.out + OUT_YS, args.out, nullptr, (float*)(F.ctl + CW_SS2)};
        pg8::gemm_phase<pg8::EpiResid, pg8::StaticOrder, true, true>(F.lds, g, S, E);
        mini::resid(F, (const pg8::bf16_t*)(ws + WS_ACT) + 8192ull * DFF, (const pg8::bf16_t*)(ws + WS_WFO), DFF, args.out + OUT_YS, args.out + OUT_YS, nullptr, (float*)(F.ctl + CW_SS2) + 8192);
    } SEAM(8);
    if (IN(9)) {
        const int gw = F.vcu * NWAVES + F.wave, NGW = F.G * NWAVES; const float* SS2 = (const float*)(F.ctl + CW_SS2);
        for (int m = gw; m < MROWS; m += NGW) { f32x4* xr = (f32x4*)(args.out + (size_t)m * 2048) + F.lane; const f32x4* gn = (const f32x4*)args.in[14] + F.lane;
            const float rr = 1.0f / sqrtf(SS2[m] * (1.0f / 2048.0f) + EPS);
#pragma unroll
            for (int j = 0; j < 8; ++j) xr[64 * j] = xr[64 * j] * rr * gn[64 * j]; }
    }
#undef IN
#undef SEAM
}
extern "C" void kernel_launch(void* const* d_in, const int* in_sizes, int n_in, void* d_out, int out_size, void* d_ws, size_t ws_size, hipStream_t stream) {
    static int grid = 0;
    if (grid == 0) {
        int dev = 0, cus = 0;
        if (ws_size < WS_END || n_in != 15) { fprintf(stderr, "kernel_launch: unexpected sizes (ws %zu, n_in %d)\n", ws_size, n_in); grid = -1; return; }
        if (hipGetDevice(&dev) != hipSuccess || hipDeviceGetAttribute(&cus, hipDeviceAttributeMultiprocessorCount, dev) != hipSuccess) { grid = -1; return; }
        if (hipFuncSetAttribute((const void*)mk_fwd, hipFuncAttributeMaxDynamicSharedMemorySize, LDS_BYTES) != hipSuccess) { fprintf(stderr, "kernel_launch: hipFuncSetAttribute failed\n"); grid = -1; return; }
        int per_cu = 0; (void)hipOccupancyMaxActiveBlocksPerMultiprocessor(&per_cu, (const void*)mk_fwd, NWAVES * 64, LDS_BYTES); (void)hipGetLastError();
        if (per_cu < 1) { fprintf(stderr, "kernel_launch: occupancy query says %d blocks per CU; nothing launched\n", per_cu); grid = -1; return; }
        grid = cus;
    }
    if (grid < 0) return;
    (void)hipMemsetAsync((char*)d_ws + WS_CTL, 0, CTL_ZERO_BYTES, stream);
    Args a{};
    for (int i = 0; i < 15; ++i) a.in[i] = (const float*)d_in[i];
    a.out = (float*)d_out; a.ws = (unsigned char*)d_ws; a.use_bar = 1; a.ph_lo = 0; a.ph_hi = 10;
    hipLaunchKernelGGL(mk_fwd, dim3(grid), dim3(NWAVES * 64), LDS_BYTES, stream, a);
}
```

```cpp
#include <hip/hip_runtime.h>
#include <cstdio>
#include <cstdint>
constexpr int DMODEL = 2048, MROWS = 8320, MPAD = 8448, NIN = 14336, DFF = 5632, NWAVES = 8;
constexpr float EPS = 1e-6f;
constexpr size_t MiB = 1u << 20;
constexpr size_t WS_CTL = 0, CTL_ZERO_BYTES = 1 * MiB;
constexpr size_t WS_WRO = 1 * MiB, WS_WHO = 9 * MiB, WS_WOUT = 13 * MiB, WS_WFI = 21 * MiB, WS_WFO = 65 * MiB, WS_WIN = 87 * MiB;
constexpr size_t WS_XB = 143 * MiB;
constexpr size_t WS_Q = 176 * MiB, WS_K = WS_Q + 8448ull * 1024 * 2, WS_V = 209 * MiB, WS_RG = 242 * MiB, WS_HQ = 275 * MiB, WS_LOGF = WS_HQ + 8448ull * 1024 * 2;
constexpr size_t WS_HI = WS_LOGF + 8448ull * 1024 * 4, WS_HG = WS_HI + 8448ull * 1024 * 2, WS_GA = WS_HG + 8448ull * 1024 * 2, WS_GB = WS_GA + 8448ull * 2048 * 2;
constexpr size_t WS_KVLOC = WS_GB + 8448ull * 2048 * 2;
constexpr size_t WS_HSLOC = WS_KVLOC + 64 * MiB;
constexpr size_t WS_OH = WS_HSLOC + 32 * MiB;
constexpr size_t WS_MISC = WS_OH + 8448ull * 1024 * 2;
constexpr size_t WS_RR1 = WS_MISC, WS_COS = WS_RR1 + 64 * 1024, WS_SIN = WS_COS + 2049 * 64 * 4 + 256, WS_LB = WS_SIN + 2049 * 64 * 4 + 256, WS_BTOT = WS_LB + 4096, WS_END = WS_BTOT + 512 * 128 * 4;
constexpr size_t WS_OR = WS_XB;
constexpr size_t WS_SRT = WS_WIN, WS_SHT = WS_WIN + 32 * MiB;
constexpr size_t WS_YT = WS_KVLOC;
constexpr size_t WS_MG = WS_Q;
constexpr size_t WS_X1B = WS_V;
constexpr size_t WS_ACT = WS_RG;
static_assert(WS_GB + 8448ull * 2048 * 2 == WS_KVLOC && WS_K + 8448ull * 1024 * 2 == WS_V && WS_V + 8448ull * 2048 * 2 == WS_RG && WS_RG + 8448ull * 2048 * 2 == WS_HQ, "map");
static_assert(WS_YT + 8448ull * 2048 * 4 <= WS_OH && WS_ACT + 8448ull * 5632 * 2 <= WS_GA && WS_END <= 541 * MiB, "map2");
constexpr int CW_BAR = 4096;
constexpr int CW_SS1 = 16384, CW_SS2 = 16384 + 8448;
static_assert((CW_SS2 + 8448) * 4 <= (int)CTL_ZERO_BYTES, "ctl");
constexpr int RING_BYTES = 131072, LDSCTL_OFF = RING_BYTES, MISC_OFF = LDSCTL_OFF + 320, LDS_BYTES = 147456;

#define GAS __attribute__((address_space(1)))
#define LAS __attribute__((address_space(3)))
typedef unsigned short bf16;
typedef unsigned v4u __attribute__((ext_vector_type(4)));
typedef unsigned v2u __attribute__((ext_vector_type(2)));
typedef float f32x4 __attribute__((ext_vector_type(4)));
typedef short bf16x8 __attribute__((ext_vector_type(8)));
typedef GAS unsigned gu32;
#define RLX_AGENT __ATOMIC_RELAXED, __HIP_MEMORY_SCOPE_AGENT
#define LDS_WAIT() asm volatile("s_waitcnt lgkmcnt(0)" ::: "memory")
#define VM_WAIT() asm volatile("s_waitcnt vmcnt(0)" ::: "memory")
__device__ __forceinline__ unsigned f2bf(float f) { unsigned u = __builtin_bit_cast(unsigned, f); return (u + 0x7fffu + ((u >> 16) & 1u)) >> 16; }
__device__ __forceinline__ unsigned pk2(float lo, float hi) { return f2bf(lo) | (f2bf(hi) << 16); }
__device__ __forceinline__ float bf2f(unsigned short b) { return __uint_as_float(((unsigned)b) << 16); }
namespace pg8 {
#define PG8_LAS __attribute__((address_space(3)))
typedef unsigned short bf16_t;
typedef short bf16x8 __attribute__((ext_vector_type(8)));
typedef float f32x4 __attribute__((ext_vector_type(4)));
typedef unsigned u32x4 __attribute__((ext_vector_type(4)));
constexpr int BM = 256, BK = 64, HALF = 128, HTB = HALF * BK * 2  , STAGE_BYTES = 8 * HTB, NXCD = 8, WGM = 8;

__host__ __device__ __forceinline__ int lds_byte(int r, int c) { const int st = (r >> 4) * 2 + (c >> 5), rr = r & 15, cc = c & 31, ob = rr * 64 + cc * 2; return st * 1024 + (ob ^ (((ob >> 9) & 1) << 5)); }
__host__ __device__ __forceinline__ void stage_rc(int b, int& R, int& C) { const int st = b / 1024, sb = b % 1024, swz = sb ^ (((sb >> 9) & 1) << 5); R = (st >> 1) * 16 + swz / 64; C = (st & 1) * 32 + (swz % 64) / 2; }
__host__ __device__ __forceinline__ int perm32(int rho) { const int n = rho >> 4, i = rho & 15; return 8 * (i >> 2) + 4 * n + (i & 3); }

struct Unit { int pm, pn; };
struct Gemm { const bf16_t* A; const bf16_t* Bt; int M, N, K; };

struct StaticOrder {
    int nM, nN, nwg, G, c;
    __host__ __device__ void init(int M, int N, int G_, int c_) { nM = M / BM; nN = N / BM; nwg = nM * nN; G = G_; c = c_; }
    __host__ __device__ bool next(int i, Unit& u) const {
        const long L = (long)i * G + c; if (L >= nwg) return false;
        int wgid = (int)L; { const int q = nwg / NXCD, r = nwg % NXCD, xcd = wgid % NXCD, off = wgid / NXCD; wgid = (xcd < r ? xcd * (q + 1) : r * (q + 1) + (xcd - r) * q) + off; }
        const int nig = WGM * nN, gid = wgid / nig, fm = gid * WGM, gsz = (nM - fm) < WGM ? (nM - fm) : WGM;
        u.pm = fm + ((wgid % nig) % gsz); u.pn = (wgid % nig) / gsz; return true;
    }
    __device__ __forceinline__ void a_ready(const Unit&) const {}
    __device__ __forceinline__ void done(const Unit&) const {}
};

__device__ __forceinline__ unsigned cvt_pk_bf16(float lo, float hi) { unsigned r; asm volatile("v_cvt_pk_bf16_f32 %0, %1, %2" : "=v"(r) : "v"(lo), "v"(hi)); return r; }
typedef float f32x2 __attribute__((ext_vector_type(2)));
typedef unsigned u32x2 __attribute__((ext_vector_type(2)));
__device__ __forceinline__ float sigm(float x) { return 1.0f / (1.0f + __expf(-x)); }
__device__ __forceinline__ f32x4 silu4(f32x4 v) { f32x4 o; o[0] = v[0] * sigm(v[0]); o[1] = v[1] * sigm(v[1]); o[2] = v[2] * sigm(v[2]); o[3] = v[3] * sigm(v[3]); return o; }
__device__ __forceinline__ f32x4 sigm4(f32x4 v) { f32x4 o; o[0] = sigm(v[0]); o[1] = sigm(v[1]); o[2] = sigm(v[2]); o[3] = sigm(v[3]); return o; }
__device__ __forceinline__ u32x4 pack8(f32x4 v0, f32x4 v1) { u32x4 w; w.x = cvt_pk_bf16(v0[0], v0[1]); w.y = cvt_pk_bf16(v0[2], v0[3]); w.z = cvt_pk_bf16(v1[0], v1[1]); w.w = cvt_pk_bf16(v1[2], v1[3]); return w; }
__device__ __forceinline__ u32x2 pack4(f32x4 v) { u32x2 w; w.x = cvt_pk_bf16(v[0], v[1]); w.y = cvt_pk_bf16(v[2], v[3]); return w; }
__device__ __forceinline__ f32x4 unpack4(u32x2 w) { f32x4 o; o[0] = __uint_as_float(w.x << 16); o[1] = __uint_as_float(w.x & 0xffff0000u); o[2] = __uint_as_float(w.y << 16); o[3] = __uint_as_float(w.y & 0xffff0000u); return o; }

struct EpiInProj {
    static constexpr bool PERM = true, AFTER_DRAIN = false;
    unsigned char* ws;
    __device__ __forceinline__ void operator()(const f32x4 (&acc)[2][2][4][2], const Unit& u, int wr, int wc, int fr, int fq) const {
        const int pn = u.pn, row0 = u.pm * BM + wr * 64 + fr;
        if (pn >= 28 && pn < 32) {
            float* Z = (float*)(ws + WS_LOGF); const int cs = (pn - 28) * 256 + wc * 32 + 8 * fq;
#pragma unroll
            for (int ai = 0; ai < 2; ++ai)
#pragma unroll
                for (int m = 0; m < 4; ++m) { const int r = row0 + ai * HALF + m * 16;
#pragma unroll
                    for (int bj = 0; bj < 2; ++bj)
#pragma unroll
                        for (int n = 0; n < 2; ++n) *(f32x4*)(Z + (size_t)r * 1024 + cs + bj * HALF + 4 * n) = acc[ai][bj][m][n]; }
        } else {
            size_t od; int pitch, p0, act; float sc = 1.0f;
            if (pn < 4) { od = WS_Q; pitch = 1024; p0 = 0; act = 0; } else if (pn < 8) { od = WS_K; pitch = 1024; p0 = 4; act = 0; sc = 0.08838834764831845f; }
            else if (pn < 16) { od = WS_V; pitch = 2048; p0 = 8; act = 0; } else if (pn < 24) { od = WS_RG; pitch = 2048; p0 = 16; act = 1; } else if (pn < 28) { od = WS_HQ; pitch = 1024; p0 = 24; act = 1; }
            else if (pn < 36) { od = WS_HI; pitch = 1024; p0 = 32; act = 0; } else if (pn < 40) { od = WS_HG; pitch = 1024; p0 = 36; act = 1; } else if (pn < 48) { od = WS_GA; pitch = 2048; p0 = 40; act = 2; } else { od = WS_GB; pitch = 2048; p0 = 48; act = 2; }
            bf16_t* dst = (bf16_t*)(ws + od);
            const int cs = (pn - p0) * 256 + wc * 32 + 8 * fq;
#pragma unroll
            for (int ai = 0; ai < 2; ++ai)
#pragma unroll
                for (int m = 0; m < 4; ++m) { const int r = row0 + ai * HALF + m * 16; bf16_t* rowp = dst + (size_t)r * pitch + cs;
#pragma unroll
                    for (int bj = 0; bj < 2; ++bj) { f32x4 v0 = acc[ai][bj][m][0] * sc, v1 = acc[ai][bj][m][1] * sc;
                        if (act == 1) { v0 = silu4(v0); v1 = silu4(v1); } else if (act == 2) { v0 = sigm4(v0); v1 = sigm4(v1); }
                        *(u32x4*)(rowp + bj * HALF) = pack8(v0, v1); } }
        }
    }
};
template <int SECOND> struct EpiGate {
    static constexpr bool PERM = true, AFTER_DRAIN = false;
    const bf16_t* G; float* YT; bf16_t* MG;
    __device__ __forceinline__ void operator()(const f32x4 (&acc)[2][2][4][2], const Unit& u, int wr, int wc, int fr, int fq) const {
        const int row0 = u.pm * BM + wr * 64 + fr, col0 = u.pn * BM + wc * 32 + 8 * fq;
#pragma unroll
        for (int ai = 0; ai < 2; ++ai)
#pragma unroll
            for (int m = 0; m < 4; ++m) { const size_t off = (size_t)(row0 + ai * HALF + m * 16) * 2048 + col0;
#pragma unroll
                for (int bj = 0; bj < 2; ++bj) { const u32x4 gw = *(const u32x4*)(G + off + bj * HALF);
                    f32x4 v0 = acc[ai][bj][m][0] * unpack4((u32x2){gw.x, gw.y}), v1 = acc[ai][bj][m][1] * unpack4((u32x2){gw.z, gw.w});
                    float* yp = YT + off + bj * HALF;
                    if (SECOND) { v0 += *(const f32x4*)yp; v1 += *(const f32x4*)(yp + 4); *(u32x4*)(MG + off + bj * HALF) = pack8(v0, v1); }
                    else { *(f32x4*)yp = v0; *(f32x4*)(yp + 4) = v1; } } }
        __builtin_amdgcn_s_waitcnt(0x0F70);
    }
};
struct EpiResid {
    static constexpr bool PERM = true, AFTER_DRAIN = false;
    const float* XP; const float* XS; float* OUT; bf16_t* XB; float* SS;
    __device__ __forceinline__ void operator()(const f32x4 (&acc)[2][2][4][2], const Unit& u, int wr, int wc, int fr, int fq) const {
        const int row0 = u.pm * BM + wr * 64 + fr, col0 = u.pn * BM + wc * 32 + 8 * fq;
#pragma unroll
        for (int ai = 0; ai < 2; ++ai)
#pragma unroll
            for (int m = 0; m < 4; ++m) { const int r = row0 + ai * HALF + m * 16; const bool live = r < 8320;
                const float* xi = (r < 8192 ? XP + (size_t)r * 2048 : XS + (size_t)(r - 8192) * 2048) + col0; float ss = 0.f;
#pragma unroll
                for (int bj = 0; bj < 2; ++bj) { f32x4 v0 = acc[ai][bj][m][0], v1 = acc[ai][bj][m][1];
                    if (live) { v0 += *(const f32x4*)(xi + bj * HALF); v1 += *(const f32x4*)(xi + bj * HALF + 4);
                        float* op = OUT + (size_t)r * 2048 + col0 + bj * HALF; *(f32x4*)op = v0; *(f32x4*)(op + 4) = v1; }
                    if (XB) *(u32x4*)(XB + (size_t)r * 2048 + col0 + bj * HALF) = pack8(v0, v1);
                    ss += (v0[0] * v0[0] + v0[1] * v0[1]) + (v0[2] * v0[2] + v0[3] * v0[3]) + (v1[0] * v1[0] + v1[1] * v1[1]) + (v1[2] * v1[2] + v1[3] * v1[3]); }
                ss += __shfl_xor(ss, 16); ss += __shfl_xor(ss, 32);
                if (fq == 0) atomicAdd(SS + r, ss); }
        __builtin_amdgcn_s_waitcnt(0x0F70);
    }
};
struct EpiSwiglu {
    static constexpr bool PERM = true, AFTER_DRAIN = false;
    const float* SS; bf16_t* ACT;
    __device__ __forceinline__ void operator()(const f32x4 (&acc)[2][2][4][2], const Unit& u, int wr, int wc, int fr, int fq) const {
        const int row0 = u.pm * BM + wr * 64 + fr, col0 = u.pn * HALF + wc * 32 + 8 * fq;
        float ssv[2][4];
#pragma unroll
        for (int ai = 0; ai < 2; ++ai)
#pragma unroll
            for (int m = 0; m < 4; ++m) ssv[ai][m] = SS[row0 + ai * HALF + m * 16];
        __builtin_amdgcn_s_waitcnt(0x0F70);
#pragma unroll
        for (int ai = 0; ai < 2; ++ai)
#pragma unroll
            for (int m = 0; m < 4; ++m) { const int r = row0 + ai * HALF + m * 16; const float r2 = 1.0f / sqrtf(ssv[ai][m] * (1.0f / 2048.0f) + 1e-6f);
                const f32x4 g0 = acc[ai][0][m][0] * r2, g1 = acc[ai][0][m][1] * r2, u0 = acc[ai][1][m][0] * r2, u1 = acc[ai][1][m][1] * r2;
                *(u32x4*)(ACT + (size_t)r * 5632 + col0) = pack8(silu4(g0) * u0, silu4(g1) * u1); }
    }
};
template <class Epi, class Sched, bool ALIGN_EPI = false, bool SP2 = false>
__device__ __forceinline__ void gemm_phase(PG8_LAS unsigned char* lds, const Gemm g, const Sched& S, const Epi& E) {
    const int tid = threadIdx.x, wid = __builtin_amdgcn_readfirstlane(tid >> 6), lane = tid & 63, wr = wid >> 2, wc = wid & 3, fr = lane & 15, fq = lane >> 4;
    const int K = g.K, nt = K / BK;
    unsigned voffA[2], voffB[2];
#pragma unroll
    for (int i = 0; i < 2; ++i) { int R, C; stage_rc(tid * 16 + i * 8192, R, C); const int Rb = Epi::PERM ? ((R & ~31) + perm32(R & 31)) : R;
        voffA[i] = (unsigned)(R * K + C) * 2u; voffB[i] = (unsigned)(Rb * K + C) * 2u; }
    const size_t kstep = (size_t)(BK * 2);
    const size_t hstep = (size_t)HALF * K * 2;
    const size_t tstep = 2 * hstep;
    const unsigned ldsw = (unsigned)wid * 1024u;
    const int aoff = lds_byte(wr * 64 + fr, fq * 8), boff = lds_byte(wc * 32 + fr, fq * 8);
#define PG8_SA(b, h) (((b) * 2 + (h)) * HTB)
#define PG8_SB(b, h) ((4 + (b) * 2 + (h)) * HTB)
#define PG8_STAGE(bufoff, gbase, voff) do { _Pragma("unroll") for (int _i = 0; _i < 2; ++_i) \
        __builtin_amdgcn_global_load_lds((const unsigned*)((const char*)(gbase) + (voff)[_i]), (PG8_LAS unsigned*)(lds + (bufoff) + ldsw + _i * 8192), 16, 0, 0); } while (0)
#define PG8_LDA(dst, b, h) do { _Pragma("unroll") for (int m = 0; m < 4; ++m) _Pragma("unroll") for (int k = 0; k < 2; ++k) dst[m][k] = *(const PG8_LAS bf16x8*)(lds + PG8_SA(b, h) + aoff + m * 2048 + k * 1024); } while (0)
#define PG8_LDB(dst, b, h) do { _Pragma("unroll") for (int n = 0; n < 2; ++n) _Pragma("unroll") for (int k = 0; k < 2; ++k) dst[n][k] = *(const PG8_LAS bf16x8*)(lds + PG8_SB(b, h) + boff + n * 2048 + k * 1024); } while (0)
#define PG8_MMA(ai, bj, At, Bt) do { __builtin_amdgcn_s_setprio(1); _Pragma("unroll") for (int m = 0; m < 4; ++m) _Pragma("unroll") for (int n = 0; n < 2; ++n) _Pragma("unroll") for (int k = 0; k < 2; ++k) \
        acc[ai][bj][m][n] = __builtin_amdgcn_mfma_f32_16x16x32_bf16(Bt[n][k], At[m][k], acc[ai][bj][m][n], 0, 0, 0); __builtin_amdgcn_s_setprio(0); } while (0)
#define PG8_WAIT_V(n) asm volatile("s_waitcnt vmcnt(" #n ")" ::: "memory")
#define PG8_WAIT_L(n) asm volatile("s_waitcnt lgkmcnt(" #n ")" ::: "memory")
#define PG8_BAR __builtin_amdgcn_s_barrier()
#define PG8_SCHED __builtin_amdgcn_sched_barrier(0)
    Unit cur, nxt; int ui = 0;
    if (!S.next(0, cur)) return;
    f32x4 acc[2][2][4][2];
#pragma unroll
    for (int a = 0; a < 2; ++a)
#pragma unroll
        for (int b = 0; b < 2; ++b)
#pragma unroll
            for (int m = 0; m < 4; ++m)
#pragma unroll
                for (int n = 0; n < 2; ++n) acc[a][b][m][n] = (f32x4){0.f, 0.f, 0.f, 0.f};
    bf16x8 At[4][2], B0[2][2], B1[2][2];
    const char* cA = (const char*)g.A + (size_t)cur.pm * tstep; const char* cB = (const char*)g.Bt + (size_t)cur.pn * tstep;
    S.a_ready(cur);
    if constexpr (SP2) {
        PG8_STAGE(PG8_SB(0, 0), cB, voffB); PG8_STAGE(PG8_SB(0, 1), cB + hstep, voffB); PG8_STAGE(PG8_SA(0, 0), cA, voffA); PG8_STAGE(PG8_SA(0, 1), cA + hstep, voffA);
        if (wr == 1) PG8_BAR;
        PG8_WAIT_V(2); PG8_BAR;
        PG8_STAGE(PG8_SB(1, 0), cB + kstep, voffB); PG8_STAGE(PG8_SA(1, 0), cA + kstep, voffA); PG8_STAGE(PG8_SB(1, 1), cB + hstep + kstep, voffB);
        PG8_WAIT_V(6); PG8_BAR;
    } else {
        PG8_STAGE(PG8_SB(0, 0), cB, voffB); PG8_STAGE(PG8_SA(0, 0), cA, voffA); PG8_STAGE(PG8_SB(0, 1), cB + hstep, voffB); PG8_STAGE(PG8_SA(0, 1), cA + hstep, voffA);
        if (wr == 1) PG8_BAR;
        PG8_WAIT_V(4); PG8_BAR;
        PG8_STAGE(PG8_SB(1, 0), cB + kstep, voffB); PG8_STAGE(PG8_SA(1, 0), cA + kstep, voffA); PG8_STAGE(PG8_SB(1, 1), cB + hstep + kstep, voffB);
        PG8_WAIT_V(6); PG8_BAR;
    }
    for (;;) {
        const bool has_next = S.next(ui + 1, nxt);
        const char* nA = has_next ? (const char*)g.A + (size_t)nxt.pm * tstep : cA; const char* nB = has_next ? (const char*)g.Bt + (size_t)nxt.pn * tstep : cB;
        for (int t = 0; t < nt; t += 2) {
            const bool last = (t == nt - 2);
            const char* a1 = cA + (size_t)(t + 1) * kstep;
            const char* a2 = last ? nA : cA + (size_t)(t + 2) * kstep; const char* b2 = last ? nB : cB + (size_t)(t + 2) * kstep;
            const char* a3 = a2 + kstep; const char* b3 = b2 + kstep;
            if (last && has_next) S.a_ready(nxt);
            if constexpr (SP2) {
            PG8_LDB(B0, 0, 0); PG8_LDB(B1, 0, 1); PG8_SCHED; PG8_LDA(At, 0, 0); PG8_STAGE(PG8_SA(1, 1), a1 + hstep, voffA);
            PG8_WAIT_V(8); PG8_WAIT_L(0); PG8_BAR; PG8_MMA(0, 0, At, B0); PG8_MMA(0, 1, At, B1); PG8_BAR; PG8_SCHED;
            PG8_LDA(At, 0, 1); PG8_STAGE(PG8_SB(0, 0), b2, voffB); PG8_STAGE(PG8_SB(0, 1), b2 + hstep, voffB); PG8_STAGE(PG8_SA(0, 0), a2, voffA);
            PG8_WAIT_V(8); PG8_WAIT_L(0); PG8_BAR; PG8_MMA(1, 0, At, B0); PG8_MMA(1, 1, At, B1); PG8_BAR; PG8_SCHED;
            PG8_LDB(B0, 1, 0); PG8_LDB(B1, 1, 1); PG8_SCHED; PG8_LDA(At, 1, 0); PG8_STAGE(PG8_SA(0, 1), a2 + hstep, voffA);
            PG8_WAIT_V(8); PG8_WAIT_L(0); PG8_BAR; PG8_MMA(0, 0, At, B0); PG8_MMA(0, 1, At, B1); PG8_BAR; PG8_SCHED;
            PG8_LDA(At, 1, 1); PG8_STAGE(PG8_SB(1, 0), b3, voffB); PG8_STAGE(PG8_SB(1, 1), b3 + hstep, voffB); PG8_STAGE(PG8_SA(1, 0), a3, voffA);
            PG8_WAIT_V(8); PG8_WAIT_L(0); PG8_BAR; PG8_MMA(1, 0, At, B0); PG8_MMA(1, 1, At, B1); PG8_BAR; PG8_SCHED;
            } else {
            PG8_LDB(B0, 0, 0); PG8_SCHED; PG8_LDA(At, 0, 0); PG8_STAGE(PG8_SA(1, 1), a1 + hstep, voffA);
            PG8_WAIT_L(8); PG8_BAR; PG8_WAIT_L(0); PG8_MMA(0, 0, At, B0); PG8_BAR; PG8_SCHED;
            PG8_LDB(B1, 0, 1); PG8_STAGE(PG8_SB(0, 0), b2, voffB);
            PG8_BAR; PG8_WAIT_L(0); PG8_MMA(0, 1, At, B1); PG8_BAR;
            PG8_LDA(At, 0, 1); PG8_STAGE(PG8_SA(0, 0), a2, voffA);
            PG8_BAR; PG8_WAIT_L(0); PG8_MMA(1, 0, At, B0); PG8_BAR; PG8_SCHED;
            PG8_STAGE(PG8_SB(0, 1), b2 + hstep, voffB);
            PG8_WAIT_V(6); PG8_BAR; PG8_MMA(1, 1, At, B1); PG8_BAR;
            PG8_LDB(B0, 1, 0); PG8_SCHED; PG8_LDA(At, 1, 0); PG8_STAGE(PG8_SA(0, 1), a2 + hstep, voffA);
            PG8_WAIT_L(8); PG8_BAR; PG8_WAIT_L(0); PG8_MMA(0, 0, At, B0); PG8_BAR; PG8_SCHED;
            PG8_LDB(B1, 1, 1); PG8_STAGE(PG8_SB(1, 0), b3, voffB);
            PG8_BAR; PG8_WAIT_L(0); PG8_MMA(0, 1, At, B1); PG8_BAR;
            PG8_LDA(At, 1, 1); PG8_STAGE(PG8_SA(1, 0), a3, voffA);
            PG8_BAR; PG8_WAIT_L(0); PG8_MMA(1, 0, At, B0); PG8_BAR; PG8_SCHED;
            PG8_STAGE(PG8_SB(1, 1), b3 + hstep, voffB);
            PG8_WAIT_V(6); PG8_BAR; PG8_MMA(1, 1, At, B1); PG8_BAR;
            }
        }
        if constexpr (ALIGN_EPI) { if (wr == 0) PG8_BAR; }
        if constexpr (!Epi::AFTER_DRAIN) { E(acc, cur, wr, wc, fr, fq); S.done(cur); }
        if (!has_next) break;
#pragma unroll
        for (int a = 0; a < 2; ++a)
#pragma unroll
            for (int b = 0; b < 2; ++b)
#pragma unroll
                for (int m = 0; m < 4; ++m)
#pragma unroll
                    for (int n = 0; n < 2; ++n) acc[a][b][m][n] = (f32x4){0.f, 0.f, 0.f, 0.f};
        cur = nxt; cA = nA; cB = nB; ++ui;
        if constexpr (ALIGN_EPI) { if (wr == 1) PG8_BAR; }
    }
    PG8_WAIT_V(0);
    if constexpr (!ALIGN_EPI) { if (wr == 0) PG8_BAR; }
    PG8_BAR;
    if constexpr (Epi::AFTER_DRAIN) { E.fused(acc, cur, wr, wc, fr, fq, lds, wid, lane); S.done(cur); }
#undef PG8_SA
#undef PG8_SB
#undef PG8_STAGE
#undef PG8_LDA
#undef PG8_LDB
#undef PG8_MMA
#undef PG8_WAIT_V
#undef PG8_WAIT_L
#undef PG8_BAR
#undef PG8_SCHED
}
}
#define XB_TMO      128
#define XB_XCNT(j)  (256  + 64 * (j))
#define XB_XSUB(j)  (1280 + 64 * (j))
#define XB_XGEN(j)  (2304 + 64 * (j))
#define XB_TOP      3328
#define XB_TOPGEN   3392
#define XCD_BAR_WORDS 3456
#define XB_SPIN_CAP (1u << 18)

__device__ __forceinline__ unsigned xb_ld(unsigned* p)              { return __hip_atomic_load(p, __ATOMIC_RELAXED, __HIP_MEMORY_SCOPE_AGENT); }
__device__ __forceinline__ unsigned xb_add(unsigned* p, unsigned v) { return __hip_atomic_fetch_add(p, v, __ATOMIC_RELAXED, __HIP_MEMORY_SCOPE_AGENT); }
__device__ __forceinline__ unsigned xb_xcc_id() { return (unsigned)__builtin_amdgcn_s_getreg((3 << 11) | 20) & 0xFu; }
#define XB_SPIN(cond, bar) do { unsigned _sp = 0; while (cond) { __builtin_amdgcn_s_sleep(1); \
    if ((++_sp & 255u) == 0u) { if (xb_ld(&(bar)[XB_TMO])) break; if (_sp > XB_SPIN_CAP) { atomicAdd(&(bar)[XB_TMO], 1u); break; } } } } while (0)

struct XcdBarrier {
    unsigned* bar; unsigned x;
    volatile LAS unsigned* st;
};

__device__ __forceinline__ XcdBarrier xcd_barrier_post(unsigned* bar, volatile LAS unsigned* st) {
    XcdBarrier b; b.bar = bar; b.x = xb_xcc_id(); b.st = st;
    if (threadIdx.x == 0) (void)xb_add(&bar[XB_XCNT(b.x)], 1u);
    return b;
}
__device__ __forceinline__ void xcd_barrier_complete(unsigned* bar, unsigned x, unsigned& nloc, unsigned& nx) {
    const unsigned G = gridDim.x * gridDim.y * gridDim.z;
    unsigned sum, cnt, mine, sp = 0u;
    for (;;) {
        sum = 0u; cnt = 0u; mine = 0u;
#pragma unroll
        for (unsigned j = 0; j < 16; ++j) { const unsigned c = xb_ld(&bar[XB_XCNT(j)]); sum += c; cnt += (c > 0u) ? 1u : 0u; mine = (j == x) ? c : mine; }
        if (sum == G) break;
        __builtin_amdgcn_s_sleep(1);
        if ((++sp & 255u) == 0u) { if (xb_ld(&bar[XB_TMO])) break; if (sp > XB_SPIN_CAP) { atomicAdd(&bar[XB_TMO], 1u); break; } }
    }
    nloc = mine > 0u ? mine : 1u; nx = cnt > 0u ? cnt : 1u;
}

__device__ __forceinline__ void xcd_barrier(const XcdBarrier& b) {
    asm volatile("s_waitcnt vmcnt(0)" ::: "memory");
    __syncthreads();
    if (threadIdx.x == 0) {
        unsigned* bar = b.bar;
        __builtin_amdgcn_s_waitcnt(0);
        unsigned nloc = b.st[0], nx = b.st[1];
        if (nloc == 0u) { xcd_barrier_complete(bar, b.x, nloc, nx); b.st[0] = nloc; b.st[1] = nx; }
        const unsigned old = xb_add(&bar[XB_XSUB(b.x)], 1u);
        const unsigned gen = old / nloc;
        if (old + 1u == (gen + 1u) * nloc) {
            __builtin_amdgcn_fence(__ATOMIC_RELEASE, "agent");
            asm volatile("s_waitcnt vmcnt(0)" ::: "memory");
            const unsigned og = xb_add(&bar[XB_TOP], 1u);
            const unsigned tg = og / nx;
            if (og + 1u == (tg + 1u) * nx) xb_add(&bar[XB_TOPGEN], 1u);
            else XB_SPIN(xb_ld(&bar[XB_TOPGEN]) == tg, bar);
            __builtin_amdgcn_fence(__ATOMIC_ACQUIRE, "agent");
            xb_add(&bar[XB_XGEN(b.x)], 1u);
            asm volatile("s_waitcnt vmcnt(0)" ::: "memory");
        } else {
            XB_SPIN(xb_ld(&bar[XB_XGEN(b.x)]) == gen, bar);
            __builtin_amdgcn_fence(__ATOMIC_ACQUIRE, "agent");
            asm volatile("s_waitcnt vmcnt(0)" ::: "memory");
        }
    }
    __syncthreads();
}
struct Frame {
    LAS unsigned char* lds; volatile LAS unsigned* MISC; gu32* ctl;
    int tid, lane, wave, vcu, G;
    float* out; unsigned char* ws;
};
__device__ __forceinline__ float wave_sum(float v) {
#pragma unroll
    for (int o = 1; o < 64; o <<= 1) v += __shfl_xor(v, o);
    return v;
}
template <int MODE> __device__ __forceinline__ int rowmap(int n) {
    if (MODE == 1) { if (n >= 2048) return n; const int j = n & 127, hb = n & ~127; return hb + (j < 64 ? 8 * (j >> 2) + (j & 3) : 8 * ((j - 64) >> 2) + 4 + (j & 3)); }
    if (MODE == 2) { return n < DFF ? (n >> 7) * 256 + (n & 127) : ((n - DFF) >> 7) * 256 + 128 + ((n - DFF) & 127); }
    return n;
}
template <int MODE> __device__ __forceinline__ void p0_transpose_item(const float* W, int K, int N, bf16* WT, const float* g, LAS unsigned* T, int item, int lane) {
    const int nblk = N / 64, kb = item / nblk, nb = item % nblk, k0 = 64 * kb, n0 = 64 * nb;
    const int l15 = lane & 15, lg = lane >> 4;
    f32x4 v[16];
#pragma unroll
    for (int i = 0; i < 16; ++i) { const int row = 8 * (i >> 1) + 2 * lg + (i & 1); v[i] = *(const f32x4*)(W + (size_t)(k0 + row) * N + n0 + 4 * l15); }
    if (g) {
#pragma unroll
        for (int i = 0; i < 16; ++i) { const int row = 8 * (i >> 1) + 2 * lg + (i & 1); v[i] = v[i] * g[k0 + row]; } }
#pragma unroll
    for (int p = 0; p < 8; ++p)
#pragma unroll
        for (int j = 0; j < 4; ++j) T[(4 * l15 + j) * 33 + 4 * p + lg] = pk2(v[2 * p][j], v[2 * p + 1][j]);
    LDS_WAIT(); asm volatile("" ::: "memory");
    const int c = lane & 7;
#pragma unroll
    for (int i = 0; i < 8; ++i) { const int n = (lane >> 3) + 8 * i; const LAS unsigned* s = T + n * 33 + 4 * c;
        v4u o; o.x = s[0]; o.y = s[1]; o.z = s[2]; o.w = s[3];
        *(GAS v4u*)(WT + (size_t)rowmap<MODE>(n0 + n) * K + k0 + 8 * c) = o; }
    LDS_WAIT(); asm volatile("" ::: "memory");
}
struct Args { const float* in[15]; float* out; unsigned char* ws; int ph_lo, ph_hi, use_bar, pad; };
__device__ __forceinline__ void p0_prologue(Frame& F, const Args& A) {
    LAS unsigned* scr = (LAS unsigned*)(F.lds + F.wave * 16384);
    const int gw = F.vcu * NWAVES + F.wave, NGW = F.G * NWAVES;
    unsigned char* ws = F.ws;
    constexpr int I_IN = 32 * (NIN / 64), I_RO = 32 * 32, I_HO = 16 * 32, I_OUT = 32 * 32, I_FI = 32 * (2 * DFF / 64), I_FO = (DFF / 64) * 32;
    constexpr int NITEMS = I_IN + I_RO + I_HO + I_OUT + I_FI + I_FO;
    for (int it = gw; it < NITEMS; it += NGW) {
        int r = it;
        if (r < I_IN) { p0_transpose_item<0>(A.in[4], 2048, NIN, (bf16*)(ws + WS_WIN), A.in[8], scr, r, F.lane); continue; } r -= I_IN;
        if (r < I_RO) { p0_transpose_item<0>(A.in[5], 2048, 2048, (bf16*)(ws + WS_WRO), nullptr, scr, r, F.lane); continue; } r -= I_RO;
        if (r < I_HO) { p0_transpose_item<0>(A.in[6], 1024, 2048, (bf16*)(ws + WS_WHO), nullptr, scr, r, F.lane); continue; } r -= I_HO;
        if (r < I_OUT) { p0_transpose_item<0>(A.in[7], 2048, 2048, (bf16*)(ws + WS_WOUT), nullptr, scr, r, F.lane); continue; } r -= I_OUT;
        if (r < I_FI) { p0_transpose_item<2>(A.in[12], 2048, 2 * DFF, (bf16*)(ws + WS_WFI), A.in[9], scr, r, F.lane); continue; } r -= I_FI;
        p0_transpose_item<0>(A.in[13], DFF, 2048, (bf16*)(ws + WS_WFO), nullptr, scr, r, F.lane);
    }
    bf16* XB = (bf16*)(ws + WS_XB);
    for (int m = gw; m < MPAD; m += NGW) {
        GAS unsigned long long* o8 = (GAS unsigned long long*)(XB + (size_t)m * 2048) + F.lane;
        if (m < MROWS) {
            const float* xrow = m < 8192 ? A.in[0] + (size_t)m * 2048 : A.in[1] + (size_t)(m - 8192) * 2048;
            const GAS f32x4* xr = (const GAS f32x4*)xrow + F.lane;
            f32x4 v[8]; float s = 0.f;
#pragma unroll
            for (int j = 0; j < 8; ++j) { v[j] = xr[64 * j]; s += (v[j].x * v[j].x + v[j].y * v[j].y) + (v[j].z * v[j].z + v[j].w * v[j].w); }
            const float rr = 1.0f / sqrtf(wave_sum(s) * (1.0f / 2048.0f) + EPS);
#pragma unroll
            for (int j = 0; j < 8; ++j) o8[64 * j] = (unsigned long long)pk2(v[j].x * rr, v[j].y * rr) | ((unsigned long long)pk2(v[j].z * rr, v[j].w * rr) << 32);
        } else {
#pragma unroll
            for (int j = 0; j < 8; ++j) o8[64 * j] = 0ull;
        }
    }
    { float* COS = (float*)(ws + WS_COS); float* SIN = (float*)(ws + WS_SIN);
      for (int i = (F.vcu * NWAVES + F.wave) * 64 + F.lane; i < 2049 * 64; i += F.G * NWAVES * 64) { const int p = i >> 6, j = i & 63; const int pos = p < 2048 ? p : 16384;
          const float inv = powf(10000.0f, -(float)j / 64.0f); const float ang = (float)pos * inv; float sn, cs; sincosf(ang, &sn, &cs); COS[i] = cs; SIN[i] = sn; } }
    { float* LB = (float*)(ws + WS_LB); const int i = (F.vcu * NWAVES + F.wave) * 64 + F.lane; if (i < 1024) { const float l0 = A.in[11][i], l1 = A.in[11][1024 + i]; LB[i] = 1.0f / (1.0f + expf(l1 - l0)); } }
}
typedef short bf16x4v __attribute__((ext_vector_type(4)));
#define MFMA16(a, b, c) __builtin_amdgcn_mfma_f32_16x16x32_bf16((a), (b), (c), 0, 0, 0)
constexpr int TP = 136;
constexpr size_t OUT_YS = 8192ull * 2048, OUT_SRP = 8320ull * 2048, OUT_SHP = OUT_SRP + 4ull * 8 * 128 * 256, OUT_SRS = OUT_SHP + 4ull * 8 * 128 * 128, OUT_SHS = OUT_SRS + 128ull * 8 * 128 * 256;
__device__ __forceinline__ float lg2gamma(int h) { return log2f(1.0f - exp2f(-5.0f - (float)h)); }
__device__ __forceinline__ float bfe(const v4u& w, int j) { const unsigned x = w[j >> 1]; return __uint_as_float((j & 1) ? (x & 0xffff0000u) : (x << 16)); }
__device__ __forceinline__ bf16x8 pack_f8(const float* v) { v4u w; w.x = pk2(v[0], v[1]); w.y = pk2(v[2], v[3]); w.z = pk2(v[4], v[5]); w.w = pk2(v[6], v[7]); return __builtin_bit_cast(bf16x8, w); }

__device__ __forceinline__ void p2_ret_item(Frame& F, int item) {
    unsigned char* ws = F.ws;
    const int c = item & 15, h = (item >> 4) & 7, b = item >> 7, r0 = b * 2048 + c * 128;
    const int w = F.wave, l15 = F.lane & 15, g = F.lane >> 4;
    LAS bf16* KT = (LAS bf16*)F.lds; LAS bf16* VT = KT + 128 * TP;
    const bf16* Kg = (const bf16*)(ws + WS_K); const bf16* Vg = (const bf16*)(ws + WS_V);
    const float* COS = (const float*)(ws + WS_COS); const float* SIN = (const float*)(ws + WS_SIN);
    const float lg = lg2gamma(h);
    __syncthreads();
#pragma unroll
    for (int i = 0; i < 2; ++i) { const int u = F.tid + 512 * i, m = u & 127, d0 = (u >> 7) * 8;
        const bf16* kp = Kg + (size_t)(r0 + m) * 1024 + h * 128 + d0; const v4u a = *(const v4u*)kp, bb = *(const v4u*)(kp + 64);
        const int pos = c * 128 + m; const f32x4 c0 = *(const f32x4*)(COS + pos * 64 + d0), c1 = *(const f32x4*)(COS + pos * 64 + d0 + 4), s0 = *(const f32x4*)(SIN + pos * 64 + d0), s1 = *(const f32x4*)(SIN + pos * 64 + d0 + 4);
        const float dec = exp2f((float)(127 - m) * lg);
#pragma unroll
        for (int j = 0; j < 8; ++j) { const float x1 = bfe(a, j), x2 = bfe(bb, j), cj = j < 4 ? c0[j & 3] : c1[j & 3], sj = j < 4 ? s0[j & 3] : s1[j & 3];
            KT[(d0 + j) * TP + m] = (bf16)f2bf((x1 * cj - x2 * sj) * dec); KT[(64 + d0 + j) * TP + m] = (bf16)f2bf((x2 * cj + x1 * sj) * dec); } }
#pragma unroll
    for (int i = 0; i < 8; ++i) { const int u = F.tid + 512 * i, m = u & 127, e0 = (u >> 7) * 8;
        const v4u a = *(const v4u*)(Vg + (size_t)(r0 + m) * 2048 + h * 256 + e0);
#pragma unroll
        for (int j = 0; j < 8; ++j) VT[(e0 + j) * TP + m] = (bf16)((a[j >> 1] >> (16 * (j & 1))) & 0xffffu); }
    __syncthreads();
    f32x4 acc[8][2];
#pragma unroll
    for (int dt = 0; dt < 8; ++dt) { acc[dt][0] = (f32x4){0.f, 0.f, 0.f, 0.f}; acc[dt][1] = (f32x4){0.f, 0.f, 0.f, 0.f}; }
#pragma unroll
    for (int ks = 0; ks < 4; ++ks) {
        const bf16x8 b0 = *(const LAS bf16x8*)&VT[(32 * w + l15) * TP + 32 * ks + 8 * g], b1 = *(const LAS bf16x8*)&VT[(32 * w + 16 + l15) * TP + 32 * ks + 8 * g];
#pragma unroll
        for (int dt = 0; dt < 8; ++dt) { const bf16x8 af = *(const LAS bf16x8*)&KT[(16 * dt + l15) * TP + 32 * ks + 8 * g];
            acc[dt][0] = MFMA16(af, b0, acc[dt][0]); acc[dt][1] = MFMA16(af, b1, acc[dt][1]); } }
    float* out = (float*)(ws + WS_KVLOC) + (size_t)item * 256 * 128;
#pragma unroll
    for (int dt = 0; dt < 8; ++dt)
#pragma unroll
        for (int et = 0; et < 2; ++et) *(f32x4*)(out + (32 * w + 16 * et + l15) * 128 + 16 * dt + 4 * g) = acc[dt][et];
}
__device__ __forceinline__ void p2_hg_item(Frame& F, int item) {
    unsigned char* ws = F.ws;
    const int sc = item & 15, h = (item >> 4) & 7, b = item >> 7, r0 = b * 2048 + sc * 128;
    const int w = F.wave, l15 = F.lane & 15, g = F.lane >> 4;
    LAS bf16* KT = (LAS bf16*)F.lds; LAS bf16* VT = KT + 128 * TP; LAS float* LQ = (LAS float*)(VT + 128 * TP);
    const float* Z = (const float*)(ws + WS_LOGF); const bf16* HI = (const bf16*)(ws + WS_HI); const float* LB = (const float*)(ws + WS_LB);
    __syncthreads();
    const int d = F.tid & 127, q = F.tid >> 7; const float oml = 1.0f - LB[h * 128 + d];
    float lf[32], kin[32]; float L = 0.f;
#pragma unroll
    for (int i = 0; i < 32; ++i) { const float z = Z[(size_t)(r0 + 32 * q + i) * 1024 + h * 128 + d]; kin[i] = oml / (1.0f + __expf(z)); lf[i] = log1pf(-kin[i]); L += lf[i]; }
    LQ[q * 128 + d] = L;
#pragma unroll
    for (int i = 0; i < 4; ++i) { const int u = F.tid + 512 * i, m = u & 127, e0 = (u >> 7) * 8;
        const v4u a = *(const v4u*)(HI + (size_t)(r0 + m) * 1024 + h * 128 + e0);
#pragma unroll
        for (int j = 0; j < 8; ++j) VT[(e0 + j) * TP + m] = (bf16)((a[j >> 1] >> (16 * (j & 1))) & 0xffffu); }
    __syncthreads();
    float run = 0.f;
#pragma unroll
    for (int q2 = 1; q2 < 4; ++q2) if (q2 > q) run += LQ[q2 * 128 + d];
#pragma unroll
    for (int blk = 3; blk >= 0; --blk) { float v[8];
#pragma unroll
        for (int jj = 7; jj >= 0; --jj) { const int i = 8 * blk + jj; v[jj] = kin[i] * __expf(run); run += lf[i]; }
        *(LAS bf16x8*)&KT[d * TP + 32 * q + 8 * blk] = pack_f8(v); }
    if (q == 0) ((float*)(ws + WS_BTOT))[item * 128 + d] = run;
    __syncthreads();
    f32x4 acc[8];
#pragma unroll
    for (int dt = 0; dt < 8; ++dt) acc[dt] = (f32x4){0.f, 0.f, 0.f, 0.f};
#pragma unroll
    for (int ks = 0; ks < 4; ++ks) { const bf16x8 b0 = *(const LAS bf16x8*)&VT[(16 * w + l15) * TP + 32 * ks + 8 * g];
#pragma unroll
        for (int dt = 0; dt < 8; ++dt) { const bf16x8 af = *(const LAS bf16x8*)&KT[(16 * dt + l15) * TP + 32 * ks + 8 * g]; acc[dt] = MFMA16(af, b0, acc[dt]); } }
    float* out = (float*)(ws + WS_HSLOC) + (size_t)item * 128 * 128;
#pragma unroll
    for (int dt = 0; dt < 8; ++dt) *(f32x4*)(out + (16 * w + l15) * 128 + 16 * dt + 4 * g) = acc[dt];
}
__device__ __forceinline__ void p2_sret_all(Frame& F, const Args& A) {
    unsigned char* ws = F.ws;
    LAS float* qs = (LAS float*)F.lds; LAS float* ks = qs + 128; LAS float* vs = ks + 128; LAS float* ored = vs + 256;
    const bf16* Q = (const bf16*)(ws + WS_Q); const bf16* K = (const bf16*)(ws + WS_K); const bf16* V = (const bf16*)(ws + WS_V);
    const int e4 = F.tid & 63, dq = F.tid >> 6;
    int it = F.vcu; if (it >= 1024) return;
    f32x4 s[16];
    { const float* Sin = A.in[2] + (size_t)it * 128 * 256;
#pragma unroll
      for (int i = 0; i < 16; ++i) s[i] = *(const f32x4*)(Sin + (size_t)(16 * dq + i) * 256 + 4 * e4); }
    for (; it < 1024; it += F.G) {
        const int h = it & 7, b = it >> 3, r = 8192 + b;
        __syncthreads();
        if (F.tid < 64) { const int d = F.tid; const float cs = ((const float*)(ws + WS_COS))[2048 * 64 + d], sn = ((const float*)(ws + WS_SIN))[2048 * 64 + d];
            const float q1 = bf2f(Q[(size_t)r * 1024 + h * 128 + d]), q2 = bf2f(Q[(size_t)r * 1024 + h * 128 + 64 + d]), k1 = bf2f(K[(size_t)r * 1024 + h * 128 + d]), k2 = bf2f(K[(size_t)r * 1024 + h * 128 + 64 + d]);
            qs[d] = q1 * cs - q2 * sn; qs[d + 64] = q2 * cs + q1 * sn; ks[d] = k1 * cs - k2 * sn; ks[d + 64] = k2 * cs + k1 * sn; }
        else if (F.tid >= 256) { const int e = F.tid - 256; vs[e] = bf2f(V[(size_t)r * 2048 + h * 256 + e]); }
        __syncthreads();
        const float gam = 1.0f - exp2f(-5.0f - (float)h);
        float* Sout = F.out + OUT_SRS + (size_t)it * 128 * 256;
        const f32x4 v4 = *(const LAS f32x4*)&vs[4 * e4]; f32x4 o = (f32x4){0.f, 0.f, 0.f, 0.f};
#pragma unroll
        for (int i = 0; i < 16; ++i) { const int d = 16 * dq + i; s[i] = s[i] * gam + v4 * ks[d]; *(f32x4*)(Sout + (size_t)d * 256 + 4 * e4) = s[i]; o += s[i] * qs[d]; }
        *(LAS f32x4*)&ored[dq * 256 + 4 * e4] = o;
        if (it + F.G < 1024) { const float* Sin = A.in[2] + (size_t)(it + F.G) * 128 * 256;
#pragma unroll
            for (int i = 0; i < 16; ++i) s[i] = *(const f32x4*)(Sin + (size_t)(16 * dq + i) * 256 + 4 * e4); }
        __syncthreads();
        if (F.wave == 0) { float oo[4]; float ss = 0.f;
#pragma unroll
            for (int k = 0; k < 4; ++k) { const int e = F.lane + 64 * k; float t = 0.f;
#pragma unroll
                for (int j = 0; j < 8; ++j) t += ored[j * 256 + e];
                oo[k] = t; ss += t * t; }
            const float rr = 1.0f / sqrtf(wave_sum(ss) * (1.0f / 256.0f) + EPS);
            const bf16* RG = (const bf16*)(ws + WS_RG); bf16* OR = (bf16*)(ws + WS_OR);
#pragma unroll
            for (int k = 0; k < 4; ++k) { const size_t ix = (size_t)r * 2048 + h * 256 + F.lane + 64 * k; OR[ix] = (bf16)f2bf(oo[k] * rr * bf2f(RG[ix])); } }
    }
}
__device__ __forceinline__ void p2_shg_all(Frame& F, const Args& A) {
    unsigned char* ws = F.ws;
    LAS float* qs = (LAS float*)F.lds; LAS float* fs = qs + 128; LAS float* kn = fs + 128; LAS float* vs = kn + 128; LAS float* ored = vs + 128;
    const int e4 = F.tid & 31, dq = F.tid >> 5;
    int it = F.vcu; if (it >= 1024) return;
    f32x4 s[8];
    { const float* Sin = A.in[3] + (size_t)it * 128 * 128;
#pragma unroll
      for (int i = 0; i < 8; ++i) s[i] = *(const f32x4*)(Sin + (size_t)(8 * dq + i) * 128 + 4 * e4); }
    for (; it < 1024; it += F.G) {
        const int h = it & 7, b = it >> 3, r = 8192 + b;
        __syncthreads();
        if (F.tid < 128) { const int d = F.tid; const size_t ix = (size_t)r * 1024 + h * 128 + d; const float z = ((const float*)(ws + WS_LOGF))[ix]; const float lb = ((const float*)(ws + WS_LB))[h * 128 + d];
            const float kin = (1.0f - lb) / (1.0f + __expf(z)); kn[d] = kin; fs[d] = 1.0f - kin; qs[d] = bf2f(((const bf16*)(ws + WS_HQ))[ix]); vs[d] = bf2f(((const bf16*)(ws + WS_HI))[ix]); }
        __syncthreads();
        float* Sout = F.out + OUT_SHS + (size_t)it * 128 * 128;
        const f32x4 v4 = *(const LAS f32x4*)&vs[4 * e4]; f32x4 o = (f32x4){0.f, 0.f, 0.f, 0.f};
#pragma unroll
        for (int i = 0; i < 8; ++i) { const int d = 8 * dq + i; s[i] = s[i] * fs[d] + v4 * kn[d]; *(f32x4*)(Sout + (size_t)d * 128 + 4 * e4) = s[i]; o += s[i] * qs[d]; }
        *(LAS f32x4*)&ored[dq * 128 + 4 * e4] = o;
        if (it + F.G < 1024) { const float* Sin = A.in[3] + (size_t)(it + F.G) * 128 * 128;
#pragma unroll
            for (int i = 0; i < 8; ++i) s[i] = *(const f32x4*)(Sin + (size_t)(8 * dq + i) * 128 + 4 * e4); }
        __syncthreads();
        if (F.wave == 0) { float oo[2]; float ss = 0.f;
#pragma unroll
            for (int k = 0; k < 2; ++k) { const int e = F.lane + 64 * k; float t = 0.f;
#pragma unroll
                for (int j = 0; j < 16; ++j) t += ored[j * 128 + e];
                oo[k] = t; ss += t * t; }
            const float rr = 1.0f / sqrtf(wave_sum(ss) * (1.0f / 128.0f) + EPS);
            const bf16* HG = (const bf16*)(ws + WS_HG); bf16* OH = (bf16*)(ws + WS_OH);
#pragma unroll
            for (int k = 0; k < 2; ++k) { const int e = F.lane + 64 * k; const size_t ix = (size_t)r * 1024 + h * 128 + e; OH[ix] = (bf16)f2bf(oo[k] * rr * A.in[10][e] * bf2f(HG[ix])); } }
    }
}
__device__ __forceinline__ void p2_phase(Frame& F, const Args& A) {
#ifndef PROBE_SUB
#define PROBE_SUB -1
#endif
    for (int rep = 0; rep < (PROBE_SUB == 20 ? 2 : 1); ++rep) for (int it = F.vcu; it < 512; it += F.G) p2_ret_item(F, it);
    for (int rep = 0; rep < (PROBE_SUB == 21 ? 2 : 1); ++rep) for (int it = F.vcu; it < 512; it += F.G) p2_hg_item(F, it);
    for (int rep = 0; rep < (PROBE_SUB == 22 ? 2 : 1); ++rep) p2_sret_all(F, A);
    for (int rep = 0; rep < (PROBE_SUB == 23 ? 2 : 1); ++rep) p2_shg_all(F, A);
}
__device__ __forceinline__ void p3_phase(Frame& F) {
    unsigned char* ws = F.ws;
    LAS float* TR = (LAS float*)F.lds;
    const int el = F.tid >> 5, d4 = F.tid & 31;
    for (int u = F.vcu; u < 32 * 16 + 32 * 8; u += F.G) {
        const bool ret = u < 512; const int uu = ret ? u : u - 512; const int bh = ret ? uu >> 4 : uu >> 3, e = 16 * (ret ? uu & 15 : uu & 7) + el;
        f32x4 S = (f32x4){0.f, 0.f, 0.f, 0.f};
        if (ret) {
            const float cd = exp2f(128.0f * lg2gamma(bh & 7));
            const float* kv = (const float*)(ws + WS_KVLOC) + ((size_t)bh * 16 * 256 + e) * 128 + 4 * d4; bf16* st = (bf16*)(ws + WS_SRT) + ((size_t)bh * 16 * 256 + e) * 128 + 4 * d4;
            f32x4 x[16];
#pragma unroll
            for (int c = 0; c < 16; ++c) x[c] = *(const f32x4*)(kv + (size_t)c * 256 * 128);
#pragma unroll
            for (int c = 0; c < 16; ++c) { v2u p; p.x = pk2(S[0], S[1]); p.y = pk2(S[2], S[3]); *(v2u*)(st + (size_t)c * 256 * 128) = p; S = S * cd + x[c]; }
        } else {
            const float* hs = (const float*)(ws + WS_HSLOC) + ((size_t)bh * 16 * 128 + e) * 128 + 4 * d4; bf16* st = (bf16*)(ws + WS_SHT) + ((size_t)bh * 16 * 128 + e) * 128 + 4 * d4;
            const float* bt = (const float*)(ws + WS_BTOT) + (size_t)bh * 16 * 128 + 4 * d4;
            f32x4 x[16], bb[16];
#pragma unroll
            for (int c = 0; c < 16; ++c) { x[c] = *(const f32x4*)(hs + (size_t)c * 128 * 128); bb[c] = *(const f32x4*)(bt + c * 128); }
#pragma unroll
            for (int c = 0; c < 16; ++c) { v2u p; p.x = pk2(S[0], S[1]); p.y = pk2(S[2], S[3]); *(v2u*)(st + (size_t)c * 128 * 128) = p;
                S[0] = S[0] * __expf(bb[c][0]) + x[c][0]; S[1] = S[1] * __expf(bb[c][1]) + x[c][1]; S[2] = S[2] * __expf(bb[c][2]) + x[c][2]; S[3] = S[3] * __expf(bb[c][3]) + x[c][3]; }
        }
        __syncthreads();
#pragma unroll
        for (int i = 0; i < 4; ++i) TR[(4 * d4 + i) * 17 + el] = S[i];
        __syncthreads();
        { const int d = F.tid >> 2, q = F.tid & 3; const LAS float* t = TR + d * 17 + 4 * q; const f32x4 o = (f32x4){t[0], t[1], t[2], t[3]};
          const int e0 = 16 * (ret ? uu & 15 : uu & 7) + 4 * q;
          float* fo = ret ? F.out + OUT_SRP + ((size_t)bh * 128 + d) * 256 + e0 : F.out + OUT_SHP + ((size_t)bh * 128 + d) * 128 + e0;
          *(f32x4*)fo = o; }
    }
}
__device__ __forceinline__ void p4_ret_item(Frame& F, int item) {
    unsigned char* ws = F.ws;
    const int c = item & 15, h = (item >> 4) & 7, b = item >> 7, r0 = b * 2048 + c * 128;
    const int w = F.wave, l15 = F.lane & 15, g = F.lane >> 4;
    LAS bf16* KS = (LAS bf16*)F.lds; LAS bf16* VT = KS + 128 * TP;
    const bf16* Qg = (const bf16*)(ws + WS_Q); const bf16* Kg = (const bf16*)(ws + WS_K); const bf16* Vg = (const bf16*)(ws + WS_V);
    const float* COS = (const float*)(ws + WS_COS); const float* SIN = (const float*)(ws + WS_SIN);
    const float lg = lg2gamma(h);
    __syncthreads();
#pragma unroll
    for (int i = 0; i < 2; ++i) { const int u = F.tid + 512 * i, d0 = (u & 7) * 8, m = u >> 3;
        const bf16* kp = Kg + (size_t)(r0 + m) * 1024 + h * 128 + d0; const v4u a = *(const v4u*)kp, bb = *(const v4u*)(kp + 64);
        const int pos = c * 128 + m; const f32x4 c0 = *(const f32x4*)(COS + pos * 64 + d0), c1 = *(const f32x4*)(COS + pos * 64 + d0 + 4), s0 = *(const f32x4*)(SIN + pos * 64 + d0), s1 = *(const f32x4*)(SIN + pos * 64 + d0 + 4);
        float o1[8], o2[8];
#pragma unroll
        for (int j = 0; j < 8; ++j) { const float x1 = bfe(a, j), x2 = bfe(bb, j), cj = j < 4 ? c0[j & 3] : c1[j & 3], sj = j < 4 ? s0[j & 3] : s1[j & 3]; o1[j] = x1 * cj - x2 * sj; o2[j] = x2 * cj + x1 * sj; }
        *(LAS bf16x8*)&KS[m * TP + d0] = pack_f8(o1); *(LAS bf16x8*)&KS[m * TP + 64 + d0] = pack_f8(o2); }
#pragma unroll
    for (int i = 0; i < 8; ++i) { const int u = F.tid + 512 * i, m = u & 127, e0 = (u >> 7) * 8;
        const v4u a = *(const v4u*)(Vg + (size_t)(r0 + m) * 2048 + h * 256 + e0);
#pragma unroll
        for (int j = 0; j < 8; ++j) VT[(e0 + j) * TP + m] = (bf16)((a[j >> 1] >> (16 * (j & 1))) & 0xffffu); }
    bf16x8 qf[4];
    { const int n = 16 * w + l15, pos = c * 128 + n; const bf16* qp = Qg + (size_t)(r0 + n) * 1024 + h * 128 + 8 * g;
      const v4u a0 = *(const v4u*)qp, a1 = *(const v4u*)(qp + 32), a2 = *(const v4u*)(qp + 64), a3 = *(const v4u*)(qp + 96);
      float r0v[8], r1v[8], r2v[8], r3v[8];
#pragma unroll
      for (int hlf = 0; hlf < 2; ++hlf) { const int dd = 32 * hlf + 8 * g;
          const f32x4 c0 = *(const f32x4*)(COS + pos * 64 + dd), c1 = *(const f32x4*)(COS + pos * 64 + dd + 4), s0 = *(const f32x4*)(SIN + pos * 64 + dd), s1 = *(const f32x4*)(SIN + pos * 64 + dd + 4);
#pragma unroll
          for (int j = 0; j < 8; ++j) { const float cj = j < 4 ? c0[j & 3] : c1[j & 3], sj = j < 4 ? s0[j & 3] : s1[j & 3];
              const float x1 = hlf == 0 ? bfe(a0, j) : bfe(a1, j), x2 = hlf == 0 ? bfe(a2, j) : bfe(a3, j);
              if (hlf == 0) { r0v[j] = x1 * cj - x2 * sj; r2v[j] = x2 * cj + x1 * sj; } else { r1v[j] = x1 * cj - x2 * sj; r3v[j] = x2 * cj + x1 * sj; } } }
      qf[0] = pack_f8(r0v); qf[1] = pack_f8(r1v); qf[2] = pack_f8(r2v); qf[3] = pack_f8(r3v); }
    __syncthreads();
    f32x4 O[16];
    { const bf16* st = (const bf16*)(ws + WS_SRT) + (size_t)item * 256 * 128 + 8 * g;
#pragma unroll
      for (int et = 0; et < 16; ++et) { f32x4 t = (f32x4){0.f, 0.f, 0.f, 0.f};
#pragma unroll
          for (int ks = 0; ks < 4; ++ks) { const bf16x8 sf = *(const bf16x8*)(st + (size_t)(16 * et + l15) * 128 + 32 * ks); t = MFMA16(qf[ks], sf, t); }
          O[et] = t; }
      float rs[4];
#pragma unroll
      for (int reg = 0; reg < 4; ++reg) rs[reg] = exp2f((float)(16 * w + 4 * g + reg + 1) * lg);
#pragma unroll
      for (int et = 0; et < 16; ++et)
#pragma unroll
          for (int reg = 0; reg < 4; ++reg) O[et][reg] *= rs[reg]; }
    bf16x8 pf[4];
#pragma unroll
    for (int s = 0; s < 4; ++s) { float pv[8];
#pragma unroll
        for (int hf = 0; hf < 2; ++hf) { const int mt = 2 * s + hf; f32x4 dd = (f32x4){0.f, 0.f, 0.f, 0.f};
            if (mt <= w) {
#pragma unroll
                for (int ks = 0; ks < 4; ++ks) { const bf16x8 kf = *(const LAS bf16x8*)&KS[(16 * mt + l15) * TP + 32 * ks + 8 * g]; dd = MFMA16(kf, qf[ks], dd); }
#pragma unroll
                for (int reg = 0; reg < 4; ++reg) { const int m = 16 * mt + 4 * g + reg, n = 16 * w + l15; dd[reg] = n >= m ? dd[reg] * exp2f((float)(n - m) * lg) : 0.f; } }
#pragma unroll
            for (int reg = 0; reg < 4; ++reg) pv[4 * hf + reg] = dd[reg]; }
        pf[s] = pack_f8(pv); }
#pragma unroll
    for (int s = 0; s < 4; ++s) if (2 * s <= w) {
#pragma unroll
        for (int et = 0; et < 16; ++et) { const LAS bf16* vp = &VT[(16 * et + l15) * TP + 32 * s + 4 * g];
            const bf16x4v lo = *(const LAS bf16x4v*)vp, hi = *(const LAS bf16x4v*)(vp + 16);
            const bf16x8 vf = __builtin_shufflevector(lo, hi, 0, 1, 2, 3, 4, 5, 6, 7); O[et] = MFMA16(pf[s], vf, O[et]); } }
    float ss[4] = {0.f, 0.f, 0.f, 0.f};
#pragma unroll
    for (int et = 0; et < 16; ++et)
#pragma unroll
        for (int reg = 0; reg < 4; ++reg) ss[reg] += O[et][reg] * O[et][reg];
#pragma unroll
    for (int reg = 0; reg < 4; ++reg) { float v = ss[reg]; v += __shfl_xor(v, 1); v += __shfl_xor(v, 2); v += __shfl_xor(v, 4); v += __shfl_xor(v, 8); ss[reg] = 1.0f / sqrtf(v * (1.0f / 256.0f) + EPS); }
    const bf16* RG = (const bf16*)(ws + WS_RG); bf16* OR = (bf16*)(ws + WS_OR);
#pragma unroll
    for (int reg = 0; reg < 4; ++reg) { const size_t rb = (size_t)(r0 + 16 * w + 4 * g + reg) * 2048 + h * 256 + l15;
#pragma unroll
        for (int et = 0; et < 16; ++et) OR[rb + 16 * et] = (bf16)f2bf(O[et][reg] * ss[reg] * bf2f(RG[rb + 16 * et])); }
}
__device__ __forceinline__ void p4_hg_item(Frame& F, const Args& A, int item) {
    unsigned char* ws = F.ws;
    const int sc = item & 15, h = (item >> 4) & 7, b = item >> 7, r0 = b * 2048 + sc * 128;
    const int w = F.wave, l15 = F.lane & 15, g = F.lane >> 4;
    LAS bf16* QP = (LAS bf16*)F.lds;
    LAS bf16* KP = QP + 64 * TP;
    LAS bf16* KU = KP + 64 * TP;
    LAS bf16* VT = KU + 128 * 72;
    LAS float* E15 = (LAS float*)(VT + 128 * 72);
    LAS float* OB = E15 + 4 * 128;
    const float* Z = (const float*)(ws + WS_LOGF); const bf16* HQ = (const bf16*)(ws + WS_HQ); const bf16* HI = (const bf16*)(ws + WS_HI); const float* LB = (const float*)(ws + WS_LB);
    f32x4 S[8];
    { const bf16* st = (const bf16*)(ws + WS_SHT) + (size_t)item * 128 * 128 + (size_t)(16 * w + l15) * 128 + 4 * g;
#pragma unroll
      for (int dt = 0; dt < 8; ++dt) { const v2u p = *(const v2u*)(st + 16 * dt); S[dt][0] = __uint_as_float(p.x << 16); S[dt][1] = __uint_as_float(p.x & 0xffff0000u); S[dt][2] = __uint_as_float(p.y << 16); S[dt][3] = __uint_as_float(p.y & 0xffff0000u); } }
    for (int hf = 0; hf < 2; ++hf) {
        const int rh = r0 + 64 * hf;
        __syncthreads();
        { const int d = F.tid & 127, sq = F.tid >> 7; const float oml = 1.0f - LB[h * 128 + d];
          float kin[16], bcum[16]; float bb = 0.f;
#pragma unroll
          for (int t = 0; t < 16; ++t) { const size_t ix = (size_t)(rh + 16 * sq + t) * 1024 + h * 128 + d; const float z = Z[ix]; const float q = bf2f(HQ[ix]);
              kin[t] = oml / (1.0f + __expf(z)); bb += log1pf(-kin[t]); bcum[t] = bb;
              QP[(16 * sq + t) * TP + d] = (bf16)f2bf(q * __expf(bb)); KP[(16 * sq + t) * TP + d] = (bf16)f2bf(kin[t] * __expf(fminf(-bb, 80.0f))); }
          E15[sq * 128 + d] = __expf(bb);
          float v[8];
#pragma unroll
          for (int t = 0; t < 8; ++t) v[t] = kin[t] * __expf(bb - bcum[t]);
          *(LAS bf16x8*)&KU[d * 72 + 16 * sq] = pack_f8(v);
#pragma unroll
          for (int t = 0; t < 8; ++t) v[t] = kin[8 + t] * __expf(bb - bcum[8 + t]);
          *(LAS bf16x8*)&KU[d * 72 + 16 * sq + 8] = pack_f8(v); }
#pragma unroll
        for (int i = 0; i < 2; ++i) { const int u = F.tid + 512 * i, m = u & 63, e0 = (u >> 6) * 8;
            const v4u a = *(const v4u*)(HI + (size_t)(rh + m) * 1024 + h * 128 + e0);
#pragma unroll
            for (int j = 0; j < 8; ++j) VT[(e0 + j) * 72 + m] = (bf16)((a[j >> 1] >> (16 * (j & 1))) & 0xffffu); }
        __syncthreads();
        const bf16x8 zero8 = (bf16x8){0, 0, 0, 0, 0, 0, 0, 0};
#pragma unroll
        for (int sq = 0; sq < 4; ++sq) {
            f32x4 at = (f32x4){0.f, 0.f, 0.f, 0.f};
#pragma unroll
            for (int ks = 0; ks < 4; ++ks) { const bf16x8 kf = *(const LAS bf16x8*)&KP[(16 * sq + l15) * TP + 32 * ks + 8 * g], qf = *(const LAS bf16x8*)&QP[(16 * sq + l15) * TP + 32 * ks + 8 * g]; at = MFMA16(kf, qf, at); }
            float pv[8];
#pragma unroll
            for (int reg = 0; reg < 4; ++reg) { pv[reg] = (4 * g + reg) <= l15 ? at[reg] : 0.f; pv[4 + reg] = 0.f; }
            const bf16x8 pfr = pack_f8(pv);
            f32x4 o;
            { const bf16x4v lo = *(const LAS bf16x4v*)&VT[(16 * w + l15) * 72 + 16 * sq + 4 * g]; const bf16x8 vf = __builtin_shufflevector(lo, (bf16x4v){0, 0, 0, 0}, 0, 1, 2, 3, 4, 5, 6, 7);
              const f32x4 z4 = {0.f, 0.f, 0.f, 0.f}; o = MFMA16(pfr, vf, z4); }
#pragma unroll
            for (int ks = 0; ks < 4; ++ks) { float sv[8];
#pragma unroll
                for (int jj = 0; jj < 8; ++jj) sv[jj] = S[2 * ks + (jj >> 2)][jj & 3];
                const bf16x8 sf = pack_f8(sv);
                const LAS bf16* qp = &QP[(16 * sq + l15) * TP + 32 * ks + 4 * g]; const bf16x4v lo = *(const LAS bf16x4v*)qp, hi = *(const LAS bf16x4v*)(qp + 16);
                const bf16x8 qf = __builtin_shufflevector(lo, hi, 0, 1, 2, 3, 4, 5, 6, 7); o = MFMA16(qf, sf, o); }
#pragma unroll
            for (int reg = 0; reg < 4; ++reg) OB[(16 * sq + 4 * g + reg) * 132 + 16 * w + l15] = o[reg];
            const bf16x8 vu = g < 2 ? *(const LAS bf16x8*)&VT[(16 * w + l15) * 72 + 16 * sq + 8 * g] : zero8;
#pragma unroll
            for (int dt = 0; dt < 8; ++dt) { const f32x4 ed = *(const LAS f32x4*)&E15[sq * 128 + 16 * dt + 4 * g];
                const bf16x8 kf = g < 2 ? *(const LAS bf16x8*)&KU[(16 * dt + l15) * 72 + 16 * sq + 8 * g] : zero8;
                S[dt] = MFMA16(kf, vu, S[dt] * ed); }
        }
        __syncthreads();
        { const bf16* HG = (const bf16*)(ws + WS_HG); bf16* OH = (bf16*)(ws + WS_OH);
#pragma unroll
          for (int i = 0; i < 8; ++i) { const int t = 8 * w + i; const float v0 = OB[t * 132 + F.lane], v1 = OB[t * 132 + 64 + F.lane];
              const float rr = 1.0f / sqrtf(wave_sum(v0 * v0 + v1 * v1) * (1.0f / 128.0f) + EPS); const size_t ix = (size_t)(rh + t) * 1024 + h * 128 + F.lane;
              OH[ix] = (bf16)f2bf(v0 * rr * A.in[10][F.lane] * bf2f(HG[ix])); OH[ix + 64] = (bf16)f2bf(v1 * rr * A.in[10][64 + F.lane] * bf2f(HG[ix + 64])); } }
    }
}
__device__ __forceinline__ void p4_phase(Frame& F, const Args& A) {
    for (int rep = 0; rep < (PROBE_SUB == 40 ? 2 : 1); ++rep) for (int it = F.vcu; it < 512; it += F.G) p4_ret_item(F, it);
    for (int rep = 0; rep < (PROBE_SUB == 41 ? 2 : 1); ++rep) for (int it = F.vcu; it < 512; it += F.G) p4_hg_item(F, A, it);
}
namespace mini {
using pg8::bf16_t; using pg8::u32x2; using pg8::silu4; using pg8::sigm4; using pg8::pack4; using pg8::unpack4;
constexpr int AP = 136;
template <bool TWO> __device__ __forceinline__ void core(Frame& F, const bf16_t* A, int lda, int K, const bf16_t* bp0, const bf16_t* bp1, f32x4 (&acc0)[8], f32x4 (&acc1)[8]) {
    LAS bf16* AS = (LAS bf16*)F.lds; const int l15 = F.lane & 15, g = F.lane >> 4; const int nch = K >> 7; int cc = F.vcu % nch;
    v4u pre[4]; bf16x8 b0[4], b1[4];
    const int prow = F.tid >> 4, pc = (F.tid & 15) * 8;
#pragma unroll
    for (int i = 0; i < 4; ++i) pre[i] = *(const v4u*)(A + (size_t)(prow + 32 * i) * lda + cc * 128 + pc);
    if (bp0) {
#pragma unroll
        for (int u = 0; u < 4; ++u) { b0[u] = *(const bf16x8*)(bp0 + cc * 128 + 32 * u); if (TWO) b1[u] = *(const bf16x8*)(bp1 + cc * 128 + 32 * u); } }
    __syncthreads();
    for (int c = 0; c < nch; ++c) {
        LAS bf16* buf = AS + (c & 1) * (128 * AP);
#pragma unroll
        for (int i = 0; i < 4; ++i) *(LAS v4u*)&buf[(prow + 32 * i) * AP + pc] = pre[i];
        bf16x8 c0[4], c1[4];
#pragma unroll
        for (int u = 0; u < 4; ++u) { c0[u] = b0[u]; if (TWO) c1[u] = b1[u]; }
        cc = cc + 1 == nch ? 0 : cc + 1;
        if (c + 1 < nch) {
#pragma unroll
            for (int i = 0; i < 4; ++i) pre[i] = *(const v4u*)(A + (size_t)(prow + 32 * i) * lda + cc * 128 + pc);
            if (bp0) {
#pragma unroll
                for (int u = 0; u < 4; ++u) { b0[u] = *(const bf16x8*)(bp0 + cc * 128 + 32 * u); if (TWO) b1[u] = *(const bf16x8*)(bp1 + cc * 128 + 32 * u); } } }
        __syncthreads();
        if (bp0) {
#pragma unroll
            for (int u = 0; u < 4; ++u)
#pragma unroll
                for (int rt = 0; rt < 8; ++rt) { const bf16x8 a = *(const LAS bf16x8*)&buf[(16 * rt + l15) * AP + 32 * u + 8 * g];
                    acc0[rt] = __builtin_amdgcn_mfma_f32_16x16x32_bf16(c0[u], a, acc0[rt], 0, 0, 0); if (TWO) acc1[rt] = __builtin_amdgcn_mfma_f32_16x16x32_bf16(c1[u], a, acc1[rt], 0, 0, 0); } }
    }
}
#define MINI_ZERO(acc) _Pragma("unroll") for (int _i = 0; _i < 8; ++_i) acc[_i] = (f32x4){0.f, 0.f, 0.f, 0.f}
__device__ __forceinline__ void inproj(Frame& F) {
    unsigned char* ws = F.ws; const int l15 = F.lane & 15, g = F.lane >> 4;
    if (F.vcu >= NIN / 16) return;
    const int t = F.vcu + F.G * F.wave; const bool has = t < NIN / 16; const int n0 = 16 * t;
    f32x4 acc[8]; MINI_ZERO(acc);
    core<false>(F, (const bf16_t*)(ws + WS_XB) + 8192ull * 2048, 2048, 2048, has ? (const bf16_t*)(ws + WS_WIN) + (size_t)(n0 + l15) * 2048 + 8 * g : nullptr, nullptr, acc, acc);
    if (!has) return;
    const int c = n0 + 4 * g;
    if (c >= 7168 && c < 8192) {
#pragma unroll
        for (int rt = 0; rt < 8; ++rt) *(f32x4*)((float*)(ws + WS_LOGF) + (size_t)(8192 + 16 * rt + l15) * 1024 + (c - 7168)) = acc[rt];
        return; }
    size_t od; int pitch, c0, act; float sc = 1.0f;
    if (c < 1024) { od = WS_Q; pitch = 1024; c0 = 0; act = 0; } else if (c < 2048) { od = WS_K; pitch = 1024; c0 = 1024; act = 0; sc = 0.08838834764831845f; }
    else if (c < 4096) { od = WS_V; pitch = 2048; c0 = 2048; act = 0; } else if (c < 6144) { od = WS_RG; pitch = 2048; c0 = 4096; act = 1; } else if (c < 7168) { od = WS_HQ; pitch = 1024; c0 = 6144; act = 1; }
    else if (c < 9216) { od = WS_HI; pitch = 1024; c0 = 8192; act = 0; } else if (c < 10240) { od = WS_HG; pitch = 1024; c0 = 9216; act = 1; } else if (c < 12288) { od = WS_GA; pitch = 2048; c0 = 10240; act = 2; } else { od = WS_GB; pitch = 2048; c0 = 12288; act = 2; }
#pragma unroll
    for (int rt = 0; rt < 8; ++rt) { f32x4 v = acc[rt] * sc; if (act == 1) v = silu4(v); else if (act == 2) v = sigm4(v);
        *(u32x2*)((bf16_t*)(ws + od) + (size_t)(8192 + 16 * rt + l15) * pitch + (c - c0)) = pack4(v); }
}
__device__ __forceinline__ void outproj(Frame& F) {
    unsigned char* ws = F.ws; const int l15 = F.lane & 15, g = F.lane >> 4;
    if (F.vcu >= 128) return;
    const int t = F.vcu + F.G * F.wave; const bool has = t < 128; const int n0 = 16 * t;
    f32x4 ya[8], yb[8]; MINI_ZERO(ya); MINI_ZERO(yb);
    core<false>(F, (const bf16_t*)(ws + WS_OR) + 8192ull * 2048, 2048, 2048, has ? (const bf16_t*)(ws + WS_WRO) + (size_t)(n0 + l15) * 2048 + 8 * g : nullptr, nullptr, ya, ya);
    core<false>(F, (const bf16_t*)(ws + WS_OH) + 8192ull * 1024, 1024, 1024, has ? (const bf16_t*)(ws + WS_WHO) + (size_t)(n0 + l15) * 1024 + 8 * g : nullptr, nullptr, yb, yb);
    if (!has) return;
#pragma unroll
    for (int rt = 0; rt < 8; ++rt) { const size_t ix = (size_t)(8192 + 16 * rt + l15) * 2048 + n0 + 4 * g;
        const f32x4 ga = unpack4(*(const u32x2*)((const bf16_t*)(ws + WS_GA) + ix)), gb = unpack4(*(const u32x2*)((const bf16_t*)(ws + WS_GB) + ix));
        *(u32x2*)((bf16_t*)(ws + WS_MG) + ix) = pack4(ga * ya[rt] + gb * yb[rt]); }
}
__device__ __forceinline__ void resid(Frame& F, const bf16_t* Arows  , const bf16_t* Bt, int K, const float* XI  , float* XO  , bf16_t* XBo  , float* SS  ) {
    const int l15 = F.lane & 15, g = F.lane >> 4;
    if (F.vcu >= 128) return;
    const int t = F.vcu + F.G * F.wave; const bool has = t < 128; const int n0 = 16 * t;
    f32x4 acc[8]; MINI_ZERO(acc);
    core<false>(F, Arows, K, K, has ? Bt + (size_t)(n0 + l15) * K + 8 * g : nullptr, nullptr, acc, acc);
    if (!has) return;
#pragma unroll
    for (int rt = 0; rt < 8; ++rt) { const int rl = 16 * rt + l15; const size_t ix = (size_t)rl * 2048 + n0 + 4 * g;
        f32x4 v = acc[rt] + *(const f32x4*)(XI + ix); *(f32x4*)(XO + ix) = v;
        if (XBo) *(u32x2*)(XBo + ix) = pack4(v);
        float ss = (v[0] * v[0] + v[1] * v[1]) + (v[2] * v[2] + v[3] * v[3]); ss += __shfl_xor(ss, 16); ss += __shfl_xor(ss, 32);
        if (g == 0) atomicAdd(SS + rl, ss); }
}
__device__ __forceinline__ void swiglu(Frame& F) {
    unsigned char* ws = F.ws; const int l15 = F.lane & 15, g = F.lane >> 4;
    const int t = F.vcu + F.G * F.wave; const bool has = t < DFF / 16; const int ng = ((16 * t) >> 7) * 256 + ((16 * t) & 127);
    f32x4 ag[8], au[8]; MINI_ZERO(ag); MINI_ZERO(au);
    const bf16_t* A = (const bf16_t*)(ws + WS_X1B) + 8192ull * 2048;
    const bf16_t* bg = has ? (const bf16_t*)(ws + WS_WFI) + (size_t)(ng + l15) * 2048 + 8 * g : nullptr;
    core<true>(F, A, 2048, 2048, bg, has ? bg + 128 * 2048 : nullptr, ag, au);
    if (!has) return;
    const float* SS1 = (const float*)(F.ctl + CW_SS1);
#pragma unroll
    for (int rt = 0; rt < 8; ++rt) { const int r = 8192 + 16 * rt + l15; const float r2 = 1.0f / sqrtf(SS1[r] * (1.0f / 2048.0f) + EPS);
        *(u32x2*)((bf16_t*)(ws + WS_ACT) + (size_t)r * DFF + 16 * t + 4 * g) = pack4(silu4(ag[rt] * r2) * (au[rt] * r2)); }
}
}
__global__ void __launch_bounds__(NWAVES * 64, 2) mk_fwd(Args args) {
    extern __shared__ __attribute__((aligned(16))) unsigned char lds[];
    Frame F;
    F.lds = (LAS unsigned char*)lds; F.MISC = (volatile LAS unsigned*)(F.lds + MISC_OFF);
    F.tid = threadIdx.x; F.lane = F.tid & 63; F.wave = __builtin_amdgcn_readfirstlane(F.tid >> 6);
    F.G = gridDim.x; { const int bx = blockIdx.x; F.vcu = (F.G % 8 == 0) ? (bx % 8) * (F.G / 8) + bx / 8 : bx; }
    F.ws = args.ws; F.out = args.out; F.ctl = (gu32*)(args.ws + WS_CTL);
    for (int u = F.tid; u < (LDS_BYTES - LDSCTL_OFF) / 4; u += NWAVES * 64) ((LAS unsigned*)(F.lds + LDSCTL_OFF))[u] = 0u;
    __syncthreads();
    XcdBarrier bar; bar.bar = (unsigned*)(F.ctl + CW_BAR); bar.x = 0; bar.st = nullptr;
    if (args.use_bar) bar = xcd_barrier_post((unsigned*)(F.ctl + CW_BAR), F.MISC + 8);
    const int lo = args.ph_lo, hi = args.ph_hi;
#define IN(k) (lo <= (k) && (k) < hi)
#define SEAM(k) do { if (IN(k) && IN((k) + 1)) xcd_barrier(bar); } while (0)
#ifndef PROBE_REPEAT
#define PROBE_REPEAT -1
#endif
#define NREP(k) ((PROBE_REPEAT == (k)) ? 2 : 1)
    unsigned char* ws = args.ws;
    if (PROBE_REPEAT == 0) { p0_prologue(F, args); xcd_barrier(bar); }
    if (IN(0)) { p0_prologue(F, args); } SEAM(0);
#define P1_BODY { \
        pg8::Gemm g{(const pg8::bf16_t*)(ws + WS_XB), (const pg8::bf16_t*)(ws + WS_WIN), 8192, NIN, 2048}; pg8::StaticOrder S; S.init(8192, NIN, F.G, (int)blockIdx.x); \
        pg8::EpiInProj E{ws}; \
        pg8::gemm_phase<pg8::EpiInProj, pg8::StaticOrder, true, true>(F.lds, g, S, E); mini::inproj(F); }
    if (PROBE_REPEAT == 1) { P1_BODY xcd_barrier(bar); }
    if (IN(1)) P1_BODY SEAM(1);
    if (PROBE_REPEAT == 2) { p2_phase(F, args); xcd_barrier(bar); }
    if (IN(2)) { p2_phase(F, args); } SEAM(2);
    if (PROBE_REPEAT == 3) { p3_phase(F); xcd_barrier(bar); }
    if (IN(3)) { p3_phase(F); } SEAM(3);
    if (PROBE_REPEAT == 4) { p4_phase(F, args); xcd_barrier(bar); }
    if (IN(4)) { p4_phase(F, args); } SEAM(4);
    if (IN(5)) {
        { pg8::Gemm g{(const pg8::bf16_t*)(ws + WS_OR), (const pg8::bf16_t*)(ws + WS_WRO), 8192, 2048, 2048}; pg8::StaticOrder S; S.init(8192, 2048, F.G, (int)blockIdx.x);
          pg8::EpiGate<0> E{(const pg8::bf16_t*)(ws + WS_GA), (float*)(ws + WS_YT), (pg8::bf16_t*)(ws + WS_MG)};
          pg8::gemm_phase<pg8::EpiGate<0>, pg8::StaticOrder, true, true>(F.lds, g, S, E); }
        { pg8::Gemm g{(const pg8::bf16_t*)(ws + WS_OH), (const pg8::bf16_t*)(ws + WS_WHO), 8192, 2048, 1024}; pg8::StaticOrder S; S.init(8192, 2048, F.G, (int)blockIdx.x);
          pg8::EpiGate<1> E{(const pg8::bf16_t*)(ws + WS_GB), (float*)(ws + WS_YT), (pg8::bf16_t*)(ws + WS_MG)};
          pg8::gemm_phase<pg8::EpiGate<1>, pg8::StaticOrder, true, true>(F.lds, g, S, E); }
        mini::outproj(F);
    } SEAM(5);
    if (IN(6)) {
        pg8::Gemm g{(const pg8::bf16_t*)(ws + WS_MG), (const pg8::bf16_t*)(ws + WS_WOUT), 8192, 2048, 2048}; pg8::StaticOrder S; S.init(8192, 2048, F.G, (int)blockIdx.x);
        pg8::EpiResid E{args.in[0], args.in[1], args.out, (pg8::bf16_t*)(ws + WS_X1B), (float*)(F.ctl + CW_SS1)};
        pg8::gemm_phase<pg8::EpiResid, pg8::StaticOrder, true, true>(F.lds, g, S, E);
        mini::resid(F, (const pg8::bf16_t*)(ws + WS_MG) + 8192ull * 2048, (const pg8::bf16_t*)(ws + WS_WOUT), 2048, args.in[1], args.out + OUT_YS, (pg8::bf16_t*)(ws + WS_X1B) + 8192ull * 2048, (float*)(F.ctl + CW_SS1) + 8192);
    } SEAM(6);
    if (IN(7)) {
        pg8::Gemm g{(const pg8::bf16_t*)(ws + WS_X1B), (const pg8::bf16_t*)(ws + WS_WFI), 8192, 2 * DFF, 2048}; pg8::StaticOrder S; S.init(8192, 2 * DFF, F.G, (int)blockIdx.x);
        pg8::EpiSwiglu E{(const float*)(F.ctl + CW_SS1), (pg8::bf16_t*)(ws + WS_ACT)};
        pg8::gemm_phase<pg8::EpiSwiglu, pg8::StaticOrder, true, true>(F.lds, g, S, E);
        mini::swiglu(F);
    } SEAM(7);
    if (IN(8)) {
        pg8::Gemm g{(const pg8::bf16_t*)(ws + WS_ACT), (const pg8::bf16_t*)(ws + WS_WFO), 8192, 2048, DFF}; pg8::StaticOrder S; S.init(8192, 2048, F.G, (int)blockIdx.x);
        pg8::EpiResid E{args.out, args.out + OUT_YS, args.out, nullptr, (float*)(F.ctl + CW_SS2)};
        pg8::gemm_phase<pg8::EpiResid, pg8::StaticOrder, true, true>(F.lds, g, S, E);
        mini::resid(F, (const pg8::bf16_t*)(ws + WS_ACT) + 8192ull * DFF, (const pg8::bf16_t*)(ws + WS_WFO), DFF, args.out + OUT_YS, args.out + OUT_YS, nullptr, (float*)(F.ctl + CW_SS2) + 8192);
    } SEAM(8);
    if (IN(9)) {
        const int gw = F.vcu * NWAVES + F.wave, NGW = F.G * NWAVES; const float* SS2 = (const float*)(F.ctl + CW_SS2);
        for (int m = gw; m < MROWS; m += NGW) { f32x4* xr = (f32x4*)(args.out + (size_t)m * 2048) + F.lane; const f32x4* gn = (const f32x4*)args.in[14] + F.lane;
            const float rr = 1.0f / sqrtf(SS2[m] * (1.0f / 2048.0f) + EPS);
#pragma unroll
            for (int j = 0; j < 8; ++j) xr[64 * j] = xr[64 * j] * rr * gn[64 * j]; }
    }
#undef IN
#undef SEAM
}
extern "C" void kernel_launch(void* const* d_in, const int* in_sizes, int n_in, void* d_out, int out_size, void* d_ws, size_t ws_size, hipStream_t stream) {
    static int grid = 0;
    if (grid == 0) {
        int dev = 0, cus = 0;
        if (ws_size < WS_END || n_in != 15) { fprintf(stderr, "kernel_launch: unexpected sizes (ws %zu, n_in %d)\n", ws_size, n_in); grid = -1; return; }
        if (hipGetDevice(&dev) != hipSuccess || hipDeviceGetAttribute(&cus, hipDeviceAttributeMultiprocessorCount, dev) != hipSuccess) { grid = -1; return; }
        if (hipFuncSetAttribute((const void*)mk_fwd, hipFuncAttributeMaxDynamicSharedMemorySize, LDS_BYTES) != hipSuccess) { fprintf(stderr, "kernel_launch: hipFuncSetAttribute failed\n"); grid = -1; return; }
        int per_cu = 0; (void)hipOccupancyMaxActiveBlocksPerMultiprocessor(&per_cu, (const void*)mk_fwd, NWAVES * 64, LDS_BYTES); (void)hipGetLastError();
        if (per_cu < 1) { fprintf(stderr, "kernel_launch: occupancy query says %d blocks per CU; nothing launched\n", per_cu); grid = -1; return; }
        grid = cus;
    }
    if (grid < 0) return;
    (void)hipMemsetAsync((char*)d_ws + WS_CTL, 0, CTL_ZERO_BYTES, stream);
    Args a{};
    for (int i = 0; i < 15; ++i) a.in[i] = (const float*)d_in[i];
    a.out = (float*)d_out; a.ws = (unsigned char*)d_ws; a.use_bar = 1; a.ph_lo = 0; a.ph_hi = 10;
    hipLaunchKernelGGL(mk_fwd, dim3(grid), dim3(NWAVES * 64), LDS_BYTES, stream, a);
}
```

```cpp
#include <hip/hip_runtime.h>
#include <cstdio>
#include <cstdint>
constexpr int DMODEL = 2048, MROWS = 8320, MPAD = 8448, NIN = 14336, DFF = 5632, NWAVES = 8;
constexpr float EPS = 1e-6f;
constexpr size_t MiB = 1u << 20;
constexpr size_t WS_CTL = 0, CTL_ZERO_BYTES = 1 * MiB;
constexpr size_t WS_WRO = 1 * MiB, WS_WHO = 9 * MiB, WS_WOUT = 13 * MiB, WS_WFI = 21 * MiB, WS_WFO = 65 * MiB, WS_WIN = 87 * MiB;
constexpr size_t WS_XB = 143 * MiB;
constexpr size_t WS_Q = 176 * MiB, WS_K = WS_Q + 8448ull * 1024 * 2, WS_V = 209 * MiB, WS_RG = 242 * MiB, WS_HQ = 275 * MiB, WS_LOGF = WS_HQ + 8448ull * 1024 * 2;
constexpr size_t WS_HI = WS_LOGF + 8448ull * 1024 * 4, WS_HG = WS_HI + 8448ull * 1024 * 2, WS_GA = WS_HG + 8448ull * 1024 * 2, WS_GB = WS_GA + 8448ull * 2048 * 2;
constexpr size_t WS_KVLOC = WS_GB + 8448ull * 2048 * 2;
constexpr size_t WS_HSLOC = WS_KVLOC + 64 * MiB;
constexpr size_t WS_OH = WS_HSLOC + 32 * MiB;
constexpr size_t WS_MISC = WS_OH + 8448ull * 1024 * 2;
constexpr size_t WS_RR1 = WS_MISC, WS_COS = WS_RR1 + 64 * 1024, WS_SIN = WS_COS + 2049 * 64 * 4 + 256, WS_LB = WS_SIN + 2049 * 64 * 4 + 256, WS_BTOT = WS_LB + 4096, WS_END = WS_BTOT + 512 * 128 * 4;
constexpr size_t WS_OR = WS_XB;
constexpr size_t WS_SRT = WS_WIN, WS_SHT = WS_WIN + 32 * MiB;
constexpr size_t WS_YT = WS_KVLOC;
constexpr size_t WS_MG = WS_Q;
constexpr size_t WS_X1B = WS_V;
constexpr size_t WS_ACT = WS_RG;
static_assert(WS_GB + 8448ull * 2048 * 2 == WS_KVLOC && WS_K + 8448ull * 1024 * 2 == WS_V && WS_V + 8448ull * 2048 * 2 == WS_RG && WS_RG + 8448ull * 2048 * 2 == WS_HQ, "map");
static_assert(WS_YT + 8448ull * 2048 * 4 <= WS_OH && WS_ACT + 8448ull * 5632 * 2 <= WS_GA && WS_END <= 541 * MiB, "map2");
constexpr int CW_BAR = 4096;
constexpr int CW_SS1 = 16384, CW_SS2 = 16384 + 8448;
static_assert((CW_SS2 + 8448) * 4 <= (int)CTL_ZERO_BYTES, "ctl");
constexpr int RING_BYTES = 131072, LDSCTL_OFF = RING_BYTES, MISC_OFF = LDSCTL_OFF + 320, LDS_BYTES = 147456;

#define GAS __attribute__((address_space(1)))
#define LAS __attribute__((address_space(3)))
typedef unsigned short bf16;
typedef unsigned v4u __attribute__((ext_vector_type(4)));
typedef unsigned v2u __attribute__((ext_vector_type(2)));
typedef float f32x4 __attribute__((ext_vector_type(4)));
typedef short bf16x8 __attribute__((ext_vector_type(8)));
typedef GAS unsigned gu32;
#define RLX_AGENT __ATOMIC_RELAXED, __HIP_MEMORY_SCOPE_AGENT
#define LDS_WAIT() asm volatile("s_waitcnt lgkmcnt(0)" ::: "memory")
#define VM_WAIT() asm volatile("s_waitcnt vmcnt(0)" ::: "memory")
__device__ __forceinline__ unsigned f2bf(float f) { unsigned u = __builtin_bit_cast(unsigned, f); return (u + 0x7fffu + ((u >> 16) & 1u)) >> 16; }
__device__ __forceinline__ unsigned pk2(float lo, float hi) { return f2bf(lo) | (f2bf(hi) << 16); }
__device__ __forceinline__ float bf2f(unsigned short b) { return __uint_as_float(((unsigned)b) << 16); }
namespace pg8 {
#define PG8_LAS __attribute__((address_space(3)))
typedef unsigned short bf16_t;
typedef short bf16x8 __attribute__((ext_vector_type(8)));
typedef float f32x4 __attribute__((ext_vector_type(4)));
typedef unsigned u32x4 __attribute__((ext_vector_type(4)));
constexpr int BM = 256, BK = 64, HALF = 128, HTB = HALF * BK * 2  , STAGE_BYTES = 8 * HTB, NXCD = 8, WGM = 8;

__host__ __device__ __forceinline__ int lds_byte(int r, int c) { const int st = (r >> 4) * 2 + (c >> 5), rr = r & 15, cc = c & 31, ob = rr * 64 + cc * 2; return st * 1024 + (ob ^ (((ob >> 9) & 1) << 5)); }
__host__ __device__ __forceinline__ void stage_rc(int b, int& R, int& C) { const int st = b / 1024, sb = b % 1024, swz = sb ^ (((sb >> 9) & 1) << 5); R = (st >> 1) * 16 + swz / 64; C = (st & 1) * 32 + (swz % 64) / 2; }
__host__ __device__ __forceinline__ int perm32(int rho) { const int n = rho >> 4, i = rho & 15; return 8 * (i >> 2) + 4 * n + (i & 3); }

struct Unit { int pm, pn; };
struct Gemm { const bf16_t* A; const bf16_t* Bt; int M, N, K; };

struct StaticOrder {
    int nM, nN, nwg, G, c;
    __host__ __device__ void init(int M, int N, int G_, int c_) { nM = M / BM; nN = N / BM; nwg = nM * nN; G = G_; c = c_; }
    __host__ __device__ bool next(int i, Unit& u) const {
        const long L = (long)i * G + c; if (L >= nwg) return false;
        int wgid = (int)L; { const int q = nwg / NXCD, r = nwg % NXCD, xcd = wgid % NXCD, off = wgid / NXCD; wgid = (xcd < r ? xcd * (q + 1) : r * (q + 1) + (xcd - r) * q) + off; }
        const int nig = WGM * nN, gid = wgid / nig, fm = gid * WGM, gsz = (nM - fm) < WGM ? (nM - fm) : WGM;
        u.pm = fm + ((wgid % nig) % gsz); u.pn = (wgid % nig) / gsz; return true;
    }
    __device__ __forceinline__ void a_ready(const Unit&) const {}
    __device__ __forceinline__ void done(const Unit&) const {}
};

__device__ __forceinline__ unsigned cvt_pk_bf16(float lo, float hi) { unsigned r; asm volatile("v_cvt_pk_bf16_f32 %0, %1, %2" : "=v"(r) : "v"(lo), "v"(hi)); return r; }
typedef float f32x2 __attribute__((ext_vector_type(2)));
typedef unsigned u32x2 __attribute__((ext_vector_type(2)));
__device__ __forceinline__ float sigm(float x) { return __builtin_amdgcn_rcpf(1.0f + __expf(-x)); }
__device__ __forceinline__ f32x4 silu4(f32x4 v) { f32x4 o; o[0] = v[0] * sigm(v[0]); o[1] = v[1] * sigm(v[1]); o[2] = v[2] * sigm(v[2]); o[3] = v[3] * sigm(v[3]); return o; }
__device__ __forceinline__ f32x4 sigm4(f32x4 v) { f32x4 o; o[0] = sigm(v[0]); o[1] = sigm(v[1]); o[2] = sigm(v[2]); o[3] = sigm(v[3]); return o; }
__device__ __forceinline__ u32x4 pack8(f32x4 v0, f32x4 v1) { u32x4 w; w.x = cvt_pk_bf16(v0[0], v0[1]); w.y = cvt_pk_bf16(v0[2], v0[3]); w.z = cvt_pk_bf16(v1[0], v1[1]); w.w = cvt_pk_bf16(v1[2], v1[3]); return w; }
__device__ __forceinline__ u32x2 pack4(f32x4 v) { u32x2 w; w.x = cvt_pk_bf16(v[0], v[1]); w.y = cvt_pk_bf16(v[2], v[3]); return w; }
__device__ __forceinline__ f32x4 unpack4(u32x2 w) { f32x4 o; o[0] = __uint_as_float(w.x << 16); o[1] = __uint_as_float(w.x & 0xffff0000u); o[2] = __uint_as_float(w.y << 16); o[3] = __uint_as_float(w.y & 0xffff0000u); return o; }

struct EpiInProj {
    static constexpr bool PERM = true, AFTER_DRAIN = false;
    unsigned char* ws;
    __device__ __forceinline__ void operator()(const f32x4 (&acc)[2][2][4][2], const Unit& u, int wr, int wc, int fr, int fq) const {
        const int pn = u.pn, row0 = u.pm * BM + wr * 64 + fr;
        if (pn >= 28 && pn < 32) {
            float* Z = (float*)(ws + WS_LOGF); const int cs = (pn - 28) * 256 + wc * 32 + 8 * fq;
#pragma unroll
            for (int ai = 0; ai < 2; ++ai)
#pragma unroll
                for (int m = 0; m < 4; ++m) { const int r = row0 + ai * HALF + m * 16;
#pragma unroll
                    for (int bj = 0; bj < 2; ++bj)
#pragma unroll
                        for (int n = 0; n < 2; ++n) *(f32x4*)(Z + (size_t)r * 1024 + cs + bj * HALF + 4 * n) = acc[ai][bj][m][n]; }
        } else {
            size_t od; int pitch, p0, act; float sc = 1.0f;
            if (pn < 4) { od = WS_Q; pitch = 1024; p0 = 0; act = 0; } else if (pn < 8) { od = WS_K; pitch = 1024; p0 = 4; act = 0; sc = 0.08838834764831845f; }
            else if (pn < 16) { od = WS_V; pitch = 2048; p0 = 8; act = 0; } else if (pn < 24) { od = WS_RG; pitch = 2048; p0 = 16; act = 1; } else if (pn < 28) { od = WS_HQ; pitch = 1024; p0 = 24; act = 1; }
            else if (pn < 36) { od = WS_HI; pitch = 1024; p0 = 32; act = 0; } else if (pn < 40) { od = WS_HG; pitch = 1024; p0 = 36; act = 1; } else if (pn < 48) { od = WS_GA; pitch = 2048; p0 = 40; act = 2; } else { od = WS_GB; pitch = 2048; p0 = 48; act = 2; }
            bf16_t* dst = (bf16_t*)(ws + od);
            const int cs = (pn - p0) * 256 + wc * 32 + 8 * fq;
#pragma unroll
            for (int ai = 0; ai < 2; ++ai)
#pragma unroll
                for (int m = 0; m < 4; ++m) { const int r = row0 + ai * HALF + m * 16; bf16_t* rowp = dst + (size_t)r * pitch + cs;
#pragma unroll
                    for (int bj = 0; bj < 2; ++bj) { f32x4 v0 = acc[ai][bj][m][0] * sc, v1 = acc[ai][bj][m][1] * sc;
                        if (act == 1) { v0 = silu4(v0); v1 = silu4(v1); } else if (act == 2) { v0 = sigm4(v0); v1 = sigm4(v1); }
                        *(u32x4*)(rowp + bj * HALF) = pack8(v0, v1); } }
        }
    }
};
template <int SECOND> struct EpiGate {
    static constexpr bool PERM = true, AFTER_DRAIN = false;
    const bf16_t* G; float* YT; bf16_t* MG;
    __device__ __forceinline__ void operator()(const f32x4 (&acc)[2][2][4][2], const Unit& u, int wr, int wc, int fr, int fq) const {
        const int row0 = u.pm * BM + wr * 64 + fr, col0 = u.pn * BM + wc * 32 + 8 * fq;
#pragma unroll
        for (int ai = 0; ai < 2; ++ai)
#pragma unroll
            for (int m = 0; m < 4; ++m) { const size_t off = (size_t)(row0 + ai * HALF + m * 16) * 2048 + col0;
#pragma unroll
                for (int bj = 0; bj < 2; ++bj) { const u32x4 gw = *(const u32x4*)(G + off + bj * HALF);
                    f32x4 v0 = acc[ai][bj][m][0] * unpack4((u32x2){gw.x, gw.y}), v1 = acc[ai][bj][m][1] * unpack4((u32x2){gw.z, gw.w});
                    float* yp = YT + off + bj * HALF;
                    if (SECOND) { v0 += *(const f32x4*)yp; v1 += *(const f32x4*)(yp + 4); *(u32x4*)(MG + off + bj * HALF) = pack8(v0, v1); }
                    else { *(f32x4*)yp = v0; *(f32x4*)(yp + 4) = v1; } } }
        __builtin_amdgcn_s_waitcnt(0x0F70);
    }
};
struct EpiResid {
    static constexpr bool PERM = true, AFTER_DRAIN = false;
    const float* XP; const float* XS; float* OUT; bf16_t* XB; float* SS;
    __device__ __forceinline__ void operator()(const f32x4 (&acc)[2][2][4][2], const Unit& u, int wr, int wc, int fr, int fq) const {
        const int row0 = u.pm * BM + wr * 64 + fr, col0 = u.pn * BM + wc * 32 + 8 * fq;
#pragma unroll
        for (int ai = 0; ai < 2; ++ai)
#pragma unroll
            for (int m = 0; m < 4; ++m) { const int r = row0 + ai * HALF + m * 16; const bool live = r < 8320;
                const float* xi = (r < 8192 ? XP + (size_t)r * 2048 : XS + (size_t)(r - 8192) * 2048) + col0; float ss = 0.f;
#pragma unroll
                for (int bj = 0; bj < 2; ++bj) { f32x4 v0 = acc[ai][bj][m][0], v1 = acc[ai][bj][m][1];
                    if (live) { v0 += *(const f32x4*)(xi + bj * HALF); v1 += *(const f32x4*)(xi + bj * HALF + 4);
                        float* op = OUT + (size_t)r * 2048 + col0 + bj * HALF; *(f32x4*)op = v0; *(f32x4*)(op + 4) = v1; }
                    if (XB) *(u32x4*)(XB + (size_t)r * 2048 + col0 + bj * HALF) = pack8(v0, v1);
                    ss += (v0[0] * v0[0] + v0[1] * v0[1]) + (v0[2] * v0[2] + v0[3] * v0[3]) + (v1[0] * v1[0] + v1[1] * v1[1]) + (v1[2] * v1[2] + v1[3] * v1[3]); }
                ss += __shfl_xor(ss, 16); ss += __shfl_xor(ss, 32);
                if (fq == 0) atomicAdd(SS + r, ss); }
        __builtin_amdgcn_s_waitcnt(0x0F70);
    }
};
struct EpiSwiglu {
    static constexpr bool PERM = true, AFTER_DRAIN = false;
    const float* SS; bf16_t* ACT;
    __device__ __forceinline__ void operator()(const f32x4 (&acc)[2][2][4][2], const Unit& u, int wr, int wc, int fr, int fq) const {
        const int row0 = u.pm * BM + wr * 64 + fr, col0 = u.pn * HALF + wc * 32 + 8 * fq;
        float ssv[2][4];
#pragma unroll
        for (int ai = 0; ai < 2; ++ai)
#pragma unroll
            for (int m = 0; m < 4; ++m) ssv[ai][m] = SS[row0 + ai * HALF + m * 16];
        __builtin_amdgcn_s_waitcnt(0x0F70);
#pragma unroll
        for (int ai = 0; ai < 2; ++ai)
#pragma unroll
            for (int m = 0; m < 4; ++m) { const int r = row0 + ai * HALF + m * 16; const float r2 = 1.0f / sqrtf(ssv[ai][m] * (1.0f / 2048.0f) + 1e-6f);
                const f32x4 g0 = acc[ai][0][m][0] * r2, g1 = acc[ai][0][m][1] * r2, u0 = acc[ai][1][m][0] * r2, u1 = acc[ai][1][m][1] * r2;
                *(u32x4*)(ACT + (size_t)r * 5632 + col0) = pack8(silu4(g0) * u0, silu4(g1) * u1); }
    }
};
template <class Epi, class Sched, bool ALIGN_EPI = false, bool SP2 = false>
__device__ __forceinline__ void gemm_phase(PG8_LAS unsigned char* lds, const Gemm g, const Sched& S, const Epi& E) {
    const int tid = threadIdx.x, wid = __builtin_amdgcn_readfirstlane(tid >> 6), lane = tid & 63, wr = wid >> 2, wc = wid & 3, fr = lane & 15, fq = lane >> 4;
    const int K = g.K, nt = K / BK;
    unsigned voffA[2], voffB[2];
#pragma unroll
    for (int i = 0; i < 2; ++i) { int R, C; stage_rc(tid * 16 + i * 8192, R, C); const int Rb = Epi::PERM ? ((R & ~31) + perm32(R & 31)) : R;
        voffA[i] = (unsigned)(R * K + C) * 2u; voffB[i] = (unsigned)(Rb * K + C) * 2u; }
    const size_t kstep = (size_t)(BK * 2);
    const size_t hstep = (size_t)HALF * K * 2;
    const size_t tstep = 2 * hstep;
    const unsigned ldsw = (unsigned)wid * 1024u;
    const int aoff = lds_byte(wr * 64 + fr, fq * 8), boff = lds_byte(wc * 32 + fr, fq * 8);
#define PG8_SA(b, h) (((b) * 2 + (h)) * HTB)
#define PG8_SB(b, h) ((4 + (b) * 2 + (h)) * HTB)
#define PG8_STAGE(bufoff, gbase, voff) do { _Pragma("unroll") for (int _i = 0; _i < 2; ++_i) \
        __builtin_amdgcn_global_load_lds((const unsigned*)((const char*)(gbase) + (voff)[_i]), (PG8_LAS unsigned*)(lds + (bufoff) + ldsw + _i * 8192), 16, 0, 0); } while (0)
#define PG8_LDA(dst, b, h) do { _Pragma("unroll") for (int m = 0; m < 4; ++m) _Pragma("unroll") for (int k = 0; k < 2; ++k) dst[m][k] = *(const PG8_LAS bf16x8*)(lds + PG8_SA(b, h) + aoff + m * 2048 + k * 1024); } while (0)
#define PG8_LDB(dst, b, h) do { _Pragma("unroll") for (int n = 0; n < 2; ++n) _Pragma("unroll") for (int k = 0; k < 2; ++k) dst[n][k] = *(const PG8_LAS bf16x8*)(lds + PG8_SB(b, h) + boff + n * 2048 + k * 1024); } while (0)
#define PG8_MMA(ai, bj, At, Bt) do { __builtin_amdgcn_s_setprio(1); _Pragma("unroll") for (int m = 0; m < 4; ++m) _Pragma("unroll") for (int n = 0; n < 2; ++n) _Pragma("unroll") for (int k = 0; k < 2; ++k) \
        acc[ai][bj][m][n] = __builtin_amdgcn_mfma_f32_16x16x32_bf16(Bt[n][k], At[m][k], acc[ai][bj][m][n], 0, 0, 0); __builtin_amdgcn_s_setprio(0); } while (0)
#define PG8_WAIT_V(n) asm volatile("s_waitcnt vmcnt(" #n ")" ::: "memory")
#define PG8_WAIT_L(n) asm volatile("s_waitcnt lgkmcnt(" #n ")" ::: "memory")
#define PG8_BAR __builtin_amdgcn_s_barrier()
#define PG8_SCHED __builtin_amdgcn_sched_barrier(0)
    Unit cur, nxt; int ui = 0;
    if (!S.next(0, cur)) return;
    f32x4 acc[2][2][4][2];
#pragma unroll
    for (int a = 0; a < 2; ++a)
#pragma unroll
        for (int b = 0; b < 2; ++b)
#pragma unroll
            for (int m = 0; m < 4; ++m)
#pragma unroll
                for (int n = 0; n < 2; ++n) acc[a][b][m][n] = (f32x4){0.f, 0.f, 0.f, 0.f};
    bf16x8 At[4][2], B0[2][2], B1[2][2];
    const char* cA = (const char*)g.A + (size_t)cur.pm * tstep; const char* cB = (const char*)g.Bt + (size_t)cur.pn * tstep;
    S.a_ready(cur);
    if constexpr (SP2) {
        PG8_STAGE(PG8_SB(0, 0), cB, voffB); PG8_STAGE(PG8_SB(0, 1), cB + hstep, voffB); PG8_STAGE(PG8_SA(0, 0), cA, voffA); PG8_STAGE(PG8_SA(0, 1), cA + hstep, voffA);
        if (wr == 1) PG8_BAR;
        PG8_WAIT_V(2); PG8_BAR;
        PG8_STAGE(PG8_SB(1, 0), cB + kstep, voffB); PG8_STAGE(PG8_SA(1, 0), cA + kstep, voffA); PG8_STAGE(PG8_SB(1, 1), cB + hstep + kstep, voffB);
        PG8_WAIT_V(6); PG8_BAR;
    } else {
        PG8_STAGE(PG8_SB(0, 0), cB, voffB); PG8_STAGE(PG8_SA(0, 0), cA, voffA); PG8_STAGE(PG8_SB(0, 1), cB + hstep, voffB); PG8_STAGE(PG8_SA(0, 1), cA + hstep, voffA);
        if (wr == 1) PG8_BAR;
        PG8_WAIT_V(4); PG8_BAR;
        PG8_STAGE(PG8_SB(1, 0), cB + kstep, voffB); PG8_STAGE(PG8_SA(1, 0), cA + kstep, voffA); PG8_STAGE(PG8_SB(1, 1), cB + hstep + kstep, voffB);
        PG8_WAIT_V(6); PG8_BAR;
    }
    for (;;) {
        const bool has_next = S.next(ui + 1, nxt);
        const char* nA = has_next ? (const char*)g.A + (size_t)nxt.pm * tstep : cA; const char* nB = has_next ? (const char*)g.Bt + (size_t)nxt.pn * tstep : cB;
        for (int t = 0; t < nt; t += 2) {
            const bool last = (t == nt - 2);
            const char* a1 = cA + (size_t)(t + 1) * kstep;
            const char* a2 = last ? nA : cA + (size_t)(t + 2) * kstep; const char* b2 = last ? nB : cB + (size_t)(t + 2) * kstep;
            const char* a3 = a2 + kstep; const char* b3 = b2 + kstep;
            if (last && has_next) S.a_ready(nxt);
            if constexpr (SP2) {
            PG8_LDB(B0, 0, 0); PG8_LDB(B1, 0, 1); PG8_SCHED; PG8_LDA(At, 0, 0); PG8_STAGE(PG8_SA(1, 1), a1 + hstep, voffA);
            PG8_WAIT_V(8); PG8_WAIT_L(0); PG8_BAR; PG8_MMA(0, 0, At, B0); PG8_MMA(0, 1, At, B1); PG8_BAR; PG8_SCHED;
            PG8_LDA(At, 0, 1); PG8_STAGE(PG8_SB(0, 0), b2, voffB); PG8_STAGE(PG8_SB(0, 1), b2 + hstep, voffB); PG8_STAGE(PG8_SA(0, 0), a2, voffA);
            PG8_WAIT_V(8); PG8_WAIT_L(0); PG8_BAR; PG8_MMA(1, 0, At, B0); PG8_MMA(1, 1, At, B1); PG8_BAR; PG8_SCHED;
            PG8_LDB(B0, 1, 0); PG8_LDB(B1, 1, 1); PG8_SCHED; PG8_LDA(At, 1, 0); PG8_STAGE(PG8_SA(0, 1), a2 + hstep, voffA);
            PG8_WAIT_V(8); PG8_WAIT_L(0); PG8_BAR; PG8_MMA(0, 0, At, B0); PG8_MMA(0, 1, At, B1); PG8_BAR; PG8_SCHED;
            PG8_LDA(At, 1, 1); PG8_STAGE(PG8_SB(1, 0), b3, voffB); PG8_STAGE(PG8_SB(1, 1), b3 + hstep, voffB); PG8_STAGE(PG8_SA(1, 0), a3, voffA);
            PG8_WAIT_V(8); PG8_WAIT_L(0); PG8_BAR; PG8_MMA(1, 0, At, B0); PG8_MMA(1, 1, At, B1); PG8_BAR; PG8_SCHED;
            } else {
            PG8_LDB(B0, 0, 0); PG8_SCHED; PG8_LDA(At, 0, 0); PG8_STAGE(PG8_SA(1, 1), a1 + hstep, voffA);
            PG8_WAIT_L(8); PG8_BAR; PG8_WAIT_L(0); PG8_MMA(0, 0, At, B0); PG8_BAR; PG8_SCHED;
            PG8_LDB(B1, 0, 1); PG8_STAGE(PG8_SB(0, 0), b2, voffB);
            PG8_BAR; PG8_WAIT_L(0); PG8_MMA(0, 1, At, B1); PG8_BAR;
            PG8_LDA(At, 0, 1); PG8_STAGE(PG8_SA(0, 0), a2, voffA);
            PG8_BAR; PG8_WAIT_L(0); PG8_MMA(1, 0, At, B0); PG8_BAR; PG8_SCHED;
            PG8_STAGE(PG8_SB(0, 1), b2 + hstep, voffB);
            PG8_WAIT_V(6); PG8_BAR; PG8_MMA(1, 1, At, B1); PG8_BAR;
            PG8_LDB(B0, 1, 0); PG8_SCHED; PG8_LDA(At, 1, 0); PG8_STAGE(PG8_SA(0, 1), a2 + hstep, voffA);
            PG8_WAIT_L(8); PG8_BAR; PG8_WAIT_L(0); PG8_MMA(0, 0, At, B0); PG8_BAR; PG8_SCHED;
            PG8_LDB(B1, 1, 1); PG8_STAGE(PG8_SB(1, 0), b3, voffB);
            PG8_BAR; PG8_WAIT_L(0); PG8_MMA(0, 1, At, B1); PG8_BAR;
            PG8_LDA(At, 1, 1); PG8_STAGE(PG8_SA(1, 0), a3, voffA);
            PG8_BAR; PG8_WAIT_L(0); PG8_MMA(1, 0, At, B0); PG8_BAR; PG8_SCHED;
            PG8_STAGE(PG8_SB(1, 1), b3 + hstep, voffB);
            PG8_WAIT_V(6); PG8_BAR; PG8_MMA(1, 1, At, B1); PG8_BAR;
            }
        }
        if constexpr (ALIGN_EPI) { if (wr == 0) PG8_BAR; }
        if constexpr (!Epi::AFTER_DRAIN) { E(acc, cur, wr, wc, fr, fq); S.done(cur); }
        if (!has_next) break;
#pragma unroll
        for (int a = 0; a < 2; ++a)
#pragma unroll
            for (int b = 0; b < 2; ++b)
#pragma unroll
                for (int m = 0; m < 4; ++m)
#pragma unroll
                    for (int n = 0; n < 2; ++n) acc[a][b][m][n] = (f32x4){0.f, 0.f, 0.f, 0.f};
        cur = nxt; cA = nA; cB = nB; ++ui;
        if constexpr (ALIGN_EPI) { if (wr == 1) PG8_BAR; }
    }
    PG8_WAIT_V(0);
    if constexpr (!ALIGN_EPI) { if (wr == 0) PG8_BAR; }
    PG8_BAR;
    if constexpr (Epi::AFTER_DRAIN) { E.fused(acc, cur, wr, wc, fr, fq, lds, wid, lane); S.done(cur); }
#undef PG8_SA
#undef PG8_SB
#undef PG8_STAGE
#undef PG8_LDA
#undef PG8_LDB
#undef PG8_MMA
#undef PG8_WAIT_V
#undef PG8_WAIT_L
#undef PG8_BAR
#undef PG8_SCHED
}
}
#define XB_TMO      128
#define XB_XCNT(j)  (256  + 64 * (j))
#define XB_XSUB(j)  (1280 + 64 * (j))
#define XB_XGEN(j)  (2304 + 64 * (j))
#define XB_TOP      3328
#define XB_TOPGEN   3392
#define XCD_BAR_WORDS 3456
#define XB_SPIN_CAP (1u << 18)

__device__ __forceinline__ unsigned xb_ld(unsigned* p)              { return __hip_atomic_load(p, __ATOMIC_RELAXED, __HIP_MEMORY_SCOPE_AGENT); }
__device__ __forceinline__ unsigned xb_add(unsigned* p, unsigned v) { return __hip_atomic_fetch_add(p, v, __ATOMIC_RELAXED, __HIP_MEMORY_SCOPE_AGENT); }
__device__ __forceinline__ unsigned xb_xcc_id() { return (unsigned)__builtin_amdgcn_s_getreg((3 << 11) | 20) & 0xFu; }
#define XB_SPIN(cond, bar) do { unsigned _sp = 0; while (cond) { __builtin_amdgcn_s_sleep(1); \
    if ((++_sp & 255u) == 0u) { if (xb_ld(&(bar)[XB_TMO])) break; if (_sp > XB_SPIN_CAP) { atomicAdd(&(bar)[XB_TMO], 1u); break; } } } } while (0)

struct XcdBarrier {
    unsigned* bar; unsigned x;
    volatile LAS unsigned* st;
};

__device__ __forceinline__ XcdBarrier xcd_barrier_post(unsigned* bar, volatile LAS unsigned* st) {
    XcdBarrier b; b.bar = bar; b.x = xb_xcc_id(); b.st = st;
    if (threadIdx.x == 0) (void)xb_add(&bar[XB_XCNT(b.x)], 1u);
    return b;
}
__device__ __forceinline__ void xcd_barrier_complete(unsigned* bar, unsigned x, unsigned& nloc, unsigned& nx) {
    const unsigned G = gridDim.x * gridDim.y * gridDim.z;
    unsigned sum, cnt, mine, sp = 0u;
    for (;;) {
        sum = 0u; cnt = 0u; mine = 0u;
#pragma unroll
        for (unsigned j = 0; j < 16; ++j) { const unsigned c = xb_ld(&bar[XB_XCNT(j)]); sum += c; cnt += (c > 0u) ? 1u : 0u; mine = (j == x) ? c : mine; }
        if (sum == G) break;
        __builtin_amdgcn_s_sleep(1);
        if ((++sp & 255u) == 0u) { if (xb_ld(&bar[XB_TMO])) break; if (sp > XB_SPIN_CAP) { atomicAdd(&bar[XB_TMO], 1u); break; } }
    }
    nloc = mine > 0u ? mine : 1u; nx = cnt > 0u ? cnt : 1u;
}

__device__ __forceinline__ void xcd_barrier(const XcdBarrier& b) {
    asm volatile("s_waitcnt vmcnt(0)" ::: "memory");
    __syncthreads();
    if (threadIdx.x == 0) {
        unsigned* bar = b.bar;
        __builtin_amdgcn_s_waitcnt(0);
        unsigned nloc = b.st[0], nx = b.st[1];
        if (nloc == 0u) { xcd_barrier_complete(bar, b.x, nloc, nx); b.st[0] = nloc; b.st[1] = nx; }
        const unsigned old = xb_add(&bar[XB_XSUB(b.x)], 1u);
        const unsigned gen = old / nloc;
        if (old + 1u == (gen + 1u) * nloc) {
            __builtin_amdgcn_fence(__ATOMIC_RELEASE, "agent");
            asm volatile("s_waitcnt vmcnt(0)" ::: "memory");
            const unsigned og = xb_add(&bar[XB_TOP], 1u);
            const unsigned tg = og / nx;
            if (og + 1u == (tg + 1u) * nx) xb_add(&bar[XB_TOPGEN], 1u);
            else XB_SPIN(xb_ld(&bar[XB_TOPGEN]) == tg, bar);
            __builtin_amdgcn_fence(__ATOMIC_ACQUIRE, "agent");
            xb_add(&bar[XB_XGEN(b.x)], 1u);
            asm volatile("s_waitcnt vmcnt(0)" ::: "memory");
        } else {
            XB_SPIN(xb_ld(&bar[XB_XGEN(b.x)]) == gen, bar);
            __builtin_amdgcn_fence(__ATOMIC_ACQUIRE, "agent");
            asm volatile("s_waitcnt vmcnt(0)" ::: "memory");
        }
    }
    __syncthreads();
}
struct Frame {
    LAS unsigned char* lds; volatile LAS unsigned* MISC; gu32* ctl;
    int tid, lane, wave, vcu, G;
    float* out; unsigned char* ws;
};
__device__ __forceinline__ float wave_sum(float v) {
#pragma unroll
    for (int o = 1; o < 64; o <<= 1) v += __shfl_xor(v, o);
    return v;
}
template <int MODE> __device__ __forceinline__ int rowmap(int n) {
    if (MODE == 1) { if (n >= 2048) return n; const int j = n & 127, hb = n & ~127; return hb + (j < 64 ? 8 * (j >> 2) + (j & 3) : 8 * ((j - 64) >> 2) + 4 + (j & 3)); }
    if (MODE == 2) { return n < DFF ? (n >> 7) * 256 + (n & 127) : ((n - DFF) >> 7) * 256 + 128 + ((n - DFF) & 127); }
    return n;
}
template <int MODE> __device__ __forceinline__ void p0_transpose_item(const float* W, int K, int N, bf16* WT, const float* g, LAS unsigned* T, int item, int lane) {
    const int nblk = N / 64, kb = item / nblk, nb = item % nblk, k0 = 64 * kb, n0 = 64 * nb;
    const int l15 = lane & 15, lg = lane >> 4;
    f32x4 v[16];
#pragma unroll
    for (int i = 0; i < 16; ++i) { const int row = 8 * (i >> 1) + 2 * lg + (i & 1); v[i] = *(const f32x4*)(W + (size_t)(k0 + row) * N + n0 + 4 * l15); }
    if (g) {
#pragma unroll
        for (int i = 0; i < 16; ++i) { const int row = 8 * (i >> 1) + 2 * lg + (i & 1); v[i] = v[i] * g[k0 + row]; } }
#pragma unroll
    for (int p = 0; p < 8; ++p)
#pragma unroll
        for (int j = 0; j < 4; ++j) T[(4 * l15 + j) * 33 + 4 * p + lg] = pk2(v[2 * p][j], v[2 * p + 1][j]);
    LDS_WAIT(); asm volatile("" ::: "memory");
    const int c = lane & 7;
#pragma unroll
    for (int i = 0; i < 8; ++i) { const int n = (lane >> 3) + 8 * i; const LAS unsigned* s = T + n * 33 + 4 * c;
        v4u o; o.x = s[0]; o.y = s[1]; o.z = s[2]; o.w = s[3];
        *(GAS v4u*)(WT + (size_t)rowmap<MODE>(n0 + n) * K + k0 + 8 * c) = o; }
    LDS_WAIT(); asm volatile("" ::: "memory");
}
struct Args { const float* in[15]; float* out; unsigned char* ws; int ph_lo, ph_hi, use_bar, pad; };
__device__ __forceinline__ void p0_prologue(Frame& F, const Args& A) {
    LAS unsigned* scr = (LAS unsigned*)(F.lds + F.wave * 16384);
    const int gw = F.vcu * NWAVES + F.wave, NGW = F.G * NWAVES;
    unsigned char* ws = F.ws;
    constexpr int I_IN = 32 * (NIN / 64), I_RO = 32 * 32, I_HO = 16 * 32, I_OUT = 32 * 32, I_FI = 32 * (2 * DFF / 64), I_FO = (DFF / 64) * 32;
    constexpr int NITEMS = I_IN + I_RO + I_HO + I_OUT + I_FI + I_FO;
    for (int it = gw; it < NITEMS; it += NGW) {
        int r = it;
        if (r < I_IN) { p0_transpose_item<0>(A.in[4], 2048, NIN, (bf16*)(ws + WS_WIN), A.in[8], scr, r, F.lane); continue; } r -= I_IN;
        if (r < I_RO) { p0_transpose_item<0>(A.in[5], 2048, 2048, (bf16*)(ws + WS_WRO), nullptr, scr, r, F.lane); continue; } r -= I_RO;
        if (r < I_HO) { p0_transpose_item<0>(A.in[6], 1024, 2048, (bf16*)(ws + WS_WHO), nullptr, scr, r, F.lane); continue; } r -= I_HO;
        if (r < I_OUT) { p0_transpose_item<0>(A.in[7], 2048, 2048, (bf16*)(ws + WS_WOUT), nullptr, scr, r, F.lane); continue; } r -= I_OUT;
        if (r < I_FI) { p0_transpose_item<2>(A.in[12], 2048, 2 * DFF, (bf16*)(ws + WS_WFI), A.in[9], scr, r, F.lane); continue; } r -= I_FI;
        p0_transpose_item<0>(A.in[13], DFF, 2048, (bf16*)(ws + WS_WFO), nullptr, scr, r, F.lane);
    }
    bf16* XB = (bf16*)(ws + WS_XB);
    for (int m = gw; m < MPAD; m += NGW) {
        GAS unsigned long long* o8 = (GAS unsigned long long*)(XB + (size_t)m * 2048) + F.lane;
        if (m < MROWS) {
            const float* xrow = m < 8192 ? A.in[0] + (size_t)m * 2048 : A.in[1] + (size_t)(m - 8192) * 2048;
            const GAS f32x4* xr = (const GAS f32x4*)xrow + F.lane;
            f32x4 v[8]; float s = 0.f;
#pragma unroll
            for (int j = 0; j < 8; ++j) { v[j] = xr[64 * j]; s += (v[j].x * v[j].x + v[j].y * v[j].y) + (v[j].z * v[j].z + v[j].w * v[j].w); }
            const float rr = 1.0f / sqrtf(wave_sum(s) * (1.0f / 2048.0f) + EPS);
#pragma unroll
            for (int j = 0; j < 8; ++j) o8[64 * j] = (unsigned long long)pk2(v[j].x * rr, v[j].y * rr) | ((unsigned long long)pk2(v[j].z * rr, v[j].w * rr) << 32);
        } else {
#pragma unroll
            for (int j = 0; j < 8; ++j) o8[64 * j] = 0ull;
        }
    }
    { float* COS = (float*)(ws + WS_COS); float* SIN = (float*)(ws + WS_SIN);
      for (int i = (F.vcu * NWAVES + F.wave) * 64 + F.lane; i < 2049 * 64; i += F.G * NWAVES * 64) { const int p = i >> 6, j = i & 63; const int pos = p < 2048 ? p : 16384;
          const float inv = powf(10000.0f, -(float)j / 64.0f); const float ang = (float)pos * inv; float sn, cs; sincosf(ang, &sn, &cs); COS[i] = cs; SIN[i] = sn; } }
    { float* LB = (float*)(ws + WS_LB); const int i = (F.vcu * NWAVES + F.wave) * 64 + F.lane; if (i < 1024) { const float l0 = A.in[11][i], l1 = A.in[11][1024 + i]; LB[i] = 1.0f / (1.0f + expf(l1 - l0)); } }
}
typedef short bf16x4v __attribute__((ext_vector_type(4)));
#define MFMA16(a, b, c) __builtin_amdgcn_mfma_f32_16x16x32_bf16((a), (b), (c), 0, 0, 0)
constexpr int TP = 136;
constexpr size_t OUT_YS = 8192ull * 2048, OUT_SRP = 8320ull * 2048, OUT_SHP = OUT_SRP + 4ull * 8 * 128 * 256, OUT_SRS = OUT_SHP + 4ull * 8 * 128 * 128, OUT_SHS = OUT_SRS + 128ull * 8 * 128 * 256;
__device__ __forceinline__ int tsw(int r, int m) { return r * TP + ((r >> 3) << 3) + m; }
__device__ __forceinline__ int tsw64(int r, int m) { return r * 72 + ((r >> 3) << 3) + m; }
constexpr int TSZ128 = 128 * TP + 128, TSZ64R = 64 * TP + 64, TSZ32R = 32 * TP + 32, TSZ256 = 256 * TP + 256, TSZ64T = 128 * 72 + 128;
__device__ __forceinline__ float lg2gamma(int h) { return log2f(1.0f - exp2f(-5.0f - (float)h)); }
__device__ __forceinline__ float bfe(const v4u& w, int j) { const unsigned x = w[j >> 1]; return __uint_as_float((j & 1) ? (x & 0xffff0000u) : (x << 16)); }
__device__ __forceinline__ bf16x8 pack_f8(const float* v) { v4u w; w.x = pk2(v[0], v[1]); w.y = pk2(v[2], v[3]); w.z = pk2(v[4], v[5]); w.w = pk2(v[6], v[7]); return __builtin_bit_cast(bf16x8, w); }

__device__ __forceinline__ void p2_ret_unit(Frame& F, int u) {
    unsigned char* ws = F.ws;
    const int es = u & 3, h = (u >> 2) & 7, b = u >> 5;
    const int w = F.wave, l15 = F.lane & 15, g = F.lane >> 4, et = w & 3, dh = w >> 2;
    LAS bf16* KT = (LAS bf16*)F.lds; LAS bf16* VT = KT + TSZ128;
    const bf16* Kg = (const bf16*)(ws + WS_K); const bf16* Vg = (const bf16*)(ws + WS_V);
    const float* COS = (const float*)(ws + WS_COS); const float* SIN = (const float*)(ws + WS_SIN);
    const float lg = lg2gamma(h), cd = exp2f(128.0f * lg);
    const int dc = F.tid & 7, m0 = F.tid >> 3;
    v4u ka[2], kb[2], va[2]; f32x4 cc[2][2], sn[2][2];
#define P2R_LOAD(c) do { _Pragma("unroll") for (int _i = 0; _i < 2; ++_i) { const int _m = m0 + 64 * _i, _r = b * 2048 + (c) * 128 + _m, _pos = (c) * 128 + _m, _d0 = 8 * dc; \
        const bf16* _kp = Kg + (size_t)_r * 1024 + h * 128 + _d0; ka[_i] = *(const v4u*)_kp; kb[_i] = *(const v4u*)(_kp + 64); va[_i] = *(const v4u*)(Vg + (size_t)_r * 2048 + h * 256 + 64 * es + _d0); \
        cc[_i][0] = *(const f32x4*)(COS + _pos * 64 + _d0); cc[_i][1] = *(const f32x4*)(COS + _pos * 64 + _d0 + 4); sn[_i][0] = *(const f32x4*)(SIN + _pos * 64 + _d0); sn[_i][1] = *(const f32x4*)(SIN + _pos * 64 + _d0 + 4); } } while (0)
    f32x4 S[4];
#pragma unroll
    for (int j = 0; j < 4; ++j) S[j] = (f32x4){0.f, 0.f, 0.f, 0.f};
    const float dec2[2] = {exp2f((float)(127 - m0) * lg), exp2f((float)(63 - m0) * lg)};
    P2R_LOAD(0);
    for (int c = 0; c < 16; ++c) {
        __syncthreads();
#pragma unroll
        for (int i = 0; i < 2; ++i) { const int m = m0 + 64 * i; const float dec = dec2[i];
            LAS bf16* k1 = KT + tsw(8 * dc, m); LAS bf16* k2 = KT + tsw(64 + 8 * dc, m); LAS bf16* vt = VT + tsw(8 * dc, m);
#pragma unroll
            for (int j = 0; j < 8; ++j) { const float x1 = bfe(ka[i], j), x2 = bfe(kb[i], j), cj = cc[i][j >> 2][j & 3], sj = sn[i][j >> 2][j & 3];
                k1[j * TP] = (bf16)f2bf((x1 * cj - x2 * sj) * dec); k2[j * TP] = (bf16)f2bf((x2 * cj + x1 * sj) * dec);
                vt[j * TP] = (bf16)((va[i][j >> 1] >> (16 * (j & 1))) & 0xffffu); } }
        if (c + 1 < 16) P2R_LOAD(c + 1);
        __syncthreads();
        f32x4 kv[4];
#pragma unroll
        for (int j = 0; j < 4; ++j) kv[j] = (f32x4){0.f, 0.f, 0.f, 0.f};
#pragma unroll
        for (int ks = 0; ks < 4; ++ks) { const bf16x8 bfr = *(const LAS bf16x8*)&VT[tsw(16 * et + l15, 32 * ks + 8 * g)];
#pragma unroll
            for (int j = 0; j < 4; ++j) { const bf16x8 af = *(const LAS bf16x8*)&KT[tsw(16 * (4 * dh + j) + l15, 32 * ks + 8 * g)]; kv[j] = MFMA16(af, bfr, kv[j]); } }
        bf16* st = (bf16*)(ws + WS_SRT) + ((size_t)((b * 8 + h) * 16 + c) * 256 + 64 * es + 16 * et + l15) * 128 + 64 * dh + 4 * g;
#pragma unroll
        for (int j = 0; j < 4; ++j) { v2u p; p.x = pk2(S[j][0], S[j][1]); p.y = pk2(S[j][2], S[j][3]); *(v2u*)(st + 16 * j) = p; S[j] = S[j] * cd + kv[j]; }
    }
#undef P2R_LOAD
    float* fo = F.out + OUT_SRP + ((size_t)(b * 8 + h) * 128 + 64 * dh + 4 * g) * 256 + 64 * es + 16 * et + l15;
#pragma unroll
    for (int j = 0; j < 4; ++j)
#pragma unroll
        for (int reg = 0; reg < 4; ++reg) fo[(size_t)(16 * j + reg) * 256] = S[j][reg];
}
__device__ __forceinline__ void p2_hg_unit(Frame& F, int u) {
    unsigned char* ws = F.ws;
    const int es = u & 3, h = (u >> 2) & 7, b = u >> 5;
    const int w = F.wave, l15 = F.lane & 15, g = F.lane >> 4, et = w & 1, dp = w >> 1;
    LAS bf16* KT = (LAS bf16*)F.lds; LAS bf16* VT = KT + TSZ128; LAS float* LQ = (LAS float*)(VT + TSZ32R); LAS float* BT = LQ + 4 * 128;
    const float* Z = (const float*)(ws + WS_LOGF); const bf16* HI = (const bf16*)(ws + WS_HI);
    const int d = F.tid & 127, q = F.tid >> 7; const float oml = 1.0f - ((const float*)(ws + WS_LB))[h * 128 + d];
    float z[32]; v4u va;
#define P2H_LOAD(sc) do { const int _r0 = b * 2048 + (sc) * 128; _Pragma("unroll") for (int _i = 0; _i < 32; ++_i) z[_i] = Z[(size_t)(_r0 + 32 * q + _i) * 1024 + h * 128 + d]; \
        va = *(const v4u*)(HI + (size_t)(_r0 + (F.tid >> 2)) * 1024 + h * 128 + 32 * es + 8 * (F.tid & 3)); } while (0)
    f32x4 S[2]; S[0] = (f32x4){0.f, 0.f, 0.f, 0.f}; S[1] = (f32x4){0.f, 0.f, 0.f, 0.f};
    P2H_LOAD(0);
    for (int sc = 0; sc < 16; ++sc) {
        float lf[32], kin[32]; float L = 0.f;
#pragma unroll
        for (int i = 0; i < 32; ++i) { kin[i] = oml * __builtin_amdgcn_rcpf(1.0f + __expf(z[i])); lf[i] = __logf(1.0f - kin[i]); L += lf[i]; }
        __syncthreads();
        LQ[q * 128 + d] = L;
#pragma unroll
        for (int j = 0; j < 8; ++j) VT[tsw(8 * (F.tid & 3), F.tid >> 2) + j * TP] = (bf16)((va[j >> 1] >> (16 * (j & 1))) & 0xffffu);
        if (sc + 1 < 16) P2H_LOAD(sc + 1);
        __syncthreads();
        float run = 0.f;
#pragma unroll
        for (int q2 = 1; q2 < 4; ++q2) if (q2 > q) run += LQ[q2 * 128 + d];
#pragma unroll
        for (int blk = 3; blk >= 0; --blk) { float v[8];
#pragma unroll
            for (int jj = 7; jj >= 0; --jj) { const int i = 8 * blk + jj; v[jj] = kin[i] * __expf(run); run += lf[i]; }
            *(LAS bf16x8*)&KT[tsw(d, 32 * q + 8 * blk)] = pack_f8(v); }
        if (q == 0) BT[d] = run;
        __syncthreads();
        f32x4 hs[2]; hs[0] = (f32x4){0.f, 0.f, 0.f, 0.f}; hs[1] = (f32x4){0.f, 0.f, 0.f, 0.f};
#pragma unroll
        for (int ks = 0; ks < 4; ++ks) { const bf16x8 bfr = *(const LAS bf16x8*)&VT[tsw(16 * et + l15, 32 * ks + 8 * g)];
#pragma unroll
            for (int j = 0; j < 2; ++j) { const bf16x8 af = *(const LAS bf16x8*)&KT[tsw(16 * (2 * dp + j) + l15, 32 * ks + 8 * g)]; hs[j] = MFMA16(af, bfr, hs[j]); } }
        bf16* st = (bf16*)(ws + WS_SHT) + ((size_t)((b * 8 + h) * 16 + sc) * 128 + 32 * es + 16 * et + l15) * 128 + 32 * dp + 4 * g;
#pragma unroll
        for (int j = 0; j < 2; ++j) { v2u p; p.x = pk2(S[j][0], S[j][1]); p.y = pk2(S[j][2], S[j][3]); *(v2u*)(st + 16 * j) = p;
            const f32x4 bt = *(const LAS f32x4*)&BT[16 * (2 * dp + j) + 4 * g];
#pragma unroll
            for (int reg = 0; reg < 4; ++reg) S[j][reg] = S[j][reg] * __expf(bt[reg]) + hs[j][reg]; }
    }
#undef P2H_LOAD
    float* fo = F.out + OUT_SHP + ((size_t)(b * 8 + h) * 128 + 32 * dp + 4 * g) * 128 + 32 * es + 16 * et + l15;
#pragma unroll
    for (int j = 0; j < 2; ++j)
#pragma unroll
        for (int reg = 0; reg < 4; ++reg) fo[(size_t)(16 * j + reg) * 128] = S[j][reg];
}
__device__ __forceinline__ void p2_sret_all(Frame& F, const Args& A) {
    unsigned char* ws = F.ws;
    LAS float* qs = (LAS float*)F.lds; LAS float* ks = qs + 128; LAS float* vs = ks + 128; LAS float* ored = vs + 256;
    const bf16* Q = (const bf16*)(ws + WS_Q); const bf16* K = (const bf16*)(ws + WS_K); const bf16* V = (const bf16*)(ws + WS_V);
    const int e4 = F.tid & 63, dq = F.tid >> 6;
    int it = F.vcu; if (it >= 1024) return;
    f32x4 s[16];
    { const float* Sin = A.in[2] + (size_t)it * 128 * 256;
#pragma unroll
      for (int i = 0; i < 16; ++i) s[i] = *(const f32x4*)(Sin + (size_t)(16 * dq + i) * 256 + 4 * e4); }
    for (; it < 1024; it += F.G) {
        const int h = it & 7, b = it >> 3, r = 8192 + b;
        __syncthreads();
        if (F.tid < 64) { const int d = F.tid; const float cs = ((const float*)(ws + WS_COS))[2048 * 64 + d], sn = ((const float*)(ws + WS_SIN))[2048 * 64 + d];
            const float q1 = bf2f(Q[(size_t)r * 1024 + h * 128 + d]), q2 = bf2f(Q[(size_t)r * 1024 + h * 128 + 64 + d]), k1 = bf2f(K[(size_t)r * 1024 + h * 128 + d]), k2 = bf2f(K[(size_t)r * 1024 + h * 128 + 64 + d]);
            qs[d] = q1 * cs - q2 * sn; qs[d + 64] = q2 * cs + q1 * sn; ks[d] = k1 * cs - k2 * sn; ks[d + 64] = k2 * cs + k1 * sn; }
        else if (F.tid >= 256) { const int e = F.tid - 256; vs[e] = bf2f(V[(size_t)r * 2048 + h * 256 + e]); }
        __syncthreads();
        const float gam = 1.0f - exp2f(-5.0f - (float)h);
        float* Sout = F.out + OUT_SRS + (size_t)it * 128 * 256;
        const f32x4 v4 = *(const LAS f32x4*)&vs[4 * e4]; f32x4 o = (f32x4){0.f, 0.f, 0.f, 0.f};
#pragma unroll
        for (int i = 0; i < 16; ++i) { const int d = 16 * dq + i; s[i] = s[i] * gam + v4 * ks[d]; *(f32x4*)(Sout + (size_t)d * 256 + 4 * e4) = s[i]; o += s[i] * qs[d]; }
        *(LAS f32x4*)&ored[dq * 256 + 4 * e4] = o;
        if (it + F.G < 1024) { const float* Sin = A.in[2] + (size_t)(it + F.G) * 128 * 256;
#pragma unroll
            for (int i = 0; i < 16; ++i) s[i] = *(const f32x4*)(Sin + (size_t)(16 * dq + i) * 256 + 4 * e4); }
        __syncthreads();
        if (F.wave == 0) { float oo[4]; float ss = 0.f;
#pragma unroll
            for (int k = 0; k < 4; ++k) { const int e = F.lane + 64 * k; float t = 0.f;
#pragma unroll
                for (int j = 0; j < 8; ++j) t += ored[j * 256 + e];
                oo[k] = t; ss += t * t; }
            const float rr = 1.0f / sqrtf(wave_sum(ss) * (1.0f / 256.0f) + EPS);
            const bf16* RG = (const bf16*)(ws + WS_RG); bf16* OR = (bf16*)(ws + WS_OR);
#pragma unroll
            for (int k = 0; k < 4; ++k) { const size_t ix = (size_t)r * 2048 + h * 256 + F.lane + 64 * k; OR[ix] = (bf16)f2bf(oo[k] * rr * bf2f(RG[ix])); } }
    }
}
__device__ __forceinline__ void p2_shg_all(Frame& F, const Args& A) {
    unsigned char* ws = F.ws;
    LAS float* qs = (LAS float*)F.lds; LAS float* fs = qs + 128; LAS float* kn = fs + 128; LAS float* vs = kn + 128; LAS float* ored = vs + 128;
    const int e4 = F.tid & 31, dq = F.tid >> 5;
    int it = F.vcu; if (it >= 1024) return;
    f32x4 s[8];
    { const float* Sin = A.in[3] + (size_t)it * 128 * 128;
#pragma unroll
      for (int i = 0; i < 8; ++i) s[i] = *(const f32x4*)(Sin + (size_t)(8 * dq + i) * 128 + 4 * e4); }
    for (; it < 1024; it += F.G) {
        const int h = it & 7, b = it >> 3, r = 8192 + b;
        __syncthreads();
        if (F.tid < 128) { const int d = F.tid; const size_t ix = (size_t)r * 1024 + h * 128 + d; const float z = ((const float*)(ws + WS_LOGF))[ix]; const float lb = ((const float*)(ws + WS_LB))[h * 128 + d];
            const float kin = (1.0f - lb) / (1.0f + __expf(z)); kn[d] = kin; fs[d] = 1.0f - kin; qs[d] = bf2f(((const bf16*)(ws + WS_HQ))[ix]); vs[d] = bf2f(((const bf16*)(ws + WS_HI))[ix]); }
        __syncthreads();
        float* Sout = F.out + OUT_SHS + (size_t)it * 128 * 128;
        const f32x4 v4 = *(const LAS f32x4*)&vs[4 * e4]; f32x4 o = (f32x4){0.f, 0.f, 0.f, 0.f};
#pragma unroll
        for (int i = 0; i < 8; ++i) { const int d = 8 * dq + i; s[i] = s[i] * fs[d] + v4 * kn[d]; *(f32x4*)(Sout + (size_t)d * 128 + 4 * e4) = s[i]; o += s[i] * qs[d]; }
        *(LAS f32x4*)&ored[dq * 128 + 4 * e4] = o;
        if (it + F.G < 1024) { const float* Sin = A.in[3] + (size_t)(it + F.G) * 128 * 128;
#pragma unroll
            for (int i = 0; i < 8; ++i) s[i] = *(const f32x4*)(Sin + (size_t)(8 * dq + i) * 128 + 4 * e4); }
        __syncthreads();
        if (F.wave == 0) { float oo[2]; float ss = 0.f;
#pragma unroll
            for (int k = 0; k < 2; ++k) { const int e = F.lane + 64 * k; float t = 0.f;
#pragma unroll
                for (int j = 0; j < 16; ++j) t += ored[j * 128 + e];
                oo[k] = t; ss += t * t; }
            const float rr = 1.0f / sqrtf(wave_sum(ss) * (1.0f / 128.0f) + EPS);
            const bf16* HG = (const bf16*)(ws + WS_HG); bf16* OH = (bf16*)(ws + WS_OH);
#pragma unroll
            for (int k = 0; k < 2; ++k) { const int e = F.lane + 64 * k; const size_t ix = (size_t)r * 1024 + h * 128 + e; OH[ix] = (bf16)f2bf(oo[k] * rr * A.in[10][e] * bf2f(HG[ix])); } }
    }
}
__device__ __forceinline__ void p2_phase(Frame& F, const Args& A) {
#ifndef PROBE_SUB
#define PROBE_SUB -1
#endif
    for (int rep = 0; rep < (PROBE_SUB == 20 ? 2 : 1); ++rep) for (int u = F.vcu; u < 256; u += F.G) { if (u < 128) p2_ret_unit(F, u); else p2_hg_unit(F, u - 128); }
    for (int rep = 0; rep < (PROBE_SUB == 22 ? 2 : 1); ++rep) p2_sret_all(F, A);
    for (int rep = 0; rep < (PROBE_SUB == 23 ? 2 : 1); ++rep) p2_shg_all(F, A);
}
__device__ __forceinline__ void p4_ret_item(Frame& F, int item) {
    unsigned char* ws = F.ws;
    const int c = item & 15, h = (item >> 4) & 7, b = item >> 7, r0 = b * 2048 + c * 128;
    const int w = F.wave, l15 = F.lane & 15, g = F.lane >> 4;
    LAS bf16* KS = (LAS bf16*)F.lds; LAS bf16* VT = KS + 128 * TP;
    const bf16* Qg = (const bf16*)(ws + WS_Q); const bf16* Kg = (const bf16*)(ws + WS_K); const bf16* Vg = (const bf16*)(ws + WS_V);
    const float* COS = (const float*)(ws + WS_COS); const float* SIN = (const float*)(ws + WS_SIN);
    const float lg = lg2gamma(h);
    __syncthreads();
#pragma unroll
    for (int i = 0; i < 2; ++i) { const int u = F.tid + 512 * i, d0 = (u & 7) * 8, m = u >> 3;
        const bf16* kp = Kg + (size_t)(r0 + m) * 1024 + h * 128 + d0; const v4u a = *(const v4u*)kp, bb = *(const v4u*)(kp + 64);
        const int pos = c * 128 + m; const f32x4 c0 = *(const f32x4*)(COS + pos * 64 + d0), c1 = *(const f32x4*)(COS + pos * 64 + d0 + 4), s0 = *(const f32x4*)(SIN + pos * 64 + d0), s1 = *(const f32x4*)(SIN + pos * 64 + d0 + 4);
        float o1[8], o2[8];
#pragma unroll
        for (int j = 0; j < 8; ++j) { const float x1 = bfe(a, j), x2 = bfe(bb, j), cj = j < 4 ? c0[j & 3] : c1[j & 3], sj = j < 4 ? s0[j & 3] : s1[j & 3]; o1[j] = x1 * cj - x2 * sj; o2[j] = x2 * cj + x1 * sj; }
        *(LAS bf16x8*)&KS[m * TP + d0] = pack_f8(o1); *(LAS bf16x8*)&KS[m * TP + 64 + d0] = pack_f8(o2); }
#pragma unroll
    for (int i = 0; i < 8; ++i) { const int u = F.tid + 512 * i, e0 = (u & 31) * 8, m = u >> 5;
        const v4u a = *(const v4u*)(Vg + (size_t)(r0 + m) * 2048 + h * 256 + e0);
        LAS bf16* vt = VT + tsw(e0, m);
#pragma unroll
        for (int j = 0; j < 8; ++j) vt[j * TP] = (bf16)((a[j >> 1] >> (16 * (j & 1))) & 0xffffu); }
    bf16x8 qf[4];
    { const int n = 16 * w + l15, pos = c * 128 + n; const bf16* qp = Qg + (size_t)(r0 + n) * 1024 + h * 128 + 8 * g;
      const v4u a0 = *(const v4u*)qp, a1 = *(const v4u*)(qp + 32), a2 = *(const v4u*)(qp + 64), a3 = *(const v4u*)(qp + 96);
      float r0v[8], r1v[8], r2v[8], r3v[8];
#pragma unroll
      for (int hlf = 0; hlf < 2; ++hlf) { const int dd = 32 * hlf + 8 * g;
          const f32x4 c0 = *(const f32x4*)(COS + pos * 64 + dd), c1 = *(const f32x4*)(COS + pos * 64 + dd + 4), s0 = *(const f32x4*)(SIN + pos * 64 + dd), s1 = *(const f32x4*)(SIN + pos * 64 + dd + 4);
#pragma unroll
          for (int j = 0; j < 8; ++j) { const float cj = j < 4 ? c0[j & 3] : c1[j & 3], sj = j < 4 ? s0[j & 3] : s1[j & 3];
              const float x1 = hlf == 0 ? bfe(a0, j) : bfe(a1, j), x2 = hlf == 0 ? bfe(a2, j) : bfe(a3, j);
              if (hlf == 0) { r0v[j] = x1 * cj - x2 * sj; r2v[j] = x2 * cj + x1 * sj; } else { r1v[j] = x1 * cj - x2 * sj; r3v[j] = x2 * cj + x1 * sj; } } }
      qf[0] = pack_f8(r0v); qf[1] = pack_f8(r1v); qf[2] = pack_f8(r2v); qf[3] = pack_f8(r3v); }
    __syncthreads();
    f32x4 O[16];
    { const bf16* st = (const bf16*)(ws + WS_SRT) + (size_t)item * 256 * 128 + 8 * g;
#pragma unroll
      for (int et = 0; et < 16; ++et) { f32x4 t = (f32x4){0.f, 0.f, 0.f, 0.f};
#pragma unroll
          for (int ks = 0; ks < 4; ++ks) { const bf16x8 sf = *(const bf16x8*)(st + (size_t)(16 * et + l15) * 128 + 32 * ks); t = MFMA16(qf[ks], sf, t); }
          O[et] = t; }
      float rs[4];
#pragma unroll
      for (int reg = 0; reg < 4; ++reg) rs[reg] = exp2f((float)(16 * w + 4 * g + reg + 1) * lg);
#pragma unroll
      for (int et = 0; et < 16; ++et)
#pragma unroll
          for (int reg = 0; reg < 4; ++reg) O[et][reg] *= rs[reg]; }
    bf16x8 pf[4];
#pragma unroll
    for (int s = 0; s < 4; ++s) { float pv[8];
#pragma unroll
        for (int hf = 0; hf < 2; ++hf) { const int mt = 2 * s + hf; f32x4 dd = (f32x4){0.f, 0.f, 0.f, 0.f};
            if (mt <= w) {
#pragma unroll
                for (int ks = 0; ks < 4; ++ks) { const bf16x8 kf = *(const LAS bf16x8*)&KS[(16 * mt + l15) * TP + 32 * ks + 8 * g]; dd = MFMA16(kf, qf[ks], dd); }
#pragma unroll
                for (int reg = 0; reg < 4; ++reg) { const int m = 16 * mt + 4 * g + reg, n = 16 * w + l15; dd[reg] = n >= m ? dd[reg] * exp2f((float)(n - m) * lg) : 0.f; } }
#pragma unroll
            for (int reg = 0; reg < 4; ++reg) pv[4 * hf + reg] = dd[reg]; }
        pf[s] = pack_f8(pv); }
#pragma unroll
    for (int s = 0; s < 4; ++s) if (2 * s <= w) {
#pragma unroll
        for (int et = 0; et < 16; ++et) { const bf16x4v lo = *(const LAS bf16x4v*)&VT[tsw(16 * et + l15, 32 * s + 4 * g)], hi = *(const LAS bf16x4v*)&VT[tsw(16 * et + l15, 32 * s + 16 + 4 * g)];
            const bf16x8 vf = __builtin_shufflevector(lo, hi, 0, 1, 2, 3, 4, 5, 6, 7); O[et] = MFMA16(pf[s], vf, O[et]); } }
    float ss[4] = {0.f, 0.f, 0.f, 0.f};
#pragma unroll
    for (int et = 0; et < 16; ++et)
#pragma unroll
        for (int reg = 0; reg < 4; ++reg) ss[reg] += O[et][reg] * O[et][reg];
#pragma unroll
    for (int reg = 0; reg < 4; ++reg) { float v = ss[reg]; v += __shfl_xor(v, 1); v += __shfl_xor(v, 2); v += __shfl_xor(v, 4); v += __shfl_xor(v, 8); ss[reg] = 1.0f / sqrtf(v * (1.0f / 256.0f) + EPS); }
    const bf16* RG = (const bf16*)(ws + WS_RG); bf16* OR = (bf16*)(ws + WS_OR);
#pragma unroll
    for (int reg = 0; reg < 4; ++reg) { const size_t rb = (size_t)(r0 + 16 * w + 4 * g + reg) * 2048 + h * 256 + l15;
#pragma unroll
        for (int et = 0; et < 16; ++et) OR[rb + 16 * et] = (bf16)f2bf(O[et][reg] * ss[reg] * bf2f(RG[rb + 16 * et])); }
}
__device__ __forceinline__ void p4_hg_item(Frame& F, const Args& A, int item) {
    unsigned char* ws = F.ws;
    const int sc = item & 15, h = (item >> 4) & 7, b = item >> 7, r0 = b * 2048 + sc * 128;
    const int w = F.wave, l15 = F.lane & 15, g = F.lane >> 4;
    LAS bf16* QP = (LAS bf16*)F.lds;
    LAS bf16* KP = QP + 64 * TP;
    LAS bf16* KU = KP + 64 * TP;
    LAS bf16* VT = KU + 128 * 72;
    LAS float* E15 = (LAS float*)(VT + TSZ64T);
    LAS float* OB = E15 + 4 * 128;
    const float* Z = (const float*)(ws + WS_LOGF); const bf16* HQ = (const bf16*)(ws + WS_HQ); const bf16* HI = (const bf16*)(ws + WS_HI); const float* LB = (const float*)(ws + WS_LB);
    f32x4 S[8];
    { const bf16* st = (const bf16*)(ws + WS_SHT) + (size_t)item * 128 * 128 + (size_t)(16 * w + l15) * 128 + 4 * g;
#pragma unroll
      for (int dt = 0; dt < 8; ++dt) { const v2u p = *(const v2u*)(st + 16 * dt); S[dt][0] = __uint_as_float(p.x << 16); S[dt][1] = __uint_as_float(p.x & 0xffff0000u); S[dt][2] = __uint_as_float(p.y << 16); S[dt][3] = __uint_as_float(p.y & 0xffff0000u); } }
    for (int hf = 0; hf < 2; ++hf) {
        const int rh = r0 + 64 * hf;
        __syncthreads();
        { const int d = F.tid & 127, sq = F.tid >> 7; const float oml = 1.0f - LB[h * 128 + d];
          float kin[16], bcum[16]; float bb = 0.f;
#pragma unroll
          for (int t = 0; t < 16; ++t) { const size_t ix = (size_t)(rh + 16 * sq + t) * 1024 + h * 128 + d; const float z = Z[ix]; const float q = bf2f(HQ[ix]);
              kin[t] = oml * __builtin_amdgcn_rcpf(1.0f + __expf(z)); bb += __logf(1.0f - kin[t]); bcum[t] = bb;
              QP[(16 * sq + t) * TP + d] = (bf16)f2bf(q * __expf(bb)); KP[(16 * sq + t) * TP + d] = (bf16)f2bf(kin[t] * __expf(fminf(-bb, 80.0f))); }
          E15[sq * 128 + d] = __expf(bb);
          float v[8];
#pragma unroll
          for (int t = 0; t < 8; ++t) v[t] = kin[t] * __expf(bb - bcum[t]);
          *(LAS bf16x8*)&KU[d * 72 + 16 * sq] = pack_f8(v);
#pragma unroll
          for (int t = 0; t < 8; ++t) v[t] = kin[8 + t] * __expf(bb - bcum[8 + t]);
          *(LAS bf16x8*)&KU[d * 72 + 16 * sq + 8] = pack_f8(v); }
#pragma unroll
        for (int i = 0; i < 2; ++i) { const int u = F.tid + 512 * i, e0 = (u & 15) * 8, m = u >> 4;
            const v4u a = *(const v4u*)(HI + (size_t)(rh + m) * 1024 + h * 128 + e0);
            LAS bf16* vt = VT + tsw64(e0, m);
#pragma unroll
            for (int j = 0; j < 8; ++j) vt[j * 72] = (bf16)((a[j >> 1] >> (16 * (j & 1))) & 0xffffu); }
        __syncthreads();
        const bf16x8 zero8 = (bf16x8){0, 0, 0, 0, 0, 0, 0, 0};
#pragma unroll
        for (int sq = 0; sq < 4; ++sq) {
            f32x4 at = (f32x4){0.f, 0.f, 0.f, 0.f};
#pragma unroll
            for (int ks = 0; ks < 4; ++ks) { const bf16x8 kf = *(const LAS bf16x8*)&KP[(16 * sq + l15) * TP + 32 * ks + 8 * g], qf = *(const LAS bf16x8*)&QP[(16 * sq + l15) * TP + 32 * ks + 8 * g]; at = MFMA16(kf, qf, at); }
            float pv[8];
#pragma unroll
            for (int reg = 0; reg < 4; ++reg) { pv[reg] = (4 * g + reg) <= l15 ? at[reg] : 0.f; pv[4 + reg] = 0.f; }
            const bf16x8 pfr = pack_f8(pv);
            f32x4 o;
            { const bf16x4v lo = *(const LAS bf16x4v*)&VT[tsw64(16 * w + l15, 16 * sq + 4 * g)]; const bf16x8 vf = __builtin_shufflevector(lo, (bf16x4v){0, 0, 0, 0}, 0, 1, 2, 3, 4, 5, 6, 7);
              const f32x4 z4 = {0.f, 0.f, 0.f, 0.f}; o = MFMA16(pfr, vf, z4); }
#pragma unroll
            for (int ks = 0; ks < 4; ++ks) { float sv[8];
#pragma unroll
                for (int jj = 0; jj < 8; ++jj) sv[jj] = S[2 * ks + (jj >> 2)][jj & 3];
                const bf16x8 sf = pack_f8(sv);
                const LAS bf16* qp = &QP[(16 * sq + l15) * TP + 32 * ks + 4 * g]; const bf16x4v lo = *(const LAS bf16x4v*)qp, hi = *(const LAS bf16x4v*)(qp + 16);
                const bf16x8 qf = __builtin_shufflevector(lo, hi, 0, 1, 2, 3, 4, 5, 6, 7); o = MFMA16(qf, sf, o); }
#pragma unroll
            for (int reg = 0; reg < 4; ++reg) OB[(16 * sq + 4 * g + reg) * 132 + 16 * w + l15] = o[reg];
            const bf16x8 vu = g < 2 ? *(const LAS bf16x8*)&VT[tsw64(16 * w + l15, 16 * sq + 8 * g)] : zero8;
#pragma unroll
            for (int dt = 0; dt < 8; ++dt) { const f32x4 ed = *(const LAS f32x4*)&E15[sq * 128 + 16 * dt + 4 * g];
                const bf16x8 kf = g < 2 ? *(const LAS bf16x8*)&KU[(16 * dt + l15) * 72 + 16 * sq + 8 * g] : zero8;
                S[dt] = MFMA16(kf, vu, S[dt] * ed); }
        }
        __syncthreads();
        { const bf16* HG = (const bf16*)(ws + WS_HG); bf16* OH = (bf16*)(ws + WS_OH);
#pragma unroll
          for (int i = 0; i < 8; ++i) { const int t = 8 * w + i; const float v0 = OB[t * 132 + F.lane], v1 = OB[t * 132 + 64 + F.lane];
              const float rr = 1.0f / sqrtf(wave_sum(v0 * v0 + v1 * v1) * (1.0f / 128.0f) + EPS); const size_t ix = (size_t)(rh + t) * 1024 + h * 128 + F.lane;
              OH[ix] = (bf16)f2bf(v0 * rr * A.in[10][F.lane] * bf2f(HG[ix])); OH[ix + 64] = (bf16)f2bf(v1 * rr * A.in[10][64 + F.lane] * bf2f(HG[ix + 64])); } }
    }
}
__device__ __forceinline__ void p4_phase(Frame& F, const Args& A) {
    for (int rep = 0; rep < (PROBE_SUB == 40 ? 2 : 1); ++rep) for (int it = F.vcu; it < 512; it += F.G) p4_ret_item(F, it);
    for (int rep = 0; rep < (PROBE_SUB == 41 ? 2 : 1); ++rep) for (int it = F.vcu; it < 512; it += F.G) p4_hg_item(F, A, it);
}
namespace mini {
using pg8::bf16_t; using pg8::u32x2; using pg8::silu4; using pg8::sigm4; using pg8::pack4; using pg8::unpack4;
constexpr int AP = 136;
template <bool TWO> __device__ __forceinline__ void core(Frame& F, const bf16_t* A, int lda, int K, const bf16_t* bp0, const bf16_t* bp1, f32x4 (&acc0)[8], f32x4 (&acc1)[8]) {
    LAS bf16* AS = (LAS bf16*)F.lds; const int l15 = F.lane & 15, g = F.lane >> 4; const int nch = K >> 7; int cc = F.vcu % nch;
    v4u pre[4]; bf16x8 b0[4], b1[4];
    const int prow = F.tid >> 4, pc = (F.tid & 15) * 8;
#pragma unroll
    for (int i = 0; i < 4; ++i) pre[i] = *(const v4u*)(A + (size_t)(prow + 32 * i) * lda + cc * 128 + pc);
    if (bp0) {
#pragma unroll
        for (int u = 0; u < 4; ++u) { b0[u] = *(const bf16x8*)(bp0 + cc * 128 + 32 * u); if (TWO) b1[u] = *(const bf16x8*)(bp1 + cc * 128 + 32 * u); } }
    __syncthreads();
    for (int c = 0; c < nch; ++c) {
        LAS bf16* buf = AS + (c & 1) * (128 * AP);
#pragma unroll
        for (int i = 0; i < 4; ++i) *(LAS v4u*)&buf[(prow + 32 * i) * AP + pc] = pre[i];
        bf16x8 c0[4], c1[4];
#pragma unroll
        for (int u = 0; u < 4; ++u) { c0[u] = b0[u]; if (TWO) c1[u] = b1[u]; }
        cc = cc + 1 == nch ? 0 : cc + 1;
        if (c + 1 < nch) {
#pragma unroll
            for (int i = 0; i < 4; ++i) pre[i] = *(const v4u*)(A + (size_t)(prow + 32 * i) * lda + cc * 128 + pc);
            if (bp0) {
#pragma unroll
                for (int u = 0; u < 4; ++u) { b0[u] = *(const bf16x8*)(bp0 + cc * 128 + 32 * u); if (TWO) b1[u] = *(const bf16x8*)(bp1 + cc * 128 + 32 * u); } } }
        __syncthreads();
        if (bp0) {
#pragma unroll
            for (int u = 0; u < 4; ++u)
#pragma unroll
                for (int rt = 0; rt < 8; ++rt) { const bf16x8 a = *(const LAS bf16x8*)&buf[(16 * rt + l15) * AP + 32 * u + 8 * g];
                    acc0[rt] = __builtin_amdgcn_mfma_f32_16x16x32_bf16(c0[u], a, acc0[rt], 0, 0, 0); if (TWO) acc1[rt] = __builtin_amdgcn_mfma_f32_16x16x32_bf16(c1[u], a, acc1[rt], 0, 0, 0); } }
    }
}
#define MINI_ZERO(acc) _Pragma("unroll") for (int _i = 0; _i < 8; ++_i) acc[_i] = (f32x4){0.f, 0.f, 0.f, 0.f}
__device__ __forceinline__ void inproj(Frame& F) {
    unsigned char* ws = F.ws; const int l15 = F.lane & 15, g = F.lane >> 4;
    if (F.vcu >= NIN / 16) return;
    const int t = F.vcu + F.G * F.wave; const bool has = t < NIN / 16; const int n0 = 16 * t;
    f32x4 acc[8]; MINI_ZERO(acc);
    core<false>(F, (const bf16_t*)(ws + WS_XB) + 8192ull * 2048, 2048, 2048, has ? (const bf16_t*)(ws + WS_WIN) + (size_t)(n0 + l15) * 2048 + 8 * g : nullptr, nullptr, acc, acc);
    if (!has) return;
    const int c = n0 + 4 * g;
    if (c >= 7168 && c < 8192) {
#pragma unroll
        for (int rt = 0; rt < 8; ++rt) *(f32x4*)((float*)(ws + WS_LOGF) + (size_t)(8192 + 16 * rt + l15) * 1024 + (c - 7168)) = acc[rt];
        return; }
    size_t od; int pitch, c0, act; float sc = 1.0f;
    if (c < 1024) { od = WS_Q; pitch = 1024; c0 = 0; act = 0; } else if (c < 2048) { od = WS_K; pitch = 1024; c0 = 1024; act = 0; sc = 0.08838834764831845f; }
    else if (c < 4096) { od = WS_V; pitch = 2048; c0 = 2048; act = 0; } else if (c < 6144) { od = WS_RG; pitch = 2048; c0 = 4096; act = 1; } else if (c < 7168) { od = WS_HQ; pitch = 1024; c0 = 6144; act = 1; }
    else if (c < 9216) { od = WS_HI; pitch = 1024; c0 = 8192; act = 0; } else if (c < 10240) { od = WS_HG; pitch = 1024; c0 = 9216; act = 1; } else if (c < 12288) { od = WS_GA; pitch = 2048; c0 = 10240; act = 2; } else { od = WS_GB; pitch = 2048; c0 = 12288; act = 2; }
#pragma unroll
    for (int rt = 0; rt < 8; ++rt) { f32x4 v = acc[rt] * sc; if (act == 1) v = silu4(v); else if (act == 2) v = sigm4(v);
        *(u32x2*)((bf16_t*)(ws + od) + (size_t)(8192 + 16 * rt + l15) * pitch + (c - c0)) = pack4(v); }
}
__device__ __forceinline__ void outproj(Frame& F) {
    unsigned char* ws = F.ws; const int l15 = F.lane & 15, g = F.lane >> 4;
    if (F.vcu >= 128) return;
    const int t = F.vcu + F.G * F.wave; const bool has = t < 128; const int n0 = 16 * t;
    f32x4 ya[8], yb[8]; MINI_ZERO(ya); MINI_ZERO(yb);
    core<false>(F, (const bf16_t*)(ws + WS_OR) + 8192ull * 2048, 2048, 2048, has ? (const bf16_t*)(ws + WS_WRO) + (size_t)(n0 + l15) * 2048 + 8 * g : nullptr, nullptr, ya, ya);
    core<false>(F, (const bf16_t*)(ws + WS_OH) + 8192ull * 1024, 1024, 1024, has ? (const bf16_t*)(ws + WS_WHO) + (size_t)(n0 + l15) * 1024 + 8 * g : nullptr, nullptr, yb, yb);
    if (!has) return;
#pragma unroll
    for (int rt = 0; rt < 8; ++rt) { const size_t ix = (size_t)(8192 + 16 * rt + l15) * 2048 + n0 + 4 * g;
        const f32x4 ga = unpack4(*(const u32x2*)((const bf16_t*)(ws + WS_GA) + ix)), gb = unpack4(*(const u32x2*)((const bf16_t*)(ws + WS_GB) + ix));
        *(u32x2*)((bf16_t*)(ws + WS_MG) + ix) = pack4(ga * ya[rt] + gb * yb[rt]); }
}
__device__ __forceinline__ void resid(Frame& F, const bf16_t* Arows  , const bf16_t* Bt, int K, const float* XI  , float* XO  , bf16_t* XBo  , float* SS  ) {
    const int l15 = F.lane & 15, g = F.lane >> 4;
    if (F.vcu >= 128) return;
    const int t = F.vcu + F.G * F.wave; const bool has = t < 128; const int n0 = 16 * t;
    f32x4 acc[8]; MINI_ZERO(acc);
    core<false>(F, Arows, K, K, has ? Bt + (size_t)(n0 + l15) * K + 8 * g : nullptr, nullptr, acc, acc);
    if (!has) return;
#pragma unroll
    for (int rt = 0; rt < 8; ++rt) { const int rl = 16 * rt + l15; const size_t ix = (size_t)rl * 2048 + n0 + 4 * g;
        f32x4 v = acc[rt] + *(const f32x4*)(XI + ix); *(f32x4*)(XO + ix) = v;
        if (XBo) *(u32x2*)(XBo + ix) = pack4(v);
        float ss = (v[0] * v[0] + v[1] * v[1]) + (v[2] * v[2] + v[3] * v[3]); ss += __shfl_xor(ss, 16); ss += __shfl_xor(ss, 32);
        if (g == 0) atomicAdd(SS + rl, ss); }
}
__device__ __forceinline__ void swiglu(Frame& F) {
    unsigned char* ws = F.ws; const int l15 = F.lane & 15, g = F.lane >> 4;
    const int t = F.vcu + F.G * F.wave; const bool has = t < DFF / 16; const int ng = ((16 * t) >> 7) * 256 + ((16 * t) & 127);
    f32x4 ag[8], au[8]; MINI_ZERO(ag); MINI_ZERO(au);
    const bf16_t* A = (const bf16_t*)(ws + WS_X1B) + 8192ull * 2048;
    const bf16_t* bg = has ? (const bf16_t*)(ws + WS_WFI) + (size_t)(ng + l15) * 2048 + 8 * g : nullptr;
    core<true>(F, A, 2048, 2048, bg, has ? bg + 128 * 2048 : nullptr, ag, au);
    if (!has) return;
    const float* SS1 = (const float*)(F.ctl + CW_SS1);
#pragma unroll
    for (int rt = 0; rt < 8; ++rt) { const int r = 8192 + 16 * rt + l15; const float r2 = 1.0f / sqrtf(SS1[r] * (1.0f / 2048.0f) + EPS);
        *(u32x2*)((bf16_t*)(ws + WS_ACT) + (size_t)r * DFF + 16 * t + 4 * g) = pack4(silu4(ag[rt] * r2) * (au[rt] * r2)); }
}
}
__global__ void __launch_bounds__(NWAVES * 64, 2) mk_fwd(Args args) {
    extern __shared__ __attribute__((aligned(16))) unsigned char lds[];
    Frame F;
    F.lds = (LAS unsigned char*)lds; F.MISC = (volatile LAS unsigned*)(F.lds + MISC_OFF);
    F.tid = threadIdx.x; F.lane = F.tid & 63; F.wave = __builtin_amdgcn_readfirstlane(F.tid >> 6);
    F.G = gridDim.x; { const int bx = blockIdx.x; F.vcu = (F.G % 8 == 0) ? (bx % 8) * (F.G / 8) + bx / 8 : bx; }
    F.ws = args.ws; F.out = args.out; F.ctl = (gu32*)(args.ws + WS_CTL);
    for (int u = F.tid; u < (LDS_BYTES - LDSCTL_OFF) / 4; u += NWAVES * 64) ((LAS unsigned*)(F.lds + LDSCTL_OFF))[u] = 0u;
    __syncthreads();
    XcdBarrier bar; bar.bar = (unsigned*)(F.ctl + CW_BAR); bar.x = 0; bar.st = nullptr;
    if (args.use_bar) bar = xcd_barrier_post((unsigned*)(F.ctl + CW_BAR), F.MISC + 8);
    const int lo = args.ph_lo, hi = args.ph_hi;
#define IN(k) (lo <= (k) && (k) < hi)
#define SEAM(k) do { if (IN(k) && IN((k) + 1)) xcd_barrier(bar); } while (0)
#ifndef PROBE_REPEAT
#define PROBE_REPEAT -1
#endif
#define NREP(k) ((PROBE_REPEAT == (k)) ? 2 : 1)
    unsigned char* ws = args.ws;
    if (PROBE_REPEAT == 0) { p0_prologue(F, args); xcd_barrier(bar); }
    if (IN(0)) { p0_prologue(F, args); } SEAM(0);
#define P1_BODY { \
        pg8::Gemm g{(const pg8::bf16_t*)(ws + WS_XB), (const pg8::bf16_t*)(ws + WS_WIN), 8192, NIN, 2048}; pg8::StaticOrder S; S.init(8192, NIN, F.G, (int)blockIdx.x); \
        pg8::EpiInProj E{ws}; \
        pg8::gemm_phase<pg8::EpiInProj, pg8::StaticOrder, true, true>(F.lds, g, S, E); mini::inproj(F); }
    if (PROBE_REPEAT == 1) { P1_BODY xcd_barrier(bar); }
    if (IN(1)) P1_BODY SEAM(1);
    if (PROBE_REPEAT == 2) { p2_phase(F, args); xcd_barrier(bar); }
    if (IN(2)) { p2_phase(F, args); } SEAM(2);
    if (PROBE_REPEAT == 3) { p4_phase(F, args); xcd_barrier(bar); }
    if (IN(3)) { p4_phase(F, args); } SEAM(3);
    if (IN(4)) {
        { pg8::Gemm g{(const pg8::bf16_t*)(ws + WS_OR), (const pg8::bf16_t*)(ws + WS_WRO), 8192, 2048, 2048}; pg8::StaticOrder S; S.init(8192, 2048, F.G, (int)blockIdx.x);
          pg8::EpiGate<0> E{(const pg8::bf16_t*)(ws + WS_GA), (float*)(ws + WS_YT), (pg8::bf16_t*)(ws + WS_MG)};
          pg8::gemm_phase<pg8::EpiGate<0>, pg8::StaticOrder, true, true>(F.lds, g, S, E); }
        { pg8::Gemm g{(const pg8::bf16_t*)(ws + WS_OH), (const pg8::bf16_t*)(ws + WS_WHO), 8192, 2048, 1024}; pg8::StaticOrder S; S.init(8192, 2048, F.G, (int)blockIdx.x);
          pg8::EpiGate<1> E{(const pg8::bf16_t*)(ws + WS_GB), (float*)(ws + WS_YT), (pg8::bf16_t*)(ws + WS_MG)};
          pg8::gemm_phase<pg8::EpiGate<1>, pg8::StaticOrder, true, true>(F.lds, g, S, E); }
        mini::outproj(F);
    } SEAM(4);
    if (IN(5)) {
        pg8::Gemm g{(const pg8::bf16_t*)(ws + WS_MG), (const pg8::bf16_t*)(ws + WS_WOUT), 8192, 2048, 2048}; pg8::StaticOrder S; S.init(8192, 2048, F.G, (int)blockIdx.x);
        pg8::EpiResid E{args.in[0], args.in[1], args.out, (pg8::bf16_t*)(ws + WS_X1B), (float*)(F.ctl + CW_SS1)};
        pg8::gemm_phase<pg8::EpiResid, pg8::StaticOrder, true, true>(F.lds, g, S, E);
        mini::resid(F, (const pg8::bf16_t*)(ws + WS_MG) + 8192ull * 2048, (const pg8::bf16_t*)(ws + WS_WOUT), 2048, args.in[1], args.out + OUT_YS, (pg8::bf16_t*)(ws + WS_X1B) + 8192ull * 2048, (float*)(F.ctl + CW_SS1) + 8192);
    } SEAM(5);
    if (IN(6)) {
        pg8::Gemm g{(const pg8::bf16_t*)(ws + WS_X1B), (const pg8::bf16_t*)(ws + WS_WFI), 8192, 2 * DFF, 2048}; pg8::StaticOrder S; S.init(8192, 2 * DFF, F.G, (int)blockIdx.x);
        pg8::EpiSwiglu E{(const float*)(F.ctl + CW_SS1), (pg8::bf16_t*)(ws + WS_ACT)};
        pg8::gemm_phase<pg8::EpiSwiglu, pg8::StaticOrder, true, true>(F.lds, g, S, E);
        mini::swiglu(F);
    } SEAM(6);
    if (IN(7)) {
        pg8::Gemm g{(const pg8::bf16_t*)(ws + WS_ACT), (const pg8::bf16_t*)(ws + WS_WFO), 8192, 2048, DFF}; pg8::StaticOrder S; S.init(8192, 2048, F.G, (int)blockIdx.x);
        pg8::EpiResid E{args.out, args.out + OUT_YS, args.out, nullptr, (float*)(F.ctl + CW_SS2)};
        pg8::gemm_phase<pg8::EpiResid, pg8::StaticOrder, true, true>(F.lds, g, S, E);
        mini::resid(F, (const pg8::bf16_t*)(ws + WS_ACT) + 8192ull * DFF, (const pg8::bf16_t*)(ws + WS_WFO), DFF, args.out + OUT_YS, args.out + OUT_YS, nullptr, (float*)(F.ctl + CW_SS2) + 8192);
    } SEAM(7);
    if (IN(8)) {
        const int gw = F.vcu * NWAVES + F.wave, NGW = F.G * NWAVES; const float* SS2 = (const float*)(F.ctl + CW_SS2);
        for (int m = gw; m < MROWS; m += NGW) { f32x4* xr = (f32x4*)(args.out + (size_t)m * 2048) + F.lane; const f32x4* gn = (const f32x4*)args.in[14] + F.lane;
            const float rr = 1.0f / sqrtf(SS2[m] * (1.0f / 2048.0f) + EPS);
#pragma unroll
            for (int j = 0; j < 8; ++j) xr[64 * j] = xr[64 * j] * rr * gn[64 * j]; }
    }
#undef IN
#undef SEAM
}
extern "C" void kernel_launch(void* const* d_in, const int* in_sizes, int n_in, void* d_out, int out_size, void* d_ws, size_t ws_size, hipStream_t stream) {
    static int grid = 0;
    if (grid == 0) {
        int dev = 0, cus = 0;
        if (ws_size < WS_END || n_in != 15) { fprintf(stderr, "kernel_launch: unexpected sizes (ws %zu, n_in %d)\n", ws_size, n_in); grid = -1; return; }
        if (hipGetDevice(&dev) != hipSuccess || hipDeviceGetAttribute(&cus, hipDeviceAttributeMultiprocessorCount, dev) != hipSuccess) { grid = -1; return; }
        if (hipFuncSetAttribute((const void*)mk_fwd, hipFuncAttributeMaxDynamicSharedMemorySize, LDS_BYTES) != hipSuccess) { fprintf(stderr, "kernel_launch: hipFuncSetAttribute failed\n"); grid = -1; return; }
        int per_cu = 0; (void)hipOccupancyMaxActiveBlocksPerMultiprocessor(&per_cu, (const void*)mk_fwd, NWAVES * 64, LDS_BYTES); (void)hipGetLastError();
        if (per_cu < 1) { fprintf(stderr, "kernel_launch: occupancy query says %d blocks per CU; nothing launched\n", per_cu); grid = -1; return; }
        grid = cus;
    }
    if (grid < 0) return;
    (void)hipMemsetAsync((char*)d_ws + WS_CTL, 0, CTL_ZERO_BYTES, stream);
    Args a{};
    for (int i = 0; i < 15; ++i) a.in[i] = (const float*)d_in[i];
    a.out = (float*)d_out; a.ws = (unsigned char*)d_ws; a.use_bar = 1; a.ph_lo = 0; a.ph_hi = 9;
    hipLaunchKernelGGL(mk_fwd, dim3(grid), dim3(NWAVES * 64), LDS_BYTES, stream, a);
}
```

```cpp
#include <hip/hip_runtime.h>
#include <cstdio>
#include <cstdint>
constexpr int DMODEL = 2048, MROWS = 8320, MPAD = 8448, NIN = 14336, DFF = 5632, NWAVES = 8;
constexpr float EPS = 1e-6f;
constexpr size_t MiB = 1u << 20;
constexpr size_t WS_CTL = 0, CTL_ZERO_BYTES = 1 * MiB;
constexpr size_t WS_WRO = 1 * MiB, WS_WHO = 9 * MiB, WS_WOUT = 13 * MiB, WS_WFI = 21 * MiB, WS_WFO = 65 * MiB, WS_WIN = 87 * MiB;
constexpr size_t WS_XB = 143 * MiB;
constexpr size_t WS_Q = 176 * MiB, WS_K = WS_Q + 8448ull * 1024 * 2, WS_V = 209 * MiB, WS_RG = 242 * MiB, WS_HQ = 275 * MiB, WS_LOGF = WS_HQ + 8448ull * 1024 * 2;
constexpr size_t WS_HI = WS_LOGF + 8448ull * 1024 * 4, WS_HG = WS_HI + 8448ull * 1024 * 2, WS_GA = WS_HG + 8448ull * 1024 * 2, WS_GB = WS_GA + 8448ull * 2048 * 2;
constexpr size_t WS_KVLOC = WS_GB + 8448ull * 2048 * 2;
constexpr size_t WS_HSLOC = WS_KVLOC + 64 * MiB;
constexpr size_t WS_OH = WS_HSLOC + 32 * MiB;
constexpr size_t WS_MISC = WS_OH + 8448ull * 1024 * 2;
constexpr size_t WS_RR1 = WS_MISC, WS_COS = WS_RR1 + 64 * 1024, WS_SIN = WS_COS + 2049 * 64 * 4 + 256, WS_LB = WS_SIN + 2049 * 64 * 4 + 256, WS_BTOT = WS_LB + 4096, WS_END = WS_BTOT + 512 * 128 * 4;
constexpr size_t WS_OR = WS_XB;
constexpr size_t WS_SRT = WS_WIN, WS_SHT = WS_WIN + 32 * MiB;
constexpr size_t WS_YT = WS_KVLOC;
constexpr size_t WS_MG = WS_Q;
constexpr size_t WS_X1B = WS_V;
constexpr size_t WS_ACT = WS_RG;
static_assert(WS_GB + 8448ull * 2048 * 2 == WS_KVLOC && WS_K + 8448ull * 1024 * 2 == WS_V && WS_V + 8448ull * 2048 * 2 == WS_RG && WS_RG + 8448ull * 2048 * 2 == WS_HQ, "map");
static_assert(WS_YT + 8448ull * 2048 * 4 <= WS_OH && WS_ACT + 8448ull * 5632 * 2 <= WS_GA && WS_END <= 541 * MiB, "map2");
constexpr int CW_BAR = 4096;
constexpr int CW_SS1 = 16384, CW_SS2 = 16384 + 8448;
static_assert((CW_SS2 + 8448) * 4 <= (int)CTL_ZERO_BYTES, "ctl");
constexpr int RING_BYTES = 131072, LDSCTL_OFF = RING_BYTES, MISC_OFF = LDSCTL_OFF + 320, LDS_BYTES = 147456;

#define GAS __attribute__((address_space(1)))
#define LAS __attribute__((address_space(3)))
typedef unsigned short bf16;
typedef unsigned v4u __attribute__((ext_vector_type(4)));
typedef unsigned v2u __attribute__((ext_vector_type(2)));
typedef float f32x4 __attribute__((ext_vector_type(4)));
typedef short bf16x8 __attribute__((ext_vector_type(8)));
typedef GAS unsigned gu32;
#define RLX_AGENT __ATOMIC_RELAXED, __HIP_MEMORY_SCOPE_AGENT
#define LDS_WAIT() asm volatile("s_waitcnt lgkmcnt(0)" ::: "memory")
#define VM_WAIT() asm volatile("s_waitcnt vmcnt(0)" ::: "memory")
__device__ __forceinline__ unsigned f2bf(float f) { unsigned u = __builtin_bit_cast(unsigned, f); return (u + 0x7fffu + ((u >> 16) & 1u)) >> 16; }
__device__ __forceinline__ unsigned pk2(float lo, float hi) { return f2bf(lo) | (f2bf(hi) << 16); }
__device__ __forceinline__ float bf2f(unsigned short b) { return __uint_as_float(((unsigned)b) << 16); }
namespace pg8 {
#define PG8_LAS __attribute__((address_space(3)))
typedef unsigned short bf16_t;
typedef short bf16x8 __attribute__((ext_vector_type(8)));
typedef float f32x4 __attribute__((ext_vector_type(4)));
typedef unsigned u32x4 __attribute__((ext_vector_type(4)));
constexpr int BM = 256, BK = 64, HALF = 128, HTB = HALF * BK * 2  , STAGE_BYTES = 8 * HTB, NXCD = 8, WGM = 8;

__host__ __device__ __forceinline__ int lds_byte(int r, int c) { const int st = (r >> 4) * 2 + (c >> 5), rr = r & 15, cc = c & 31, ob = rr * 64 + cc * 2; return st * 1024 + (ob ^ (((ob >> 9) & 1) << 5)); }
__host__ __device__ __forceinline__ void stage_rc(int b, int& R, int& C) { const int st = b / 1024, sb = b % 1024, swz = sb ^ (((sb >> 9) & 1) << 5); R = (st >> 1) * 16 + swz / 64; C = (st & 1) * 32 + (swz % 64) / 2; }
__host__ __device__ __forceinline__ int perm32(int rho) { const int n = rho >> 4, i = rho & 15; return 8 * (i >> 2) + 4 * n + (i & 3); }

struct Unit { int pm, pn; };
struct Gemm { const bf16_t* A; const bf16_t* Bt; int M, N, K; };

struct StaticOrder {
    int nM, nN, nwg, G, c;
    __host__ __device__ void init(int M, int N, int G_, int c_) { nM = M / BM; nN = N / BM; nwg = nM * nN; G = G_; c = c_; }
    __host__ __device__ bool next(int i, Unit& u) const {
        const long L = (long)i * G + c; if (L >= nwg) return false;
        int wgid = (int)L; { const int q = nwg / NXCD, r = nwg % NXCD, xcd = wgid % NXCD, off = wgid / NXCD; wgid = (xcd < r ? xcd * (q + 1) : r * (q + 1) + (xcd - r) * q) + off; }
        const int nig = WGM * nN, gid = wgid / nig, fm = gid * WGM, gsz = (nM - fm) < WGM ? (nM - fm) : WGM;
        u.pm = fm + ((wgid % nig) % gsz); u.pn = (wgid % nig) / gsz; return true;
    }
    __device__ __forceinline__ void a_ready(const Unit&) const {}
    __device__ __forceinline__ void done(const Unit&) const {}
};

__device__ __forceinline__ unsigned cvt_pk_bf16(float lo, float hi) { unsigned r; asm volatile("v_cvt_pk_bf16_f32 %0, %1, %2" : "=v"(r) : "v"(lo), "v"(hi)); return r; }
typedef float f32x2 __attribute__((ext_vector_type(2)));
typedef unsigned u32x2 __attribute__((ext_vector_type(2)));
__device__ __forceinline__ float sigm(float x) { return __builtin_amdgcn_rcpf(1.0f + __expf(-x)); }
__device__ __forceinline__ f32x4 silu4(f32x4 v) { f32x4 o; o[0] = v[0] * sigm(v[0]); o[1] = v[1] * sigm(v[1]); o[2] = v[2] * sigm(v[2]); o[3] = v[3] * sigm(v[3]); return o; }
__device__ __forceinline__ f32x4 sigm4(f32x4 v) { f32x4 o; o[0] = sigm(v[0]); o[1] = sigm(v[1]); o[2] = sigm(v[2]); o[3] = sigm(v[3]); return o; }
__device__ __forceinline__ u32x4 pack8(f32x4 v0, f32x4 v1) { u32x4 w; w.x = cvt_pk_bf16(v0[0], v0[1]); w.y = cvt_pk_bf16(v0[2], v0[3]); w.z = cvt_pk_bf16(v1[0], v1[1]); w.w = cvt_pk_bf16(v1[2], v1[3]); return w; }
__device__ __forceinline__ u32x2 pack4(f32x4 v) { u32x2 w; w.x = cvt_pk_bf16(v[0], v[1]); w.y = cvt_pk_bf16(v[2], v[3]); return w; }
__device__ __forceinline__ f32x4 unpack4(u32x2 w) { f32x4 o; o[0] = __uint_as_float(w.x << 16); o[1] = __uint_as_float(w.x & 0xffff0000u); o[2] = __uint_as_float(w.y << 16); o[3] = __uint_as_float(w.y & 0xffff0000u); return o; }

struct EpiInProj {
    static constexpr bool PERM = true, AFTER_DRAIN = false;
    unsigned char* ws;
    __device__ __forceinline__ void operator()(const f32x4 (&acc)[2][2][4][2], const Unit& u, int wr, int wc, int fr, int fq) const {
        const int pn = u.pn, row0 = u.pm * BM + wr * 64 + fr;
        if (pn >= 28 && pn < 32) {
            float* Z = (float*)(ws + WS_LOGF); const int cs = (pn - 28) * 256 + wc * 32 + 8 * fq;
#pragma unroll
            for (int ai = 0; ai < 2; ++ai)
#pragma unroll
                for (int m = 0; m < 4; ++m) { const int r = row0 + ai * HALF + m * 16;
#pragma unroll
                    for (int bj = 0; bj < 2; ++bj)
#pragma unroll
                        for (int n = 0; n < 2; ++n) *(f32x4*)(Z + (size_t)r * 1024 + cs + bj * HALF + 4 * n) = acc[ai][bj][m][n]; }
        } else {
            size_t od; int pitch, p0, act; float sc = 1.0f;
            if (pn < 4) { od = WS_Q; pitch = 1024; p0 = 0; act = 0; } else if (pn < 8) { od = WS_K; pitch = 1024; p0 = 4; act = 0; sc = 0.08838834764831845f; }
            else if (pn < 16) { od = WS_V; pitch = 2048; p0 = 8; act = 0; } else if (pn < 24) { od = WS_RG; pitch = 2048; p0 = 16; act = 1; } else if (pn < 28) { od = WS_HQ; pitch = 1024; p0 = 24; act = 1; }
            else if (pn < 36) { od = WS_HI; pitch = 1024; p0 = 32; act = 0; } else if (pn < 40) { od = WS_HG; pitch = 1024; p0 = 36; act = 1; } else if (pn < 48) { od = WS_GA; pitch = 2048; p0 = 40; act = 2; } else { od = WS_GB; pitch = 2048; p0 = 48; act = 2; }
            bf16_t* dst = (bf16_t*)(ws + od);
            const int cs = (pn - p0) * 256 + wc * 32 + 8 * fq;
#pragma unroll
            for (int ai = 0; ai < 2; ++ai)
#pragma unroll
                for (int m = 0; m < 4; ++m) { const int r = row0 + ai * HALF + m * 16; bf16_t* rowp = dst + (size_t)r * pitch + cs;
#pragma unroll
                    for (int bj = 0; bj < 2; ++bj) { f32x4 v0 = acc[ai][bj][m][0] * sc, v1 = acc[ai][bj][m][1] * sc;
                        if (act == 1) { v0 = silu4(v0); v1 = silu4(v1); } else if (act == 2) { v0 = sigm4(v0); v1 = sigm4(v1); }
                        *(u32x4*)(rowp + bj * HALF) = pack8(v0, v1); } }
        }
    }
};
template <int SECOND> struct EpiGate {
    static constexpr bool PERM = true, AFTER_DRAIN = false;
    const bf16_t* G; float* YT; bf16_t* MG;
    __device__ __forceinline__ void operator()(const f32x4 (&acc)[2][2][4][2], const Unit& u, int wr, int wc, int fr, int fq) const {
        const int row0 = u.pm * BM + wr * 64 + fr, col0 = u.pn * BM + wc * 32 + 8 * fq;
#pragma unroll
        for (int ai = 0; ai < 2; ++ai)
#pragma unroll
            for (int m = 0; m < 4; ++m) { const size_t off = (size_t)(row0 + ai * HALF + m * 16) * 2048 + col0;
#pragma unroll
                for (int bj = 0; bj < 2; ++bj) { const u32x4 gw = *(const u32x4*)(G + off + bj * HALF);
                    f32x4 v0 = acc[ai][bj][m][0] * unpack4((u32x2){gw.x, gw.y}), v1 = acc[ai][bj][m][1] * unpack4((u32x2){gw.z, gw.w});
                    float* yp = YT + off + bj * HALF;
                    if (SECOND) { v0 += *(const f32x4*)yp; v1 += *(const f32x4*)(yp + 4); *(u32x4*)(MG + off + bj * HALF) = pack8(v0, v1); }
                    else { *(f32x4*)yp = v0; *(f32x4*)(yp + 4) = v1; } } }
        __builtin_amdgcn_s_waitcnt(0x0F70);
    }
};
struct EpiResid {
    static constexpr bool PERM = true, AFTER_DRAIN = false;
    const float* XP; const float* XS; float* OUT; bf16_t* XB; float* SS;
    __device__ __forceinline__ void operator()(const f32x4 (&acc)[2][2][4][2], const Unit& u, int wr, int wc, int fr, int fq) const {
        const int row0 = u.pm * BM + wr * 64 + fr, col0 = u.pn * BM + wc * 32 + 8 * fq;
#pragma unroll
        for (int ai = 0; ai < 2; ++ai)
#pragma unroll
            for (int m = 0; m < 4; ++m) { const int r = row0 + ai * HALF + m * 16; const bool live = r < 8320;
                const float* xi = (r < 8192 ? XP + (size_t)r * 2048 : XS + (size_t)(r - 8192) * 2048) + col0; float ss = 0.f;
#pragma unroll
                for (int bj = 0; bj < 2; ++bj) { f32x4 v0 = acc[ai][bj][m][0], v1 = acc[ai][bj][m][1];
                    if (live) { v0 += *(const f32x4*)(xi + bj * HALF); v1 += *(const f32x4*)(xi + bj * HALF + 4);
                        float* op = OUT + (size_t)r * 2048 + col0 + bj * HALF; *(f32x4*)op = v0; *(f32x4*)(op + 4) = v1; }
                    if (XB) *(u32x4*)(XB + (size_t)r * 2048 + col0 + bj * HALF) = pack8(v0, v1);
                    ss += (v0[0] * v0[0] + v0[1] * v0[1]) + (v0[2] * v0[2] + v0[3] * v0[3]) + (v1[0] * v1[0] + v1[1] * v1[1]) + (v1[2] * v1[2] + v1[3] * v1[3]); }
                ss += __shfl_xor(ss, 16); ss += __shfl_xor(ss, 32);
                if (fq == 0) atomicAdd(SS + r, ss); }
        __builtin_amdgcn_s_waitcnt(0x0F70);
    }
};
struct EpiSwiglu {
    static constexpr bool PERM = true, AFTER_DRAIN = false;
    const float* SS; bf16_t* ACT;
    __device__ __forceinline__ void operator()(const f32x4 (&acc)[2][2][4][2], const Unit& u, int wr, int wc, int fr, int fq) const {
        const int row0 = u.pm * BM + wr * 64 + fr, col0 = u.pn * HALF + wc * 32 + 8 * fq;
        float ssv[2][4];
#pragma unroll
        for (int ai = 0; ai < 2; ++ai)
#pragma unroll
            for (int m = 0; m < 4; ++m) ssv[ai][m] = SS[row0 + ai * HALF + m * 16];
        __builtin_amdgcn_s_waitcnt(0x0F70);
#pragma unroll
        for (int ai = 0; ai < 2; ++ai)
#pragma unroll
            for (int m = 0; m < 4; ++m) { const int r = row0 + ai * HALF + m * 16; const float r2 = 1.0f / sqrtf(ssv[ai][m] * (1.0f / 2048.0f) + 1e-6f);
                const f32x4 g0 = acc[ai][0][m][0] * r2, g1 = acc[ai][0][m][1] * r2, u0 = acc[ai][1][m][0] * r2, u1 = acc[ai][1][m][1] * r2;
                *(u32x4*)(ACT + (size_t)r * 5632 + col0) = pack8(silu4(g0) * u0, silu4(g1) * u1); }
    }
};
template <class Epi, class Sched, bool ALIGN_EPI = false, bool SP2 = false>
__device__ __forceinline__ void gemm_phase(PG8_LAS unsigned char* lds, const Gemm g, const Sched& S, const Epi& E) {
    const int tid = threadIdx.x, wid = __builtin_amdgcn_readfirstlane(tid >> 6), lane = tid & 63, wr = wid >> 2, wc = wid & 3, fr = lane & 15, fq = lane >> 4;
    const int K = g.K, nt = K / BK;
    unsigned voffA[2], voffB[2];
#pragma unroll
    for (int i = 0; i < 2; ++i) { int R, C; stage_rc(tid * 16 + i * 8192, R, C); const int Rb = Epi::PERM ? ((R & ~31) + perm32(R & 31)) : R;
        voffA[i] = (unsigned)(R * K + C) * 2u; voffB[i] = (unsigned)(Rb * K + C) * 2u; }
    const size_t kstep = (size_t)(BK * 2);
    const size_t hstep = (size_t)HALF * K * 2;
    const size_t tstep = 2 * hstep;
    const unsigned ldsw = (unsigned)wid * 1024u;
    const int aoff = lds_byte(wr * 64 + fr, fq * 8), boff = lds_byte(wc * 32 + fr, fq * 8);
#define PG8_SA(b, h) (((b) * 2 + (h)) * HTB)
#define PG8_SB(b, h) ((4 + (b) * 2 + (h)) * HTB)
#define PG8_STAGE(bufoff, gbase, voff) do { _Pragma("unroll") for (int _i = 0; _i < 2; ++_i) \
        __builtin_amdgcn_global_load_lds((const unsigned*)((const char*)(gbase) + (voff)[_i]), (PG8_LAS unsigned*)(lds + (bufoff) + ldsw + _i * 8192), 16, 0, 0); } while (0)
#define PG8_LDA(dst, b, h) do { _Pragma("unroll") for (int m = 0; m < 4; ++m) _Pragma("unroll") for (int k = 0; k < 2; ++k) dst[m][k] = *(const PG8_LAS bf16x8*)(lds + PG8_SA(b, h) + aoff + m * 2048 + k * 1024); } while (0)
#define PG8_LDB(dst, b, h) do { _Pragma("unroll") for (int n = 0; n < 2; ++n) _Pragma("unroll") for (int k = 0; k < 2; ++k) dst[n][k] = *(const PG8_LAS bf16x8*)(lds + PG8_SB(b, h) + boff + n * 2048 + k * 1024); } while (0)
#define PG8_MMA(ai, bj, At, Bt) do { __builtin_amdgcn_s_setprio(1); _Pragma("unroll") for (int m = 0; m < 4; ++m) _Pragma("unroll") for (int n = 0; n < 2; ++n) _Pragma("unroll") for (int k = 0; k < 2; ++k) \
        acc[ai][bj][m][n] = __builtin_amdgcn_mfma_f32_16x16x32_bf16(Bt[n][k], At[m][k], acc[ai][bj][m][n], 0, 0, 0); __builtin_amdgcn_s_setprio(0); } while (0)
#define PG8_WAIT_V(n) asm volatile("s_waitcnt vmcnt(" #n ")" ::: "memory")
#define PG8_WAIT_L(n) asm volatile("s_waitcnt lgkmcnt(" #n ")" ::: "memory")
#define PG8_BAR __builtin_amdgcn_s_barrier()
#define PG8_SCHED __builtin_amdgcn_sched_barrier(0)
    Unit cur, nxt; int ui = 0;
    if (!S.next(0, cur)) return;
    f32x4 acc[2][2][4][2];
#pragma unroll
    for (int a = 0; a < 2; ++a)
#pragma unroll
        for (int b = 0; b < 2; ++b)
#pragma unroll
            for (int m = 0; m < 4; ++m)
#pragma unroll
                for (int n = 0; n < 2; ++n) acc[a][b][m][n] = (f32x4){0.f, 0.f, 0.f, 0.f};
    bf16x8 At[4][2], B0[2][2], B1[2][2];
    const char* cA = (const char*)g.A + (size_t)cur.pm * tstep; const char* cB = (const char*)g.Bt + (size_t)cur.pn * tstep;
    S.a_ready(cur);
    if constexpr (SP2) {
        PG8_STAGE(PG8_SB(0, 0), cB, voffB); PG8_STAGE(PG8_SB(0, 1), cB + hstep, voffB); PG8_STAGE(PG8_SA(0, 0), cA, voffA); PG8_STAGE(PG8_SA(0, 1), cA + hstep, voffA);
        if (wr == 1) PG8_BAR;
        PG8_WAIT_V(2); PG8_BAR;
        PG8_STAGE(PG8_SB(1, 0), cB + kstep, voffB); PG8_STAGE(PG8_SA(1, 0), cA + kstep, voffA); PG8_STAGE(PG8_SB(1, 1), cB + hstep + kstep, voffB);
        PG8_WAIT_V(6); PG8_BAR;
    } else {
        PG8_STAGE(PG8_SB(0, 0), cB, voffB); PG8_STAGE(PG8_SA(0, 0), cA, voffA); PG8_STAGE(PG8_SB(0, 1), cB + hstep, voffB); PG8_STAGE(PG8_SA(0, 1), cA + hstep, voffA);
        if (wr == 1) PG8_BAR;
        PG8_WAIT_V(4); PG8_BAR;
        PG8_STAGE(PG8_SB(1, 0), cB + kstep, voffB); PG8_STAGE(PG8_SA(1, 0), cA + kstep, voffA); PG8_STAGE(PG8_SB(1, 1), cB + hstep + kstep, voffB);
        PG8_WAIT_V(6); PG8_BAR;
    }
    for (;;) {
        const bool has_next = S.next(ui + 1, nxt);
        const char* nA = has_next ? (const char*)g.A + (size_t)nxt.pm * tstep : cA; const char* nB = has_next ? (const char*)g.Bt + (size_t)nxt.pn * tstep : cB;
        for (int t = 0; t < nt; t += 2) {
            const bool last = (t == nt - 2);
            const char* a1 = cA + (size_t)(t + 1) * kstep;
            const char* a2 = last ? nA : cA + (size_t)(t + 2) * kstep; const char* b2 = last ? nB : cB + (size_t)(t + 2) * kstep;
            const char* a3 = a2 + kstep; const char* b3 = b2 + kstep;
            if (last && has_next) S.a_ready(nxt);
            if constexpr (SP2) {
            PG8_LDB(B0, 0, 0); PG8_LDB(B1, 0, 1); PG8_SCHED; PG8_LDA(At, 0, 0); PG8_STAGE(PG8_SA(1, 1), a1 + hstep, voffA);
            PG8_WAIT_V(8); PG8_WAIT_L(0); PG8_BAR; PG8_MMA(0, 0, At, B0); PG8_MMA(0, 1, At, B1); PG8_BAR; PG8_SCHED;
            PG8_LDA(At, 0, 1); PG8_STAGE(PG8_SB(0, 0), b2, voffB); PG8_STAGE(PG8_SB(0, 1), b2 + hstep, voffB); PG8_STAGE(PG8_SA(0, 0), a2, voffA);
            PG8_WAIT_V(8); PG8_WAIT_L(0); PG8_BAR; PG8_MMA(1, 0, At, B0); PG8_MMA(1, 1, At, B1); PG8_BAR; PG8_SCHED;
            PG8_LDB(B0, 1, 0); PG8_LDB(B1, 1, 1); PG8_SCHED; PG8_LDA(At, 1, 0); PG8_STAGE(PG8_SA(0, 1), a2 + hstep, voffA);
            PG8_WAIT_V(8); PG8_WAIT_L(0); PG8_BAR; PG8_MMA(0, 0, At, B0); PG8_MMA(0, 1, At, B1); PG8_BAR; PG8_SCHED;
            PG8_LDA(At, 1, 1); PG8_STAGE(PG8_SB(1, 0), b3, voffB); PG8_STAGE(PG8_SB(1, 1), b3 + hstep, voffB); PG8_STAGE(PG8_SA(1, 0), a3, voffA);
            PG8_WAIT_V(8); PG8_WAIT_L(0); PG8_BAR; PG8_MMA(1, 0, At, B0); PG8_MMA(1, 1, At, B1); PG8_BAR; PG8_SCHED;
            } else {
            PG8_LDB(B0, 0, 0); PG8_SCHED; PG8_LDA(At, 0, 0); PG8_STAGE(PG8_SA(1, 1), a1 + hstep, voffA);
            PG8_WAIT_L(8); PG8_BAR; PG8_WAIT_L(0); PG8_MMA(0, 0, At, B0); PG8_BAR; PG8_SCHED;
            PG8_LDB(B1, 0, 1); PG8_STAGE(PG8_SB(0, 0), b2, voffB);
            PG8_BAR; PG8_WAIT_L(0); PG8_MMA(0, 1, At, B1); PG8_BAR;
            PG8_LDA(At, 0, 1); PG8_STAGE(PG8_SA(0, 0), a2, voffA);
            PG8_BAR; PG8_WAIT_L(0); PG8_MMA(1, 0, At, B0); PG8_BAR; PG8_SCHED;
            PG8_STAGE(PG8_SB(0, 1), b2 + hstep, voffB);
            PG8_WAIT_V(6); PG8_BAR; PG8_MMA(1, 1, At, B1); PG8_BAR;
            PG8_LDB(B0, 1, 0); PG8_SCHED; PG8_LDA(At, 1, 0); PG8_STAGE(PG8_SA(0, 1), a2 + hstep, voffA);
            PG8_WAIT_L(8); PG8_BAR; PG8_WAIT_L(0); PG8_MMA(0, 0, At, B0); PG8_BAR; PG8_SCHED;
            PG8_LDB(B1, 1, 1); PG8_STAGE(PG8_SB(1, 0), b3, voffB);
            PG8_BAR; PG8_WAIT_L(0); PG8_MMA(0, 1, At, B1); PG8_BAR;
            PG8_LDA(At, 1, 1); PG8_STAGE(PG8_SA(1, 0), a3, voffA);
            PG8_BAR; PG8_WAIT_L(0); PG8_MMA(1, 0, At, B0); PG8_BAR; PG8_SCHED;
            PG8_STAGE(PG8_SB(1, 1), b3 + hstep, voffB);
            PG8_WAIT_V(6); PG8_BAR; PG8_MMA(1, 1, At, B1); PG8_BAR;
            }
        }
        if constexpr (ALIGN_EPI) { if (wr == 0) PG8_BAR; }
        if constexpr (!Epi::AFTER_DRAIN) { E(acc, cur, wr, wc, fr, fq); S.done(cur); }
        if (!has_next) break;
#pragma unroll
        for (int a = 0; a < 2; ++a)
#pragma unroll
            for (int b = 0; b < 2; ++b)
#pragma unroll
                for (int m = 0; m < 4; ++m)
#pragma unroll
                    for (int n = 0; n < 2; ++n) acc[a][b][m][n] = (f32x4){0.f, 0.f, 0.f, 0.f};
        cur = nxt; cA = nA; cB = nB; ++ui;
        if constexpr (ALIGN_EPI) { if (wr == 1) PG8_BAR; }
    }
    PG8_WAIT_V(0);
    if constexpr (!ALIGN_EPI) { if (wr == 0) PG8_BAR; }
    PG8_BAR;
    if constexpr (Epi::AFTER_DRAIN) { E.fused(acc, cur, wr, wc, fr, fq, lds, wid, lane); S.done(cur); }
#undef PG8_SA
#undef PG8_SB
#undef PG8_STAGE
#undef PG8_LDA
#undef PG8_LDB
#undef PG8_MMA
#undef PG8_WAIT_V
#undef PG8_WAIT_L
#undef PG8_BAR
#undef PG8_SCHED
}
}
#define XB_TMO      128
#define XB_XCNT(j)  (256  + 64 * (j))
#define XB_XSUB(j)  (1280 + 64 * (j))
#define XB_XGEN(j)  (2304 + 64 * (j))
#define XB_TOP      3328
#define XB_TOPGEN   3392
#define XCD_BAR_WORDS 3456
#define XB_SPIN_CAP (1u << 18)

__device__ __forceinline__ unsigned xb_ld(unsigned* p)              { return __hip_atomic_load(p, __ATOMIC_RELAXED, __HIP_MEMORY_SCOPE_AGENT); }
__device__ __forceinline__ unsigned xb_add(unsigned* p, unsigned v) { return __hip_atomic_fetch_add(p, v, __ATOMIC_RELAXED, __HIP_MEMORY_SCOPE_AGENT); }
__device__ __forceinline__ unsigned xb_xcc_id() { return (unsigned)__builtin_amdgcn_s_getreg((3 << 11) | 20) & 0xFu; }
#define XB_SPIN(cond, bar) do { unsigned _sp = 0; while (cond) { __builtin_amdgcn_s_sleep(1); \
    if ((++_sp & 255u) == 0u) { if (xb_ld(&(bar)[XB_TMO])) break; if (_sp > XB_SPIN_CAP) { atomicAdd(&(bar)[XB_TMO], 1u); break; } } } } while (0)

struct XcdBarrier {
    unsigned* bar; unsigned x;
    volatile LAS unsigned* st;
};

__device__ __forceinline__ XcdBarrier xcd_barrier_post(unsigned* bar, volatile LAS unsigned* st) {
    XcdBarrier b; b.bar = bar; b.x = xb_xcc_id(); b.st = st;
    if (threadIdx.x == 0) (void)xb_add(&bar[XB_XCNT(b.x)], 1u);
    return b;
}
__device__ __forceinline__ void xcd_barrier_complete(unsigned* bar, unsigned x, unsigned& nloc, unsigned& nx) {
    const unsigned G = gridDim.x * gridDim.y * gridDim.z;
    unsigned sum, cnt, mine, sp = 0u;
    for (;;) {
        sum = 0u; cnt = 0u; mine = 0u;
#pragma unroll
        for (unsigned j = 0; j < 16; ++j) { const unsigned c = xb_ld(&bar[XB_XCNT(j)]); sum += c; cnt += (c > 0u) ? 1u : 0u; mine = (j == x) ? c : mine; }
        if (sum == G) break;
        __builtin_amdgcn_s_sleep(1);
        if ((++sp & 255u) == 0u) { if (xb_ld(&bar[XB_TMO])) break; if (sp > XB_SPIN_CAP) { atomicAdd(&bar[XB_TMO], 1u); break; } }
    }
    nloc = mine > 0u ? mine : 1u; nx = cnt > 0u ? cnt : 1u;
}

__device__ __forceinline__ void xcd_barrier(const XcdBarrier& b) {
    asm volatile("s_waitcnt vmcnt(0)" ::: "memory");
    __syncthreads();
    if (threadIdx.x == 0) {
        unsigned* bar = b.bar;
        __builtin_amdgcn_s_waitcnt(0);
        unsigned nloc = b.st[0], nx = b.st[1];
        if (nloc == 0u) { xcd_barrier_complete(bar, b.x, nloc, nx); b.st[0] = nloc; b.st[1] = nx; }
        const unsigned old = xb_add(&bar[XB_XSUB(b.x)], 1u);
        const unsigned gen = old / nloc;
        if (old + 1u == (gen + 1u) * nloc) {
            __builtin_amdgcn_fence(__ATOMIC_RELEASE, "agent");
            asm volatile("s_waitcnt vmcnt(0)" ::: "memory");
            const unsigned og = xb_add(&bar[XB_TOP], 1u);
            const unsigned tg = og / nx;
            if (og + 1u == (tg + 1u) * nx) xb_add(&bar[XB_TOPGEN], 1u);
            else XB_SPIN(xb_ld(&bar[XB_TOPGEN]) == tg, bar);
            __builtin_amdgcn_fence(__ATOMIC_ACQUIRE, "agent");
            xb_add(&bar[XB_XGEN(b.x)], 1u);
            asm volatile("s_waitcnt vmcnt(0)" ::: "memory");
        } else {
            XB_SPIN(xb_ld(&bar[XB_XGEN(b.x)]) == gen, bar);
            __builtin_amdgcn_fence(__ATOMIC_ACQUIRE, "agent");
            asm volatile("s_waitcnt vmcnt(0)" ::: "memory");
        }
    }
    __syncthreads();
}
struct Frame {
    LAS unsigned char* lds; volatile LAS unsigned* MISC; gu32* ctl;
    int tid, lane, wave, vcu, G;
    float* out; unsigned char* ws;
};
__device__ __forceinline__ float wave_sum(float v) {
#pragma unroll
    for (int o = 1; o < 64; o <<= 1) v += __shfl_xor(v, o);
    return v;
}
template <int MODE> __device__ __forceinline__ int rowmap(int n) {
    if (MODE == 1) { if (n >= 2048) return n; const int j = n & 127, hb = n & ~127; return hb + (j < 64 ? 8 * (j >> 2) + (j & 3) : 8 * ((j - 64) >> 2) + 4 + (j & 3)); }
    if (MODE == 2) { return n < DFF ? (n >> 7) * 256 + (n & 127) : ((n - DFF) >> 7) * 256 + 128 + ((n - DFF) & 127); }
    return n;
}
template <int MODE> __device__ __forceinline__ void p0_transpose_item(const float* W, int K, int N, bf16* WT, const float* g, LAS unsigned* T, int item, int lane) {
    const int nblk = N / 64, kb = item / nblk, nb = item % nblk, k0 = 64 * kb, n0 = 64 * nb;
    const int l15 = lane & 15, lg = lane >> 4;
    f32x4 v[16];
#pragma unroll
    for (int i = 0; i < 16; ++i) { const int row = 8 * (i >> 1) + 2 * lg + (i & 1); v[i] = *(const f32x4*)(W + (size_t)(k0 + row) * N + n0 + 4 * l15); }
    if (g) {
#pragma unroll
        for (int i = 0; i < 16; ++i) { const int row = 8 * (i >> 1) + 2 * lg + (i & 1); v[i] = v[i] * g[k0 + row]; } }
#pragma unroll
    for (int p = 0; p < 8; ++p)
#pragma unroll
        for (int j = 0; j < 4; ++j) T[(4 * l15 + j) * 33 + 4 * p + lg] = pk2(v[2 * p][j], v[2 * p + 1][j]);
    LDS_WAIT(); asm volatile("" ::: "memory");
    const int c = lane & 7;
#pragma unroll
    for (int i = 0; i < 8; ++i) { const int n = (lane >> 3) + 8 * i; const LAS unsigned* s = T + n * 33 + 4 * c;
        v4u o; o.x = s[0]; o.y = s[1]; o.z = s[2]; o.w = s[3];
        *(GAS v4u*)(WT + (size_t)rowmap<MODE>(n0 + n) * K + k0 + 8 * c) = o; }
    LDS_WAIT(); asm volatile("" ::: "memory");
}
struct Args { const float* in[15]; float* out; unsigned char* ws; int ph_lo, ph_hi, use_bar, pad; };
__device__ __forceinline__ void p0_prologue(Frame& F, const Args& A) {
    LAS unsigned* scr = (LAS unsigned*)(F.lds + F.wave * 16384);
    const int gw = F.vcu * NWAVES + F.wave, NGW = F.G * NWAVES;
    unsigned char* ws = F.ws;
    constexpr int I_IN = 32 * (NIN / 64), I_RO = 32 * 32, I_HO = 16 * 32, I_OUT = 32 * 32, I_FI = 32 * (2 * DFF / 64), I_FO = (DFF / 64) * 32;
    constexpr int NITEMS = I_IN + I_RO + I_HO + I_OUT + I_FI + I_FO;
    for (int it = gw; it < NITEMS; it += NGW) {
        int r = it;
        if (r < I_IN) { p0_transpose_item<0>(A.in[4], 2048, NIN, (bf16*)(ws + WS_WIN), A.in[8], scr, r, F.lane); continue; } r -= I_IN;
        if (r < I_RO) { p0_transpose_item<0>(A.in[5], 2048, 2048, (bf16*)(ws + WS_WRO), nullptr, scr, r, F.lane); continue; } r -= I_RO;
        if (r < I_HO) { p0_transpose_item<0>(A.in[6], 1024, 2048, (bf16*)(ws + WS_WHO), nullptr, scr, r, F.lane); continue; } r -= I_HO;
        if (r < I_OUT) { p0_transpose_item<0>(A.in[7], 2048, 2048, (bf16*)(ws + WS_WOUT), nullptr, scr, r, F.lane); continue; } r -= I_OUT;
        if (r < I_FI) { p0_transpose_item<2>(A.in[12], 2048, 2 * DFF, (bf16*)(ws + WS_WFI), A.in[9], scr, r, F.lane); continue; } r -= I_FI;
        p0_transpose_item<0>(A.in[13], DFF, 2048, (bf16*)(ws + WS_WFO), nullptr, scr, r, F.lane);
    }
    bf16* XB = (bf16*)(ws + WS_XB);
    for (int m = gw; m < MPAD; m += NGW) {
        GAS unsigned long long* o8 = (GAS unsigned long long*)(XB + (size_t)m * 2048) + F.lane;
        if (m < MROWS) {
            const float* xrow = m < 8192 ? A.in[0] + (size_t)m * 2048 : A.in[1] + (size_t)(m - 8192) * 2048;
            const GAS f32x4* xr = (const GAS f32x4*)xrow + F.lane;
            f32x4 v[8]; float s = 0.f;
#pragma unroll
            for (int j = 0; j < 8; ++j) { v[j] = xr[64 * j]; s += (v[j].x * v[j].x + v[j].y * v[j].y) + (v[j].z * v[j].z + v[j].w * v[j].w); }
            const float rr = 1.0f / sqrtf(wave_sum(s) * (1.0f / 2048.0f) + EPS);
#pragma unroll
            for (int j = 0; j < 8; ++j) o8[64 * j] = (unsigned long long)pk2(v[j].x * rr, v[j].y * rr) | ((unsigned long long)pk2(v[j].z * rr, v[j].w * rr) << 32);
        } else {
#pragma unroll
            for (int j = 0; j < 8; ++j) o8[64 * j] = 0ull;
        }
    }
    { float* COS = (float*)(ws + WS_COS); float* SIN = (float*)(ws + WS_SIN);
      for (int i = (F.vcu * NWAVES + F.wave) * 64 + F.lane; i < 2049 * 64; i += F.G * NWAVES * 64) { const int p = i >> 6, j = i & 63; const int pos = p < 2048 ? p : 16384;
          const float inv = powf(10000.0f, -(float)j / 64.0f); const float ang = (float)pos * inv; float sn, cs; sincosf(ang, &sn, &cs); COS[i] = cs; SIN[i] = sn; } }
    { float* LB = (float*)(ws + WS_LB); const int i = (F.vcu * NWAVES + F.wave) * 64 + F.lane; if (i < 1024) { const float l0 = A.in[11][i], l1 = A.in[11][1024 + i]; LB[i] = 1.0f / (1.0f + expf(l1 - l0)); } }
}
typedef short bf16x4v __attribute__((ext_vector_type(4)));
#define MFMA16(a, b, c) __builtin_amdgcn_mfma_f32_16x16x32_bf16((a), (b), (c), 0, 0, 0)
constexpr int TP = 136;
constexpr size_t OUT_YS = 8192ull * 2048, OUT_SRP = 8320ull * 2048, OUT_SHP = OUT_SRP + 4ull * 8 * 128 * 256, OUT_SRS = OUT_SHP + 4ull * 8 * 128 * 128, OUT_SHS = OUT_SRS + 128ull * 8 * 128 * 256;
__device__ __forceinline__ int tsw(int r, int m) { return r * TP + ((r >> 3) << 3) + m; }
__device__ __forceinline__ int tsw64(int r, int m) { return r * 72 + ((r >> 3) << 3) + m; }
constexpr int TSZ128 = 128 * TP + 128, TSZ64R = 64 * TP + 64, TSZ32R = 32 * TP + 32, TSZ256 = 256 * TP + 256, TSZ64T = 128 * 72 + 128;
__device__ __forceinline__ float lg2gamma(int h) { return log2f(1.0f - exp2f(-5.0f - (float)h)); }
__device__ __forceinline__ float bfe(const v4u& w, int j) { const unsigned x = w[j >> 1]; return __uint_as_float((j & 1) ? (x & 0xffff0000u) : (x << 16)); }
__device__ __forceinline__ bf16x8 pack_f8(const float* v) { v4u w; w.x = pk2(v[0], v[1]); w.y = pk2(v[2], v[3]); w.z = pk2(v[4], v[5]); w.w = pk2(v[6], v[7]); return __builtin_bit_cast(bf16x8, w); }

__device__ __forceinline__ void p2_ret_unit(Frame& F, int u) {
    unsigned char* ws = F.ws;
    const int es = u & 1, h = (u >> 1) & 7, b = u >> 4;
    const int w = F.wave, l15 = F.lane & 15, g = F.lane >> 4;
    LAS bf16* KT = (LAS bf16*)F.lds; LAS bf16* VT = KT + TSZ128;
    const bf16* Kg = (const bf16*)(ws + WS_K); const bf16* Vg = (const bf16*)(ws + WS_V);
    const float* COS = (const float*)(ws + WS_COS); const float* SIN = (const float*)(ws + WS_SIN);
    const float lg = lg2gamma(h), cd = exp2f(128.0f * lg);
    const int dc = F.tid & 7, m0 = F.tid >> 3;
    const int vc = F.tid & 15, vm0 = F.tid >> 4;
    v4u ka[2], kb[2], va[4]; f32x4 cc[2][2], sn[2][2];
#define P2R_LOAD(c) do { _Pragma("unroll") for (int _i = 0; _i < 2; ++_i) { const int _m = m0 + 64 * _i, _r = b * 2048 + (c) * 128 + _m, _pos = (c) * 128 + _m, _d0 = 8 * dc; \
        const bf16* _kp = Kg + (size_t)_r * 1024 + h * 128 + _d0; ka[_i] = *(const v4u*)_kp; kb[_i] = *(const v4u*)(_kp + 64); \
        cc[_i][0] = *(const f32x4*)(COS + _pos * 64 + _d0); cc[_i][1] = *(const f32x4*)(COS + _pos * 64 + _d0 + 4); sn[_i][0] = *(const f32x4*)(SIN + _pos * 64 + _d0); sn[_i][1] = *(const f32x4*)(SIN + _pos * 64 + _d0 + 4); } \
        _Pragma("unroll") for (int _i = 0; _i < 4; ++_i) va[_i] = *(const v4u*)(Vg + (size_t)(b * 2048 + (c) * 128 + vm0 + 32 * _i) * 2048 + h * 256 + 128 * es + 8 * vc); } while (0)
    f32x4 S[8];
#pragma unroll
    for (int j = 0; j < 8; ++j) S[j] = (f32x4){0.f, 0.f, 0.f, 0.f};
    const float dec2[2] = {exp2f((float)(127 - m0) * lg), exp2f((float)(63 - m0) * lg)};
    P2R_LOAD(0);
    for (int c = 0; c < 16; ++c) {
        __syncthreads();
#pragma unroll
        for (int i = 0; i < 2; ++i) { const int m = m0 + 64 * i; const float dec = dec2[i];
            LAS bf16* k1 = KT + tsw(8 * dc, m); LAS bf16* k2 = KT + tsw(64 + 8 * dc, m);
#pragma unroll
            for (int j = 0; j < 8; ++j) { const float x1 = bfe(ka[i], j), x2 = bfe(kb[i], j), cj = cc[i][j >> 2][j & 3], sj = sn[i][j >> 2][j & 3];
                k1[j * TP] = (bf16)f2bf((x1 * cj - x2 * sj) * dec); k2[j * TP] = (bf16)f2bf((x2 * cj + x1 * sj) * dec); } }
#pragma unroll
        for (int i = 0; i < 4; ++i) { LAS bf16* vt = VT + tsw(8 * vc, vm0 + 32 * i);
#pragma unroll
            for (int j = 0; j < 8; ++j) vt[j * TP] = (bf16)((va[i][j >> 1] >> (16 * (j & 1))) & 0xffffu); }
        if (c + 1 < 16) P2R_LOAD(c + 1);
        __syncthreads();
        f32x4 kv[8];
#pragma unroll
        for (int j = 0; j < 8; ++j) kv[j] = (f32x4){0.f, 0.f, 0.f, 0.f};
#pragma unroll
        for (int ks = 0; ks < 4; ++ks) { const bf16x8 bfr = *(const LAS bf16x8*)&VT[tsw(16 * w + l15, 32 * ks + 8 * g)];
#pragma unroll
            for (int j = 0; j < 8; ++j) { const bf16x8 af = *(const LAS bf16x8*)&KT[tsw(16 * j + l15, 32 * ks + 8 * g)]; kv[j] = MFMA16(af, bfr, kv[j]); } }
        bf16* st = (bf16*)(ws + WS_SRT) + ((size_t)((b * 8 + h) * 16 + c) * 256 + 128 * es + 16 * w + l15) * 128 + 4 * g;
#pragma unroll
        for (int j = 0; j < 8; ++j) { v2u p; p.x = pk2(S[j][0], S[j][1]); p.y = pk2(S[j][2], S[j][3]); *(v2u*)(st + 16 * j) = p; S[j] = S[j] * cd + kv[j]; }
    }
#undef P2R_LOAD
    float* fo = F.out + OUT_SRP + ((size_t)(b * 8 + h) * 128 + 4 * g) * 256 + 128 * es + 16 * w + l15;
#pragma unroll
    for (int j = 0; j < 8; ++j)
#pragma unroll
        for (int reg = 0; reg < 4; ++reg) fo[(size_t)(16 * j + reg) * 256] = S[j][reg];
}
__device__ __forceinline__ void p2_hg_unit(Frame& F, int u) {
    unsigned char* ws = F.ws;
    const int es = u & 1, h = (u >> 1) & 7, b = u >> 4;
    const int w = F.wave, l15 = F.lane & 15, g = F.lane >> 4, et = w & 3, dh = w >> 2;
    LAS bf16* KT = (LAS bf16*)F.lds; LAS bf16* VT = KT + TSZ128; LAS float* LQ = (LAS float*)(VT + TSZ64R); LAS float* BT = LQ + 4 * 128;
    const float* Z = (const float*)(ws + WS_LOGF); const bf16* HI = (const bf16*)(ws + WS_HI);
    const int d = F.tid & 127, q = F.tid >> 7; const float oml = 1.0f - ((const float*)(ws + WS_LB))[h * 128 + d];
    const int vc = F.tid & 7, vm0 = F.tid >> 3;
    float z[32]; v4u va[2];
#define P2H_LOAD(sc) do { const int _r0 = b * 2048 + (sc) * 128; _Pragma("unroll") for (int _i = 0; _i < 32; ++_i) z[_i] = Z[(size_t)(_r0 + 32 * q + _i) * 1024 + h * 128 + d]; \
        _Pragma("unroll") for (int _i = 0; _i < 2; ++_i) va[_i] = *(const v4u*)(HI + (size_t)(_r0 + vm0 + 64 * _i) * 1024 + h * 128 + 64 * es + 8 * vc); } while (0)
    f32x4 S[4];
#pragma unroll
    for (int j = 0; j < 4; ++j) S[j] = (f32x4){0.f, 0.f, 0.f, 0.f};
    P2H_LOAD(0);
    for (int sc = 0; sc < 16; ++sc) {
        float lf[32], kin[32]; float L = 0.f;
#pragma unroll
        for (int i = 0; i < 32; ++i) { kin[i] = oml * __builtin_amdgcn_rcpf(1.0f + __expf(z[i])); lf[i] = __logf(1.0f - kin[i]); L += lf[i]; }
        __syncthreads();
        LQ[q * 128 + d] = L;
#pragma unroll
        for (int i = 0; i < 2; ++i) { LAS bf16* vt = VT + tsw(8 * vc, vm0 + 64 * i);
#pragma unroll
            for (int j = 0; j < 8; ++j) vt[j * TP] = (bf16)((va[i][j >> 1] >> (16 * (j & 1))) & 0xffffu); }
        if (sc + 1 < 16) P2H_LOAD(sc + 1);
        __syncthreads();
        float run = 0.f;
#pragma unroll
        for (int q2 = 1; q2 < 4; ++q2) if (q2 > q) run += LQ[q2 * 128 + d];
#pragma unroll
        for (int blk = 3; blk >= 0; --blk) { float v[8];
#pragma unroll
            for (int jj = 7; jj >= 0; --jj) { const int i = 8 * blk + jj; v[jj] = kin[i] * __expf(run); run += lf[i]; }
            *(LAS bf16x8*)&KT[tsw(d, 32 * q + 8 * blk)] = pack_f8(v); }
        if (q == 0) BT[d] = run;
        __syncthreads();
        f32x4 hs[4];
#pragma unroll
        for (int j = 0; j < 4; ++j) hs[j] = (f32x4){0.f, 0.f, 0.f, 0.f};
#pragma unroll
        for (int ks = 0; ks < 4; ++ks) { const bf16x8 bfr = *(const LAS bf16x8*)&VT[tsw(16 * et + l15, 32 * ks + 8 * g)];
#pragma unroll
            for (int j = 0; j < 4; ++j) { const bf16x8 af = *(const LAS bf16x8*)&KT[tsw(16 * (4 * dh + j) + l15, 32 * ks + 8 * g)]; hs[j] = MFMA16(af, bfr, hs[j]); } }
        bf16* st = (bf16*)(ws + WS_SHT) + ((size_t)((b * 8 + h) * 16 + sc) * 128 + 64 * es + 16 * et + l15) * 128 + 64 * dh + 4 * g;
#pragma unroll
        for (int j = 0; j < 4; ++j) { v2u p; p.x = pk2(S[j][0], S[j][1]); p.y = pk2(S[j][2], S[j][3]); *(v2u*)(st + 16 * j) = p;
            const f32x4 bt = *(const LAS f32x4*)&BT[16 * (4 * dh + j) + 4 * g];
#pragma unroll
            for (int reg = 0; reg < 4; ++reg) S[j][reg] = S[j][reg] * __expf(bt[reg]) + hs[j][reg]; }
    }
#undef P2H_LOAD
    float* fo = F.out + OUT_SHP + ((size_t)(b * 8 + h) * 128 + 64 * dh + 4 * g) * 128 + 64 * es + 16 * et + l15;
#pragma unroll
    for (int j = 0; j < 4; ++j)
#pragma unroll
        for (int reg = 0; reg < 4; ++reg) fo[(size_t)(16 * j + reg) * 128] = S[j][reg];
}
__device__ __forceinline__ void p2_sret_all(Frame& F, const Args& A, int first, int stride) {
    unsigned char* ws = F.ws;
    LAS float* qs = (LAS float*)F.lds; LAS float* ks = qs + 128; LAS float* vs = ks + 128; LAS float* ored = vs + 256;
    const bf16* Q = (const bf16*)(ws + WS_Q); const bf16* K = (const bf16*)(ws + WS_K); const bf16* V = (const bf16*)(ws + WS_V);
    const int e4 = F.tid & 63, dq = F.tid >> 6;
    int it = first; if (it >= 1024) return;
    f32x4 s[16];
    { const float* Sin = A.in[2] + (size_t)it * 128 * 256;
#pragma unroll
      for (int i = 0; i < 16; ++i) s[i] = *(const f32x4*)(Sin + (size_t)(16 * dq + i) * 256 + 4 * e4); }
    for (; it < 1024; it += stride) {
        const int h = it & 7, b = it >> 3, r = 8192 + b;
        __syncthreads();
        if (F.tid < 64) { const int d = F.tid; const float cs = ((const float*)(ws + WS_COS))[2048 * 64 + d], sn = ((const float*)(ws + WS_SIN))[2048 * 64 + d];
            const float q1 = bf2f(Q[(size_t)r * 1024 + h * 128 + d]), q2 = bf2f(Q[(size_t)r * 1024 + h * 128 + 64 + d]), k1 = bf2f(K[(size_t)r * 1024 + h * 128 + d]), k2 = bf2f(K[(size_t)r * 1024 + h * 128 + 64 + d]);
            qs[d] = q1 * cs - q2 * sn; qs[d + 64] = q2 * cs + q1 * sn; ks[d] = k1 * cs - k2 * sn; ks[d + 64] = k2 * cs + k1 * sn; }
        else if (F.tid >= 256) { const int e = F.tid - 256; vs[e] = bf2f(V[(size_t)r * 2048 + h * 256 + e]); }
        __syncthreads();
        const float gam = 1.0f - exp2f(-5.0f - (float)h);
        float* Sout = F.out + OUT_SRS + (size_t)it * 128 * 256;
        const f32x4 v4 = *(const LAS f32x4*)&vs[4 * e4]; f32x4 o = (f32x4){0.f, 0.f, 0.f, 0.f};
#pragma unroll
        for (int i = 0; i < 16; ++i) { const int d = 16 * dq + i; s[i] = s[i] * gam + v4 * ks[d]; *(f32x4*)(Sout + (size_t)d * 256 + 4 * e4) = s[i]; o += s[i] * qs[d]; }
        *(LAS f32x4*)&ored[dq * 256 + 4 * e4] = o;
        if (it + stride < 1024) { const float* Sin = A.in[2] + (size_t)(it + stride) * 128 * 256;
#pragma unroll
            for (int i = 0; i < 16; ++i) s[i] = *(const f32x4*)(Sin + (size_t)(16 * dq + i) * 256 + 4 * e4); }
        __syncthreads();
        if (F.wave == 0) { float oo[4]; float ss = 0.f;
#pragma unroll
            for (int k = 0; k < 4; ++k) { const int e = F.lane + 64 * k; float t = 0.f;
#pragma unroll
                for (int j = 0; j < 8; ++j) t += ored[j * 256 + e];
                oo[k] = t; ss += t * t; }
            const float rr = 1.0f / sqrtf(wave_sum(ss) * (1.0f / 256.0f) + EPS);
            const bf16* RG = (const bf16*)(ws + WS_RG); bf16* OR = (bf16*)(ws + WS_OR);
#pragma unroll
            for (int k = 0; k < 4; ++k) { const size_t ix = (size_t)r * 2048 + h * 256 + F.lane + 64 * k; OR[ix] = (bf16)f2bf(oo[k] * rr * bf2f(RG[ix])); } }
    }
}
__device__ __forceinline__ void p2_shg_all(Frame& F, const Args& A, int first, int stride) {
    unsigned char* ws = F.ws;
    LAS float* qs = (LAS float*)F.lds; LAS float* fs = qs + 128; LAS float* kn = fs + 128; LAS float* vs = kn + 128; LAS float* ored = vs + 128;
    const int e4 = F.tid & 31, dq = F.tid >> 5;
    int it = first; if (it >= 1024) return;
    f32x4 s[8];
    { const float* Sin = A.in[3] + (size_t)it * 128 * 128;
#pragma unroll
      for (int i = 0; i < 8; ++i) s[i] = *(const f32x4*)(Sin + (size_t)(8 * dq + i) * 128 + 4 * e4); }
    for (; it < 1024; it += stride) {
        const int h = it & 7, b = it >> 3, r = 8192 + b;
        __syncthreads();
        if (F.tid < 128) { const int d = F.tid; const size_t ix = (size_t)r * 1024 + h * 128 + d; const float z = ((const float*)(ws + WS_LOGF))[ix]; const float lb = ((const float*)(ws + WS_LB))[h * 128 + d];
            const float kin = (1.0f - lb) / (1.0f + __expf(z)); kn[d] = kin; fs[d] = 1.0f - kin; qs[d] = bf2f(((const bf16*)(ws + WS_HQ))[ix]); vs[d] = bf2f(((const bf16*)(ws + WS_HI))[ix]); }
        __syncthreads();
        float* Sout = F.out + OUT_SHS + (size_t)it * 128 * 128;
        const f32x4 v4 = *(const LAS f32x4*)&vs[4 * e4]; f32x4 o = (f32x4){0.f, 0.f, 0.f, 0.f};
#pragma unroll
        for (int i = 0; i < 8; ++i) { const int d = 8 * dq + i; s[i] = s[i] * fs[d] + v4 * kn[d]; *(f32x4*)(Sout + (size_t)d * 128 + 4 * e4) = s[i]; o += s[i] * qs[d]; }
        *(LAS f32x4*)&ored[dq * 128 + 4 * e4] = o;
        if (it + stride < 1024) { const float* Sin = A.in[3] + (size_t)(it + stride) * 128 * 128;
#pragma unroll
            for (int i = 0; i < 8; ++i) s[i] = *(const f32x4*)(Sin + (size_t)(8 * dq + i) * 128 + 4 * e4); }
        __syncthreads();
        if (F.wave == 0) { float oo[2]; float ss = 0.f;
#pragma unroll
            for (int k = 0; k < 2; ++k) { const int e = F.lane + 64 * k; float t = 0.f;
#pragma unroll
                for (int j = 0; j < 16; ++j) t += ored[j * 128 + e];
                oo[k] = t; ss += t * t; }
            const float rr = 1.0f / sqrtf(wave_sum(ss) * (1.0f / 128.0f) + EPS);
            const bf16* HG = (const bf16*)(ws + WS_HG); bf16* OH = (bf16*)(ws + WS_OH);
#pragma unroll
            for (int k = 0; k < 2; ++k) { const int e = F.lane + 64 * k; const size_t ix = (size_t)r * 1024 + h * 128 + e; OH[ix] = (bf16)f2bf(oo[k] * rr * A.in[10][e] * bf2f(HG[ix])); } }
    }
}
__device__ __forceinline__ void p2_phase(Frame& F, const Args& A) {
    const int half = F.G >> 1;
    if (half == 0 || (F.vcu & 1) == 0) { const int stride = half ? half : 1;
        for (int u = F.vcu >> 1; u < 64; u += stride) p2_ret_unit(F, u);
        for (int u = (F.vcu >> 1) - 64; u < 64; u += stride) if (u >= 0) p2_hg_unit(F, u); }
    if (half == 0 || (F.vcu & 1) == 1) { const int first = half ? (F.vcu >> 1) : 0, stride = half ? half : 1;
        p2_sret_all(F, A, first, stride); p2_shg_all(F, A, first, stride); }
}
__device__ __forceinline__ void p4_ret_item(Frame& F, int item) {
    unsigned char* ws = F.ws;
    const int c = item & 15, h = (item >> 4) & 7, b = item >> 7, r0 = b * 2048 + c * 128;
    const int w = F.wave, l15 = F.lane & 15, g = F.lane >> 4;
    LAS bf16* KS = (LAS bf16*)F.lds; LAS bf16* VT = KS + 128 * TP;
    const bf16* Qg = (const bf16*)(ws + WS_Q); const bf16* Kg = (const bf16*)(ws + WS_K); const bf16* Vg = (const bf16*)(ws + WS_V);
    const float* COS = (const float*)(ws + WS_COS); const float* SIN = (const float*)(ws + WS_SIN);
    const float lg = lg2gamma(h);
    __syncthreads();
#pragma unroll
    for (int i = 0; i < 2; ++i) { const int u = F.tid + 512 * i, d0 = (u & 7) * 8, m = u >> 3;
        const bf16* kp = Kg + (size_t)(r0 + m) * 1024 + h * 128 + d0; const v4u a = *(const v4u*)kp, bb = *(const v4u*)(kp + 64);
        const int pos = c * 128 + m; const f32x4 c0 = *(const f32x4*)(COS + pos * 64 + d0), c1 = *(const f32x4*)(COS + pos * 64 + d0 + 4), s0 = *(const f32x4*)(SIN + pos * 64 + d0), s1 = *(const f32x4*)(SIN + pos * 64 + d0 + 4);
        float o1[8], o2[8];
#pragma unroll
        for (int j = 0; j < 8; ++j) { const float x1 = bfe(a, j), x2 = bfe(bb, j), cj = j < 4 ? c0[j & 3] : c1[j & 3], sj = j < 4 ? s0[j & 3] : s1[j & 3]; o1[j] = x1 * cj - x2 * sj; o2[j] = x2 * cj + x1 * sj; }
        *(LAS bf16x8*)&KS[m * TP + d0] = pack_f8(o1); *(LAS bf16x8*)&KS[m * TP + 64 + d0] = pack_f8(o2); }
#pragma unroll
    for (int i = 0; i < 8; ++i) { const int u = F.tid + 512 * i, e0 = (u & 31) * 8, m = u >> 5;
        const v4u a = *(const v4u*)(Vg + (size_t)(r0 + m) * 2048 + h * 256 + e0);
        LAS bf16* vt = VT + tsw(e0, m);
#pragma unroll
        for (int j = 0; j < 8; ++j) vt[j * TP] = (bf16)((a[j >> 1] >> (16 * (j & 1))) & 0xffffu); }
    bf16x8 qf[4];
    { const int n = 16 * w + l15, pos = c * 128 + n; const bf16* qp = Qg + (size_t)(r0 + n) * 1024 + h * 128 + 8 * g;
      const v4u a0 = *(const v4u*)qp, a1 = *(const v4u*)(qp + 32), a2 = *(const v4u*)(qp + 64), a3 = *(const v4u*)(qp + 96);
      float r0v[8], r1v[8], r2v[8], r3v[8];
#pragma unroll
      for (int hlf = 0; hlf < 2; ++hlf) { const int dd = 32 * hlf + 8 * g;
          const f32x4 c0 = *(const f32x4*)(COS + pos * 64 + dd), c1 = *(const f32x4*)(COS + pos * 64 + dd + 4), s0 = *(const f32x4*)(SIN + pos * 64 + dd), s1 = *(const f32x4*)(SIN + pos * 64 + dd + 4);
#pragma unroll
          for (int j = 0; j < 8; ++j) { const float cj = j < 4 ? c0[j & 3] : c1[j & 3], sj = j < 4 ? s0[j & 3] : s1[j & 3];
              const float x1 = hlf == 0 ? bfe(a0, j) : bfe(a1, j), x2 = hlf == 0 ? bfe(a2, j) : bfe(a3, j);
              if (hlf == 0) { r0v[j] = x1 * cj - x2 * sj; r2v[j] = x2 * cj + x1 * sj; } else { r1v[j] = x1 * cj - x2 * sj; r3v[j] = x2 * cj + x1 * sj; } } }
      qf[0] = pack_f8(r0v); qf[1] = pack_f8(r1v); qf[2] = pack_f8(r2v); qf[3] = pack_f8(r3v); }
    __syncthreads();
    f32x4 O[16];
    { const bf16* st = (const bf16*)(ws + WS_SRT) + (size_t)item * 256 * 128 + 8 * g;
#pragma unroll
      for (int et = 0; et < 16; ++et) { f32x4 t = (f32x4){0.f, 0.f, 0.f, 0.f};
#pragma unroll
          for (int ks = 0; ks < 4; ++ks) { const bf16x8 sf = *(const bf16x8*)(st + (size_t)(16 * et + l15) * 128 + 32 * ks); t = MFMA16(qf[ks], sf, t); }
          O[et] = t; }
      float rs[4];
#pragma unroll
      for (int reg = 0; reg < 4; ++reg) rs[reg] = exp2f((float)(16 * w + 4 * g + reg + 1) * lg);
#pragma unroll
      for (int et = 0; et < 16; ++et)
#pragma unroll
          for (int reg = 0; reg < 4; ++reg) O[et][reg] *= rs[reg]; }
    bf16x8 pf[4];
#pragma unroll
    for (int s = 0; s < 4; ++s) { float pv[8];
#pragma unroll
        for (int hf = 0; hf < 2; ++hf) { const int mt = 2 * s + hf; f32x4 dd = (f32x4){0.f, 0.f, 0.f, 0.f};
            if (mt <= w) {
#pragma unroll
                for (int ks = 0; ks < 4; ++ks) { const bf16x8 kf = *(const LAS bf16x8*)&KS[(16 * mt + l15) * TP + 32 * ks + 8 * g]; dd = MFMA16(kf, qf[ks], dd); }
#pragma unroll
                for (int reg = 0; reg < 4; ++reg) { const int m = 16 * mt + 4 * g + reg, n = 16 * w + l15; dd[reg] = n >= m ? dd[reg] * exp2f((float)(n - m) * lg) : 0.f; } }
#pragma unroll
            for (int reg = 0; reg < 4; ++reg) pv[4 * hf + reg] = dd[reg]; }
        pf[s] = pack_f8(pv); }
#pragma unroll
    for (int s = 0; s < 4; ++s) if (2 * s <= w) {
#pragma unroll
        for (int et = 0; et < 16; ++et) { const bf16x4v lo = *(const LAS bf16x4v*)&VT[tsw(16 * et + l15, 32 * s + 4 * g)], hi = *(const LAS bf16x4v*)&VT[tsw(16 * et + l15, 32 * s + 16 + 4 * g)];
            const bf16x8 vf = __builtin_shufflevector(lo, hi, 0, 1, 2, 3, 4, 5, 6, 7); O[et] = MFMA16(pf[s], vf, O[et]); } }
    float ss[4] = {0.f, 0.f, 0.f, 0.f};
#pragma unroll
    for (int et = 0; et < 16; ++et)
#pragma unroll
        for (int reg = 0; reg < 4; ++reg) ss[reg] += O[et][reg] * O[et][reg];
#pragma unroll
    for (int reg = 0; reg < 4; ++reg) { float v = ss[reg]; v += __shfl_xor(v, 1); v += __shfl_xor(v, 2); v += __shfl_xor(v, 4); v += __shfl_xor(v, 8); ss[reg] = 1.0f / sqrtf(v * (1.0f / 256.0f) + EPS); }
    const bf16* RG = (const bf16*)(ws + WS_RG); bf16* OR = (bf16*)(ws + WS_OR);
#pragma unroll
    for (int reg = 0; reg < 4; ++reg) { const size_t rb = (size_t)(r0 + 16 * w + 4 * g + reg) * 2048 + h * 256 + l15;
#pragma unroll
        for (int et = 0; et < 16; ++et) OR[rb + 16 * et] = (bf16)f2bf(O[et][reg] * ss[reg] * bf2f(RG[rb + 16 * et])); }
}
__device__ __forceinline__ void p4_hg_item(Frame& F, const Args& A, int item) {
    unsigned char* ws = F.ws;
    const int sc = item & 15, h = (item >> 4) & 7, b = item >> 7, r0 = b * 2048 + sc * 128;
    const int w = F.wave, l15 = F.lane & 15, g = F.lane >> 4;
    LAS bf16* QP = (LAS bf16*)F.lds;
    LAS bf16* KP = QP + 64 * TP;
    LAS bf16* KU = KP + 64 * TP;
    LAS bf16* VT = KU + 128 * 72;
    LAS float* E15 = (LAS float*)(VT + TSZ64T);
    LAS float* OB = E15 + 4 * 128;
    const float* Z = (const float*)(ws + WS_LOGF); const bf16* HQ = (const bf16*)(ws + WS_HQ); const bf16* HI = (const bf16*)(ws + WS_HI); const float* LB = (const float*)(ws + WS_LB);
    f32x4 S[8];
    { const bf16* st = (const bf16*)(ws + WS_SHT) + (size_t)item * 128 * 128 + (size_t)(16 * w + l15) * 128 + 4 * g;
#pragma unroll
      for (int dt = 0; dt < 8; ++dt) { const v2u p = *(const v2u*)(st + 16 * dt); S[dt][0] = __uint_as_float(p.x << 16); S[dt][1] = __uint_as_float(p.x & 0xffff0000u); S[dt][2] = __uint_as_float(p.y << 16); S[dt][3] = __uint_as_float(p.y & 0xffff0000u); } }
    for (int hf = 0; hf < 2; ++hf) {
        const int rh = r0 + 64 * hf;
        __syncthreads();
        { const int d = F.tid & 127, sq = F.tid >> 7; const float oml = 1.0f - LB[h * 128 + d];
          float kin[16], bcum[16]; float bb = 0.f;
#pragma unroll
          for (int t = 0; t < 16; ++t) { const size_t ix = (size_t)(rh + 16 * sq + t) * 1024 + h * 128 + d; const float z = Z[ix]; const float q = bf2f(HQ[ix]);
              kin[t] = oml * __builtin_amdgcn_rcpf(1.0f + __expf(z)); bb += __logf(1.0f - kin[t]); bcum[t] = bb;
              QP[(16 * sq + t) * TP + d] = (bf16)f2bf(q * __expf(bb)); KP[(16 * sq + t) * TP + d] = (bf16)f2bf(kin[t] * __expf(fminf(-bb, 80.0f))); }
          E15[sq * 128 + d] = __expf(bb);
          float v[8];
#pragma unroll
          for (int t = 0; t < 8; ++t) v[t] = kin[t] * __expf(bb - bcum[t]);
          *(LAS bf16x8*)&KU[d * 72 + 16 * sq] = pack_f8(v);
#pragma unroll
          for (int t = 0; t < 8; ++t) v[t] = kin[8 + t] * __expf(bb - bcum[8 + t]);
          *(LAS bf16x8*)&KU[d * 72 + 16 * sq + 8] = pack_f8(v); }
#pragma unroll
        for (int i = 0; i < 2; ++i) { const int u = F.tid + 512 * i, e0 = (u & 15) * 8, m = u >> 4;
            const v4u a = *(const v4u*)(HI + (size_t)(rh + m) * 1024 + h * 128 + e0);
            LAS bf16* vt = VT + tsw64(e0, m);
#pragma unroll
            for (int j = 0; j < 8; ++j) vt[j * 72] = (bf16)((a[j >> 1] >> (16 * (j & 1))) & 0xffffu); }
        __syncthreads();
        const bf16x8 zero8 = (bf16x8){0, 0, 0, 0, 0, 0, 0, 0};
#pragma unroll
        for (int sq = 0; sq < 4; ++sq) {
            f32x4 at = (f32x4){0.f, 0.f, 0.f, 0.f};
#pragma unroll
            for (int ks = 0; ks < 4; ++ks) { const bf16x8 kf = *(const LAS bf16x8*)&KP[(16 * sq + l15) * TP + 32 * ks + 8 * g], qf = *(const LAS bf16x8*)&QP[(16 * sq + l15) * TP + 32 * ks + 8 * g]; at = MFMA16(kf, qf, at); }
            float pv[8];
#pragma unroll
            for (int reg = 0; reg < 4; ++reg) { pv[reg] = (4 * g + reg) <= l15 ? at[reg] : 0.f; pv[4 + reg] = 0.f; }
            const bf16x8 pfr = pack_f8(pv);
            f32x4 o;
            { const bf16x4v lo = *(const LAS bf16x4v*)&VT[tsw64(16 * w + l15, 16 * sq + 4 * g)]; const bf16x8 vf = __builtin_shufflevector(lo, (bf16x4v){0, 0, 0, 0}, 0, 1, 2, 3, 4, 5, 6, 7);
              const f32x4 z4 = {0.f, 0.f, 0.f, 0.f}; o = MFMA16(pfr, vf, z4); }
#pragma unroll
            for (int ks = 0; ks < 4; ++ks) { float sv[8];
#pragma unroll
                for (int jj = 0; jj < 8; ++jj) sv[jj] = S[2 * ks + (jj >> 2)][jj & 3];
                const bf16x8 sf = pack_f8(sv);
                const LAS bf16* qp = &QP[(16 * sq + l15) * TP + 32 * ks + 4 * g]; const bf16x4v lo = *(const LAS bf16x4v*)qp, hi = *(const LAS bf16x4v*)(qp + 16);
                const bf16x8 qf = __builtin_shufflevector(lo, hi, 0, 1, 2, 3, 4, 5, 6, 7); o = MFMA16(qf, sf, o); }
#pragma unroll
            for (int reg = 0; reg < 4; ++reg) OB[(16 * sq + 4 * g + reg) * 132 + 16 * w + l15] = o[reg];
            const bf16x8 vu = g < 2 ? *(const LAS bf16x8*)&VT[tsw64(16 * w + l15, 16 * sq + 8 * g)] : zero8;
#pragma unroll
            for (int dt = 0; dt < 8; ++dt) { const f32x4 ed = *(const LAS f32x4*)&E15[sq * 128 + 16 * dt + 4 * g];
                const bf16x8 kf = g < 2 ? *(const LAS bf16x8*)&KU[(16 * dt + l15) * 72 + 16 * sq + 8 * g] : zero8;
                S[dt] = MFMA16(kf, vu, S[dt] * ed); }
        }
        __syncthreads();
        { const bf16* HG = (const bf16*)(ws + WS_HG); bf16* OH = (bf16*)(ws + WS_OH);
#pragma unroll
          for (int i = 0; i < 8; ++i) { const int t = 8 * w + i; const float v0 = OB[t * 132 + F.lane], v1 = OB[t * 132 + 64 + F.lane];
              const float rr = 1.0f / sqrtf(wave_sum(v0 * v0 + v1 * v1) * (1.0f / 128.0f) + EPS); const size_t ix = (size_t)(rh + t) * 1024 + h * 128 + F.lane;
              OH[ix] = (bf16)f2bf(v0 * rr * A.in[10][F.lane] * bf2f(HG[ix])); OH[ix + 64] = (bf16)f2bf(v1 * rr * A.in[10][64 + F.lane] * bf2f(HG[ix + 64])); } }
    }
}
__device__ __forceinline__ void p4_phase(Frame& F, const Args& A) {
    for (int it = F.vcu; it < 512; it += F.G) p4_ret_item(F, it);
    for (int it = F.vcu; it < 512; it += F.G) p4_hg_item(F, A, it);
}
namespace mini {
using pg8::bf16_t; using pg8::u32x2; using pg8::silu4; using pg8::sigm4; using pg8::pack4; using pg8::unpack4;
constexpr int AP = 136;
template <bool TWO> __device__ __forceinline__ void core(Frame& F, const bf16_t* A, int lda, int K, const bf16_t* bp0, const bf16_t* bp1, f32x4 (&acc0)[8], f32x4 (&acc1)[8]) {
    LAS bf16* AS = (LAS bf16*)F.lds; const int l15 = F.lane & 15, g = F.lane >> 4; const int nch = K >> 7; int cc = F.vcu % nch;
    v4u pre[4]; bf16x8 b0[4], b1[4];
    const int prow = F.tid >> 4, pc = (F.tid & 15) * 8;
#pragma unroll
    for (int i = 0; i < 4; ++i) pre[i] = *(const v4u*)(A + (size_t)(prow + 32 * i) * lda + cc * 128 + pc);
    if (bp0) {
#pragma unroll
        for (int u = 0; u < 4; ++u) { b0[u] = *(const bf16x8*)(bp0 + cc * 128 + 32 * u); if (TWO) b1[u] = *(const bf16x8*)(bp1 + cc * 128 + 32 * u); } }
    __syncthreads();
    for (int c = 0; c < nch; ++c) {
        LAS bf16* buf = AS + (c & 1) * (128 * AP);
#pragma unroll
        for (int i = 0; i < 4; ++i) *(LAS v4u*)&buf[(prow + 32 * i) * AP + pc] = pre[i];
        bf16x8 c0[4], c1[4];
#pragma unroll
        for (int u = 0; u < 4; ++u) { c0[u] = b0[u]; if (TWO) c1[u] = b1[u]; }
        cc = cc + 1 == nch ? 0 : cc + 1;
        if (c + 1 < nch) {
#pragma unroll
            for (int i = 0; i < 4; ++i) pre[i] = *(const v4u*)(A + (size_t)(prow + 32 * i) * lda + cc * 128 + pc);
            if (bp0) {
#pragma unroll
                for (int u = 0; u < 4; ++u) { b0[u] = *(const bf16x8*)(bp0 + cc * 128 + 32 * u); if (TWO) b1[u] = *(const bf16x8*)(bp1 + cc * 128 + 32 * u); } } }
        __syncthreads();
        if (bp0) {
#pragma unroll
            for (int u = 0; u < 4; ++u)
#pragma unroll
                for (int rt = 0; rt < 8; ++rt) { const bf16x8 a = *(const LAS bf16x8*)&buf[(16 * rt + l15) * AP + 32 * u + 8 * g];
                    acc0[rt] = __builtin_amdgcn_mfma_f32_16x16x32_bf16(c0[u], a, acc0[rt], 0, 0, 0); if (TWO) acc1[rt] = __builtin_amdgcn_mfma_f32_16x16x32_bf16(c1[u], a, acc1[rt], 0, 0, 0); } }
    }
}
#define MINI_ZERO(acc) _Pragma("unroll") for (int _i = 0; _i < 8; ++_i) acc[_i] = (f32x4){0.f, 0.f, 0.f, 0.f}
__device__ __forceinline__ void inproj(Frame& F) {
    unsigned char* ws = F.ws; const int l15 = F.lane & 15, g = F.lane >> 4;
    if (F.vcu >= NIN / 16) return;
    const int t = F.vcu + F.G * F.wave; const bool has = t < NIN / 16; const int n0 = 16 * t;
    f32x4 acc[8]; MINI_ZERO(acc);
    core<false>(F, (const bf16_t*)(ws + WS_XB) + 8192ull * 2048, 2048, 2048, has ? (const bf16_t*)(ws + WS_WIN) + (size_t)(n0 + l15) * 2048 + 8 * g : nullptr, nullptr, acc, acc);
    if (!has) return;
    const int c = n0 + 4 * g;
    if (c >= 7168 && c < 8192) {
#pragma unroll
        for (int rt = 0; rt < 8; ++rt) *(f32x4*)((float*)(ws + WS_LOGF) + (size_t)(8192 + 16 * rt + l15) * 1024 + (c - 7168)) = acc[rt];
        return; }
    size_t od; int pitch, c0, act; float sc = 1.0f;
    if (c < 1024) { od = WS_Q; pitch = 1024; c0 = 0; act = 0; } else if (c < 2048) { od = WS_K; pitch = 1024; c0 = 1024; act = 0; sc = 0.08838834764831845f; }
    else if (c < 4096) { od = WS_V; pitch = 2048; c0 = 2048; act = 0; } else if (c < 6144) { od = WS_RG; pitch = 2048; c0 = 4096; act = 1; } else if (c < 7168) { od = WS_HQ; pitch = 1024; c0 = 6144; act = 1; }
    else if (c < 9216) { od = WS_HI; pitch = 1024; c0 = 8192; act = 0; } else if (c < 10240) { od = WS_HG; pitch = 1024; c0 = 9216; act = 1; } else if (c < 12288) { od = WS_GA; pitch = 2048; c0 = 10240; act = 2; } else { od = WS_GB; pitch = 2048; c0 = 12288; act = 2; }
#pragma unroll
    for (int rt = 0; rt < 8; ++rt) { f32x4 v = acc[rt] * sc; if (act == 1) v = silu4(v); else if (act == 2) v = sigm4(v);
        *(u32x2*)((bf16_t*)(ws + od) + (size_t)(8192 + 16 * rt + l15) * pitch + (c - c0)) = pack4(v); }
}
__device__ __forceinline__ void outproj(Frame& F) {
    unsigned char* ws = F.ws; const int l15 = F.lane & 15, g = F.lane >> 4;
    if (F.vcu >= 128) return;
    const int t = F.vcu + F.G * F.wave; const bool has = t < 128; const int n0 = 16 * t;
    f32x4 ya[8], yb[8]; MINI_ZERO(ya); MINI_ZERO(yb);
    core<false>(F, (const bf16_t*)(ws + WS_OR) + 8192ull * 2048, 2048, 2048, has ? (const bf16_t*)(ws + WS_WRO) + (size_t)(n0 + l15) * 2048 + 8 * g : nullptr, nullptr, ya, ya);
    core<false>(F, (const bf16_t*)(ws + WS_OH) + 8192ull * 1024, 1024, 1024, has ? (const bf16_t*)(ws + WS_WHO) + (size_t)(n0 + l15) * 1024 + 8 * g : nullptr, nullptr, yb, yb);
    if (!has) return;
#pragma unroll
    for (int rt = 0; rt < 8; ++rt) { const size_t ix = (size_t)(8192 + 16 * rt + l15) * 2048 + n0 + 4 * g;
        const f32x4 ga = unpack4(*(const u32x2*)((const bf16_t*)(ws + WS_GA) + ix)), gb = unpack4(*(const u32x2*)((const bf16_t*)(ws + WS_GB) + ix));
        *(u32x2*)((bf16_t*)(ws + WS_MG) + ix) = pack4(ga * ya[rt] + gb * yb[rt]); }
}
__device__ __forceinline__ void resid(Frame& F, const bf16_t* Arows  , const bf16_t* Bt, int K, const float* XI  , float* XO  , bf16_t* XBo  , float* SS  ) {
    const int l15 = F.lane & 15, g = F.lane >> 4;
    if (F.vcu >= 128) return;
    const int t = F.vcu + F.G * F.wave; const bool has = t < 128; const int n0 = 16 * t;
    f32x4 acc[8]; MINI_ZERO(acc);
    core<false>(F, Arows, K, K, has ? Bt + (size_t)(n0 + l15) * K + 8 * g : nullptr, nullptr, acc, acc);
    if (!has) return;
#pragma unroll
    for (int rt = 0; rt < 8; ++rt) { const int rl = 16 * rt + l15; const size_t ix = (size_t)rl * 2048 + n0 + 4 * g;
        f32x4 v = acc[rt] + *(const f32x4*)(XI + ix); *(f32x4*)(XO + ix) = v;
        if (XBo) *(u32x2*)(XBo + ix) = pack4(v);
        float ss = (v[0] * v[0] + v[1] * v[1]) + (v[2] * v[2] + v[3] * v[3]); ss += __shfl_xor(ss, 16); ss += __shfl_xor(ss, 32);
        if (g == 0) atomicAdd(SS + rl, ss); }
}
__device__ __forceinline__ void swiglu(Frame& F) {
    unsigned char* ws = F.ws; const int l15 = F.lane & 15, g = F.lane >> 4;
    const int t = F.vcu + F.G * F.wave; const bool has = t < DFF / 16; const int ng = ((16 * t) >> 7) * 256 + ((16 * t) & 127);
    f32x4 ag[8], au[8]; MINI_ZERO(ag); MINI_ZERO(au);
    const bf16_t* A = (const bf16_t*)(ws + WS_X1B) + 8192ull * 2048;
    const bf16_t* bg = has ? (const bf16_t*)(ws + WS_WFI) + (size_t)(ng + l15) * 2048 + 8 * g : nullptr;
    core<true>(F, A, 2048, 2048, bg, has ? bg + 128 * 2048 : nullptr, ag, au);
    if (!has) return;
    const float* SS1 = (const float*)(F.ctl + CW_SS1);
#pragma unroll
    for (int rt = 0; rt < 8; ++rt) { const int r = 8192 + 16 * rt + l15; const float r2 = 1.0f / sqrtf(SS1[r] * (1.0f / 2048.0f) + EPS);
        *(u32x2*)((bf16_t*)(ws + WS_ACT) + (size_t)r * DFF + 16 * t + 4 * g) = pack4(silu4(ag[rt] * r2) * (au[rt] * r2)); }
}
}
__global__ void __launch_bounds__(NWAVES * 64, 2) mk_fwd(Args args) {
    extern __shared__ __attribute__((aligned(16))) unsigned char lds[];
    Frame F;
    F.lds = (LAS unsigned char*)lds; F.MISC = (volatile LAS unsigned*)(F.lds + MISC_OFF);
    F.tid = threadIdx.x; F.lane = F.tid & 63; F.wave = __builtin_amdgcn_readfirstlane(F.tid >> 6);
    F.G = gridDim.x; { const int bx = blockIdx.x; F.vcu = (F.G % 8 == 0) ? (bx % 8) * (F.G / 8) + bx / 8 : bx; }
    F.ws = args.ws; F.out = args.out; F.ctl = (gu32*)(args.ws + WS_CTL);
    for (int u = F.tid; u < (LDS_BYTES - LDSCTL_OFF) / 4; u += NWAVES * 64) ((LAS unsigned*)(F.lds + LDSCTL_OFF))[u] = 0u;
    __syncthreads();
    XcdBarrier bar; bar.bar = (unsigned*)(F.ctl + CW_BAR); bar.x = 0; bar.st = nullptr;
    if (args.use_bar) bar = xcd_barrier_post((unsigned*)(F.ctl + CW_BAR), F.MISC + 8);
    const int lo = args.ph_lo, hi = args.ph_hi;
#define IN(k) (lo <= (k) && (k) < hi)
#define SEAM(k) do { if (IN(k) && IN((k) + 1)) xcd_barrier(bar); } while (0)
#ifndef PROBE_REPEAT
#define PROBE_REPEAT -1
#endif
#define NREP(k) ((PROBE_REPEAT == (k)) ? 2 : 1)
    unsigned char* ws = args.ws;
    if (PROBE_REPEAT == 0) { p0_prologue(F, args); xcd_barrier(bar); }
    if (IN(0)) { p0_prologue(F, args); } SEAM(0);
#define P1_BODY { \
        pg8::Gemm g{(const pg8::bf16_t*)(ws + WS_XB), (const pg8::bf16_t*)(ws + WS_WIN), 8192, NIN, 2048}; pg8::StaticOrder S; S.init(8192, NIN, F.G, (int)blockIdx.x); \
        pg8::EpiInProj E{ws}; \
        pg8::gemm_phase<pg8::EpiInProj, pg8::StaticOrder, true, true>(F.lds, g, S, E); mini::inproj(F); }
    if (PROBE_REPEAT == 1) { P1_BODY xcd_barrier(bar); }
    if (IN(1)) P1_BODY SEAM(1);
    if (PROBE_REPEAT == 2) { p2_phase(F, args); xcd_barrier(bar); }
    if (IN(2)) { p2_phase(F, args); } SEAM(2);
    if (PROBE_REPEAT == 3) { p4_phase(F, args); xcd_barrier(bar); }
    if (IN(3)) { p4_phase(F, args); } SEAM(3);
    if (IN(4)) {
        { pg8::Gemm g{(const pg8::bf16_t*)(ws + WS_OR), (const pg8::bf16_t*)(ws + WS_WRO), 8192, 2048, 2048}; pg8::StaticOrder S; S.init(8192, 2048, F.G, (int)blockIdx.x);
          pg8::EpiGate<0> E{(const pg8::bf16_t*)(ws + WS_GA), (float*)(ws + WS_YT), (pg8::bf16_t*)(ws + WS_MG)};
          pg8::gemm_phase<pg8::EpiGate<0>, pg8::StaticOrder, true, true>(F.lds, g, S, E); }
        { pg8::Gemm g{(const pg8::bf16_t*)(ws + WS_OH), (const pg8::bf16_t*)(ws + WS_WHO), 8192, 2048, 1024}; pg8::StaticOrder S; S.init(8192, 2048, F.G, (int)blockIdx.x);
          pg8::EpiGate<1> E{(const pg8::bf16_t*)(ws + WS_GB), (float*)(ws + WS_YT), (pg8::bf16_t*)(ws + WS_MG)};
          pg8::gemm_phase<pg8::EpiGate<1>, pg8::StaticOrder, true, true>(F.lds, g, S, E); }
        mini::outproj(F);
    } SEAM(4);
    if (IN(5)) {
        pg8::Gemm g{(const pg8::bf16_t*)(ws + WS_MG), (const pg8::bf16_t*)(ws + WS_WOUT), 8192, 2048, 2048}; pg8::StaticOrder S; S.init(8192, 2048, F.G, (int)blockIdx.x);
        pg8::EpiResid E{args.in[0], args.in[1], args.out, (pg8::bf16_t*)(ws + WS_X1B), (float*)(F.ctl + CW_SS1)};
        pg8::gemm_phase<pg8::EpiResid, pg8::StaticOrder, true, true>(F.lds, g, S, E);
        mini::resid(F, (const pg8::bf16_t*)(ws + WS_MG) + 8192ull * 2048, (const pg8::bf16_t*)(ws + WS_WOUT), 2048, args.in[1], args.out + OUT_YS, (pg8::bf16_t*)(ws + WS_X1B) + 8192ull * 2048, (float*)(F.ctl + CW_SS1) + 8192);
    } SEAM(5);
    if (IN(6)) {
        pg8::Gemm g{(const pg8::bf16_t*)(ws + WS_X1B), (const pg8::bf16_t*)(ws + WS_WFI), 8192, 2 * DFF, 2048}; pg8::StaticOrder S; S.init(8192, 2 * DFF, F.G, (int)blockIdx.x);
        pg8::EpiSwiglu E{(const float*)(F.ctl + CW_SS1), (pg8::bf16_t*)(ws + WS_ACT)};
        pg8::gemm_phase<pg8::EpiSwiglu, pg8::StaticOrder, true, true>(F.lds, g, S, E);
        mini::swiglu(F);
    } SEAM(6);
    if (IN(7)) {
        pg8::Gemm g{(const pg8::bf16_t*)(ws + WS_ACT), (const pg8::bf16_t*)(ws + WS_WFO), 8192, 2048, DFF}; pg8::StaticOrder S; S.init(8192, 2048, F.G, (int)blockIdx.x);
        pg8::EpiResid E{args.out, args.out + OUT_YS, args.out, nullptr, (float*)(F.ctl + CW_SS2)};
        pg8::gemm_phase<pg8::EpiResid, pg8::StaticOrder, true, true>(F.lds, g, S, E);
        mini::resid(F, (const pg8::bf16_t*)(ws + WS_ACT) + 8192ull * DFF, (const pg8::bf16_t*)(ws + WS_WFO), DFF, args.out + OUT_YS, args.out + OUT_YS, nullptr, (float*)(F.ctl + CW_SS2) + 8192);
    } SEAM(7);
    if (IN(8)) {
        const int gw = F.vcu * NWAVES + F.wave, NGW = F.G * NWAVES; const float* SS2 = (const float*)(F.ctl + CW_SS2);
        for (int m = gw; m < MROWS; m += NGW) { f32x4* xr = (f32x4*)(args.out + (size_t)m * 2048) + F.lane; const f32x4* gn = (const f32x4*)args.in[14] + F.lane;
            const float rr = 1.0f / sqrtf(SS2[m] * (1.0f / 2048.0f) + EPS);
#pragma unroll
            for (int j = 0; j < 8; ++j) xr[64 * j] = xr[64 * j] * rr * gn[64 * j]; }
    }
#undef IN
#undef SEAM
}
extern "C" void kernel_launch(void* const* d_in, const int* in_sizes, int n_in, void* d_out, int out_size, void* d_ws, size_t ws_size, hipStream_t stream) {
    static int grid = 0;
    if (grid == 0) {
        int dev = 0, cus = 0;
        if (ws_size < WS_END || n_in != 15) { fprintf(stderr, "kernel_launch: unexpected sizes (ws %zu, n_in %d)\n", ws_size, n_in); grid = -1; return; }
        if (hipGetDevice(&dev) != hipSuccess || hipDeviceGetAttribute(&cus, hipDeviceAttributeMultiprocessorCount, dev) != hipSuccess) { grid = -1; return; }
        if (hipFuncSetAttribute((const void*)mk_fwd, hipFuncAttributeMaxDynamicSharedMemorySize, LDS_BYTES) != hipSuccess) { fprintf(stderr, "kernel_launch: hipFuncSetAttribute failed\n"); grid = -1; return; }
        int per_cu = 0; (void)hipOccupancyMaxActiveBlocksPerMultiprocessor(&per_cu, (const void*)mk_fwd, NWAVES * 64, LDS_BYTES); (void)hipGetLastError();
        if (per_cu < 1) { fprintf(stderr, "kernel_launch: occupancy query says %d blocks per CU; nothing launched\n", per_cu); grid = -1; return; }
        grid = cus;
    }
    if (grid < 0) return;
    (void)hipMemsetAsync((char*)d_ws + WS_CTL, 0, CTL_ZERO_BYTES, stream);
    Args a{};
    for (int i = 0; i < 15; ++i) a.in[i] = (const float*)d_in[i];
    a.out = (float*)d_out; a.ws = (unsigned char*)d_ws; a.use_bar = 1; a.ph_lo = 0; a.ph_hi = 9;
    hipLaunchKernelGGL(mk_fwd, dim3(grid), dim3(NWAVES * 64), LDS_BYTES, stream, a);
}
```

```cpp
#include <hip/hip_runtime.h>
#include <cstdio>
#include <cstdint>
constexpr int DMODEL = 2048, MROWS = 8320, MPAD = 8448, NIN = 14336, DFF = 5632, NWAVES = 8;
constexpr float EPS = 1e-6f;
constexpr size_t MiB = 1u << 20;
constexpr size_t WS_CTL = 0, CTL_ZERO_BYTES = 1 * MiB;
constexpr size_t WS_WRO = 1 * MiB, WS_WHO = 9 * MiB, WS_WOUT = 13 * MiB, WS_WFI = 21 * MiB, WS_WFO = 65 * MiB, WS_WIN = 87 * MiB;
constexpr size_t WS_XB = 143 * MiB;
constexpr size_t WS_Q = 176 * MiB, WS_K = WS_Q + 8448ull * 1024 * 2, WS_V = 209 * MiB, WS_RG = 242 * MiB, WS_HQ = 275 * MiB, WS_LOGF = WS_HQ + 8448ull * 1024 * 2;
constexpr size_t WS_HI = WS_LOGF + 8448ull * 1024 * 4, WS_HG = WS_HI + 8448ull * 1024 * 2, WS_GA = WS_HG + 8448ull * 1024 * 2, WS_GB = WS_GA + 8448ull * 2048 * 2;
constexpr size_t WS_KVLOC = WS_GB + 8448ull * 2048 * 2;
constexpr size_t WS_HSLOC = WS_KVLOC + 64 * MiB;
constexpr size_t WS_OH = WS_HSLOC + 32 * MiB;
constexpr size_t WS_MISC = WS_OH + 8448ull * 1024 * 2;
constexpr size_t WS_RR1 = WS_MISC, WS_COS = WS_RR1 + 64 * 1024, WS_SIN = WS_COS + 2049 * 64 * 4 + 256, WS_LB = WS_SIN + 2049 * 64 * 4 + 256, WS_BTOT = WS_LB + 4096, WS_END = WS_BTOT + 512 * 128 * 4;
constexpr size_t WS_OR = WS_XB;
constexpr size_t WS_SRT = WS_WIN, WS_SHT = WS_WIN + 32 * MiB;
constexpr size_t WS_YT = WS_KVLOC;
constexpr size_t WS_MG = WS_Q;
constexpr size_t WS_X1B = WS_V;
constexpr size_t WS_ACT = WS_RG;
static_assert(WS_GB + 8448ull * 2048 * 2 == WS_KVLOC && WS_K + 8448ull * 1024 * 2 == WS_V && WS_V + 8448ull * 2048 * 2 == WS_RG && WS_RG + 8448ull * 2048 * 2 == WS_HQ, "map");
static_assert(WS_YT + 8448ull * 2048 * 4 <= WS_OH && WS_ACT + 8448ull * 5632 * 2 <= WS_GA && WS_END <= 541 * MiB, "map2");
constexpr int CW_BAR = 4096;
constexpr int CW_SS1 = 16384, CW_SS2 = 16384 + 8448;
static_assert((CW_SS2 + 8448) * 4 <= (int)CTL_ZERO_BYTES, "ctl");
constexpr int RING_BYTES = 131072, LDSCTL_OFF = RING_BYTES, MISC_OFF = LDSCTL_OFF + 320, LDS_BYTES = 147456;

#define GAS __attribute__((address_space(1)))
#define LAS __attribute__((address_space(3)))
typedef unsigned short bf16;
typedef unsigned v4u __attribute__((ext_vector_type(4)));
typedef unsigned v2u __attribute__((ext_vector_type(2)));
typedef float f32x4 __attribute__((ext_vector_type(4)));
typedef short bf16x8 __attribute__((ext_vector_type(8)));
typedef GAS unsigned gu32;
#define RLX_AGENT __ATOMIC_RELAXED, __HIP_MEMORY_SCOPE_AGENT
#define LDS_WAIT() asm volatile("s_waitcnt lgkmcnt(0)" ::: "memory")
#define VM_WAIT() asm volatile("s_waitcnt vmcnt(0)" ::: "memory")
__device__ __forceinline__ unsigned f2bf(float f) { unsigned u = __builtin_bit_cast(unsigned, f); return (u + 0x7fffu + ((u >> 16) & 1u)) >> 16; }
__device__ __forceinline__ unsigned pk2(float lo, float hi) { return f2bf(lo) | (f2bf(hi) << 16); }
__device__ __forceinline__ float bf2f(unsigned short b) { return __uint_as_float(((unsigned)b) << 16); }
namespace pg8 {
#define PG8_LAS __attribute__((address_space(3)))
typedef unsigned short bf16_t;
typedef short bf16x8 __attribute__((ext_vector_type(8)));
typedef float f32x4 __attribute__((ext_vector_type(4)));
typedef unsigned u32x4 __attribute__((ext_vector_type(4)));
constexpr int BM = 256, BK = 64, HALF = 128, HTB = HALF * BK * 2  , STAGE_BYTES = 8 * HTB, NXCD = 8, WGM = 8;

__host__ __device__ __forceinline__ int lds_byte(int r, int c) { const int st = (r >> 4) * 2 + (c >> 5), rr = r & 15, cc = c & 31, ob = rr * 64 + cc * 2; return st * 1024 + (ob ^ (((ob >> 9) & 1) << 5)); }
__host__ __device__ __forceinline__ void stage_rc(int b, int& R, int& C) { const int st = b / 1024, sb = b % 1024, swz = sb ^ (((sb >> 9) & 1) << 5); R = (st >> 1) * 16 + swz / 64; C = (st & 1) * 32 + (swz % 64) / 2; }
__host__ __device__ __forceinline__ int perm32(int rho) { const int n = rho >> 4, i = rho & 15; return 8 * (i >> 2) + 4 * n + (i & 3); }

struct Unit { int pm, pn; };
struct Gemm { const bf16_t* A; const bf16_t* Bt; int M, N, K; };

struct StaticOrder {
    int nM, nN, nwg, G, c;
    __host__ __device__ void init(int M, int N, int G_, int c_) { nM = M / BM; nN = N / BM; nwg = nM * nN; G = G_; c = c_; }
    __host__ __device__ bool next(int i, Unit& u) const {
        const long L = (long)i * G + c; if (L >= nwg) return false;
        int wgid = (int)L; { const int q = nwg / NXCD, r = nwg % NXCD, xcd = wgid % NXCD, off = wgid / NXCD; wgid = (xcd < r ? xcd * (q + 1) : r * (q + 1) + (xcd - r) * q) + off; }
        const int nig = WGM * nN, gid = wgid / nig, fm = gid * WGM, gsz = (nM - fm) < WGM ? (nM - fm) : WGM;
        u.pm = fm + ((wgid % nig) % gsz); u.pn = (wgid % nig) / gsz; return true;
    }
    __device__ __forceinline__ void a_ready(const Unit&) const {}
    __device__ __forceinline__ void done(const Unit&) const {}
};

__device__ __forceinline__ unsigned cvt_pk_bf16(float lo, float hi) { unsigned r; asm volatile("v_cvt_pk_bf16_f32 %0, %1, %2" : "=v"(r) : "v"(lo), "v"(hi)); return r; }
typedef float f32x2 __attribute__((ext_vector_type(2)));
typedef unsigned u32x2 __attribute__((ext_vector_type(2)));
__device__ __forceinline__ float sigm(float x) { return __builtin_amdgcn_rcpf(1.0f + __expf(-x)); }
__device__ __forceinline__ f32x4 silu4(f32x4 v) { f32x4 o; o[0] = v[0] * sigm(v[0]); o[1] = v[1] * sigm(v[1]); o[2] = v[2] * sigm(v[2]); o[3] = v[3] * sigm(v[3]); return o; }
__device__ __forceinline__ f32x4 sigm4(f32x4 v) { f32x4 o; o[0] = sigm(v[0]); o[1] = sigm(v[1]); o[2] = sigm(v[2]); o[3] = sigm(v[3]); return o; }
__device__ __forceinline__ u32x4 pack8(f32x4 v0, f32x4 v1) { u32x4 w; w.x = cvt_pk_bf16(v0[0], v0[1]); w.y = cvt_pk_bf16(v0[2], v0[3]); w.z = cvt_pk_bf16(v1[0], v1[1]); w.w = cvt_pk_bf16(v1[2], v1[3]); return w; }
__device__ __forceinline__ u32x2 pack4(f32x4 v) { u32x2 w; w.x = cvt_pk_bf16(v[0], v[1]); w.y = cvt_pk_bf16(v[2], v[3]); return w; }
__device__ __forceinline__ f32x4 unpack4(u32x2 w) { f32x4 o; o[0] = __uint_as_float(w.x << 16); o[1] = __uint_as_float(w.x & 0xffff0000u); o[2] = __uint_as_float(w.y << 16); o[3] = __uint_as_float(w.y & 0xffff0000u); return o; }

struct EpiInProj {
    static constexpr bool PERM = true, AFTER_DRAIN = false;
    unsigned char* ws;
    __device__ __forceinline__ void operator()(const f32x4 (&acc)[2][2][4][2], const Unit& u, int wr, int wc, int fr, int fq) const {
        const int pn = u.pn, row0 = u.pm * BM + wr * 64 + fr;
        if (pn >= 28 && pn < 32) {
            float* Z = (float*)(ws + WS_LOGF); const int cs = (pn - 28) * 256 + wc * 32 + 8 * fq;
#pragma unroll
            for (int ai = 0; ai < 2; ++ai)
#pragma unroll
                for (int m = 0; m < 4; ++m) { const int r = row0 + ai * HALF + m * 16;
#pragma unroll
                    for (int bj = 0; bj < 2; ++bj)
#pragma unroll
                        for (int n = 0; n < 2; ++n) *(f32x4*)(Z + (size_t)r * 1024 + cs + bj * HALF + 4 * n) = acc[ai][bj][m][n]; }
        } else {
            size_t od; int pitch, p0, act; float sc = 1.0f;
            if (pn < 4) { od = WS_Q; pitch = 1024; p0 = 0; act = 0; } else if (pn < 8) { od = WS_K; pitch = 1024; p0 = 4; act = 0; sc = 0.08838834764831845f; }
            else if (pn < 16) { od = WS_V; pitch = 2048; p0 = 8; act = 0; } else if (pn < 24) { od = WS_RG; pitch = 2048; p0 = 16; act = 1; } else if (pn < 28) { od = WS_HQ; pitch = 1024; p0 = 24; act = 1; }
            else if (pn < 36) { od = WS_HI; pitch = 1024; p0 = 32; act = 0; } else if (pn < 40) { od = WS_HG; pitch = 1024; p0 = 36; act = 1; } else if (pn < 48) { od = WS_GA; pitch = 2048; p0 = 40; act = 2; } else { od = WS_GB; pitch = 2048; p0 = 48; act = 2; }
            bf16_t* dst = (bf16_t*)(ws + od);
            const int cs = (pn - p0) * 256 + wc * 32 + 8 * fq;
#pragma unroll
            for (int ai = 0; ai < 2; ++ai)
#pragma unroll
                for (int m = 0; m < 4; ++m) { const int r = row0 + ai * HALF + m * 16; bf16_t* rowp = dst + (size_t)r * pitch + cs;
#pragma unroll
                    for (int bj = 0; bj < 2; ++bj) { f32x4 v0 = acc[ai][bj][m][0] * sc, v1 = acc[ai][bj][m][1] * sc;
                        if (act == 1) { v0 = silu4(v0); v1 = silu4(v1); } else if (act == 2) { v0 = sigm4(v0); v1 = sigm4(v1); }
                        *(u32x4*)(rowp + bj * HALF) = pack8(v0, v1); } }
        }
    }
};
struct EpiNull {
    static constexpr bool PERM = true, AFTER_DRAIN = false;
    __device__ __forceinline__ void operator()(const f32x4 (&acc)[2][2][4][2], const Unit& u, int wr, int wc, int fr, int fq) const {
#pragma unroll
        for (int ai = 0; ai < 2; ++ai)
#pragma unroll
            for (int m = 0; m < 4; ++m)
#pragma unroll
                for (int bj = 0; bj < 2; ++bj) { asm volatile("" :: "v"(acc[ai][bj][m][0]), "v"(acc[ai][bj][m][1])); }
    }
};
template <int SECOND> struct EpiGate {
    static constexpr bool PERM = true, AFTER_DRAIN = false;
    const bf16_t* G; float* YT; bf16_t* MG;
    __device__ __forceinline__ void operator()(const f32x4 (&acc)[2][2][4][2], const Unit& u, int wr, int wc, int fr, int fq) const {
        const int row0 = u.pm * BM + wr * 64 + fr, col0 = u.pn * BM + wc * 32 + 8 * fq;
#pragma unroll
        for (int ai = 0; ai < 2; ++ai)
#pragma unroll
            for (int m = 0; m < 4; ++m) { const size_t off = (size_t)(row0 + ai * HALF + m * 16) * 2048 + col0;
#pragma unroll
                for (int bj = 0; bj < 2; ++bj) { const u32x4 gw = *(const u32x4*)(G + off + bj * HALF);
                    f32x4 v0 = acc[ai][bj][m][0] * unpack4((u32x2){gw.x, gw.y}), v1 = acc[ai][bj][m][1] * unpack4((u32x2){gw.z, gw.w});
                    float* yp = YT + off + bj * HALF;
                    if (SECOND) { v0 += *(const f32x4*)yp; v1 += *(const f32x4*)(yp + 4); *(u32x4*)(MG + off + bj * HALF) = pack8(v0, v1); }
                    else { *(f32x4*)yp = v0; *(f32x4*)(yp + 4) = v1; } } }
        __builtin_amdgcn_s_waitcnt(0x0F70);
    }
};
struct EpiResid {
    static constexpr bool PERM = true, AFTER_DRAIN = false;
    const float* XP; const float* XS; float* OUT; bf16_t* XB; float* SS;
    __device__ __forceinline__ void operator()(const f32x4 (&acc)[2][2][4][2], const Unit& u, int wr, int wc, int fr, int fq) const {
        const int row0 = u.pm * BM + wr * 64 + fr, col0 = u.pn * BM + wc * 32 + 8 * fq;
#pragma unroll
        for (int ai = 0; ai < 2; ++ai)
#pragma unroll
            for (int m = 0; m < 4; ++m) { const int r = row0 + ai * HALF + m * 16; const bool live = r < 8320;
                const float* xi = (r < 8192 ? XP + (size_t)r * 2048 : XS + (size_t)(r - 8192) * 2048) + col0; float ss = 0.f;
#pragma unroll
                for (int bj = 0; bj < 2; ++bj) { f32x4 v0 = acc[ai][bj][m][0], v1 = acc[ai][bj][m][1];
                    if (live) { v0 += *(const f32x4*)(xi + bj * HALF); v1 += *(const f32x4*)(xi + bj * HALF + 4);
                        float* op = OUT + (size_t)r * 2048 + col0 + bj * HALF; *(f32x4*)op = v0; *(f32x4*)(op + 4) = v1; }
                    if (XB) *(u32x4*)(XB + (size_t)r * 2048 + col0 + bj * HALF) = pack8(v0, v1);
                    ss += (v0[0] * v0[0] + v0[1] * v0[1]) + (v0[2] * v0[2] + v0[3] * v0[3]) + (v1[0] * v1[0] + v1[1] * v1[1]) + (v1[2] * v1[2] + v1[3] * v1[3]); }
                ss += __shfl_xor(ss, 16); ss += __shfl_xor(ss, 32);
                if (fq == 0) atomicAdd(SS + r, ss); }
        __builtin_amdgcn_s_waitcnt(0x0F70);
    }
};
struct EpiSwiglu {
    static constexpr bool PERM = true, AFTER_DRAIN = false;
    const float* SS; bf16_t* ACT;
    __device__ __forceinline__ void operator()(const f32x4 (&acc)[2][2][4][2], const Unit& u, int wr, int wc, int fr, int fq) const {
        const int row0 = u.pm * BM + wr * 64 + fr, col0 = u.pn * HALF + wc * 32 + 8 * fq;
        float ssv[2][4];
#pragma unroll
        for (int ai = 0; ai < 2; ++ai)
#pragma unroll
            for (int m = 0; m < 4; ++m) ssv[ai][m] = SS[row0 + ai * HALF + m * 16];
        __builtin_amdgcn_s_waitcnt(0x0F70);
#pragma unroll
        for (int ai = 0; ai < 2; ++ai)
#pragma unroll
            for (int m = 0; m < 4; ++m) { const int r = row0 + ai * HALF + m * 16; const float r2 = 1.0f / sqrtf(ssv[ai][m] * (1.0f / 2048.0f) + 1e-6f);
                const f32x4 g0 = acc[ai][0][m][0] * r2, g1 = acc[ai][0][m][1] * r2, u0 = acc[ai][1][m][0] * r2, u1 = acc[ai][1][m][1] * r2;
                *(u32x4*)(ACT + (size_t)r * 5632 + col0) = pack8(silu4(g0) * u0, silu4(g1) * u1); }
    }
};
template <class Epi, class Sched, bool ALIGN_EPI = false, bool SP2 = false>
__device__ __forceinline__ void gemm_phase(PG8_LAS unsigned char* lds, const Gemm g, const Sched& S, const Epi& E) {
    const int tid = threadIdx.x, wid = __builtin_amdgcn_readfirstlane(tid >> 6), lane = tid & 63, wr = wid >> 2, wc = wid & 3, fr = lane & 15, fq = lane >> 4;
    const int K = g.K, nt = K / BK;
    unsigned voffA[2], voffB[2];
#pragma unroll
    for (int i = 0; i < 2; ++i) { int R, C; stage_rc(tid * 16 + i * 8192, R, C); const int Rb = Epi::PERM ? ((R & ~31) + perm32(R & 31)) : R;
        voffA[i] = (unsigned)(R * K + C) * 2u; voffB[i] = (unsigned)(Rb * K + C) * 2u; }
    const size_t kstep = (size_t)(BK * 2);
    const size_t hstep = (size_t)HALF * K * 2;
    const size_t tstep = 2 * hstep;
    const unsigned ldsw = (unsigned)wid * 1024u;
    const int aoff = lds_byte(wr * 64 + fr, fq * 8), boff = lds_byte(wc * 32 + fr, fq * 8);
#define PG8_SA(b, h) (((b) * 2 + (h)) * HTB)
#define PG8_SB(b, h) ((4 + (b) * 2 + (h)) * HTB)
#define PG8_STAGE(bufoff, gbase, voff) do { _Pragma("unroll") for (int _i = 0; _i < 2; ++_i) \
        __builtin_amdgcn_global_load_lds((const unsigned*)((const char*)(gbase) + (voff)[_i]), (PG8_LAS unsigned*)(lds + (bufoff) + ldsw + _i * 8192), 16, 0, 0); } while (0)
#define PG8_LDA(dst, b, h) do { _Pragma("unroll") for (int m = 0; m < 4; ++m) _Pragma("unroll") for (int k = 0; k < 2; ++k) dst[m][k] = *(const PG8_LAS bf16x8*)(lds + PG8_SA(b, h) + aoff + m * 2048 + k * 1024); } while (0)
#define PG8_LDB(dst, b, h) do { _Pragma("unroll") for (int n = 0; n < 2; ++n) _Pragma("unroll") for (int k = 0; k < 2; ++k) dst[n][k] = *(const PG8_LAS bf16x8*)(lds + PG8_SB(b, h) + boff + n * 2048 + k * 1024); } while (0)
#define PG8_MMA(ai, bj, At, Bt) do { __builtin_amdgcn_s_setprio(1); _Pragma("unroll") for (int m = 0; m < 4; ++m) _Pragma("unroll") for (int n = 0; n < 2; ++n) _Pragma("unroll") for (int k = 0; k < 2; ++k) \
        acc[ai][bj][m][n] = __builtin_amdgcn_mfma_f32_16x16x32_bf16(Bt[n][k], At[m][k], acc[ai][bj][m][n], 0, 0, 0); __builtin_amdgcn_s_setprio(0); } while (0)
#define PG8_WAIT_V(n) asm volatile("s_waitcnt vmcnt(" #n ")" ::: "memory")
#define PG8_WAIT_L(n) asm volatile("s_waitcnt lgkmcnt(" #n ")" ::: "memory")
#define PG8_BAR __builtin_amdgcn_s_barrier()
#define PG8_SCHED __builtin_amdgcn_sched_barrier(0)
    Unit cur, nxt; int ui = 0;
    if (!S.next(0, cur)) return;
    f32x4 acc[2][2][4][2];
#pragma unroll
    for (int a = 0; a < 2; ++a)
#pragma unroll
        for (int b = 0; b < 2; ++b)
#pragma unroll
            for (int m = 0; m < 4; ++m)
#pragma unroll
                for (int n = 0; n < 2; ++n) acc[a][b][m][n] = (f32x4){0.f, 0.f, 0.f, 0.f};
    bf16x8 At[4][2], B0[2][2], B1[2][2];
    const char* cA = (const char*)g.A + (size_t)cur.pm * tstep; const char* cB = (const char*)g.Bt + (size_t)cur.pn * tstep;
    S.a_ready(cur);
    if constexpr (SP2) {
        PG8_STAGE(PG8_SB(0, 0), cB, voffB); PG8_STAGE(PG8_SB(0, 1), cB + hstep, voffB); PG8_STAGE(PG8_SA(0, 0), cA, voffA); PG8_STAGE(PG8_SA(0, 1), cA + hstep, voffA);
        if (wr == 1) PG8_BAR;
        PG8_WAIT_V(2); PG8_BAR;
        PG8_STAGE(PG8_SB(1, 0), cB + kstep, voffB); PG8_STAGE(PG8_SA(1, 0), cA + kstep, voffA); PG8_STAGE(PG8_SB(1, 1), cB + hstep + kstep, voffB);
        PG8_WAIT_V(6); PG8_BAR;
    } else {
        PG8_STAGE(PG8_SB(0, 0), cB, voffB); PG8_STAGE(PG8_SA(0, 0), cA, voffA); PG8_STAGE(PG8_SB(0, 1), cB + hstep, voffB); PG8_STAGE(PG8_SA(0, 1), cA + hstep, voffA);
        if (wr == 1) PG8_BAR;
        PG8_WAIT_V(4); PG8_BAR;
        PG8_STAGE(PG8_SB(1, 0), cB + kstep, voffB); PG8_STAGE(PG8_SA(1, 0), cA + kstep, voffA); PG8_STAGE(PG8_SB(1, 1), cB + hstep + kstep, voffB);
        PG8_WAIT_V(6); PG8_BAR;
    }
    for (;;) {
        const bool has_next = S.next(ui + 1, nxt);
        const char* nA = has_next ? (const char*)g.A + (size_t)nxt.pm * tstep : cA; const char* nB = has_next ? (const char*)g.Bt + (size_t)nxt.pn * tstep : cB;
        for (int t = 0; t < nt; t += 2) {
            const bool last = (t == nt - 2);
            const char* a1 = cA + (size_t)(t + 1) * kstep;
            const char* a2 = last ? nA : cA + (size_t)(t + 2) * kstep; const char* b2 = last ? nB : cB + (size_t)(t + 2) * kstep;
            const char* a3 = a2 + kstep; const char* b3 = b2 + kstep;
            if (last && has_next) S.a_ready(nxt);
            if constexpr (SP2) {
            PG8_LDB(B0, 0, 0); PG8_LDB(B1, 0, 1); PG8_SCHED; PG8_LDA(At, 0, 0); PG8_STAGE(PG8_SA(1, 1), a1 + hstep, voffA);
            PG8_WAIT_V(8); PG8_WAIT_L(0); PG8_BAR; PG8_MMA(0, 0, At, B0); PG8_MMA(0, 1, At, B1); PG8_BAR; PG8_SCHED;
            PG8_LDA(At, 0, 1); PG8_STAGE(PG8_SB(0, 0), b2, voffB); PG8_STAGE(PG8_SB(0, 1), b2 + hstep, voffB); PG8_STAGE(PG8_SA(0, 0), a2, voffA);
            PG8_WAIT_V(8); PG8_WAIT_L(0); PG8_BAR; PG8_MMA(1, 0, At, B0); PG8_MMA(1, 1, At, B1); PG8_BAR; PG8_SCHED;
            PG8_LDB(B0, 1, 0); PG8_LDB(B1, 1, 1); PG8_SCHED; PG8_LDA(At, 1, 0); PG8_STAGE(PG8_SA(0, 1), a2 + hstep, voffA);
            PG8_WAIT_V(8); PG8_WAIT_L(0); PG8_BAR; PG8_MMA(0, 0, At, B0); PG8_MMA(0, 1, At, B1); PG8_BAR; PG8_SCHED;
            PG8_LDA(At, 1, 1); PG8_STAGE(PG8_SB(1, 0), b3, voffB); PG8_STAGE(PG8_SB(1, 1), b3 + hstep, voffB); PG8_STAGE(PG8_SA(1, 0), a3, voffA);
            PG8_WAIT_V(8); PG8_WAIT_L(0); PG8_BAR; PG8_MMA(1, 0, At, B0); PG8_MMA(1, 1, At, B1); PG8_BAR; PG8_SCHED;
            } else {
            PG8_LDB(B0, 0, 0); PG8_SCHED; PG8_LDA(At, 0, 0); PG8_STAGE(PG8_SA(1, 1), a1 + hstep, voffA);
            PG8_WAIT_L(8); PG8_BAR; PG8_WAIT_L(0); PG8_MMA(0, 0, At, B0); PG8_BAR; PG8_SCHED;
            PG8_LDB(B1, 0, 1); PG8_STAGE(PG8_SB(0, 0), b2, voffB);
            PG8_BAR; PG8_WAIT_L(0); PG8_MMA(0, 1, At, B1); PG8_BAR;
            PG8_LDA(At, 0, 1); PG8_STAGE(PG8_SA(0, 0), a2, voffA);
            PG8_BAR; PG8_WAIT_L(0); PG8_MMA(1, 0, At, B0); PG8_BAR; PG8_SCHED;
            PG8_STAGE(PG8_SB(0, 1), b2 + hstep, voffB);
            PG8_WAIT_V(6); PG8_BAR; PG8_MMA(1, 1, At, B1); PG8_BAR;
            PG8_LDB(B0, 1, 0); PG8_SCHED; PG8_LDA(At, 1, 0); PG8_STAGE(PG8_SA(0, 1), a2 + hstep, voffA);
            PG8_WAIT_L(8); PG8_BAR; PG8_WAIT_L(0); PG8_MMA(0, 0, At, B0); PG8_BAR; PG8_SCHED;
            PG8_LDB(B1, 1, 1); PG8_STAGE(PG8_SB(1, 0), b3, voffB);
            PG8_BAR; PG8_WAIT_L(0); PG8_MMA(0, 1, At, B1); PG8_BAR;
            PG8_LDA(At, 1, 1); PG8_STAGE(PG8_SA(1, 0), a3, voffA);
            PG8_BAR; PG8_WAIT_L(0); PG8_MMA(1, 0, At, B0); PG8_BAR; PG8_SCHED;
            PG8_STAGE(PG8_SB(1, 1), b3 + hstep, voffB);
            PG8_WAIT_V(6); PG8_BAR; PG8_MMA(1, 1, At, B1); PG8_BAR;
            }
        }
        if constexpr (ALIGN_EPI) { if (wr == 0) PG8_BAR; }
        if constexpr (!Epi::AFTER_DRAIN) { E(acc, cur, wr, wc, fr, fq); S.done(cur); }
        if (!has_next) break;
#pragma unroll
        for (int a = 0; a < 2; ++a)
#pragma unroll
            for (int b = 0; b < 2; ++b)
#pragma unroll
                for (int m = 0; m < 4; ++m)
#pragma unroll
                    for (int n = 0; n < 2; ++n) acc[a][b][m][n] = (f32x4){0.f, 0.f, 0.f, 0.f};
        cur = nxt; cA = nA; cB = nB; ++ui;
        if constexpr (ALIGN_EPI) { if (wr == 1) PG8_BAR; }
    }
    PG8_WAIT_V(0);
    if constexpr (!ALIGN_EPI) { if (wr == 0) PG8_BAR; }
    PG8_BAR;
    if constexpr (Epi::AFTER_DRAIN) { E.fused(acc, cur, wr, wc, fr, fq, lds, wid, lane); S.done(cur); }
#undef PG8_SA
#undef PG8_SB
#undef PG8_STAGE
#undef PG8_LDA
#undef PG8_LDB
#undef PG8_MMA
#undef PG8_WAIT_V
#undef PG8_WAIT_L
#undef PG8_BAR
#undef PG8_SCHED
}
}
#define XB_TMO      128
#define XB_XCNT(j)  (256  + 64 * (j))
#define XB_XSUB(j)  (1280 + 64 * (j))
#define XB_XGEN(j)  (2304 + 64 * (j))
#define XB_TOP      3328
#define XB_TOPGEN   3392
#define XCD_BAR_WORDS 3456
#define XB_SPIN_CAP (1u << 18)

__device__ __forceinline__ unsigned xb_ld(unsigned* p)              { return __hip_atomic_load(p, __ATOMIC_RELAXED, __HIP_MEMORY_SCOPE_AGENT); }
__device__ __forceinline__ unsigned xb_add(unsigned* p, unsigned v) { return __hip_atomic_fetch_add(p, v, __ATOMIC_RELAXED, __HIP_MEMORY_SCOPE_AGENT); }
__device__ __forceinline__ unsigned xb_xcc_id() { return (unsigned)__builtin_amdgcn_s_getreg((3 << 11) | 20) & 0xFu; }
#define XB_SPIN(cond, bar) do { unsigned _sp = 0; while (cond) { __builtin_amdgcn_s_sleep(1); \
    if ((++_sp & 255u) == 0u) { if (xb_ld(&(bar)[XB_TMO])) break; if (_sp > XB_SPIN_CAP) { atomicAdd(&(bar)[XB_TMO], 1u); break; } } } } while (0)

struct XcdBarrier {
    unsigned* bar; unsigned x;
    volatile LAS unsigned* st;
};

__device__ __forceinline__ XcdBarrier xcd_barrier_post(unsigned* bar, volatile LAS unsigned* st) {
    XcdBarrier b; b.bar = bar; b.x = xb_xcc_id(); b.st = st;
    if (threadIdx.x == 0) (void)xb_add(&bar[XB_XCNT(b.x)], 1u);
    return b;
}
__device__ __forceinline__ void xcd_barrier_complete(unsigned* bar, unsigned x, unsigned& nloc, unsigned& nx) {
    const unsigned G = gridDim.x * gridDim.y * gridDim.z;
    unsigned sum, cnt, mine, sp = 0u;
    for (;;) {
        sum = 0u; cnt = 0u; mine = 0u;
#pragma unroll
        for (unsigned j = 0; j < 16; ++j) { const unsigned c = xb_ld(&bar[XB_XCNT(j)]); sum += c; cnt += (c > 0u) ? 1u : 0u; mine = (j == x) ? c : mine; }
        if (sum == G) break;
        __builtin_amdgcn_s_sleep(1);
        if ((++sp & 255u) == 0u) { if (xb_ld(&bar[XB_TMO])) break; if (sp > XB_SPIN_CAP) { atomicAdd(&bar[XB_TMO], 1u); break; } }
    }
    nloc = mine > 0u ? mine : 1u; nx = cnt > 0u ? cnt : 1u;
}

__device__ __forceinline__ void xcd_barrier(const XcdBarrier& b) {
    asm volatile("s_waitcnt vmcnt(0)" ::: "memory");
    __syncthreads();
    if (threadIdx.x == 0) {
        unsigned* bar = b.bar;
        __builtin_amdgcn_s_waitcnt(0);
        unsigned nloc = b.st[0], nx = b.st[1];
        if (nloc == 0u) { xcd_barrier_complete(bar, b.x, nloc, nx); b.st[0] = nloc; b.st[1] = nx; }
        const unsigned old = xb_add(&bar[XB_XSUB(b.x)], 1u);
        const unsigned gen = old / nloc;
        if (old + 1u == (gen + 1u) * nloc) {
            __builtin_amdgcn_fence(__ATOMIC_RELEASE, "agent");
            asm volatile("s_waitcnt vmcnt(0)" ::: "memory");
            const unsigned og = xb_add(&bar[XB_TOP], 1u);
            const unsigned tg = og / nx;
            if (og + 1u == (tg + 1u) * nx) xb_add(&bar[XB_TOPGEN], 1u);
            else XB_SPIN(xb_ld(&bar[XB_TOPGEN]) == tg, bar);
            __builtin_amdgcn_fence(__ATOMIC_ACQUIRE, "agent");
            xb_add(&bar[XB_XGEN(b.x)], 1u);
            asm volatile("s_waitcnt vmcnt(0)" ::: "memory");
        } else {
            XB_SPIN(xb_ld(&bar[XB_XGEN(b.x)]) == gen, bar);
            __builtin_amdgcn_fence(__ATOMIC_ACQUIRE, "agent");
            asm volatile("s_waitcnt vmcnt(0)" ::: "memory");
        }
    }
    __syncthreads();
}
struct Frame {
    LAS unsigned char* lds; volatile LAS unsigned* MISC; gu32* ctl;
    int tid, lane, wave, vcu, G;
    float* out; unsigned char* ws;
};
__device__ __forceinline__ float wave_sum(float v) {
#pragma unroll
    for (int o = 1; o < 64; o <<= 1) v += __shfl_xor(v, o);
    return v;
}
template <int MODE> __device__ __forceinline__ int rowmap(int n) {
    if (MODE == 1) { if (n >= 2048) return n; const int j = n & 127, hb = n & ~127; return hb + (j < 64 ? 8 * (j >> 2) + (j & 3) : 8 * ((j - 64) >> 2) + 4 + (j & 3)); }
    if (MODE == 2) { return n < DFF ? (n >> 7) * 256 + (n & 127) : ((n - DFF) >> 7) * 256 + 128 + ((n - DFF) & 127); }
    return n;
}
template <int MODE> __device__ __forceinline__ void p0_transpose_item(const float* W, int K, int N, bf16* WT, const float* g, LAS unsigned* T, int item, int lane) {
    const int nblk = N / 64, kb = item / nblk, nb = item % nblk, k0 = 64 * kb, n0 = 64 * nb;
    const int l15 = lane & 15, lg = lane >> 4;
    f32x4 v[16];
#pragma unroll
    for (int i = 0; i < 16; ++i) { const int row = 8 * (i >> 1) + 2 * lg + (i & 1); v[i] = *(const f32x4*)(W + (size_t)(k0 + row) * N + n0 + 4 * l15); }
    if (g) {
#pragma unroll
        for (int i = 0; i < 16; ++i) { const int row = 8 * (i >> 1) + 2 * lg + (i & 1); v[i] = v[i] * g[k0 + row]; } }
#pragma unroll
    for (int p = 0; p < 8; ++p)
#pragma unroll
        for (int j = 0; j < 4; ++j) T[(4 * l15 + j) * 33 + 4 * p + lg] = pk2(v[2 * p][j], v[2 * p + 1][j]);
    LDS_WAIT(); asm volatile("" ::: "memory");
    const int c = lane & 7;
#pragma unroll
    for (int i = 0; i < 8; ++i) { const int n = (lane >> 3) + 8 * i; const LAS unsigned* s = T + n * 33 + 4 * c;
        v4u o; o.x = s[0]; o.y = s[1]; o.z = s[2]; o.w = s[3];
        *(GAS v4u*)(WT + (size_t)rowmap<MODE>(n0 + n) * K + k0 + 8 * c) = o; }
    LDS_WAIT(); asm volatile("" ::: "memory");
}
struct Args { const float* in[15]; float* out; unsigned char* ws; int ph_lo, ph_hi, use_bar, pad; };
__device__ __forceinline__ void p0_prologue(Frame& F, const Args& A) {
    LAS unsigned* scr = (LAS unsigned*)(F.lds + F.wave * 16384);
    const int gw = F.vcu * NWAVES + F.wave, NGW = F.G * NWAVES;
    unsigned char* ws = F.ws;
    constexpr int I_IN = 32 * (NIN / 64), I_RO = 32 * 32, I_HO = 16 * 32, I_OUT = 32 * 32, I_FI = 32 * (2 * DFF / 64), I_FO = (DFF / 64) * 32;
    constexpr int NITEMS = I_IN + I_RO + I_HO + I_OUT + I_FI + I_FO;
    for (int it = gw; it < NITEMS; it += NGW) {
        int r = it;
        if (r < I_IN) { p0_transpose_item<0>(A.in[4], 2048, NIN, (bf16*)(ws + WS_WIN), A.in[8], scr, r, F.lane); continue; } r -= I_IN;
        if (r < I_RO) { p0_transpose_item<0>(A.in[5], 2048, 2048, (bf16*)(ws + WS_WRO), nullptr, scr, r, F.lane); continue; } r -= I_RO;
        if (r < I_HO) { p0_transpose_item<0>(A.in[6], 1024, 2048, (bf16*)(ws + WS_WHO), nullptr, scr, r, F.lane); continue; } r -= I_HO;
        if (r < I_OUT) { p0_transpose_item<0>(A.in[7], 2048, 2048, (bf16*)(ws + WS_WOUT), nullptr, scr, r, F.lane); continue; } r -= I_OUT;
        if (r < I_FI) { p0_transpose_item<2>(A.in[12], 2048, 2 * DFF, (bf16*)(ws + WS_WFI), A.in[9], scr, r, F.lane); continue; } r -= I_FI;
        p0_transpose_item<0>(A.in[13], DFF, 2048, (bf16*)(ws + WS_WFO), nullptr, scr, r, F.lane);
    }
    bf16* XB = (bf16*)(ws + WS_XB);
    for (int m = gw; m < MPAD; m += NGW) {
        GAS unsigned long long* o8 = (GAS unsigned long long*)(XB + (size_t)m * 2048) + F.lane;
        if (m < MROWS) {
            const float* xrow = m < 8192 ? A.in[0] + (size_t)m * 2048 : A.in[1] + (size_t)(m - 8192) * 2048;
            const GAS f32x4* xr = (const GAS f32x4*)xrow + F.lane;
            f32x4 v[8]; float s = 0.f;
#pragma unroll
            for (int j = 0; j < 8; ++j) { v[j] = xr[64 * j]; s += (v[j].x * v[j].x + v[j].y * v[j].y) + (v[j].z * v[j].z + v[j].w * v[j].w); }
            const float rr = 1.0f / sqrtf(wave_sum(s) * (1.0f / 2048.0f) + EPS);
#pragma unroll
            for (int j = 0; j < 8; ++j) o8[64 * j] = (unsigned long long)pk2(v[j].x * rr, v[j].y * rr) | ((unsigned long long)pk2(v[j].z * rr, v[j].w * rr) << 32);
        } else {
#pragma unroll
            for (int j = 0; j < 8; ++j) o8[64 * j] = 0ull;
        }
    }
    { float* COS = (float*)(ws + WS_COS); float* SIN = (float*)(ws + WS_SIN);
      for (int i = (F.vcu * NWAVES + F.wave) * 64 + F.lane; i < 2049 * 64; i += F.G * NWAVES * 64) { const int p = i >> 6, j = i & 63; const int pos = p < 2048 ? p : 16384;
          const float inv = powf(10000.0f, -(float)j / 64.0f); const float ang = (float)pos * inv; float sn, cs; sincosf(ang, &sn, &cs); COS[i] = cs; SIN[i] = sn; } }
    { float* LB = (float*)(ws + WS_LB); const int i = (F.vcu * NWAVES + F.wave) * 64 + F.lane; if (i < 1024) { const float l0 = A.in[11][i], l1 = A.in[11][1024 + i]; LB[i] = 1.0f / (1.0f + expf(l1 - l0)); } }
}
typedef short bf16x4v __attribute__((ext_vector_type(4)));
#define MFMA16(a, b, c) __builtin_amdgcn_mfma_f32_16x16x32_bf16((a), (b), (c), 0, 0, 0)
constexpr int TP = 136;
constexpr size_t OUT_YS = 8192ull * 2048, OUT_SRP = 8320ull * 2048, OUT_SHP = OUT_SRP + 4ull * 8 * 128 * 256, OUT_SRS = OUT_SHP + 4ull * 8 * 128 * 128, OUT_SHS = OUT_SRS + 128ull * 8 * 128 * 256;
__device__ __forceinline__ int tsw(int r, int m) { return r * TP + ((r >> 3) << 3) + m; }
__device__ __forceinline__ int tsw64(int r, int m) { return r * 72 + ((r >> 3) << 3) + m; }
constexpr int TSZ128 = 128 * TP + 128, TSZ64R = 64 * TP + 64, TSZ32R = 32 * TP + 32, TSZ256 = 256 * TP + 256, TSZ64T = 128 * 72 + 128;
__device__ __forceinline__ float lg2gamma(int h) { return log2f(1.0f - exp2f(-5.0f - (float)h)); }
__device__ __forceinline__ float bfe(const v4u& w, int j) { const unsigned x = w[j >> 1]; return __uint_as_float((j & 1) ? (x & 0xffff0000u) : (x << 16)); }
__device__ __forceinline__ bf16x8 pack_f8(const float* v) { v4u w; w.x = pk2(v[0], v[1]); w.y = pk2(v[2], v[3]); w.z = pk2(v[4], v[5]); w.w = pk2(v[6], v[7]); return __builtin_bit_cast(bf16x8, w); }

__device__ __forceinline__ void p2_ret_unit(Frame& F, int u) {
    unsigned char* ws = F.ws;
    const int es = u & 1, h = (u >> 1) & 7, b = u >> 4;
    const int w = F.wave, l15 = F.lane & 15, g = F.lane >> 4;
    LAS bf16* KT = (LAS bf16*)F.lds; LAS bf16* VT = KT + TSZ128;
    const bf16* Kg = (const bf16*)(ws + WS_K); const bf16* Vg = (const bf16*)(ws + WS_V);
    const float* COS = (const float*)(ws + WS_COS); const float* SIN = (const float*)(ws + WS_SIN);
    const float lg = lg2gamma(h), cd = exp2f(128.0f * lg);
    const int dc = F.tid & 7, m0 = F.tid >> 3;
    const int vc = F.tid & 15, vm0 = F.tid >> 4;
    v4u ka[2], kb[2], va[4]; f32x4 cc[2][2], sn[2][2];
#define P2R_LOAD(c) do { _Pragma("unroll") for (int _i = 0; _i < 2; ++_i) { const int _m = m0 + 64 * _i, _r = b * 2048 + (c) * 128 + _m, _pos = (c) * 128 + _m, _d0 = 8 * dc; \
        const bf16* _kp = Kg + (size_t)_r * 1024 + h * 128 + _d0; ka[_i] = *(const v4u*)_kp; kb[_i] = *(const v4u*)(_kp + 64); \
        cc[_i][0] = *(const f32x4*)(COS + _pos * 64 + _d0); cc[_i][1] = *(const f32x4*)(COS + _pos * 64 + _d0 + 4); sn[_i][0] = *(const f32x4*)(SIN + _pos * 64 + _d0); sn[_i][1] = *(const f32x4*)(SIN + _pos * 64 + _d0 + 4); } \
        _Pragma("unroll") for (int _i = 0; _i < 4; ++_i) va[_i] = *(const v4u*)(Vg + (size_t)(b * 2048 + (c) * 128 + vm0 + 32 * _i) * 2048 + h * 256 + 128 * es + 8 * vc); } while (0)
    f32x4 S[8];
#pragma unroll
    for (int j = 0; j < 8; ++j) S[j] = (f32x4){0.f, 0.f, 0.f, 0.f};
    const float dec2[2] = {exp2f((float)(127 - m0) * lg), exp2f((float)(63 - m0) * lg)};
    P2R_LOAD(0);
    for (int c = 0; c < 16; ++c) {
        __syncthreads();
#pragma unroll
        for (int i = 0; i < 2; ++i) { const int m = m0 + 64 * i; const float dec = dec2[i];
            LAS bf16* k1 = KT + tsw(8 * dc, m); LAS bf16* k2 = KT + tsw(64 + 8 * dc, m);
#pragma unroll
            for (int j = 0; j < 8; ++j) { const float x1 = bfe(ka[i], j), x2 = bfe(kb[i], j), cj = cc[i][j >> 2][j & 3], sj = sn[i][j >> 2][j & 3];
                k1[j * TP] = (bf16)f2bf((x1 * cj - x2 * sj) * dec); k2[j * TP] = (bf16)f2bf((x2 * cj + x1 * sj) * dec); } }
#pragma unroll
        for (int i = 0; i < 4; ++i) { LAS bf16* vt = VT + tsw(8 * vc, vm0 + 32 * i);
#pragma unroll
            for (int j = 0; j < 8; ++j) vt[j * TP] = (bf16)((va[i][j >> 1] >> (16 * (j & 1))) & 0xffffu); }
        if (c + 1 < 16) P2R_LOAD(c + 1);
        __syncthreads();
        f32x4 kv[8];
#pragma unroll
        for (int j = 0; j < 8; ++j) kv[j] = (f32x4){0.f, 0.f, 0.f, 0.f};
#pragma unroll
        for (int ks = 0; ks < 4; ++ks) { const bf16x8 bfr = *(const LAS bf16x8*)&VT[tsw(16 * w + l15, 32 * ks + 8 * g)];
#pragma unroll
            for (int j = 0; j < 8; ++j) { const bf16x8 af = *(const LAS bf16x8*)&KT[tsw(16 * j + l15, 32 * ks + 8 * g)]; kv[j] = MFMA16(af, bfr, kv[j]); } }
        bf16* st = (bf16*)(ws + WS_SRT) + ((size_t)((b * 8 + h) * 16 + c) * 256 + 128 * es + 16 * w + l15) * 128 + 4 * g;
#pragma unroll
        for (int j = 0; j < 8; ++j) { v2u p; p.x = pk2(S[j][0], S[j][1]); p.y = pk2(S[j][2], S[j][3]); *(v2u*)(st + 16 * j) = p; S[j] = S[j] * cd + kv[j]; }
    }
#undef P2R_LOAD
    float* fo = F.out + OUT_SRP + ((size_t)(b * 8 + h) * 128 + 4 * g) * 256 + 128 * es + 16 * w + l15;
#pragma unroll
    for (int j = 0; j < 8; ++j)
#pragma unroll
        for (int reg = 0; reg < 4; ++reg) fo[(size_t)(16 * j + reg) * 256] = S[j][reg];
}
__device__ __forceinline__ void p2_hg_unit(Frame& F, int u) {
    unsigned char* ws = F.ws;
    const int es = u & 1, h = (u >> 1) & 7, b = u >> 4;
    const int w = F.wave, l15 = F.lane & 15, g = F.lane >> 4, et = w & 3, dh = w >> 2;
    LAS bf16* KT = (LAS bf16*)F.lds; LAS bf16* VT = KT + TSZ128; LAS float* LQ = (LAS float*)(VT + TSZ64R); LAS float* BT = LQ + 4 * 128;
    const float* Z = (const float*)(ws + WS_LOGF); const bf16* HI = (const bf16*)(ws + WS_HI);
    const int d = F.tid & 127, q = F.tid >> 7; const float oml = 1.0f - ((const float*)(ws + WS_LB))[h * 128 + d];
    const int vc = F.tid & 7, vm0 = F.tid >> 3;
    float z[32]; v4u va[2];
#define P2H_LOAD(sc) do { const int _r0 = b * 2048 + (sc) * 128; _Pragma("unroll") for (int _i = 0; _i < 32; ++_i) z[_i] = Z[(size_t)(_r0 + 32 * q + _i) * 1024 + h * 128 + d]; \
        _Pragma("unroll") for (int _i = 0; _i < 2; ++_i) va[_i] = *(const v4u*)(HI + (size_t)(_r0 + vm0 + 64 * _i) * 1024 + h * 128 + 64 * es + 8 * vc); } while (0)
    f32x4 S[4];
#pragma unroll
    for (int j = 0; j < 4; ++j) S[j] = (f32x4){0.f, 0.f, 0.f, 0.f};
    P2H_LOAD(0);
    for (int sc = 0; sc < 16; ++sc) {
        float lf[32], kin[32]; float L = 0.f;
#pragma unroll
        for (int i = 0; i < 32; ++i) { kin[i] = oml * __builtin_amdgcn_rcpf(1.0f + __expf(z[i])); lf[i] = __logf(1.0f - kin[i]); L += lf[i]; }
        __syncthreads();
        LQ[q * 128 + d] = L;
#pragma unroll
        for (int i = 0; i < 2; ++i) { LAS bf16* vt = VT + tsw(8 * vc, vm0 + 64 * i);
#pragma unroll
            for (int j = 0; j < 8; ++j) vt[j * TP] = (bf16)((va[i][j >> 1] >> (16 * (j & 1))) & 0xffffu); }
        if (sc + 1 < 16) P2H_LOAD(sc + 1);
        __syncthreads();
        float run = 0.f;
#pragma unroll
        for (int q2 = 1; q2 < 4; ++q2) if (q2 > q) run += LQ[q2 * 128 + d];
#pragma unroll
        for (int blk = 3; blk >= 0; --blk) { float v[8];
#pragma unroll
            for (int jj = 7; jj >= 0; --jj) { const int i = 8 * blk + jj; v[jj] = kin[i] * __expf(run); run += lf[i]; }
            *(LAS bf16x8*)&KT[tsw(d, 32 * q + 8 * blk)] = pack_f8(v); }
        if (q == 0) BT[d] = run;
        __syncthreads();
        f32x4 hs[4];
#pragma unroll
        for (int j = 0; j < 4; ++j) hs[j] = (f32x4){0.f, 0.f, 0.f, 0.f};
#pragma unroll
        for (int ks = 0; ks < 4; ++ks) { const bf16x8 bfr = *(const LAS bf16x8*)&VT[tsw(16 * et + l15, 32 * ks + 8 * g)];
#pragma unroll
            for (int j = 0; j < 4; ++j) { const bf16x8 af = *(const LAS bf16x8*)&KT[tsw(16 * (4 * dh + j) + l15, 32 * ks + 8 * g)]; hs[j] = MFMA16(af, bfr, hs[j]); } }
        bf16* st = (bf16*)(ws + WS_SHT) + ((size_t)((b * 8 + h) * 16 + sc) * 128 + 64 * es + 16 * et + l15) * 128 + 64 * dh + 4 * g;
#pragma unroll
        for (int j = 0; j < 4; ++j) { v2u p; p.x = pk2(S[j][0], S[j][1]); p.y = pk2(S[j][2], S[j][3]); *(v2u*)(st + 16 * j) = p;
            const f32x4 bt = *(const LAS f32x4*)&BT[16 * (4 * dh + j) + 4 * g];
#pragma unroll
            for (int reg = 0; reg < 4; ++reg) S[j][reg] = S[j][reg] * __expf(bt[reg]) + hs[j][reg]; }
    }
#undef P2H_LOAD
    float* fo = F.out + OUT_SHP + ((size_t)(b * 8 + h) * 128 + 64 * dh + 4 * g) * 128 + 64 * es + 16 * et + l15;
#pragma unroll
    for (int j = 0; j < 4; ++j)
#pragma unroll
        for (int reg = 0; reg < 4; ++reg) fo[(size_t)(16 * j + reg) * 128] = S[j][reg];
}
__device__ __forceinline__ void p2_sret_all(Frame& F, const Args& A, unsigned* ctr) {
    unsigned char* ws = F.ws;
    LAS float* qs = (LAS float*)F.lds; LAS float* ks = qs + 128; LAS float* vs = ks + 128; LAS float* ored = vs + 256;
    const bf16* Q = (const bf16*)(ws + WS_Q); const bf16* K = (const bf16*)(ws + WS_K); const bf16* V = (const bf16*)(ws + WS_V);
    const int e4 = F.tid & 63, dq = F.tid >> 6;
    __syncthreads();
    if (F.tid == 0) F.MISC[16] = atomicAdd(ctr, 1u);
    __syncthreads();
    int it = (int)F.MISC[16]; if (it >= 1024) return;
    f32x4 s[16];
    { const float* Sin = A.in[2] + (size_t)it * 128 * 256;
#pragma unroll
      for (int i = 0; i < 16; ++i) s[i] = *(const f32x4*)(Sin + (size_t)(16 * dq + i) * 256 + 4 * e4); }
    for (;;) {
        const int h = it & 7, b = it >> 3, r = 8192 + b;
        __syncthreads();
        if (F.tid == 0) F.MISC[16] = atomicAdd(ctr, 1u);
        if (F.tid < 64) { const int d = F.tid; const float cs = ((const float*)(ws + WS_COS))[2048 * 64 + d], sn = ((const float*)(ws + WS_SIN))[2048 * 64 + d];
            const float q1 = bf2f(Q[(size_t)r * 1024 + h * 128 + d]), q2 = bf2f(Q[(size_t)r * 1024 + h * 128 + 64 + d]), k1 = bf2f(K[(size_t)r * 1024 + h * 128 + d]), k2 = bf2f(K[(size_t)r * 1024 + h * 128 + 64 + d]);
            qs[d] = q1 * cs - q2 * sn; qs[d + 64] = q2 * cs + q1 * sn; ks[d] = k1 * cs - k2 * sn; ks[d + 64] = k2 * cs + k1 * sn; }
        else if (F.tid >= 256) { const int e = F.tid - 256; vs[e] = bf2f(V[(size_t)r * 2048 + h * 256 + e]); }
        __syncthreads();
        const int nx = (int)F.MISC[16];
        const float gam = 1.0f - exp2f(-5.0f - (float)h);
        float* Sout = F.out + OUT_SRS + (size_t)it * 128 * 256;
        const f32x4 v4 = *(const LAS f32x4*)&vs[4 * e4]; f32x4 o = (f32x4){0.f, 0.f, 0.f, 0.f};
#pragma unroll
        for (int i = 0; i < 16; ++i) { const int d = 16 * dq + i; s[i] = s[i] * gam + v4 * ks[d]; *(f32x4*)(Sout + (size_t)d * 256 + 4 * e4) = s[i]; o += s[i] * qs[d]; }
        *(LAS f32x4*)&ored[dq * 256 + 4 * e4] = o;
        if (nx < 1024) { const float* Sin = A.in[2] + (size_t)nx * 128 * 256;
#pragma unroll
            for (int i = 0; i < 16; ++i) s[i] = *(const f32x4*)(Sin + (size_t)(16 * dq + i) * 256 + 4 * e4); }
        __syncthreads();
        if (F.wave == 0) { float oo[4]; float ss = 0.f;
#pragma unroll
            for (int k = 0; k < 4; ++k) { const int e = F.lane + 64 * k; float t = 0.f;
#pragma unroll
                for (int j = 0; j < 8; ++j) t += ored[j * 256 + e];
                oo[k] = t; ss += t * t; }
            const float rr = 1.0f / sqrtf(wave_sum(ss) * (1.0f / 256.0f) + EPS);
            const bf16* RG = (const bf16*)(ws + WS_RG); bf16* OR = (bf16*)(ws + WS_OR);
#pragma unroll
            for (int k = 0; k < 4; ++k) { const size_t ix = (size_t)r * 2048 + h * 256 + F.lane + 64 * k; OR[ix] = (bf16)f2bf(oo[k] * rr * bf2f(RG[ix])); } }
        it = nx; if (it >= 1024) break;
    }
}
__device__ __forceinline__ void p2_shg_all(Frame& F, const Args& A, unsigned* ctr) {
    unsigned char* ws = F.ws;
    LAS float* qs = (LAS float*)F.lds; LAS float* fs = qs + 128; LAS float* kn = fs + 128; LAS float* vs = kn + 128; LAS float* ored = vs + 128;
    const int e4 = F.tid & 31, dq = F.tid >> 5;
    __syncthreads();
    if (F.tid == 0) F.MISC[16] = atomicAdd(ctr, 1u);
    __syncthreads();
    int it = (int)F.MISC[16]; if (it >= 1024) return;
    f32x4 s[8];
    { const float* Sin = A.in[3] + (size_t)it * 128 * 128;
#pragma unroll
      for (int i = 0; i < 8; ++i) s[i] = *(const f32x4*)(Sin + (size_t)(8 * dq + i) * 128 + 4 * e4); }
    for (;;) {
        const int h = it & 7, b = it >> 3, r = 8192 + b;
        __syncthreads();
        if (F.tid == 0) F.MISC[16] = atomicAdd(ctr, 1u);
        if (F.tid < 128) { const int d = F.tid; const size_t ix = (size_t)r * 1024 + h * 128 + d; const float z = ((const float*)(ws + WS_LOGF))[ix]; const float lb = ((const float*)(ws + WS_LB))[h * 128 + d];
            const float kin = (1.0f - lb) / (1.0f + __expf(z)); kn[d] = kin; fs[d] = 1.0f - kin; qs[d] = bf2f(((const bf16*)(ws + WS_HQ))[ix]); vs[d] = bf2f(((const bf16*)(ws + WS_HI))[ix]); }
        __syncthreads();
        const int nx = (int)F.MISC[16];
        float* Sout = F.out + OUT_SHS + (size_t)it * 128 * 128;
        const f32x4 v4 = *(const LAS f32x4*)&vs[4 * e4]; f32x4 o = (f32x4){0.f, 0.f, 0.f, 0.f};
#pragma unroll
        for (int i = 0; i < 8; ++i) { const int d = 8 * dq + i; s[i] = s[i] * fs[d] + v4 * kn[d]; *(f32x4*)(Sout + (size_t)d * 128 + 4 * e4) = s[i]; o += s[i] * qs[d]; }
        *(LAS f32x4*)&ored[dq * 128 + 4 * e4] = o;
        if (nx < 1024) { const float* Sin = A.in[3] + (size_t)nx * 128 * 128;
#pragma unroll
            for (int i = 0; i < 8; ++i) s[i] = *(const f32x4*)(Sin + (size_t)(8 * dq + i) * 128 + 4 * e4); }
        __syncthreads();
        if (F.wave == 0) { float oo[2]; float ss = 0.f;
#pragma unroll
            for (int k = 0; k < 2; ++k) { const int e = F.lane + 64 * k; float t = 0.f;
#pragma unroll
                for (int j = 0; j < 16; ++j) t += ored[j * 128 + e];
                oo[k] = t; ss += t * t; }
            const float rr = 1.0f / sqrtf(wave_sum(ss) * (1.0f / 128.0f) + EPS);
            const bf16* HG = (const bf16*)(ws + WS_HG); bf16* OH = (bf16*)(ws + WS_OH);
#pragma unroll
            for (int k = 0; k < 2; ++k) { const int e = F.lane + 64 * k; const size_t ix = (size_t)r * 1024 + h * 128 + e; OH[ix] = (bf16)f2bf(oo[k] * rr * A.in[10][e] * bf2f(HG[ix])); } }
        it = nx; if (it >= 1024) break;
    }
}
__device__ __forceinline__ void p2_phase(Frame& F, const Args& A) {
    const int half = F.G >> 1;
    if (half == 0 || (F.vcu & 1) == 0) { const int stride = half ? half : 1;
        for (int u = F.vcu >> 1; u < 64; u += stride) p2_ret_unit(F, u);
        for (int u = (F.vcu >> 1) - 64; u < 64; u += stride) if (u >= 0) p2_hg_unit(F, u); }
    p2_sret_all(F, A, (unsigned*)(F.ctl + 64)); p2_shg_all(F, A, (unsigned*)(F.ctl + 128));
}
__device__ __forceinline__ void p4_ret_item(Frame& F, int item) {
    unsigned char* ws = F.ws;
    const int c = item & 15, h = (item >> 4) & 7, b = item >> 7, r0 = b * 2048 + c * 128;
    const int w = F.wave, l15 = F.lane & 15, g = F.lane >> 4;
    LAS bf16* KS = (LAS bf16*)F.lds; LAS bf16* VT = KS + 128 * TP;
    const bf16* Qg = (const bf16*)(ws + WS_Q); const bf16* Kg = (const bf16*)(ws + WS_K); const bf16* Vg = (const bf16*)(ws + WS_V);
    const float* COS = (const float*)(ws + WS_COS); const float* SIN = (const float*)(ws + WS_SIN);
    const float lg = lg2gamma(h);
    __syncthreads();
#pragma unroll
    for (int i = 0; i < 2; ++i) { const int u = F.tid + 512 * i, d0 = (u & 7) * 8, m = u >> 3;
        const bf16* kp = Kg + (size_t)(r0 + m) * 1024 + h * 128 + d0; const v4u a = *(const v4u*)kp, bb = *(const v4u*)(kp + 64);
        const int pos = c * 128 + m; const f32x4 c0 = *(const f32x4*)(COS + pos * 64 + d0), c1 = *(const f32x4*)(COS + pos * 64 + d0 + 4), s0 = *(const f32x4*)(SIN + pos * 64 + d0), s1 = *(const f32x4*)(SIN + pos * 64 + d0 + 4);
        float o1[8], o2[8];
#pragma unroll
        for (int j = 0; j < 8; ++j) { const float x1 = bfe(a, j), x2 = bfe(bb, j), cj = j < 4 ? c0[j & 3] : c1[j & 3], sj = j < 4 ? s0[j & 3] : s1[j & 3]; o1[j] = x1 * cj - x2 * sj; o2[j] = x2 * cj + x1 * sj; }
        *(LAS bf16x8*)&KS[m * TP + d0] = pack_f8(o1); *(LAS bf16x8*)&KS[m * TP + 64 + d0] = pack_f8(o2); }
#pragma unroll
    for (int i = 0; i < 8; ++i) { const int u = F.tid + 512 * i, e0 = (u & 31) * 8, m = u >> 5;
        const v4u a = *(const v4u*)(Vg + (size_t)(r0 + m) * 2048 + h * 256 + e0);
        LAS bf16* vt = VT + tsw(e0, m);
#pragma unroll
        for (int j = 0; j < 8; ++j) vt[j * TP] = (bf16)((a[j >> 1] >> (16 * (j & 1))) & 0xffffu); }
    bf16x8 qf[4];
    { const int n = 16 * w + l15, pos = c * 128 + n; const bf16* qp = Qg + (size_t)(r0 + n) * 1024 + h * 128 + 8 * g;
      const v4u a0 = *(const v4u*)qp, a1 = *(const v4u*)(qp + 32), a2 = *(const v4u*)(qp + 64), a3 = *(const v4u*)(qp + 96);
      float r0v[8], r1v[8], r2v[8], r3v[8];
#pragma unroll
      for (int hlf = 0; hlf < 2; ++hlf) { const int dd = 32 * hlf + 8 * g;
          const f32x4 c0 = *(const f32x4*)(COS + pos * 64 + dd), c1 = *(const f32x4*)(COS + pos * 64 + dd + 4), s0 = *(const f32x4*)(SIN + pos * 64 + dd), s1 = *(const f32x4*)(SIN + pos * 64 + dd + 4);
#pragma unroll
          for (int j = 0; j < 8; ++j) { const float cj = j < 4 ? c0[j & 3] : c1[j & 3], sj = j < 4 ? s0[j & 3] : s1[j & 3];
              const float x1 = hlf == 0 ? bfe(a0, j) : bfe(a1, j), x2 = hlf == 0 ? bfe(a2, j) : bfe(a3, j);
              if (hlf == 0) { r0v[j] = x1 * cj - x2 * sj; r2v[j] = x2 * cj + x1 * sj; } else { r1v[j] = x1 * cj - x2 * sj; r3v[j] = x2 * cj + x1 * sj; } } }
      qf[0] = pack_f8(r0v); qf[1] = pack_f8(r1v); qf[2] = pack_f8(r2v); qf[3] = pack_f8(r3v); }
    __syncthreads();
    f32x4 O[16];
    { const bf16* st = (const bf16*)(ws + WS_SRT) + (size_t)item * 256 * 128 + 8 * g;
#pragma unroll
      for (int et = 0; et < 16; ++et) { f32x4 t = (f32x4){0.f, 0.f, 0.f, 0.f};
#pragma unroll
          for (int ks = 0; ks < 4; ++ks) { const bf16x8 sf = *(const bf16x8*)(st + (size_t)(16 * et + l15) * 128 + 32 * ks); t = MFMA16(qf[ks], sf, t); }
          O[et] = t; }
      float rs[4];
#pragma unroll
      for (int reg = 0; reg < 4; ++reg) rs[reg] = exp2f((float)(16 * w + 4 * g + reg + 1) * lg);
#pragma unroll
      for (int et = 0; et < 16; ++et)
#pragma unroll
          for (int reg = 0; reg < 4; ++reg) O[et][reg] *= rs[reg]; }
    bf16x8 pf[4];
#pragma unroll
    for (int s = 0; s < 4; ++s) { float pv[8];
#pragma unroll
        for (int hf = 0; hf < 2; ++hf) { const int mt = 2 * s + hf; f32x4 dd = (f32x4){0.f, 0.f, 0.f, 0.f};
            if (mt <= w) {
#pragma unroll
                for (int ks = 0; ks < 4; ++ks) { const bf16x8 kf = *(const LAS bf16x8*)&KS[(16 * mt + l15) * TP + 32 * ks + 8 * g]; dd = MFMA16(kf, qf[ks], dd); }
#pragma unroll
                for (int reg = 0; reg < 4; ++reg) { const int m = 16 * mt + 4 * g + reg, n = 16 * w + l15; dd[reg] = n >= m ? dd[reg] * exp2f((float)(n - m) * lg) : 0.f; } }
#pragma unroll
            for (int reg = 0; reg < 4; ++reg) pv[4 * hf + reg] = dd[reg]; }
        pf[s] = pack_f8(pv); }
#pragma unroll
    for (int s = 0; s < 4; ++s) if (2 * s <= w) {
#pragma unroll
        for (int et = 0; et < 16; ++et) { const bf16x4v lo = *(const LAS bf16x4v*)&VT[tsw(16 * et + l15, 32 * s + 4 * g)], hi = *(const LAS bf16x4v*)&VT[tsw(16 * et + l15, 32 * s + 16 + 4 * g)];
            const bf16x8 vf = __builtin_shufflevector(lo, hi, 0, 1, 2, 3, 4, 5, 6, 7); O[et] = MFMA16(pf[s], vf, O[et]); } }
    float ss[4] = {0.f, 0.f, 0.f, 0.f};
#pragma unroll
    for (int et = 0; et < 16; ++et)
#pragma unroll
        for (int reg = 0; reg < 4; ++reg) ss[reg] += O[et][reg] * O[et][reg];
#pragma unroll
    for (int reg = 0; reg < 4; ++reg) { float v = ss[reg]; v += __shfl_xor(v, 1); v += __shfl_xor(v, 2); v += __shfl_xor(v, 4); v += __shfl_xor(v, 8); ss[reg] = 1.0f / sqrtf(v * (1.0f / 256.0f) + EPS); }
    const bf16* RG = (const bf16*)(ws + WS_RG); bf16* OR = (bf16*)(ws + WS_OR);
#pragma unroll
    for (int reg = 0; reg < 4; ++reg) { const size_t rb = (size_t)(r0 + 16 * w + 4 * g + reg) * 2048 + h * 256 + l15;
#pragma unroll
        for (int et = 0; et < 16; ++et) OR[rb + 16 * et] = (bf16)f2bf(O[et][reg] * ss[reg] * bf2f(RG[rb + 16 * et])); }
}
__device__ __forceinline__ void p4_hg_item(Frame& F, const Args& A, int item) {
    unsigned char* ws = F.ws;
    const int sc = item & 15, h = (item >> 4) & 7, b = item >> 7, r0 = b * 2048 + sc * 128;
    const int w = F.wave, l15 = F.lane & 15, g = F.lane >> 4;
    LAS bf16* QP = (LAS bf16*)F.lds;
    LAS bf16* KP = QP + 64 * TP;
    LAS bf16* KU = KP + 64 * TP;
    LAS bf16* VT = KU + 128 * 72;
    LAS float* E15 = (LAS float*)(VT + TSZ64T);
    LAS float* OB = E15 + 4 * 128;
    const float* Z = (const float*)(ws + WS_LOGF); const bf16* HQ = (const bf16*)(ws + WS_HQ); const bf16* HI = (const bf16*)(ws + WS_HI); const float* LB = (const float*)(ws + WS_LB);
    f32x4 S[8];
    { const bf16* st = (const bf16*)(ws + WS_SHT) + (size_t)item * 128 * 128 + (size_t)(16 * w + l15) * 128 + 4 * g;
#pragma unroll
      for (int dt = 0; dt < 8; ++dt) { const v2u p = *(const v2u*)(st + 16 * dt); S[dt][0] = __uint_as_float(p.x << 16); S[dt][1] = __uint_as_float(p.x & 0xffff0000u); S[dt][2] = __uint_as_float(p.y << 16); S[dt][3] = __uint_as_float(p.y & 0xffff0000u); } }
    for (int hf = 0; hf < 2; ++hf) {
        const int rh = r0 + 64 * hf;
        __syncthreads();
        { const int d = F.tid & 127, sq = F.tid >> 7; const float oml = 1.0f - LB[h * 128 + d];
          float kin[16], bcum[16]; float bb = 0.f;
#pragma unroll
          for (int t = 0; t < 16; ++t) { const size_t ix = (size_t)(rh + 16 * sq + t) * 1024 + h * 128 + d; const float z = Z[ix]; const float q = bf2f(HQ[ix]);
              kin[t] = oml * __builtin_amdgcn_rcpf(1.0f + __expf(z)); bb += __logf(1.0f - kin[t]); bcum[t] = bb;
              QP[(16 * sq + t) * TP + d] = (bf16)f2bf(q * __expf(bb)); KP[(16 * sq + t) * TP + d] = (bf16)f2bf(kin[t] * __expf(fminf(-bb, 80.0f))); }
          E15[sq * 128 + d] = __expf(bb);
          float v[8];
#pragma unroll
          for (int t = 0; t < 8; ++t) v[t] = kin[t] * __expf(bb - bcum[t]);
          *(LAS bf16x8*)&KU[d * 72 + 16 * sq] = pack_f8(v);
#pragma unroll
          for (int t = 0; t < 8; ++t) v[t] = kin[8 + t] * __expf(bb - bcum[8 + t]);
          *(LAS bf16x8*)&KU[d * 72 + 16 * sq + 8] = pack_f8(v); }
#pragma unroll
        for (int i = 0; i < 2; ++i) { const int u = F.tid + 512 * i, e0 = (u & 15) * 8, m = u >> 4;
            const v4u a = *(const v4u*)(HI + (size_t)(rh + m) * 1024 + h * 128 + e0);
            LAS bf16* vt = VT + tsw64(e0, m);
#pragma unroll
            for (int j = 0; j < 8; ++j) vt[j * 72] = (bf16)((a[j >> 1] >> (16 * (j & 1))) & 0xffffu); }
        __syncthreads();
        const bf16x8 zero8 = (bf16x8){0, 0, 0, 0, 0, 0, 0, 0};
#pragma unroll
        for (int sq = 0; sq < 4; ++sq) {
            f32x4 at = (f32x4){0.f, 0.f, 0.f, 0.f};
#pragma unroll
            for (int ks = 0; ks < 4; ++ks) { const bf16x8 kf = *(const LAS bf16x8*)&KP[(16 * sq + l15) * TP + 32 * ks + 8 * g], qf = *(const LAS bf16x8*)&QP[(16 * sq + l15) * TP + 32 * ks + 8 * g]; at = MFMA16(kf, qf, at); }
            float pv[8];
#pragma unroll
            for (int reg = 0; reg < 4; ++reg) { pv[reg] = (4 * g + reg) <= l15 ? at[reg] : 0.f; pv[4 + reg] = 0.f; }
            const bf16x8 pfr = pack_f8(pv);
            f32x4 o;
            { const bf16x4v lo = *(const LAS bf16x4v*)&VT[tsw64(16 * w + l15, 16 * sq + 4 * g)]; const bf16x8 vf = __builtin_shufflevector(lo, (bf16x4v){0, 0, 0, 0}, 0, 1, 2, 3, 4, 5, 6, 7);
              const f32x4 z4 = {0.f, 0.f, 0.f, 0.f}; o = MFMA16(pfr, vf, z4); }
#pragma unroll
            for (int ks = 0; ks < 4; ++ks) { float sv[8];
#pragma unroll
                for (int jj = 0; jj < 8; ++jj) sv[jj] = S[2 * ks + (jj >> 2)][jj & 3];
                const bf16x8 sf = pack_f8(sv);
                const LAS bf16* qp = &QP[(16 * sq + l15) * TP + 32 * ks + 4 * g]; const bf16x4v lo = *(const LAS bf16x4v*)qp, hi = *(const LAS bf16x4v*)(qp + 16);
                const bf16x8 qf = __builtin_shufflevector(lo, hi, 0, 1, 2, 3, 4, 5, 6, 7); o = MFMA16(qf, sf, o); }
#pragma unroll
            for (int reg = 0; reg < 4; ++reg) OB[(16 * sq + 4 * g + reg) * 132 + 16 * w + l15] = o[reg];
            const bf16x8 vu = g < 2 ? *(const LAS bf16x8*)&VT[tsw64(16 * w + l15, 16 * sq + 8 * g)] : zero8;
#pragma unroll
            for (int dt = 0; dt < 8; ++dt) { const f32x4 ed = *(const LAS f32x4*)&E15[sq * 128 + 16 * dt + 4 * g];
                const bf16x8 kf = g < 2 ? *(const LAS bf16x8*)&KU[(16 * dt + l15) * 72 + 16 * sq + 8 * g] : zero8;
                S[dt] = MFMA16(kf, vu, S[dt] * ed); }
        }
        __syncthreads();
        { const bf16* HG = (const bf16*)(ws + WS_HG); bf16* OH = (bf16*)(ws + WS_OH);
#pragma unroll
          for (int i = 0; i < 8; ++i) { const int t = 8 * w + i; const float v0 = OB[t * 132 + F.lane], v1 = OB[t * 132 + 64 + F.lane];
              const float rr = 1.0f / sqrtf(wave_sum(v0 * v0 + v1 * v1) * (1.0f / 128.0f) + EPS); const size_t ix = (size_t)(rh + t) * 1024 + h * 128 + F.lane;
              OH[ix] = (bf16)f2bf(v0 * rr * A.in[10][F.lane] * bf2f(HG[ix])); OH[ix + 64] = (bf16)f2bf(v1 * rr * A.in[10][64 + F.lane] * bf2f(HG[ix + 64])); } }
    }
}
__device__ __forceinline__ void p4_phase(Frame& F, const Args& A) {
    for (int it = F.vcu; it < 512; it += F.G) p4_ret_item(F, it);
    for (int it = F.vcu; it < 512; it += F.G) p4_hg_item(F, A, it);
}
namespace mini {
using pg8::bf16_t; using pg8::u32x2; using pg8::silu4; using pg8::sigm4; using pg8::pack4; using pg8::unpack4;
constexpr int AP = 136;
template <bool TWO> __device__ __forceinline__ void core(Frame& F, const bf16_t* A, int lda, int K, const bf16_t* bp0, const bf16_t* bp1, f32x4 (&acc0)[8], f32x4 (&acc1)[8]) {
    LAS bf16* AS = (LAS bf16*)F.lds; const int l15 = F.lane & 15, g = F.lane >> 4; const int nch = K >> 7; int cc = F.vcu % nch;
    v4u pre[4]; bf16x8 b0[4], b1[4];
    const int prow = F.tid >> 4, pc = (F.tid & 15) * 8;
#pragma unroll
    for (int i = 0; i < 4; ++i) pre[i] = *(const v4u*)(A + (size_t)(prow + 32 * i) * lda + cc * 128 + pc);
    if (bp0) {
#pragma unroll
        for (int u = 0; u < 4; ++u) { b0[u] = *(const bf16x8*)(bp0 + cc * 128 + 32 * u); if (TWO) b1[u] = *(const bf16x8*)(bp1 + cc * 128 + 32 * u); } }
    __syncthreads();
    for (int c = 0; c < nch; ++c) {
        LAS bf16* buf = AS + (c & 1) * (128 * AP);
#pragma unroll
        for (int i = 0; i < 4; ++i) *(LAS v4u*)&buf[(prow + 32 * i) * AP + pc] = pre[i];
        bf16x8 c0[4], c1[4];
#pragma unroll
        for (int u = 0; u < 4; ++u) { c0[u] = b0[u]; if (TWO) c1[u] = b1[u]; }
        cc = cc + 1 == nch ? 0 : cc + 1;
        if (c + 1 < nch) {
#pragma unroll
            for (int i = 0; i < 4; ++i) pre[i] = *(const v4u*)(A + (size_t)(prow + 32 * i) * lda + cc * 128 + pc);
            if (bp0) {
#pragma unroll
                for (int u = 0; u < 4; ++u) { b0[u] = *(const bf16x8*)(bp0 + cc * 128 + 32 * u); if (TWO) b1[u] = *(const bf16x8*)(bp1 + cc * 128 + 32 * u); } } }
        __syncthreads();
        if (bp0) {
#pragma unroll
            for (int u = 0; u < 4; ++u)
#pragma unroll
                for (int rt = 0; rt < 8; ++rt) { const bf16x8 a = *(const LAS bf16x8*)&buf[(16 * rt + l15) * AP + 32 * u + 8 * g];
                    acc0[rt] = __builtin_amdgcn_mfma_f32_16x16x32_bf16(c0[u], a, acc0[rt], 0, 0, 0); if (TWO) acc1[rt] = __builtin_amdgcn_mfma_f32_16x16x32_bf16(c1[u], a, acc1[rt], 0, 0, 0); } }
    }
}
#define MINI_ZERO(acc) _Pragma("unroll") for (int _i = 0; _i < 8; ++_i) acc[_i] = (f32x4){0.f, 0.f, 0.f, 0.f}
__device__ __forceinline__ void inproj(Frame& F) {
    unsigned char* ws = F.ws; const int l15 = F.lane & 15, g = F.lane >> 4;
    if (F.vcu >= NIN / 16) return;
    const int t = F.vcu + F.G * F.wave; const bool has = t < NIN / 16; const int n0 = 16 * t;
    f32x4 acc[8]; MINI_ZERO(acc);
    core<false>(F, (const bf16_t*)(ws + WS_XB) + 8192ull * 2048, 2048, 2048, has ? (const bf16_t*)(ws + WS_WIN) + (size_t)(n0 + l15) * 2048 + 8 * g : nullptr, nullptr, acc, acc);
    if (!has) return;
    const int c = n0 + 4 * g;
    if (c >= 7168 && c < 8192) {
#pragma unroll
        for (int rt = 0; rt < 8; ++rt) *(f32x4*)((float*)(ws + WS_LOGF) + (size_t)(8192 + 16 * rt + l15) * 1024 + (c - 7168)) = acc[rt];
        return; }
    size_t od; int pitch, c0, act; float sc = 1.0f;
    if (c < 1024) { od = WS_Q; pitch = 1024; c0 = 0; act = 0; } else if (c < 2048) { od = WS_K; pitch = 1024; c0 = 1024; act = 0; sc = 0.08838834764831845f; }
    else if (c < 4096) { od = WS_V; pitch = 2048; c0 = 2048; act = 0; } else if (c < 6144) { od = WS_RG; pitch = 2048; c0 = 4096; act = 1; } else if (c < 7168) { od = WS_HQ; pitch = 1024; c0 = 6144; act = 1; }
    else if (c < 9216) { od = WS_HI; pitch = 1024; c0 = 8192; act = 0; } else if (c < 10240) { od = WS_HG; pitch = 1024; c0 = 9216; act = 1; } else if (c < 12288) { od = WS_GA; pitch = 2048; c0 = 10240; act = 2; } else { od = WS_GB; pitch = 2048; c0 = 12288; act = 2; }
#pragma unroll
    for (int rt = 0; rt < 8; ++rt) { f32x4 v = acc[rt] * sc; if (act == 1) v = silu4(v); else if (act == 2) v = sigm4(v);
        *(u32x2*)((bf16_t*)(ws + od) + (size_t)(8192 + 16 * rt + l15) * pitch + (c - c0)) = pack4(v); }
}
__device__ __forceinline__ void outproj(Frame& F) {
    unsigned char* ws = F.ws; const int l15 = F.lane & 15, g = F.lane >> 4;
    if (F.vcu >= 128) return;
    const int t = F.vcu + F.G * F.wave; const bool has = t < 128; const int n0 = 16 * t;
    f32x4 ya[8], yb[8]; MINI_ZERO(ya); MINI_ZERO(yb);
    core<false>(F, (const bf16_t*)(ws + WS_OR) + 8192ull * 2048, 2048, 2048, has ? (const bf16_t*)(ws + WS_WRO) + (size_t)(n0 + l15) * 2048 + 8 * g : nullptr, nullptr, ya, ya);
    core<false>(F, (const bf16_t*)(ws + WS_OH) + 8192ull * 1024, 1024, 1024, has ? (const bf16_t*)(ws + WS_WHO) + (size_t)(n0 + l15) * 1024 + 8 * g : nullptr, nullptr, yb, yb);
    if (!has) return;
#pragma unroll
    for (int rt = 0; rt < 8; ++rt) { const size_t ix = (size_t)(8192 + 16 * rt + l15) * 2048 + n0 + 4 * g;
        const f32x4 ga = unpack4(*(const u32x2*)((const bf16_t*)(ws + WS_GA) + ix)), gb = unpack4(*(const u32x2*)((const bf16_t*)(ws + WS_GB) + ix));
        *(u32x2*)((bf16_t*)(ws + WS_MG) + ix) = pack4(ga * ya[rt] + gb * yb[rt]); }
}
__device__ __forceinline__ void resid(Frame& F, const bf16_t* Arows  , const bf16_t* Bt, int K, const float* XI  , float* XO  , bf16_t* XBo  , float* SS  ) {
    const int l15 = F.lane & 15, g = F.lane >> 4;
    if (F.vcu >= 128) return;
    const int t = F.vcu + F.G * F.wave; const bool has = t < 128; const int n0 = 16 * t;
    f32x4 acc[8]; MINI_ZERO(acc);
    core<false>(F, Arows, K, K, has ? Bt + (size_t)(n0 + l15) * K + 8 * g : nullptr, nullptr, acc, acc);
    if (!has) return;
#pragma unroll
    for (int rt = 0; rt < 8; ++rt) { const int rl = 16 * rt + l15; const size_t ix = (size_t)rl * 2048 + n0 + 4 * g;
        f32x4 v = acc[rt] + *(const f32x4*)(XI + ix); *(f32x4*)(XO + ix) = v;
        if (XBo) *(u32x2*)(XBo + ix) = pack4(v);
        float ss = (v[0] * v[0] + v[1] * v[1]) + (v[2] * v[2] + v[3] * v[3]); ss += __shfl_xor(ss, 16); ss += __shfl_xor(ss, 32);
        if (g == 0) atomicAdd(SS + rl, ss); }
}
__device__ __forceinline__ void swiglu(Frame& F) {
    unsigned char* ws = F.ws; const int l15 = F.lane & 15, g = F.lane >> 4;
    const int t = F.vcu + F.G * F.wave; const bool has = t < DFF / 16; const int ng = ((16 * t) >> 7) * 256 + ((16 * t) & 127);
    f32x4 ag[8], au[8]; MINI_ZERO(ag); MINI_ZERO(au);
    const bf16_t* A = (const bf16_t*)(ws + WS_X1B) + 8192ull * 2048;
    const bf16_t* bg = has ? (const bf16_t*)(ws + WS_WFI) + (size_t)(ng + l15) * 2048 + 8 * g : nullptr;
    core<true>(F, A, 2048, 2048, bg, has ? bg + 128 * 2048 : nullptr, ag, au);
    if (!has) return;
    const float* SS1 = (const float*)(F.ctl + CW_SS1);
#pragma unroll
    for (int rt = 0; rt < 8; ++rt) { const int r = 8192 + 16 * rt + l15; const float r2 = 1.0f / sqrtf(SS1[r] * (1.0f / 2048.0f) + EPS);
        *(u32x2*)((bf16_t*)(ws + WS_ACT) + (size_t)r * DFF + 16 * t + 4 * g) = pack4(silu4(ag[rt] * r2) * (au[rt] * r2)); }
}
}
__global__ void __launch_bounds__(NWAVES * 64, 2) mk_fwd(Args args) {
    extern __shared__ __attribute__((aligned(16))) unsigned char lds[];
    Frame F;
    F.lds = (LAS unsigned char*)lds; F.MISC = (volatile LAS unsigned*)(F.lds + MISC_OFF);
    F.tid = threadIdx.x; F.lane = F.tid & 63; F.wave = __builtin_amdgcn_readfirstlane(F.tid >> 6);
    F.G = gridDim.x; { const int bx = blockIdx.x; F.vcu = (F.G % 8 == 0) ? (bx % 8) * (F.G / 8) + bx / 8 : bx; }
    F.ws = args.ws; F.out = args.out; F.ctl = (gu32*)(args.ws + WS_CTL);
    for (int u = F.tid; u < (LDS_BYTES - LDSCTL_OFF) / 4; u += NWAVES * 64) ((LAS unsigned*)(F.lds + LDSCTL_OFF))[u] = 0u;
    __syncthreads();
    XcdBarrier bar; bar.bar = (unsigned*)(F.ctl + CW_BAR); bar.x = 0; bar.st = nullptr;
    if (args.use_bar) bar = xcd_barrier_post((unsigned*)(F.ctl + CW_BAR), F.MISC + 8);
    const int lo = args.ph_lo, hi = args.ph_hi;
#define IN(k) (lo <= (k) && (k) < hi)
#define SEAM(k) do { if (IN(k) && IN((k) + 1)) xcd_barrier(bar); } while (0)
#ifndef PROBE_REPEAT
#define PROBE_REPEAT -1
#endif
#define NREP(k) ((PROBE_REPEAT == (k)) ? 2 : 1)
    unsigned char* ws = args.ws;
    if (PROBE_REPEAT == 0) { p0_prologue(F, args); xcd_barrier(bar); }
    if (IN(0)) { p0_prologue(F, args); } SEAM(0);
#define P1_BODY { \
        pg8::Gemm g{(const pg8::bf16_t*)(ws + WS_XB), (const pg8::bf16_t*)(ws + WS_WIN), 8192, NIN, 2048}; pg8::StaticOrder S; S.init(8192, NIN, F.G, (int)blockIdx.x); \
        pg8::EpiInProj E{ws}; \
        pg8::gemm_phase<pg8::EpiInProj, pg8::StaticOrder, true, true>(F.lds, g, S, E); mini::inproj(F); }
    if (PROBE_REPEAT == 1) { P1_BODY xcd_barrier(bar); }
    if (PROBE_REPEAT == 101) { pg8::Gemm g{(const pg8::bf16_t*)(ws + WS_XB), (const pg8::bf16_t*)(ws + WS_WIN), 8192, NIN, 2048}; pg8::StaticOrder S; S.init(8192, NIN, F.G, (int)blockIdx.x);
        pg8::EpiNull E{}; pg8::gemm_phase<pg8::EpiNull, pg8::StaticOrder, true, true>(F.lds, g, S, E); xcd_barrier(bar); }
    if (PROBE_REPEAT == 102) { pg8::Gemm g{(const pg8::bf16_t*)(ws + WS_XB), (const pg8::bf16_t*)(ws + WS_WIN), 8192, 2048, 2048}; pg8::StaticOrder S; S.init(8192, 2048, F.G, (int)blockIdx.x);
        pg8::EpiNull E{}; pg8::gemm_phase<pg8::EpiNull, pg8::StaticOrder, true, true>(F.lds, g, S, E); xcd_barrier(bar); }
    if (IN(1)) P1_BODY SEAM(1);
    if (PROBE_REPEAT == 2) { p2_phase(F, args); xcd_barrier(bar); }
    if (IN(2)) { p2_phase(F, args); } SEAM(2);
    if (PROBE_REPEAT == 3) { p4_phase(F, args); xcd_barrier(bar); }
    if (IN(3)) { p4_phase(F, args); } SEAM(3);
    if (IN(4)) {
        { pg8::Gemm g{(const pg8::bf16_t*)(ws + WS_OR), (const pg8::bf16_t*)(ws + WS_WRO), 8192, 2048, 2048}; pg8::StaticOrder S; S.init(8192, 2048, F.G, (int)blockIdx.x);
          pg8::EpiGate<0> E{(const pg8::bf16_t*)(ws + WS_GA), (float*)(ws + WS_YT), (pg8::bf16_t*)(ws + WS_MG)};
          pg8::gemm_phase<pg8::EpiGate<0>, pg8::StaticOrder, true, true>(F.lds, g, S, E); }
        { pg8::Gemm g{(const pg8::bf16_t*)(ws + WS_OH), (const pg8::bf16_t*)(ws + WS_WHO), 8192, 2048, 1024}; pg8::StaticOrder S; S.init(8192, 2048, F.G, (int)blockIdx.x);
          pg8::EpiGate<1> E{(const pg8::bf16_t*)(ws + WS_GB), (float*)(ws + WS_YT), (pg8::bf16_t*)(ws + WS_MG)};
          pg8::gemm_phase<pg8::EpiGate<1>, pg8::StaticOrder, true, true>(F.lds, g, S, E); }
        mini::outproj(F);
    } SEAM(4);
    if (IN(5)) {
        pg8::Gemm g{(const pg8::bf16_t*)(ws + WS_MG), (const pg8::bf16_t*)(ws + WS_WOUT), 8192, 2048, 2048}; pg8::StaticOrder S; S.init(8192, 2048, F.G, (int)blockIdx.x);
        pg8::EpiResid E{args.in[0], args.in[1], args.out, (pg8::bf16_t*)(ws + WS_X1B), (float*)(F.ctl + CW_SS1)};
        pg8::gemm_phase<pg8::EpiResid, pg8::StaticOrder, true, true>(F.lds, g, S, E);
        mini::resid(F, (const pg8::bf16_t*)(ws + WS_MG) + 8192ull * 2048, (const pg8::bf16_t*)(ws + WS_WOUT), 2048, args.in[1], args.out + OUT_YS, (pg8::bf16_t*)(ws + WS_X1B) + 8192ull * 2048, (float*)(F.ctl + CW_SS1) + 8192);
    } SEAM(5);
    if (IN(6)) {
        pg8::Gemm g{(const pg8::bf16_t*)(ws + WS_X1B), (const pg8::bf16_t*)(ws + WS_WFI), 8192, 2 * DFF, 2048}; pg8::StaticOrder S; S.init(8192, 2 * DFF, F.G, (int)blockIdx.x);
        pg8::EpiSwiglu E{(const float*)(F.ctl + CW_SS1), (pg8::bf16_t*)(ws + WS_ACT)};
        pg8::gemm_phase<pg8::EpiSwiglu, pg8::StaticOrder, true, true>(F.lds, g, S, E);
        mini::swiglu(F);
    } SEAM(6);
    if (IN(7)) {
        pg8::Gemm g{(const pg8::bf16_t*)(ws + WS_ACT), (const pg8::bf16_t*)(ws + WS_WFO), 8192, 2048, DFF}; pg8::StaticOrder S; S.init(8192, 2048, F.G, (int)blockIdx.x);
        pg8::EpiResid E{args.out, args.out + OUT_YS, args.out, nullptr, (float*)(F.ctl + CW_SS2)};
        pg8::gemm_phase<pg8::EpiResid, pg8::StaticOrder, true, true>(F.lds, g, S, E);
        mini::resid(F, (const pg8::bf16_t*)(ws + WS_ACT) + 8192ull * DFF, (const pg8::bf16_t*)(ws + WS_WFO), DFF, args.out + OUT_YS, args.out + OUT_YS, nullptr, (float*)(F.ctl + CW_SS2) + 8192);
    } SEAM(7);
    if (IN(8)) {
        const int gw = F.vcu * NWAVES + F.wave, NGW = F.G * NWAVES; const float* SS2 = (const float*)(F.ctl + CW_SS2);
        for (int m = gw; m < MROWS; m += NGW) { f32x4* xr = (f32x4*)(args.out + (size_t)m * 2048) + F.lane; const f32x4* gn = (const f32x4*)args.in[14] + F.lane;
            const float rr = 1.0f / sqrtf(SS2[m] * (1.0f / 2048.0f) + EPS);
#pragma unroll
            for (int j = 0; j < 8; ++j) xr[64 * j] = xr[64 * j] * rr * gn[64 * j]; }
    }
#undef IN
#undef SEAM
}
extern "C" void kernel_launch(void* const* d_in, const int* in_sizes, int n_in, void* d_out, int out_size, void* d_ws, size_t ws_size, hipStream_t stream) {
    static int grid = 0;
    if (grid == 0) {
        int dev = 0, cus = 0;
        if (ws_size < WS_END || n_in != 15) { fprintf(stderr, "kernel_launch: unexpected sizes (ws %zu, n_in %d)\n", ws_size, n_in); grid = -1; return; }
        if (hipGetDevice(&dev) != hipSuccess || hipDeviceGetAttribute(&cus, hipDeviceAttributeMultiprocessorCount, dev) != hipSuccess) { grid = -1; return; }
        if (hipFuncSetAttribute((const void*)mk_fwd, hipFuncAttributeMaxDynamicSharedMemorySize, LDS_BYTES) != hipSuccess) { fprintf(stderr, "kernel_launch: hipFuncSetAttribute failed\n"); grid = -1; return; }
        int per_cu = 0; (void)hipOccupancyMaxActiveBlocksPerMultiprocessor(&per_cu, (const void*)mk_fwd, NWAVES * 64, LDS_BYTES); (void)hipGetLastError();
        if (per_cu < 1) { fprintf(stderr, "kernel_launch: occupancy query says %d blocks per CU; nothing launched\n", per_cu); grid = -1; return; }
        grid = cus;
    }
    if (grid < 0) return;
    (void)hipMemsetAsync((char*)d_ws + WS_CTL, 0, CTL_ZERO_BYTES, stream);
    Args a{};
    for (int i = 0; i < 15; ++i) a.in[i] = (const float*)d_in[i];
    a.out = (float*)d_out; a.ws = (unsigned char*)d_ws; a.use_bar = 1; a.ph_lo = 0; a.ph_hi = 9;
    hipLaunchKernelGGL(mk_fwd, dim3(grid), dim3(NWAVES * 64), LDS_BYTES, stream, a);
}
```

```cpp
#include <hip/hip_runtime.h>
#include <cstdio>
#include <cstdint>
constexpr int DMODEL = 2048, MROWS = 8320, MPAD = 8448, NIN = 14336, DFF = 5632, NWAVES = 8;
constexpr float EPS = 1e-6f;
constexpr size_t MiB = 1u << 20;
constexpr size_t WS_CTL = 0, CTL_ZERO_BYTES = 1 * MiB;
constexpr size_t WS_WRO = 1 * MiB, WS_WHO = 9 * MiB, WS_WOUT = 13 * MiB, WS_WFI = 21 * MiB, WS_WFO = 65 * MiB, WS_WIN = 87 * MiB;
constexpr size_t WS_XB = 143 * MiB;
constexpr size_t WS_Q = 176 * MiB, WS_K = WS_Q + 8448ull * 1024 * 2, WS_V = 209 * MiB, WS_RG = 242 * MiB, WS_HQ = 275 * MiB, WS_LOGF = WS_HQ + 8448ull * 1024 * 2;
constexpr size_t WS_HI = WS_LOGF + 8448ull * 1024 * 4, WS_HG = WS_HI + 8448ull * 1024 * 2, WS_GA = WS_HG + 8448ull * 1024 * 2, WS_GB = WS_GA + 8448ull * 2048 * 2;
constexpr size_t WS_KVLOC = WS_GB + 8448ull * 2048 * 2;
constexpr size_t WS_HSLOC = WS_KVLOC + 64 * MiB;
constexpr size_t WS_OH = WS_HSLOC + 32 * MiB;
constexpr size_t WS_MISC = WS_OH + 8448ull * 1024 * 2;
constexpr size_t WS_RR1 = WS_MISC, WS_COS = WS_RR1 + 64 * 1024, WS_SIN = WS_COS + 2049 * 64 * 4 + 256, WS_LB = WS_SIN + 2049 * 64 * 4 + 256, WS_BTOT = WS_LB + 4096, WS_END = WS_BTOT + 512 * 128 * 4;
constexpr size_t WS_OR = WS_XB;
constexpr size_t WS_SRT = WS_WIN, WS_SHT = WS_WIN + 32 * MiB;
constexpr size_t WS_YT = WS_KVLOC;
constexpr size_t WS_MG = WS_Q;
constexpr size_t WS_X1B = WS_V;
constexpr size_t WS_ACT = WS_RG;
static_assert(WS_GB + 8448ull * 2048 * 2 == WS_KVLOC && WS_K + 8448ull * 1024 * 2 == WS_V && WS_V + 8448ull * 2048 * 2 == WS_RG && WS_RG + 8448ull * 2048 * 2 == WS_HQ, "map");
static_assert(WS_YT + 8448ull * 2048 * 4 <= WS_OH && WS_ACT + 8448ull * 5632 * 2 <= WS_GA && WS_END <= 541 * MiB, "map2");
constexpr int CW_BAR = 4096;
constexpr int CW_SS1 = 16384, CW_SS2 = 16384 + 8448;
static_assert((CW_SS2 + 8448) * 4 <= (int)CTL_ZERO_BYTES, "ctl");
constexpr int RING_BYTES = 131072, LDSCTL_OFF = RING_BYTES, MISC_OFF = LDSCTL_OFF + 320, LDS_BYTES = 147456;

#define GAS __attribute__((address_space(1)))
#define LAS __attribute__((address_space(3)))
typedef unsigned short bf16;
typedef unsigned v4u __attribute__((ext_vector_type(4)));
typedef unsigned v2u __attribute__((ext_vector_type(2)));
typedef float f32x4 __attribute__((ext_vector_type(4)));
typedef short bf16x8 __attribute__((ext_vector_type(8)));
typedef GAS unsigned gu32;
#define RLX_AGENT __ATOMIC_RELAXED, __HIP_MEMORY_SCOPE_AGENT
#define LDS_WAIT() asm volatile("s_waitcnt lgkmcnt(0)" ::: "memory")
#define VM_WAIT() asm volatile("s_waitcnt vmcnt(0)" ::: "memory")
__device__ __forceinline__ unsigned f2bf(float f) { unsigned u = __builtin_bit_cast(unsigned, f); return (u + 0x7fffu + ((u >> 16) & 1u)) >> 16; }
__device__ __forceinline__ unsigned pk2(float lo, float hi) { return f2bf(lo) | (f2bf(hi) << 16); }
__device__ __forceinline__ float bf2f(unsigned short b) { return __uint_as_float(((unsigned)b) << 16); }
namespace pg8 {
#define PG8_LAS __attribute__((address_space(3)))
typedef unsigned short bf16_t;
typedef short bf16x8 __attribute__((ext_vector_type(8)));
typedef float f32x4 __attribute__((ext_vector_type(4)));
typedef unsigned u32x4 __attribute__((ext_vector_type(4)));
constexpr int BM = 256, BK = 64, HALF = 128, HTB = HALF * BK * 2  , STAGE_BYTES = 8 * HTB, NXCD = 8, WGM = 8;

__host__ __device__ __forceinline__ int lds_byte(int r, int c) { const int st = (r >> 4) * 2 + (c >> 5), rr = r & 15, cc = c & 31, ob = rr * 64 + cc * 2; return st * 1024 + (ob ^ (((ob >> 9) & 1) << 5)); }
__host__ __device__ __forceinline__ void stage_rc(int b, int& R, int& C) { const int st = b / 1024, sb = b % 1024, swz = sb ^ (((sb >> 9) & 1) << 5); R = (st >> 1) * 16 + swz / 64; C = (st & 1) * 32 + (swz % 64) / 2; }
__host__ __device__ __forceinline__ int perm32(int rho) { const int n = rho >> 4, i = rho & 15; return 8 * (i >> 2) + 4 * n + (i & 3); }

struct Unit { int pm, pn; };
struct Gemm { const bf16_t* A; const bf16_t* Bt; int M, N, K; };

struct StaticOrder {
    int nM, nN, nwg, G, c;
    __host__ __device__ void init(int M, int N, int G_, int c_) { nM = M / BM; nN = N / BM; nwg = nM * nN; G = G_; c = c_; }
    __host__ __device__ bool next(int i, Unit& u) const {
        const long L = (long)i * G + c; if (L >= nwg) return false;
        int wgid = (int)L; { const int q = nwg / NXCD, r = nwg % NXCD, xcd = wgid % NXCD, off = wgid / NXCD; wgid = (xcd < r ? xcd * (q + 1) : r * (q + 1) + (xcd - r) * q) + off; }
        const int nig = WGM * nN, gid = wgid / nig, fm = gid * WGM, gsz = (nM - fm) < WGM ? (nM - fm) : WGM;
        u.pm = fm + ((wgid % nig) % gsz); u.pn = (wgid % nig) / gsz; return true;
    }
    __device__ __forceinline__ void a_ready(const Unit&) const {}
    __device__ __forceinline__ void done(const Unit&) const {}
};

__device__ __forceinline__ unsigned cvt_pk_bf16(float lo, float hi) { unsigned r; asm volatile("v_cvt_pk_bf16_f32 %0, %1, %2" : "=v"(r) : "v"(lo), "v"(hi)); return r; }
typedef float f32x2 __attribute__((ext_vector_type(2)));
typedef unsigned u32x2 __attribute__((ext_vector_type(2)));
__device__ __forceinline__ float sigm(float x) { return __builtin_amdgcn_rcpf(1.0f + __expf(-x)); }
__device__ __forceinline__ f32x4 silu4(f32x4 v) { f32x4 o; o[0] = v[0] * sigm(v[0]); o[1] = v[1] * sigm(v[1]); o[2] = v[2] * sigm(v[2]); o[3] = v[3] * sigm(v[3]); return o; }
__device__ __forceinline__ f32x4 sigm4(f32x4 v) { f32x4 o; o[0] = sigm(v[0]); o[1] = sigm(v[1]); o[2] = sigm(v[2]); o[3] = sigm(v[3]); return o; }
__device__ __forceinline__ u32x4 pack8(f32x4 v0, f32x4 v1) { u32x4 w; w.x = cvt_pk_bf16(v0[0], v0[1]); w.y = cvt_pk_bf16(v0[2], v0[3]); w.z = cvt_pk_bf16(v1[0], v1[1]); w.w = cvt_pk_bf16(v1[2], v1[3]); return w; }
__device__ __forceinline__ u32x2 pack4(f32x4 v) { u32x2 w; w.x = cvt_pk_bf16(v[0], v[1]); w.y = cvt_pk_bf16(v[2], v[3]); return w; }
__device__ __forceinline__ f32x4 unpack4(u32x2 w) { f32x4 o; o[0] = __uint_as_float(w.x << 16); o[1] = __uint_as_float(w.x & 0xffff0000u); o[2] = __uint_as_float(w.y << 16); o[3] = __uint_as_float(w.y & 0xffff0000u); return o; }

struct EpiInProj {
    static constexpr bool PERM = true, AFTER_DRAIN = false;
    unsigned char* ws;
    __device__ __forceinline__ void operator()(const f32x4 (&acc)[2][2][4][2], const Unit& u, int wr, int wc, int fr, int fq) const {
        const int pn = u.pn, row0 = u.pm * BM + wr * 64 + fr;
        if (pn >= 28 && pn < 32) {
            float* Z = (float*)(ws + WS_LOGF); const int cs = (pn - 28) * 256 + wc * 32 + 8 * fq;
#pragma unroll
            for (int ai = 0; ai < 2; ++ai)
#pragma unroll
                for (int m = 0; m < 4; ++m) { const int r = row0 + ai * HALF + m * 16;
#pragma unroll
                    for (int bj = 0; bj < 2; ++bj)
#pragma unroll
                        for (int n = 0; n < 2; ++n) *(f32x4*)(Z + (size_t)r * 1024 + cs + bj * HALF + 4 * n) = acc[ai][bj][m][n]; }
        } else {
            size_t od; int pitch, p0, act; float sc = 1.0f;
            if (pn < 4) { od = WS_Q; pitch = 1024; p0 = 0; act = 0; } else if (pn < 8) { od = WS_K; pitch = 1024; p0 = 4; act = 0; sc = 0.08838834764831845f; }
            else if (pn < 16) { od = WS_V; pitch = 2048; p0 = 8; act = 0; } else if (pn < 24) { od = WS_RG; pitch = 2048; p0 = 16; act = 1; } else if (pn < 28) { od = WS_HQ; pitch = 1024; p0 = 24; act = 1; }
            else if (pn < 36) { od = WS_HI; pitch = 1024; p0 = 32; act = 0; } else if (pn < 40) { od = WS_HG; pitch = 1024; p0 = 36; act = 1; } else if (pn < 48) { od = WS_GA; pitch = 2048; p0 = 40; act = 2; } else { od = WS_GB; pitch = 2048; p0 = 48; act = 2; }
            bf16_t* dst = (bf16_t*)(ws + od);
            const int cs = (pn - p0) * 256 + wc * 32 + 8 * fq;
#pragma unroll
            for (int ai = 0; ai < 2; ++ai)
#pragma unroll
                for (int m = 0; m < 4; ++m) { const int r = row0 + ai * HALF + m * 16; bf16_t* rowp = dst + (size_t)r * pitch + cs;
#pragma unroll
                    for (int bj = 0; bj < 2; ++bj) { f32x4 v0 = acc[ai][bj][m][0] * sc, v1 = acc[ai][bj][m][1] * sc;
                        if (act == 1) { v0 = silu4(v0); v1 = silu4(v1); } else if (act == 2) { v0 = sigm4(v0); v1 = sigm4(v1); }
                        *(u32x4*)(rowp + bj * HALF) = pack8(v0, v1); } }
        }
    }
};
struct EpiNull {
    static constexpr bool PERM = true, AFTER_DRAIN = false;
    __device__ __forceinline__ void operator()(const f32x4 (&acc)[2][2][4][2], const Unit& u, int wr, int wc, int fr, int fq) const {
#pragma unroll
        for (int ai = 0; ai < 2; ++ai)
#pragma unroll
            for (int m = 0; m < 4; ++m)
#pragma unroll
                for (int bj = 0; bj < 2; ++bj) { asm volatile("" :: "v"(acc[ai][bj][m][0]), "v"(acc[ai][bj][m][1])); }
    }
};
template <int SECOND> struct EpiGate {
    static constexpr bool PERM = true, AFTER_DRAIN = false;
    const bf16_t* G; float* YT; bf16_t* MG;
    __device__ __forceinline__ void operator()(const f32x4 (&acc)[2][2][4][2], const Unit& u, int wr, int wc, int fr, int fq) const {
        const int row0 = u.pm * BM + wr * 64 + fr, col0 = u.pn * BM + wc * 32 + 8 * fq;
#pragma unroll
        for (int ai = 0; ai < 2; ++ai)
#pragma unroll
            for (int m = 0; m < 4; ++m) { const size_t off = (size_t)(row0 + ai * HALF + m * 16) * 2048 + col0;
#pragma unroll
                for (int bj = 0; bj < 2; ++bj) { const u32x4 gw = *(const u32x4*)(G + off + bj * HALF);
                    f32x4 v0 = acc[ai][bj][m][0] * unpack4((u32x2){gw.x, gw.y}), v1 = acc[ai][bj][m][1] * unpack4((u32x2){gw.z, gw.w});
                    float* yp = YT + off + bj * HALF;
                    if (SECOND) { v0 += *(const f32x4*)yp; v1 += *(const f32x4*)(yp + 4); *(u32x4*)(MG + off + bj * HALF) = pack8(v0, v1); }
                    else { *(f32x4*)yp = v0; *(f32x4*)(yp + 4) = v1; } } }
        __builtin_amdgcn_s_waitcnt(0x0F70);
    }
};
struct EpiResid {
    static constexpr bool PERM = true, AFTER_DRAIN = false;
    const float* XP; const float* XS; float* OUT; bf16_t* XB; float* SS;
    __device__ __forceinline__ void operator()(const f32x4 (&acc)[2][2][4][2], const Unit& u, int wr, int wc, int fr, int fq) const {
        const int row0 = u.pm * BM + wr * 64 + fr, col0 = u.pn * BM + wc * 32 + 8 * fq;
#pragma unroll
        for (int ai = 0; ai < 2; ++ai)
#pragma unroll
            for (int m = 0; m < 4; ++m) { const int r = row0 + ai * HALF + m * 16; const bool live = r < 8320;
                const float* xi = (r < 8192 ? XP + (size_t)r * 2048 : XS + (size_t)(r - 8192) * 2048) + col0; float ss = 0.f;
#pragma unroll
                for (int bj = 0; bj < 2; ++bj) { f32x4 v0 = acc[ai][bj][m][0], v1 = acc[ai][bj][m][1];
                    if (live) { v0 += *(const f32x4*)(xi + bj * HALF); v1 += *(const f32x4*)(xi + bj * HALF + 4);
                        float* op = OUT + (size_t)r * 2048 + col0 + bj * HALF; *(f32x4*)op = v0; *(f32x4*)(op + 4) = v1; }
                    if (XB) *(u32x4*)(XB + (size_t)r * 2048 + col0 + bj * HALF) = pack8(v0, v1);
                    ss += (v0[0] * v0[0] + v0[1] * v0[1]) + (v0[2] * v0[2] + v0[3] * v0[3]) + (v1[0] * v1[0] + v1[1] * v1[1]) + (v1[2] * v1[2] + v1[3] * v1[3]); }
                ss += __shfl_xor(ss, 16); ss += __shfl_xor(ss, 32);
                if (fq == 0) atomicAdd(SS + r, ss); }
        __builtin_amdgcn_s_waitcnt(0x0F70);
    }
};
struct EpiSwiglu {
    static constexpr bool PERM = true, AFTER_DRAIN = false;
    const float* SS; bf16_t* ACT;
    __device__ __forceinline__ void operator()(const f32x4 (&acc)[2][2][4][2], const Unit& u, int wr, int wc, int fr, int fq) const {
        const int row0 = u.pm * BM + wr * 64 + fr, col0 = u.pn * HALF + wc * 32 + 8 * fq;
        float ssv[2][4];
#pragma unroll
        for (int ai = 0; ai < 2; ++ai)
#pragma unroll
            for (int m = 0; m < 4; ++m) ssv[ai][m] = SS[row0 + ai * HALF + m * 16];
        __builtin_amdgcn_s_waitcnt(0x0F70);
#pragma unroll
        for (int ai = 0; ai < 2; ++ai)
#pragma unroll
            for (int m = 0; m < 4; ++m) { const int r = row0 + ai * HALF + m * 16; const float r2 = 1.0f / sqrtf(ssv[ai][m] * (1.0f / 2048.0f) + 1e-6f);
                const f32x4 g0 = acc[ai][0][m][0] * r2, g1 = acc[ai][0][m][1] * r2, u0 = acc[ai][1][m][0] * r2, u1 = acc[ai][1][m][1] * r2;
                *(u32x4*)(ACT + (size_t)r * 5632 + col0) = pack8(silu4(g0) * u0, silu4(g1) * u1); }
    }
};
template <class Epi, class Sched, bool ALIGN_EPI = false, bool SP2 = false>
__device__ __forceinline__ void gemm_phase(PG8_LAS unsigned char* lds, const Gemm g, const Sched& S, const Epi& E) {
    int tid_ = threadIdx.x; asm volatile("" : "+v"(tid_));
    const int tid = tid_, wid = __builtin_amdgcn_readfirstlane(tid >> 6), lane = tid & 63, wr = wid >> 2, wc = wid & 3, fr = lane & 15, fq = lane >> 4;
    const int K = g.K, nt = K / BK;
    unsigned voffA[2], voffB[2];
#pragma unroll
    for (int i = 0; i < 2; ++i) { int R, C; stage_rc(tid * 16 + i * 8192, R, C); const int Rb = Epi::PERM ? ((R & ~31) + perm32(R & 31)) : R;
        voffA[i] = (unsigned)(R * K + C) * 2u; voffB[i] = (unsigned)(Rb * K + C) * 2u; }
    const size_t kstep = (size_t)(BK * 2);
    const size_t hstep = (size_t)HALF * K * 2;
    const size_t tstep = 2 * hstep;
    const unsigned ldsw = (unsigned)wid * 1024u;
    const int aoff = lds_byte(wr * 64 + fr, fq * 8), boff = lds_byte(wc * 32 + fr, fq * 8);
#define PG8_SA(b, h) (((b) * 2 + (h)) * HTB)
#define PG8_SB(b, h) ((4 + (b) * 2 + (h)) * HTB)
#define PG8_STAGE(bufoff, gbase, voff) do { _Pragma("unroll") for (int _i = 0; _i < 2; ++_i) \
        __builtin_amdgcn_global_load_lds((const unsigned*)((const char*)(gbase) + (voff)[_i]), (PG8_LAS unsigned*)(lds + (bufoff) + ldsw + _i * 8192), 16, 0, 0); } while (0)
#define PG8_LDA(dst, b, h) do { _Pragma("unroll") for (int m = 0; m < 4; ++m) _Pragma("unroll") for (int k = 0; k < 2; ++k) dst[m][k] = *(const PG8_LAS bf16x8*)(lds + PG8_SA(b, h) + aoff + m * 2048 + k * 1024); } while (0)
#define PG8_LDB(dst, b, h) do { _Pragma("unroll") for (int n = 0; n < 2; ++n) _Pragma("unroll") for (int k = 0; k < 2; ++k) dst[n][k] = *(const PG8_LAS bf16x8*)(lds + PG8_SB(b, h) + boff + n * 2048 + k * 1024); } while (0)
#define PG8_MMA(ai, bj, At, Bt) do { __builtin_amdgcn_s_setprio(1); _Pragma("unroll") for (int m = 0; m < 4; ++m) _Pragma("unroll") for (int n = 0; n < 2; ++n) _Pragma("unroll") for (int k = 0; k < 2; ++k) \
        acc[ai][bj][m][n] = __builtin_amdgcn_mfma_f32_16x16x32_bf16(Bt[n][k], At[m][k], acc[ai][bj][m][n], 0, 0, 0); __builtin_amdgcn_s_setprio(0); } while (0)
#define PG8_WAIT_V(n) asm volatile("s_waitcnt vmcnt(" #n ")" ::: "memory")
#define PG8_WAIT_L(n) asm volatile("s_waitcnt lgkmcnt(" #n ")" ::: "memory")
#define PG8_BAR __builtin_amdgcn_s_barrier()
#define PG8_SCHED __builtin_amdgcn_sched_barrier(0)
    Unit cur, nxt; int ui = 0;
    if (!S.next(0, cur)) return;
    f32x4 acc[2][2][4][2];
#pragma unroll
    for (int a = 0; a < 2; ++a)
#pragma unroll
        for (int b = 0; b < 2; ++b)
#pragma unroll
            for (int m = 0; m < 4; ++m)
#pragma unroll
                for (int n = 0; n < 2; ++n) acc[a][b][m][n] = (f32x4){0.f, 0.f, 0.f, 0.f};
    bf16x8 At[4][2], B0[2][2], B1[2][2];
    const char* cA = (const char*)g.A + (size_t)cur.pm * tstep; const char* cB = (const char*)g.Bt + (size_t)cur.pn * tstep;
    S.a_ready(cur);
    if constexpr (SP2) {
        PG8_STAGE(PG8_SB(0, 0), cB, voffB); PG8_STAGE(PG8_SB(0, 1), cB + hstep, voffB); PG8_STAGE(PG8_SA(0, 0), cA, voffA); PG8_STAGE(PG8_SA(0, 1), cA + hstep, voffA);
        if (wr == 1) PG8_BAR;
        PG8_WAIT_V(2); PG8_BAR;
        PG8_STAGE(PG8_SB(1, 0), cB + kstep, voffB); PG8_STAGE(PG8_SA(1, 0), cA + kstep, voffA); PG8_STAGE(PG8_SB(1, 1), cB + hstep + kstep, voffB);
        PG8_WAIT_V(6); PG8_BAR;
    } else {
        PG8_STAGE(PG8_SB(0, 0), cB, voffB); PG8_STAGE(PG8_SA(0, 0), cA, voffA); PG8_STAGE(PG8_SB(0, 1), cB + hstep, voffB); PG8_STAGE(PG8_SA(0, 1), cA + hstep, voffA);
        if (wr == 1) PG8_BAR;
        PG8_WAIT_V(4); PG8_BAR;
        PG8_STAGE(PG8_SB(1, 0), cB + kstep, voffB); PG8_STAGE(PG8_SA(1, 0), cA + kstep, voffA); PG8_STAGE(PG8_SB(1, 1), cB + hstep + kstep, voffB);
        PG8_WAIT_V(6); PG8_BAR;
    }
    for (;;) {
        const bool has_next = S.next(ui + 1, nxt);
        const char* nA = has_next ? (const char*)g.A + (size_t)nxt.pm * tstep : cA; const char* nB = has_next ? (const char*)g.Bt + (size_t)nxt.pn * tstep : cB;
        for (int t = 0; t < nt; t += 2) {
            const bool last = (t == nt - 2);
            const char* a1 = cA + (size_t)(t + 1) * kstep;
            const char* a2 = last ? nA : cA + (size_t)(t + 2) * kstep; const char* b2 = last ? nB : cB + (size_t)(t + 2) * kstep;
            const char* a3 = a2 + kstep; const char* b3 = b2 + kstep;
            if (last && has_next) S.a_ready(nxt);
            if constexpr (SP2) {
            PG8_LDB(B0, 0, 0); PG8_LDB(B1, 0, 1); PG8_SCHED; PG8_LDA(At, 0, 0); PG8_STAGE(PG8_SA(1, 1), a1 + hstep, voffA);
            PG8_WAIT_V(8); PG8_WAIT_L(0); PG8_BAR; PG8_MMA(0, 0, At, B0); PG8_MMA(0, 1, At, B1); PG8_BAR; PG8_SCHED;
            PG8_LDA(At, 0, 1); PG8_STAGE(PG8_SB(0, 0), b2, voffB); PG8_STAGE(PG8_SB(0, 1), b2 + hstep, voffB); PG8_STAGE(PG8_SA(0, 0), a2, voffA);
            PG8_WAIT_V(8); PG8_WAIT_L(0); PG8_BAR; PG8_MMA(1, 0, At, B0); PG8_MMA(1, 1, At, B1); PG8_BAR; PG8_SCHED;
            PG8_LDB(B0, 1, 0); PG8_LDB(B1, 1, 1); PG8_SCHED; PG8_LDA(At, 1, 0); PG8_STAGE(PG8_SA(0, 1), a2 + hstep, voffA);
            PG8_WAIT_V(8); PG8_WAIT_L(0); PG8_BAR; PG8_MMA(0, 0, At, B0); PG8_MMA(0, 1, At, B1); PG8_BAR; PG8_SCHED;
            PG8_LDA(At, 1, 1); PG8_STAGE(PG8_SB(1, 0), b3, voffB); PG8_STAGE(PG8_SB(1, 1), b3 + hstep, voffB); PG8_STAGE(PG8_SA(1, 0), a3, voffA);
            PG8_WAIT_V(8); PG8_WAIT_L(0); PG8_BAR; PG8_MMA(1, 0, At, B0); PG8_MMA(1, 1, At, B1); PG8_BAR; PG8_SCHED;
            } else {
            PG8_LDB(B0, 0, 0); PG8_SCHED; PG8_LDA(At, 0, 0); PG8_STAGE(PG8_SA(1, 1), a1 + hstep, voffA);
            PG8_WAIT_L(8); PG8_BAR; PG8_WAIT_L(0); PG8_MMA(0, 0, At, B0); PG8_BAR; PG8_SCHED;
            PG8_LDB(B1, 0, 1); PG8_STAGE(PG8_SB(0, 0), b2, voffB);
            PG8_BAR; PG8_WAIT_L(0); PG8_MMA(0, 1, At, B1); PG8_BAR;
            PG8_LDA(At, 0, 1); PG8_STAGE(PG8_SA(0, 0), a2, voffA);
            PG8_BAR; PG8_WAIT_L(0); PG8_MMA(1, 0, At, B0); PG8_BAR; PG8_SCHED;
            PG8_STAGE(PG8_SB(0, 1), b2 + hstep, voffB);
            PG8_WAIT_V(6); PG8_BAR; PG8_MMA(1, 1, At, B1); PG8_BAR;
            PG8_LDB(B0, 1, 0); PG8_SCHED; PG8_LDA(At, 1, 0); PG8_STAGE(PG8_SA(0, 1), a2 + hstep, voffA);
            PG8_WAIT_L(8); PG8_BAR; PG8_WAIT_L(0); PG8_MMA(0, 0, At, B0); PG8_BAR; PG8_SCHED;
            PG8_LDB(B1, 1, 1); PG8_STAGE(PG8_SB(1, 0), b3, voffB);
            PG8_BAR; PG8_WAIT_L(0); PG8_MMA(0, 1, At, B1); PG8_BAR;
            PG8_LDA(At, 1, 1); PG8_STAGE(PG8_SA(1, 0), a3, voffA);
            PG8_BAR; PG8_WAIT_L(0); PG8_MMA(1, 0, At, B0); PG8_BAR; PG8_SCHED;
            PG8_STAGE(PG8_SB(1, 1), b3 + hstep, voffB);
            PG8_WAIT_V(6); PG8_BAR; PG8_MMA(1, 1, At, B1); PG8_BAR;
            }
        }
        if constexpr (ALIGN_EPI) { if (wr == 0) PG8_BAR; }
        if constexpr (!Epi::AFTER_DRAIN) { E(acc, cur, wr, wc, fr, fq); S.done(cur); }
        if (!has_next) break;
#pragma unroll
        for (int a = 0; a < 2; ++a)
#pragma unroll
            for (int b = 0; b < 2; ++b)
#pragma unroll
                for (int m = 0; m < 4; ++m)
#pragma unroll
                    for (int n = 0; n < 2; ++n) acc[a][b][m][n] = (f32x4){0.f, 0.f, 0.f, 0.f};
        cur = nxt; cA = nA; cB = nB; ++ui;
        if constexpr (ALIGN_EPI) { if (wr == 1) PG8_BAR; }
    }
    PG8_WAIT_V(0);
    if constexpr (!ALIGN_EPI) { if (wr == 0) PG8_BAR; }
    PG8_BAR;
    if constexpr (Epi::AFTER_DRAIN) { E.fused(acc, cur, wr, wc, fr, fq, lds, wid, lane); S.done(cur); }
#undef PG8_SA
#undef PG8_SB
#undef PG8_STAGE
#undef PG8_LDA
#undef PG8_LDB
#undef PG8_MMA
#undef PG8_WAIT_V
#undef PG8_WAIT_L
#undef PG8_BAR
#undef PG8_SCHED
}
}
#define XB_TMO      128
#define XB_XCNT(j)  (256  + 64 * (j))
#define XB_XSUB(j)  (1280 + 64 * (j))
#define XB_XGEN(j)  (2304 + 64 * (j))
#define XB_TOP      3328
#define XB_TOPGEN   3392
#define XCD_BAR_WORDS 3456
#define XB_SPIN_CAP (1u << 18)

__device__ __forceinline__ unsigned xb_ld(unsigned* p)              { return __hip_atomic_load(p, __ATOMIC_RELAXED, __HIP_MEMORY_SCOPE_AGENT); }
__device__ __forceinline__ unsigned xb_add(unsigned* p, unsigned v) { return __hip_atomic_fetch_add(p, v, __ATOMIC_RELAXED, __HIP_MEMORY_SCOPE_AGENT); }
__device__ __forceinline__ unsigned xb_xcc_id() { return (unsigned)__builtin_amdgcn_s_getreg((3 << 11) | 20) & 0xFu; }
#define XB_SPIN(cond, bar) do { unsigned _sp = 0; while (cond) { __builtin_amdgcn_s_sleep(1); \
    if ((++_sp & 255u) == 0u) { if (xb_ld(&(bar)[XB_TMO])) break; if (_sp > XB_SPIN_CAP) { atomicAdd(&(bar)[XB_TMO], 1u); break; } } } } while (0)

struct XcdBarrier {
    unsigned* bar; unsigned x;
    volatile LAS unsigned* st;
};

__device__ __forceinline__ XcdBarrier xcd_barrier_post(unsigned* bar, volatile LAS unsigned* st) {
    XcdBarrier b; b.bar = bar; b.x = xb_xcc_id(); b.st = st;
    if (threadIdx.x == 0) (void)xb_add(&bar[XB_XCNT(b.x)], 1u);
    return b;
}
__device__ __forceinline__ void xcd_barrier_complete(unsigned* bar, unsigned x, unsigned& nloc, unsigned& nx) {
    const unsigned G = gridDim.x * gridDim.y * gridDim.z;
    unsigned sum, cnt, mine, sp = 0u;
    for (;;) {
        sum = 0u; cnt = 0u; mine = 0u;
#pragma unroll
        for (unsigned j = 0; j < 16; ++j) { const unsigned c = xb_ld(&bar[XB_XCNT(j)]); sum += c; cnt += (c > 0u) ? 1u : 0u; mine = (j == x) ? c : mine; }
        if (sum == G) break;
        __builtin_amdgcn_s_sleep(1);
        if ((++sp & 255u) == 0u) { if (xb_ld(&bar[XB_TMO])) break; if (sp > XB_SPIN_CAP) { atomicAdd(&bar[XB_TMO], 1u); break; } }
    }
    nloc = mine > 0u ? mine : 1u; nx = cnt > 0u ? cnt : 1u;
}

__device__ __forceinline__ void xcd_barrier(const XcdBarrier& b) {
    asm volatile("s_waitcnt vmcnt(0)" ::: "memory");
    __syncthreads();
    if (threadIdx.x == 0) {
        unsigned* bar = b.bar;
        __builtin_amdgcn_s_waitcnt(0);
        unsigned nloc = b.st[0], nx = b.st[1];
        if (nloc == 0u) { xcd_barrier_complete(bar, b.x, nloc, nx); b.st[0] = nloc; b.st[1] = nx; }
        const unsigned old = xb_add(&bar[XB_XSUB(b.x)], 1u);
        const unsigned gen = old / nloc;
        if (old + 1u == (gen + 1u) * nloc) {
            __builtin_amdgcn_fence(__ATOMIC_RELEASE, "agent");
            asm volatile("s_waitcnt vmcnt(0)" ::: "memory");
            const unsigned og = xb_add(&bar[XB_TOP], 1u);
            const unsigned tg = og / nx;
            if (og + 1u == (tg + 1u) * nx) xb_add(&bar[XB_TOPGEN], 1u);
            else XB_SPIN(xb_ld(&bar[XB_TOPGEN]) == tg, bar);
            __builtin_amdgcn_fence(__ATOMIC_ACQUIRE, "agent");
            xb_add(&bar[XB_XGEN(b.x)], 1u);
            asm volatile("s_waitcnt vmcnt(0)" ::: "memory");
        } else {
            XB_SPIN(xb_ld(&bar[XB_XGEN(b.x)]) == gen, bar);
            __builtin_amdgcn_fence(__ATOMIC_ACQUIRE, "agent");
            asm volatile("s_waitcnt vmcnt(0)" ::: "memory");
        }
    }
    __syncthreads();
}
struct Frame {
    LAS unsigned char* lds; volatile LAS unsigned* MISC; gu32* ctl;
    int tid, lane, wave, vcu, G;
    float* out; unsigned char* ws;
};
__device__ __forceinline__ float wave_sum(float v) {
#pragma unroll
    for (int o = 1; o < 64; o <<= 1) v += __shfl_xor(v, o);
    return v;
}
template <int MODE> __device__ __forceinline__ int rowmap(int n) {
    if (MODE == 1) { if (n >= 2048) return n; const int j = n & 127, hb = n & ~127; return hb + (j < 64 ? 8 * (j >> 2) + (j & 3) : 8 * ((j - 64) >> 2) + 4 + (j & 3)); }
    if (MODE == 2) { return n < DFF ? (n >> 7) * 256 + (n & 127) : ((n - DFF) >> 7) * 256 + 128 + ((n - DFF) & 127); }
    return n;
}
template <int MODE> __device__ __forceinline__ void p0_transpose_item(const float* W, int K, int N, bf16* WT, const float* g, LAS unsigned* T, int item, int lane) {
    const int nblk = N / 64, kb = item / nblk, nb = item % nblk, k0 = 64 * kb, n0 = 64 * nb;
    const int l15 = lane & 15, lg = lane >> 4;
    f32x4 v[16];
#pragma unroll
    for (int i = 0; i < 16; ++i) { const int row = 8 * (i >> 1) + 2 * lg + (i & 1); v[i] = *(const f32x4*)(W + (size_t)(k0 + row) * N + n0 + 4 * l15); }
    if (g) {
#pragma unroll
        for (int i = 0; i < 16; ++i) { const int row = 8 * (i >> 1) + 2 * lg + (i & 1); v[i] = v[i] * g[k0 + row]; } }
#pragma unroll
    for (int p = 0; p < 8; ++p)
#pragma unroll
        for (int j = 0; j < 4; ++j) T[(4 * l15 + j) * 33 + 4 * p + lg] = pk2(v[2 * p][j], v[2 * p + 1][j]);
    LDS_WAIT(); asm volatile("" ::: "memory");
    const int c = lane & 7;
#pragma unroll
    for (int i = 0; i < 8; ++i) { const int n = (lane >> 3) + 8 * i; const LAS unsigned* s = T + n * 33 + 4 * c;
        v4u o; o.x = s[0]; o.y = s[1]; o.z = s[2]; o.w = s[3];
        *(GAS v4u*)(WT + (size_t)rowmap<MODE>(n0 + n) * K + k0 + 8 * c) = o; }
    LDS_WAIT(); asm volatile("" ::: "memory");
}
struct Args { const float* in[15]; float* out; unsigned char* ws; int ph_lo, ph_hi, use_bar, pad; };
__device__ __forceinline__ void p0_prologue(Frame& F, const Args& A) {
    LAS unsigned* scr = (LAS unsigned*)(F.lds + F.wave * 16384);
    const int gw = F.vcu * NWAVES + F.wave, NGW = F.G * NWAVES;
    unsigned char* ws = F.ws;
    constexpr int I_IN = 32 * (NIN / 64), I_RO = 32 * 32, I_HO = 16 * 32, I_OUT = 32 * 32, I_FI = 32 * (2 * DFF / 64), I_FO = (DFF / 64) * 32;
    constexpr int NITEMS = I_IN + I_RO + I_HO + I_OUT + I_FI + I_FO;
    for (int it = gw; it < NITEMS; it += NGW) {
        int r = it;
        if (r < I_IN) { p0_transpose_item<0>(A.in[4], 2048, NIN, (bf16*)(ws + WS_WIN), A.in[8], scr, r, F.lane); continue; } r -= I_IN;
        if (r < I_RO) { p0_transpose_item<0>(A.in[5], 2048, 2048, (bf16*)(ws + WS_WRO), nullptr, scr, r, F.lane); continue; } r -= I_RO;
        if (r < I_HO) { p0_transpose_item<0>(A.in[6], 1024, 2048, (bf16*)(ws + WS_WHO), nullptr, scr, r, F.lane); continue; } r -= I_HO;
        if (r < I_OUT) { p0_transpose_item<0>(A.in[7], 2048, 2048, (bf16*)(ws + WS_WOUT), nullptr, scr, r, F.lane); continue; } r -= I_OUT;
        if (r < I_FI) { p0_transpose_item<2>(A.in[12], 2048, 2 * DFF, (bf16*)(ws + WS_WFI), A.in[9], scr, r, F.lane); continue; } r -= I_FI;
        p0_transpose_item<0>(A.in[13], DFF, 2048, (bf16*)(ws + WS_WFO), nullptr, scr, r, F.lane);
    }
    bf16* XB = (bf16*)(ws + WS_XB);
    for (int m = gw; m < MPAD; m += NGW) {
        GAS unsigned long long* o8 = (GAS unsigned long long*)(XB + (size_t)m * 2048) + F.lane;
        if (m < MROWS) {
            const float* xrow = m < 8192 ? A.in[0] + (size_t)m * 2048 : A.in[1] + (size_t)(m - 8192) * 2048;
            const GAS f32x4* xr = (const GAS f32x4*)xrow + F.lane;
            f32x4 v[8]; float s = 0.f;
#pragma unroll
            for (int j = 0; j < 8; ++j) { v[j] = xr[64 * j]; s += (v[j].x * v[j].x + v[j].y * v[j].y) + (v[j].z * v[j].z + v[j].w * v[j].w); }
            const float rr = 1.0f / sqrtf(wave_sum(s) * (1.0f / 2048.0f) + EPS);
#pragma unroll
            for (int j = 0; j < 8; ++j) o8[64 * j] = (unsigned long long)pk2(v[j].x * rr, v[j].y * rr) | ((unsigned long long)pk2(v[j].z * rr, v[j].w * rr) << 32);
        } else {
#pragma unroll
            for (int j = 0; j < 8; ++j) o8[64 * j] = 0ull;
        }
    }
    { float* COS = (float*)(ws + WS_COS); float* SIN = (float*)(ws + WS_SIN);
      for (int i = (F.vcu * NWAVES + F.wave) * 64 + F.lane; i < 2049 * 64; i += F.G * NWAVES * 64) { const int p = i >> 6, j = i & 63; const int pos = p < 2048 ? p : 16384;
          const float inv = powf(10000.0f, -(float)j / 64.0f); const float ang = (float)pos * inv; float sn, cs; sincosf(ang, &sn, &cs); COS[i] = cs; SIN[i] = sn; } }
    { float* LB = (float*)(ws + WS_LB); const int i = (F.vcu * NWAVES + F.wave) * 64 + F.lane; if (i < 1024) { const float l0 = A.in[11][i], l1 = A.in[11][1024 + i]; LB[i] = 1.0f / (1.0f + expf(l1 - l0)); } }
}
typedef short bf16x4v __attribute__((ext_vector_type(4)));
#define MFMA16(a, b, c) __builtin_amdgcn_mfma_f32_16x16x32_bf16((a), (b), (c), 0, 0, 0)
constexpr int TP = 136;
constexpr size_t OUT_YS = 8192ull * 2048, OUT_SRP = 8320ull * 2048, OUT_SHP = OUT_SRP + 4ull * 8 * 128 * 256, OUT_SRS = OUT_SHP + 4ull * 8 * 128 * 128, OUT_SHS = OUT_SRS + 128ull * 8 * 128 * 256;
__device__ __forceinline__ int tsw(int r, int m) { return r * TP + ((r >> 3) << 3) + m; }
__device__ __forceinline__ int tsw64(int r, int m) { return r * 72 + ((r >> 3) << 3) + m; }
constexpr int TSZ128 = 128 * TP + 128, TSZ64R = 64 * TP + 64, TSZ32R = 32 * TP + 32, TSZ256 = 256 * TP + 256, TSZ64T = 128 * 72 + 128;
__device__ __forceinline__ float lg2gamma(int h) { return log2f(1.0f - exp2f(-5.0f - (float)h)); }
__device__ __forceinline__ float bfe(const v4u& w, int j) { const unsigned x = w[j >> 1]; return __uint_as_float((j & 1) ? (x & 0xffff0000u) : (x << 16)); }
__device__ __forceinline__ bf16x8 pack_f8(const float* v) { v4u w; w.x = pk2(v[0], v[1]); w.y = pk2(v[2], v[3]); w.z = pk2(v[4], v[5]); w.w = pk2(v[6], v[7]); return __builtin_bit_cast(bf16x8, w); }

__device__ __forceinline__ void p2_ret_unit(Frame& F, int u) {
    unsigned char* ws = F.ws;
    const int es = u & 1, h = (u >> 1) & 7, b = u >> 4;
    const int w = F.wave, l15 = F.lane & 15, g = F.lane >> 4;
    LAS bf16* KT = (LAS bf16*)F.lds; LAS bf16* VT = KT + TSZ128;
    const bf16* Kg = (const bf16*)(ws + WS_K); const bf16* Vg = (const bf16*)(ws + WS_V);
    const float* COS = (const float*)(ws + WS_COS); const float* SIN = (const float*)(ws + WS_SIN);
    const float lg = lg2gamma(h), cd = exp2f(128.0f * lg);
    const int dc = F.tid & 7, m0 = F.tid >> 3;
    const int vc = F.tid & 15, vm0 = F.tid >> 4;
    v4u ka[2], kb[2], va[4]; f32x4 cc[2][2], sn[2][2];
#define P2R_LOAD(c) do { _Pragma("unroll") for (int _i = 0; _i < 2; ++_i) { const int _m = m0 + 64 * _i, _r = b * 2048 + (c) * 128 + _m, _pos = (c) * 128 + _m, _d0 = 8 * dc; \
        const bf16* _kp = Kg + (size_t)_r * 1024 + h * 128 + _d0; ka[_i] = *(const v4u*)_kp; kb[_i] = *(const v4u*)(_kp + 64); \
        cc[_i][0] = *(const f32x4*)(COS + _pos * 64 + _d0); cc[_i][1] = *(const f32x4*)(COS + _pos * 64 + _d0 + 4); sn[_i][0] = *(const f32x4*)(SIN + _pos * 64 + _d0); sn[_i][1] = *(const f32x4*)(SIN + _pos * 64 + _d0 + 4); } \
        _Pragma("unroll") for (int _i = 0; _i < 4; ++_i) va[_i] = *(const v4u*)(Vg + (size_t)(b * 2048 + (c) * 128 + vm0 + 32 * _i) * 2048 + h * 256 + 128 * es + 8 * vc); } while (0)
    f32x4 S[8];
#pragma unroll
    for (int j = 0; j < 8; ++j) S[j] = (f32x4){0.f, 0.f, 0.f, 0.f};
    const float dec2[2] = {exp2f((float)(127 - m0) * lg), exp2f((float)(63 - m0) * lg)};
    P2R_LOAD(0);
    for (int c = 0; c < 16; ++c) {
        __syncthreads();
#pragma unroll
        for (int i = 0; i < 2; ++i) { const int m = m0 + 64 * i; const float dec = dec2[i];
            LAS bf16* k1 = KT + tsw(8 * dc, m); LAS bf16* k2 = KT + tsw(64 + 8 * dc, m);
#pragma unroll
            for (int j = 0; j < 8; ++j) { const float x1 = bfe(ka[i], j), x2 = bfe(kb[i], j), cj = cc[i][j >> 2][j & 3], sj = sn[i][j >> 2][j & 3];
                k1[j * TP] = (bf16)f2bf((x1 * cj - x2 * sj) * dec); k2[j * TP] = (bf16)f2bf((x2 * cj + x1 * sj) * dec); } }
#pragma unroll
        for (int i = 0; i < 4; ++i) { LAS bf16* vt = VT + tsw(8 * vc, vm0 + 32 * i);
#pragma unroll
            for (int j = 0; j < 8; ++j) vt[j * TP] = (bf16)((va[i][j >> 1] >> (16 * (j & 1))) & 0xffffu); }
        if (c + 1 < 16) P2R_LOAD(c + 1);
        __syncthreads();
        f32x4 kv[8];
#pragma unroll
        for (int j = 0; j < 8; ++j) kv[j] = (f32x4){0.f, 0.f, 0.f, 0.f};
#pragma unroll
        for (int ks = 0; ks < 4; ++ks) { const bf16x8 bfr = *(const LAS bf16x8*)&VT[tsw(16 * w + l15, 32 * ks + 8 * g)];
#pragma unroll
            for (int j = 0; j < 8; ++j) { const bf16x8 af = *(const LAS bf16x8*)&KT[tsw(16 * j + l15, 32 * ks + 8 * g)]; kv[j] = MFMA16(af, bfr, kv[j]); } }
        bf16* st = (bf16*)(ws + WS_SRT) + ((size_t)((b * 8 + h) * 16 + c) * 256 + 128 * es + 16 * w + l15) * 128 + 4 * g;
#pragma unroll
        for (int j = 0; j < 8; ++j) { v2u p; p.x = pk2(S[j][0], S[j][1]); p.y = pk2(S[j][2], S[j][3]); *(v2u*)(st + 16 * j) = p; S[j] = S[j] * cd + kv[j]; }
    }
#undef P2R_LOAD
    float* fo = F.out + OUT_SRP + ((size_t)(b * 8 + h) * 128 + 4 * g) * 256 + 128 * es + 16 * w + l15;
#pragma unroll
    for (int j = 0; j < 8; ++j)
#pragma unroll
        for (int reg = 0; reg < 4; ++reg) fo[(size_t)(16 * j + reg) * 256] = S[j][reg];
}
__device__ __forceinline__ void p2_hg_unit(Frame& F, int u) {
    unsigned char* ws = F.ws;
    const int es = u & 1, h = (u >> 1) & 7, b = u >> 4;
    const int w = F.wave, l15 = F.lane & 15, g = F.lane >> 4, et = w & 3, dh = w >> 2;
    LAS bf16* KT = (LAS bf16*)F.lds; LAS bf16* VT = KT + TSZ128; LAS float* LQ = (LAS float*)(VT + TSZ64R); LAS float* BT = LQ + 4 * 128;
    const float* Z = (const float*)(ws + WS_LOGF); const bf16* HI = (const bf16*)(ws + WS_HI);
    const int d = F.tid & 127, q = F.tid >> 7; const float oml = 1.0f - ((const float*)(ws + WS_LB))[h * 128 + d];
    const int vc = F.tid & 7, vm0 = F.tid >> 3;
    float z[32]; v4u va[2];
#define P2H_LOAD(sc) do { const int _r0 = b * 2048 + (sc) * 128; _Pragma("unroll") for (int _i = 0; _i < 32; ++_i) z[_i] = Z[(size_t)(_r0 + 32 * q + _i) * 1024 + h * 128 + d]; \
        _Pragma("unroll") for (int _i = 0; _i < 2; ++_i) va[_i] = *(const v4u*)(HI + (size_t)(_r0 + vm0 + 64 * _i) * 1024 + h * 128 + 64 * es + 8 * vc); } while (0)
    f32x4 S[4];
#pragma unroll
    for (int j = 0; j < 4; ++j) S[j] = (f32x4){0.f, 0.f, 0.f, 0.f};
    P2H_LOAD(0);
    for (int sc = 0; sc < 16; ++sc) {
        float lf[32], kin[32]; float L = 0.f;
#pragma unroll
        for (int i = 0; i < 32; ++i) { kin[i] = oml * __builtin_amdgcn_rcpf(1.0f + __expf(z[i])); lf[i] = __logf(1.0f - kin[i]); L += lf[i]; }
        __syncthreads();
        LQ[q * 128 + d] = L;
#pragma unroll
        for (int i = 0; i < 2; ++i) { LAS bf16* vt = VT + tsw(8 * vc, vm0 + 64 * i);
#pragma unroll
            for (int j = 0; j < 8; ++j) vt[j * TP] = (bf16)((va[i][j >> 1] >> (16 * (j & 1))) & 0xffffu); }
        if (sc + 1 < 16) P2H_LOAD(sc + 1);
        __syncthreads();
        float run = 0.f;
#pragma unroll
        for (int q2 = 1; q2 < 4; ++q2) if (q2 > q) run += LQ[q2 * 128 + d];
#pragma unroll
        for (int blk = 3; blk >= 0; --blk) { float v[8];
#pragma unroll
            for (int jj = 7; jj >= 0; --jj) { const int i = 8 * blk + jj; v[jj] = kin[i] * __expf(run); run += lf[i]; }
            *(LAS bf16x8*)&KT[tsw(d, 32 * q + 8 * blk)] = pack_f8(v); }
        if (q == 0) BT[d] = run;
        __syncthreads();
        f32x4 hs[4];
#pragma unroll
        for (int j = 0; j < 4; ++j) hs[j] = (f32x4){0.f, 0.f, 0.f, 0.f};
#pragma unroll
        for (int ks = 0; ks < 4; ++ks) { const bf16x8 bfr = *(const LAS bf16x8*)&VT[tsw(16 * et + l15, 32 * ks + 8 * g)];
#pragma unroll
            for (int j = 0; j < 4; ++j) { const bf16x8 af = *(const LAS bf16x8*)&KT[tsw(16 * (4 * dh + j) + l15, 32 * ks + 8 * g)]; hs[j] = MFMA16(af, bfr, hs[j]); } }
        bf16* st = (bf16*)(ws + WS_SHT) + ((size_t)((b * 8 + h) * 16 + sc) * 128 + 64 * es + 16 * et + l15) * 128 + 64 * dh + 4 * g;
#pragma unroll
        for (int j = 0; j < 4; ++j) { v2u p; p.x = pk2(S[j][0], S[j][1]); p.y = pk2(S[j][2], S[j][3]); *(v2u*)(st + 16 * j) = p;
            const f32x4 bt = *(const LAS f32x4*)&BT[16 * (4 * dh + j) + 4 * g];
#pragma unroll
            for (int reg = 0; reg < 4; ++reg) S[j][reg] = S[j][reg] * __expf(bt[reg]) + hs[j][reg]; }
    }
#undef P2H_LOAD
    float* fo = F.out + OUT_SHP + ((size_t)(b * 8 + h) * 128 + 64 * dh + 4 * g) * 128 + 64 * es + 16 * et + l15;
#pragma unroll
    for (int j = 0; j < 4; ++j)
#pragma unroll
        for (int reg = 0; reg < 4; ++reg) fo[(size_t)(16 * j + reg) * 128] = S[j][reg];
}
__device__ __forceinline__ void p2_sret_all(Frame& F, const Args& A, unsigned* ctr) {
    unsigned char* ws = F.ws;
    LAS float* qs = (LAS float*)F.lds; LAS float* ks = qs + 128; LAS float* vs = ks + 128; LAS float* ored = vs + 256;
    const bf16* Q = (const bf16*)(ws + WS_Q); const bf16* K = (const bf16*)(ws + WS_K); const bf16* V = (const bf16*)(ws + WS_V);
    const int e4 = F.tid & 63, dq = F.tid >> 6;
    __syncthreads();
    if (F.tid == 0) F.MISC[16] = atomicAdd(ctr, 1u);
    __syncthreads();
    int it = (int)F.MISC[16]; if (it >= 1024) return;
    f32x4 s[16];
    { const float* Sin = A.in[2] + (size_t)it * 128 * 256;
#pragma unroll
      for (int i = 0; i < 16; ++i) s[i] = *(const f32x4*)(Sin + (size_t)(16 * dq + i) * 256 + 4 * e4); }
    for (;;) {
        const int h = it & 7, b = it >> 3, r = 8192 + b;
        __syncthreads();
        if (F.tid == 0) F.MISC[16] = atomicAdd(ctr, 1u);
        if (F.tid < 64) { const int d = F.tid; const float cs = ((const float*)(ws + WS_COS))[2048 * 64 + d], sn = ((const float*)(ws + WS_SIN))[2048 * 64 + d];
            const float q1 = bf2f(Q[(size_t)r * 1024 + h * 128 + d]), q2 = bf2f(Q[(size_t)r * 1024 + h * 128 + 64 + d]), k1 = bf2f(K[(size_t)r * 1024 + h * 128 + d]), k2 = bf2f(K[(size_t)r * 1024 + h * 128 + 64 + d]);
            qs[d] = q1 * cs - q2 * sn; qs[d + 64] = q2 * cs + q1 * sn; ks[d] = k1 * cs - k2 * sn; ks[d + 64] = k2 * cs + k1 * sn; }
        else if (F.tid >= 256) { const int e = F.tid - 256; vs[e] = bf2f(V[(size_t)r * 2048 + h * 256 + e]); }
        __syncthreads();
        const int nx = (int)F.MISC[16];
        const float gam = 1.0f - exp2f(-5.0f - (float)h);
        float* Sout = F.out + OUT_SRS + (size_t)it * 128 * 256;
        const f32x4 v4 = *(const LAS f32x4*)&vs[4 * e4]; f32x4 o = (f32x4){0.f, 0.f, 0.f, 0.f};
#pragma unroll
        for (int i = 0; i < 16; ++i) { const int d = 16 * dq + i; s[i] = s[i] * gam + v4 * ks[d]; *(f32x4*)(Sout + (size_t)d * 256 + 4 * e4) = s[i]; o += s[i] * qs[d]; }
        *(LAS f32x4*)&ored[dq * 256 + 4 * e4] = o;
        if (nx < 1024) { const float* Sin = A.in[2] + (size_t)nx * 128 * 256;
#pragma unroll
            for (int i = 0; i < 16; ++i) s[i] = *(const f32x4*)(Sin + (size_t)(16 * dq + i) * 256 + 4 * e4); }
        __syncthreads();
        if (F.wave == 0) { float oo[4]; float ss = 0.f;
#pragma unroll
            for (int k = 0; k < 4; ++k) { const int e = F.lane + 64 * k; float t = 0.f;
#pragma unroll
                for (int j = 0; j < 8; ++j) t += ored[j * 256 + e];
                oo[k] = t; ss += t * t; }
            const float rr = 1.0f / sqrtf(wave_sum(ss) * (1.0f / 256.0f) + EPS);
            const bf16* RG = (const bf16*)(ws + WS_RG); bf16* OR = (bf16*)(ws + WS_OR);
#pragma unroll
            for (int k = 0; k < 4; ++k) { const size_t ix = (size_t)r * 2048 + h * 256 + F.lane + 64 * k; OR[ix] = (bf16)f2bf(oo[k] * rr * bf2f(RG[ix])); } }
        it = nx; if (it >= 1024) break;
    }
}
__device__ __forceinline__ void p2_shg_all(Frame& F, const Args& A, unsigned* ctr) {
    unsigned char* ws = F.ws;
    LAS float* qs = (LAS float*)F.lds; LAS float* fs = qs + 128; LAS float* kn = fs + 128; LAS float* vs = kn + 128; LAS float* ored = vs + 128;
    const int e4 = F.tid & 31, dq = F.tid >> 5;
    __syncthreads();
    if (F.tid == 0) F.MISC[16] = atomicAdd(ctr, 1u);
    __syncthreads();
    int it = (int)F.MISC[16]; if (it >= 1024) return;
    f32x4 s[8];
    { const float* Sin = A.in[3] + (size_t)it * 128 * 128;
#pragma unroll
      for (int i = 0; i < 8; ++i) s[i] = *(const f32x4*)(Sin + (size_t)(8 * dq + i) * 128 + 4 * e4); }
    for (;;) {
        const int h = it & 7, b = it >> 3, r = 8192 + b;
        __syncthreads();
        if (F.tid == 0) F.MISC[16] = atomicAdd(ctr, 1u);
        if (F.tid < 128) { const int d = F.tid; const size_t ix = (size_t)r * 1024 + h * 128 + d; const float z = ((const float*)(ws + WS_LOGF))[ix]; const float lb = ((const float*)(ws + WS_LB))[h * 128 + d];
            const float kin = (1.0f - lb) / (1.0f + __expf(z)); kn[d] = kin; fs[d] = 1.0f - kin; qs[d] = bf2f(((const bf16*)(ws + WS_HQ))[ix]); vs[d] = bf2f(((const bf16*)(ws + WS_HI))[ix]); }
        __syncthreads();
        const int nx = (int)F.MISC[16];
        float* Sout = F.out + OUT_SHS + (size_t)it * 128 * 128;
        const f32x4 v4 = *(const LAS f32x4*)&vs[4 * e4]; f32x4 o = (f32x4){0.f, 0.f, 0.f, 0.f};
#pragma unroll
        for (int i = 0; i < 8; ++i) { const int d = 8 * dq + i; s[i] = s[i] * fs[d] + v4 * kn[d]; *(f32x4*)(Sout + (size_t)d * 128 + 4 * e4) = s[i]; o += s[i] * qs[d]; }
        *(LAS f32x4*)&ored[dq * 128 + 4 * e4] = o;
        if (nx < 1024) { const float* Sin = A.in[3] + (size_t)nx * 128 * 128;
#pragma unroll
            for (int i = 0; i < 8; ++i) s[i] = *(const f32x4*)(Sin + (size_t)(8 * dq + i) * 128 + 4 * e4); }
        __syncthreads();
        if (F.wave == 0) { float oo[2]; float ss = 0.f;
#pragma unroll
            for (int k = 0; k < 2; ++k) { const int e = F.lane + 64 * k; float t = 0.f;
#pragma unroll
                for (int j = 0; j < 16; ++j) t += ored[j * 128 + e];
                oo[k] = t; ss += t * t; }
            const float rr = 1.0f / sqrtf(wave_sum(ss) * (1.0f / 128.0f) + EPS);
            const bf16* HG = (const bf16*)(ws + WS_HG); bf16* OH = (bf16*)(ws + WS_OH);
#pragma unroll
            for (int k = 0; k < 2; ++k) { const int e = F.lane + 64 * k; const size_t ix = (size_t)r * 1024 + h * 128 + e; OH[ix] = (bf16)f2bf(oo[k] * rr * A.in[10][e] * bf2f(HG[ix])); } }
        it = nx; if (it >= 1024) break;
    }
}
__device__ __forceinline__ void p2_phase(Frame& F, const Args& A) {
    const int half = F.G >> 1;
    if (half == 0 || (F.vcu & 1) == 0) { const int stride = half ? half : 1;
        for (int u = F.vcu >> 1; u < 64; u += stride) p2_ret_unit(F, u);
        asm volatile("" : "+v"(F.tid), "+v"(F.lane));
        for (int u = (F.vcu >> 1) - 64; u < 64; u += stride) if (u >= 0) p2_hg_unit(F, u); }
    asm volatile("" : "+v"(F.tid), "+v"(F.lane));
    p2_sret_all(F, A, (unsigned*)(F.ctl + 64));
    asm volatile("" : "+v"(F.tid), "+v"(F.lane));
    p2_shg_all(F, A, (unsigned*)(F.ctl + 128));
}
__device__ __forceinline__ void p4_ret_item(Frame& F, int item) {
    unsigned char* ws = F.ws;
    const int c = item & 15, h = (item >> 4) & 7, b = item >> 7, r0 = b * 2048 + c * 128;
    const int w = F.wave, l15 = F.lane & 15, g = F.lane >> 4;
    LAS bf16* KS = (LAS bf16*)F.lds; LAS bf16* VT = KS + 128 * TP;
    const bf16* Qg = (const bf16*)(ws + WS_Q); const bf16* Kg = (const bf16*)(ws + WS_K); const bf16* Vg = (const bf16*)(ws + WS_V);
    const float* COS = (const float*)(ws + WS_COS); const float* SIN = (const float*)(ws + WS_SIN);
    const float lg = lg2gamma(h);
    __syncthreads();
#pragma unroll
    for (int i = 0; i < 2; ++i) { const int u = F.tid + 512 * i, d0 = (u & 7) * 8, m = u >> 3;
        const bf16* kp = Kg + (size_t)(r0 + m) * 1024 + h * 128 + d0; const v4u a = *(const v4u*)kp, bb = *(const v4u*)(kp + 64);
        const int pos = c * 128 + m; const f32x4 c0 = *(const f32x4*)(COS + pos * 64 + d0), c1 = *(const f32x4*)(COS + pos * 64 + d0 + 4), s0 = *(const f32x4*)(SIN + pos * 64 + d0), s1 = *(const f32x4*)(SIN + pos * 64 + d0 + 4);
        float o1[8], o2[8];
#pragma unroll
        for (int j = 0; j < 8; ++j) { const float x1 = bfe(a, j), x2 = bfe(bb, j), cj = j < 4 ? c0[j & 3] : c1[j & 3], sj = j < 4 ? s0[j & 3] : s1[j & 3]; o1[j] = x1 * cj - x2 * sj; o2[j] = x2 * cj + x1 * sj; }
        *(LAS bf16x8*)&KS[m * TP + d0] = pack_f8(o1); *(LAS bf16x8*)&KS[m * TP + 64 + d0] = pack_f8(o2); }
#pragma unroll
    for (int i = 0; i < 8; ++i) { const int u = F.tid + 512 * i, e0 = (u & 31) * 8, m = u >> 5;
        const v4u a = *(const v4u*)(Vg + (size_t)(r0 + m) * 2048 + h * 256 + e0);
        LAS bf16* vt = VT + tsw(e0, m);
#pragma unroll
        for (int j = 0; j < 8; ++j) vt[j * TP] = (bf16)((a[j >> 1] >> (16 * (j & 1))) & 0xffffu); }
    bf16x8 qf[4];
    { const int n = 16 * w + l15, pos = c * 128 + n; const bf16* qp = Qg + (size_t)(r0 + n) * 1024 + h * 128 + 8 * g;
      const v4u a0 = *(const v4u*)qp, a1 = *(const v4u*)(qp + 32), a2 = *(const v4u*)(qp + 64), a3 = *(const v4u*)(qp + 96);
      float r0v[8], r1v[8], r2v[8], r3v[8];
#pragma unroll
      for (int hlf = 0; hlf < 2; ++hlf) { const int dd = 32 * hlf + 8 * g;
          const f32x4 c0 = *(const f32x4*)(COS + pos * 64 + dd), c1 = *(const f32x4*)(COS + pos * 64 + dd + 4), s0 = *(const f32x4*)(SIN + pos * 64 + dd), s1 = *(const f32x4*)(SIN + pos * 64 + dd + 4);
#pragma unroll
          for (int j = 0; j < 8; ++j) { const float cj = j < 4 ? c0[j & 3] : c1[j & 3], sj = j < 4 ? s0[j & 3] : s1[j & 3];
              const float x1 = hlf == 0 ? bfe(a0, j) : bfe(a1, j), x2 = hlf == 0 ? bfe(a2, j) : bfe(a3, j);
              if (hlf == 0) { r0v[j] = x1 * cj - x2 * sj; r2v[j] = x2 * cj + x1 * sj; } else { r1v[j] = x1 * cj - x2 * sj; r3v[j] = x2 * cj + x1 * sj; } } }
      qf[0] = pack_f8(r0v); qf[1] = pack_f8(r1v); qf[2] = pack_f8(r2v); qf[3] = pack_f8(r3v); }
    __syncthreads();
    f32x4 O[16];
    { const bf16* st = (const bf16*)(ws + WS_SRT) + (size_t)item * 256 * 128 + 8 * g;
#pragma unroll
      for (int et = 0; et < 16; ++et) { f32x4 t = (f32x4){0.f, 0.f, 0.f, 0.f};
#pragma unroll
          for (int ks = 0; ks < 4; ++ks) { const bf16x8 sf = *(const bf16x8*)(st + (size_t)(16 * et + l15) * 128 + 32 * ks); t = MFMA16(qf[ks], sf, t); }
          O[et] = t; }
      float rs[4];
#pragma unroll
      for (int reg = 0; reg < 4; ++reg) rs[reg] = exp2f((float)(16 * w + 4 * g + reg + 1) * lg);
#pragma unroll
      for (int et = 0; et < 16; ++et)
#pragma unroll
          for (int reg = 0; reg < 4; ++reg) O[et][reg] *= rs[reg]; }
    bf16x8 pf[4];
#pragma unroll
    for (int s = 0; s < 4; ++s) { float pv[8];
#pragma unroll
        for (int hf = 0; hf < 2; ++hf) { const int mt = 2 * s + hf; f32x4 dd = (f32x4){0.f, 0.f, 0.f, 0.f};
            if (mt <= w) {
#pragma unroll
                for (int ks = 0; ks < 4; ++ks) { const bf16x8 kf = *(const LAS bf16x8*)&KS[(16 * mt + l15) * TP + 32 * ks + 8 * g]; dd = MFMA16(kf, qf[ks], dd); }
#pragma unroll
                for (int reg = 0; reg < 4; ++reg) { const int m = 16 * mt + 4 * g + reg, n = 16 * w + l15; dd[reg] = n >= m ? dd[reg] * exp2f((float)(n - m) * lg) : 0.f; } }
#pragma unroll
            for (int reg = 0; reg < 4; ++reg) pv[4 * hf + reg] = dd[reg]; }
        pf[s] = pack_f8(pv); }
#pragma unroll
    for (int s = 0; s < 4; ++s) if (2 * s <= w) {
#pragma unroll
        for (int et = 0; et < 16; ++et) { const bf16x4v lo = *(const LAS bf16x4v*)&VT[tsw(16 * et + l15, 32 * s + 4 * g)], hi = *(const LAS bf16x4v*)&VT[tsw(16 * et + l15, 32 * s + 16 + 4 * g)];
            const bf16x8 vf = __builtin_shufflevector(lo, hi, 0, 1, 2, 3, 4, 5, 6, 7); O[et] = MFMA16(pf[s], vf, O[et]); } }
    float ss[4] = {0.f, 0.f, 0.f, 0.f};
#pragma unroll
    for (int et = 0; et < 16; ++et)
#pragma unroll
        for (int reg = 0; reg < 4; ++reg) ss[reg] += O[et][reg] * O[et][reg];
#pragma unroll
    for (int reg = 0; reg < 4; ++reg) { float v = ss[reg]; v += __shfl_xor(v, 1); v += __shfl_xor(v, 2); v += __shfl_xor(v, 4); v += __shfl_xor(v, 8); ss[reg] = 1.0f / sqrtf(v * (1.0f / 256.0f) + EPS); }
    const bf16* RG = (const bf16*)(ws + WS_RG); bf16* OR = (bf16*)(ws + WS_OR);
#pragma unroll
    for (int reg = 0; reg < 4; ++reg) { const size_t rb = (size_t)(r0 + 16 * w + 4 * g + reg) * 2048 + h * 256 + l15;
#pragma unroll
        for (int et = 0; et < 16; ++et) OR[rb + 16 * et] = (bf16)f2bf(O[et][reg] * ss[reg] * bf2f(RG[rb + 16 * et])); }
}
__device__ __forceinline__ void p4_hg_item(Frame& F, const Args& A, int item) {
    unsigned char* ws = F.ws;
    const int sc = item & 15, h = (item >> 4) & 7, b = item >> 7, r0 = b * 2048 + sc * 128;
    const int w = F.wave, l15 = F.lane & 15, g = F.lane >> 4;
    LAS bf16* QP = (LAS bf16*)F.lds;
    LAS bf16* KP = QP + 64 * TP;
    LAS bf16* KU = KP + 64 * TP;
    LAS bf16* VT = KU + 128 * 72;
    LAS float* E15 = (LAS float*)(VT + TSZ64T);
    LAS float* OB = E15 + 4 * 128;
    const float* Z = (const float*)(ws + WS_LOGF); const bf16* HQ = (const bf16*)(ws + WS_HQ); const bf16* HI = (const bf16*)(ws + WS_HI); const float* LB = (const float*)(ws + WS_LB);
    f32x4 S[8];
    { const bf16* st = (const bf16*)(ws + WS_SHT) + (size_t)item * 128 * 128 + (size_t)(16 * w + l15) * 128 + 4 * g;
#pragma unroll
      for (int dt = 0; dt < 8; ++dt) { const v2u p = *(const v2u*)(st + 16 * dt); S[dt][0] = __uint_as_float(p.x << 16); S[dt][1] = __uint_as_float(p.x & 0xffff0000u); S[dt][2] = __uint_as_float(p.y << 16); S[dt][3] = __uint_as_float(p.y & 0xffff0000u); } }
    for (int hf = 0; hf < 2; ++hf) {
        const int rh = r0 + 64 * hf;
        __syncthreads();
        { const int d = F.tid & 127, sq = F.tid >> 7; const float oml = 1.0f - LB[h * 128 + d];
          float kin[16], bcum[16]; float bb = 0.f;
#pragma unroll
          for (int t = 0; t < 16; ++t) { const size_t ix = (size_t)(rh + 16 * sq + t) * 1024 + h * 128 + d; const float z = Z[ix]; const float q = bf2f(HQ[ix]);
              kin[t] = oml * __builtin_amdgcn_rcpf(1.0f + __expf(z)); bb += __logf(1.0f - kin[t]); bcum[t] = bb;
              QP[(16 * sq + t) * TP + d] = (bf16)f2bf(q * __expf(bb)); KP[(16 * sq + t) * TP + d] = (bf16)f2bf(kin[t] * __expf(fminf(-bb, 80.0f))); }
          E15[sq * 128 + d] = __expf(bb);
          float v[8];
#pragma unroll
          for (int t = 0; t < 8; ++t) v[t] = kin[t] * __expf(bb - bcum[t]);
          *(LAS bf16x8*)&KU[d * 72 + 16 * sq] = pack_f8(v);
#pragma unroll
          for (int t = 0; t < 8; ++t) v[t] = kin[8 + t] * __expf(bb - bcum[8 + t]);
          *(LAS bf16x8*)&KU[d * 72 + 16 * sq + 8] = pack_f8(v); }
#pragma unroll
        for (int i = 0; i < 2; ++i) { const int u = F.tid + 512 * i, e0 = (u & 15) * 8, m = u >> 4;
            const v4u a = *(const v4u*)(HI + (size_t)(rh + m) * 1024 + h * 128 + e0);
            LAS bf16* vt = VT + tsw64(e0, m);
#pragma unroll
            for (int j = 0; j < 8; ++j) vt[j * 72] = (bf16)((a[j >> 1] >> (16 * (j & 1))) & 0xffffu); }
        __syncthreads();
        const bf16x8 zero8 = (bf16x8){0, 0, 0, 0, 0, 0, 0, 0};
#pragma unroll
        for (int sq = 0; sq < 4; ++sq) {
            f32x4 at = (f32x4){0.f, 0.f, 0.f, 0.f};
#pragma unroll
            for (int ks = 0; ks < 4; ++ks) { const bf16x8 kf = *(const LAS bf16x8*)&KP[(16 * sq + l15) * TP + 32 * ks + 8 * g], qf = *(const LAS bf16x8*)&QP[(16 * sq + l15) * TP + 32 * ks + 8 * g]; at = MFMA16(kf, qf, at); }
            float pv[8];
#pragma unroll
            for (int reg = 0; reg < 4; ++reg) { pv[reg] = (4 * g + reg) <= l15 ? at[reg] : 0.f; pv[4 + reg] = 0.f; }
            const bf16x8 pfr = pack_f8(pv);
            f32x4 o;
            { const bf16x4v lo = *(const LAS bf16x4v*)&VT[tsw64(16 * w + l15, 16 * sq + 4 * g)]; const bf16x8 vf = __builtin_shufflevector(lo, (bf16x4v){0, 0, 0, 0}, 0, 1, 2, 3, 4, 5, 6, 7);
              const f32x4 z4 = {0.f, 0.f, 0.f, 0.f}; o = MFMA16(pfr, vf, z4); }
#pragma unroll
            for (int ks = 0; ks < 4; ++ks) { float sv[8];
#pragma unroll
                for (int jj = 0; jj < 8; ++jj) sv[jj] = S[2 * ks + (jj >> 2)][jj & 3];
                const bf16x8 sf = pack_f8(sv);
                const LAS bf16* qp = &QP[(16 * sq + l15) * TP + 32 * ks + 4 * g]; const bf16x4v lo = *(const LAS bf16x4v*)qp, hi = *(const LAS bf16x4v*)(qp + 16);
                const bf16x8 qf = __builtin_shufflevector(lo, hi, 0, 1, 2, 3, 4, 5, 6, 7); o = MFMA16(qf, sf, o); }
#pragma unroll
            for (int reg = 0; reg < 4; ++reg) OB[(16 * sq + 4 * g + reg) * 132 + 16 * w + l15] = o[reg];
            const bf16x8 vu = g < 2 ? *(const LAS bf16x8*)&VT[tsw64(16 * w + l15, 16 * sq + 8 * g)] : zero8;
#pragma unroll
            for (int dt = 0; dt < 8; ++dt) { const f32x4 ed = *(const LAS f32x4*)&E15[sq * 128 + 16 * dt + 4 * g];
                const bf16x8 kf = g < 2 ? *(const LAS bf16x8*)&KU[(16 * dt + l15) * 72 + 16 * sq + 8 * g] : zero8;
                S[dt] = MFMA16(kf, vu, S[dt] * ed); }
        }
        __syncthreads();
        { const bf16* HG = (const bf16*)(ws + WS_HG); bf16* OH = (bf16*)(ws + WS_OH);
#pragma unroll
          for (int i = 0; i < 8; ++i) { const int t = 8 * w + i; const float v0 = OB[t * 132 + F.lane], v1 = OB[t * 132 + 64 + F.lane];
              const float rr = 1.0f / sqrtf(wave_sum(v0 * v0 + v1 * v1) * (1.0f / 128.0f) + EPS); const size_t ix = (size_t)(rh + t) * 1024 + h * 128 + F.lane;
              OH[ix] = (bf16)f2bf(v0 * rr * A.in[10][F.lane] * bf2f(HG[ix])); OH[ix + 64] = (bf16)f2bf(v1 * rr * A.in[10][64 + F.lane] * bf2f(HG[ix + 64])); } }
    }
}
__device__ __forceinline__ void p4_phase(Frame& F, const Args& A) {
    for (int it = F.vcu; it < 512; it += F.G) p4_ret_item(F, it);
    asm volatile("" : "+v"(F.tid), "+v"(F.lane));
    for (int it = F.vcu; it < 512; it += F.G) p4_hg_item(F, A, it);
}
namespace mini {
using pg8::bf16_t; using pg8::u32x2; using pg8::silu4; using pg8::sigm4; using pg8::pack4; using pg8::unpack4;
constexpr int AP = 136;
template <bool TWO> __device__ __forceinline__ void core(Frame& F, const bf16_t* A, int lda, int K, const bf16_t* bp0, const bf16_t* bp1, f32x4 (&acc0)[8], f32x4 (&acc1)[8]) {
    LAS bf16* AS = (LAS bf16*)F.lds; const int l15 = F.lane & 15, g = F.lane >> 4; const int nch = K >> 7; int cc = F.vcu % nch;
    v4u pre[4]; bf16x8 b0[4], b1[4];
    const int prow = F.tid >> 4, pc = (F.tid & 15) * 8;
#pragma unroll
    for (int i = 0; i < 4; ++i) pre[i] = *(const v4u*)(A + (size_t)(prow + 32 * i) * lda + cc * 128 + pc);
    if (bp0) {
#pragma unroll
        for (int u = 0; u < 4; ++u) { b0[u] = *(const bf16x8*)(bp0 + cc * 128 + 32 * u); if (TWO) b1[u] = *(const bf16x8*)(bp1 + cc * 128 + 32 * u); } }
    __syncthreads();
    for (int c = 0; c < nch; ++c) {
        LAS bf16* buf = AS + (c & 1) * (128 * AP);
#pragma unroll
        for (int i = 0; i < 4; ++i) *(LAS v4u*)&buf[(prow + 32 * i) * AP + pc] = pre[i];
        bf16x8 c0[4], c1[4];
#pragma unroll
        for (int u = 0; u < 4; ++u) { c0[u] = b0[u]; if (TWO) c1[u] = b1[u]; }
        cc = cc + 1 == nch ? 0 : cc + 1;
        if (c + 1 < nch) {
#pragma unroll
            for (int i = 0; i < 4; ++i) pre[i] = *(const v4u*)(A + (size_t)(prow + 32 * i) * lda + cc * 128 + pc);
            if (bp0) {
#pragma unroll
                for (int u = 0; u < 4; ++u) { b0[u] = *(const bf16x8*)(bp0 + cc * 128 + 32 * u); if (TWO) b1[u] = *(const bf16x8*)(bp1 + cc * 128 + 32 * u); } } }
        __syncthreads();
        if (bp0) {
#pragma unroll
            for (int u = 0; u < 4; ++u)
#pragma unroll
                for (int rt = 0; rt < 8; ++rt) { const bf16x8 a = *(const LAS bf16x8*)&buf[(16 * rt + l15) * AP + 32 * u + 8 * g];
                    acc0[rt] = __builtin_amdgcn_mfma_f32_16x16x32_bf16(c0[u], a, acc0[rt], 0, 0, 0); if (TWO) acc1[rt] = __builtin_amdgcn_mfma_f32_16x16x32_bf16(c1[u], a, acc1[rt], 0, 0, 0); } }
    }
}
#define MINI_ZERO(acc) _Pragma("unroll") for (int _i = 0; _i < 8; ++_i) acc[_i] = (f32x4){0.f, 0.f, 0.f, 0.f}
__device__ __forceinline__ void inproj(Frame& F, int j, int nj) {
    unsigned char* ws = F.ws; const int l15 = F.lane & 15, g = F.lane >> 4;
    if (j >= NIN / 16) return;
    const int t = j + nj * F.wave; const bool has = t < NIN / 16; const int n0 = 16 * t;
    f32x4 acc[8]; MINI_ZERO(acc);
    core<false>(F, (const bf16_t*)(ws + WS_XB) + 8192ull * 2048, 2048, 2048, has ? (const bf16_t*)(ws + WS_WIN) + (size_t)(n0 + l15) * 2048 + 8 * g : nullptr, nullptr, acc, acc);
    if (!has) return;
    const int c = n0 + 4 * g;
    if (c >= 7168 && c < 8192) {
#pragma unroll
        for (int rt = 0; rt < 8; ++rt) *(f32x4*)((float*)(ws + WS_LOGF) + (size_t)(8192 + 16 * rt + l15) * 1024 + (c - 7168)) = acc[rt];
        return; }
    size_t od; int pitch, c0, act; float sc = 1.0f;
    if (c < 1024) { od = WS_Q; pitch = 1024; c0 = 0; act = 0; } else if (c < 2048) { od = WS_K; pitch = 1024; c0 = 1024; act = 0; sc = 0.08838834764831845f; }
    else if (c < 4096) { od = WS_V; pitch = 2048; c0 = 2048; act = 0; } else if (c < 6144) { od = WS_RG; pitch = 2048; c0 = 4096; act = 1; } else if (c < 7168) { od = WS_HQ; pitch = 1024; c0 = 6144; act = 1; }
    else if (c < 9216) { od = WS_HI; pitch = 1024; c0 = 8192; act = 0; } else if (c < 10240) { od = WS_HG; pitch = 1024; c0 = 9216; act = 1; } else if (c < 12288) { od = WS_GA; pitch = 2048; c0 = 10240; act = 2; } else { od = WS_GB; pitch = 2048; c0 = 12288; act = 2; }
#pragma unroll
    for (int rt = 0; rt < 8; ++rt) { f32x4 v = acc[rt] * sc; if (act == 1) v = silu4(v); else if (act == 2) v = sigm4(v);
        *(u32x2*)((bf16_t*)(ws + od) + (size_t)(8192 + 16 * rt + l15) * pitch + (c - c0)) = pack4(v); }
}
__device__ __forceinline__ void outproj(Frame& F) {
    unsigned char* ws = F.ws; const int l15 = F.lane & 15, g = F.lane >> 4;
    if (F.vcu >= 128) return;
    const int t = F.vcu + F.G * F.wave; const bool has = t < 128; const int n0 = 16 * t;
    f32x4 ya[8], yb[8]; MINI_ZERO(ya); MINI_ZERO(yb);
    core<false>(F, (const bf16_t*)(ws + WS_OR) + 8192ull * 2048, 2048, 2048, has ? (const bf16_t*)(ws + WS_WRO) + (size_t)(n0 + l15) * 2048 + 8 * g : nullptr, nullptr, ya, ya);
    core<false>(F, (const bf16_t*)(ws + WS_OH) + 8192ull * 1024, 1024, 1024, has ? (const bf16_t*)(ws + WS_WHO) + (size_t)(n0 + l15) * 1024 + 8 * g : nullptr, nullptr, yb, yb);
    if (!has) return;
#pragma unroll
    for (int rt = 0; rt < 8; ++rt) { const size_t ix = (size_t)(8192 + 16 * rt + l15) * 2048 + n0 + 4 * g;
        const f32x4 ga = unpack4(*(const u32x2*)((const bf16_t*)(ws + WS_GA) + ix)), gb = unpack4(*(const u32x2*)((const bf16_t*)(ws + WS_GB) + ix));
        *(u32x2*)((bf16_t*)(ws + WS_MG) + ix) = pack4(ga * ya[rt] + gb * yb[rt]); }
}
__device__ __forceinline__ void resid(Frame& F, const bf16_t* Arows  , const bf16_t* Bt, int K, const float* XI  , float* XO  , bf16_t* XBo  , float* SS  ) {
    const int l15 = F.lane & 15, g = F.lane >> 4;
    if (F.vcu >= 128) return;
    const int t = F.vcu + F.G * F.wave; const bool has = t < 128; const int n0 = 16 * t;
    f32x4 acc[8]; MINI_ZERO(acc);
    core<false>(F, Arows, K, K, has ? Bt + (size_t)(n0 + l15) * K + 8 * g : nullptr, nullptr, acc, acc);
    if (!has) return;
#pragma unroll
    for (int rt = 0; rt < 8; ++rt) { const int rl = 16 * rt + l15; const size_t ix = (size_t)rl * 2048 + n0 + 4 * g;
        f32x4 v = acc[rt] + *(const f32x4*)(XI + ix); *(f32x4*)(XO + ix) = v;
        if (XBo) *(u32x2*)(XBo + ix) = pack4(v);
        float ss = (v[0] * v[0] + v[1] * v[1]) + (v[2] * v[2] + v[3] * v[3]); ss += __shfl_xor(ss, 16); ss += __shfl_xor(ss, 32);
        if (g == 0) atomicAdd(SS + rl, ss); }
}
__device__ __forceinline__ void swiglu(Frame& F, int j, int nj) {
    unsigned char* ws = F.ws; const int l15 = F.lane & 15, g = F.lane >> 4;
    if (j >= DFF / 16) return;
    const int t = j + nj * F.wave; const bool has = t < DFF / 16; const int ng = ((16 * t) >> 7) * 256 + ((16 * t) & 127);
    f32x4 ag[8], au[8]; MINI_ZERO(ag); MINI_ZERO(au);
    const bf16_t* A = (const bf16_t*)(ws + WS_X1B) + 8192ull * 2048;
    const bf16_t* bg = has ? (const bf16_t*)(ws + WS_WFI) + (size_t)(ng + l15) * 2048 + 8 * g : nullptr;
    core<true>(F, A, 2048, 2048, bg, has ? bg + 128 * 2048 : nullptr, ag, au);
    if (!has) return;
    const float* SS1 = (const float*)(F.ctl + CW_SS1);
#pragma unroll
    for (int rt = 0; rt < 8; ++rt) { const int r = 8192 + 16 * rt + l15; const float r2 = 1.0f / sqrtf(SS1[r] * (1.0f / 2048.0f) + EPS);
        *(u32x2*)((bf16_t*)(ws + WS_ACT) + (size_t)r * DFF + 16 * t + 4 * g) = pack4(silu4(ag[rt] * r2) * (au[rt] * r2)); }
}
}
__global__ void __launch_bounds__(NWAVES * 64, 2) mk_fwd(Args args) {
    extern __shared__ __attribute__((aligned(16))) unsigned char lds[];
    Frame F;
    F.lds = (LAS unsigned char*)lds; F.MISC = (volatile LAS unsigned*)(F.lds + MISC_OFF);
    F.tid = threadIdx.x; F.lane = F.tid & 63; F.wave = __builtin_amdgcn_readfirstlane(F.tid >> 6);
    F.G = gridDim.x; { const int bx = blockIdx.x; F.vcu = (F.G % 8 == 0) ? (bx % 8) * (F.G / 8) + bx / 8 : bx; }
    F.ws = args.ws; F.out = args.out; F.ctl = (gu32*)(args.ws + WS_CTL);
    for (int u = F.tid; u < (LDS_BYTES - LDSCTL_OFF) / 4; u += NWAVES * 64) ((LAS unsigned*)(F.lds + LDSCTL_OFF))[u] = 0u;
    __syncthreads();
    XcdBarrier bar; bar.bar = (unsigned*)(F.ctl + CW_BAR); bar.x = 0; bar.st = nullptr;
    if (args.use_bar) bar = xcd_barrier_post((unsigned*)(F.ctl + CW_BAR), F.MISC + 8);
    const int lo = args.ph_lo, hi = args.ph_hi;
#define IN(k) (lo <= (k) && (k) < hi)
#define SEAM(k) do { if (IN(k) && IN((k) + 1)) xcd_barrier(bar); } while (0)
#ifndef PROBE_REPEAT
#define PROBE_REPEAT -1
#endif
#define NREP(k) ((PROBE_REPEAT == (k)) ? 2 : 1)
    unsigned char* ws = args.ws;
    if (PROBE_REPEAT == 0) { p0_prologue(F, args); xcd_barrier(bar); }
    if (IN(0)) { p0_prologue(F, args); } SEAM(0);
#define P1_BODY { \
          \
        if (F.G >= 2 && (F.vcu & 1)) { mini::inproj(F, F.vcu >> 1, F.G >> 1); __syncthreads(); } else if (F.G < 2) { mini::inproj(F, F.vcu, F.G); __syncthreads(); } \
        pg8::Gemm g{(const pg8::bf16_t*)(ws + WS_XB), (const pg8::bf16_t*)(ws + WS_WIN), 8192, NIN, 2048}; pg8::StaticOrder S; S.init(8192, NIN, F.G, (int)blockIdx.x); \
        pg8::EpiInProj E{ws}; \
        pg8::gemm_phase<pg8::EpiInProj, pg8::StaticOrder, true, true>(F.lds, g, S, E); }
    if (PROBE_REPEAT == 1) { P1_BODY xcd_barrier(bar); }
    if (PROBE_REPEAT == 101) { pg8::Gemm g{(const pg8::bf16_t*)(ws + WS_XB), (const pg8::bf16_t*)(ws + WS_WIN), 8192, NIN, 2048}; pg8::StaticOrder S; S.init(8192, NIN, F.G, (int)blockIdx.x);
        pg8::EpiNull E{}; pg8::gemm_phase<pg8::EpiNull, pg8::StaticOrder, true, true>(F.lds, g, S, E); xcd_barrier(bar); }
    if (PROBE_REPEAT == 102) { pg8::Gemm g{(const pg8::bf16_t*)(ws + WS_XB), (const pg8::bf16_t*)(ws + WS_WIN), 8192, 2048, 2048}; pg8::StaticOrder S; S.init(8192, 2048, F.G, (int)blockIdx.x);
        pg8::EpiNull E{}; pg8::gemm_phase<pg8::EpiNull, pg8::StaticOrder, true, true>(F.lds, g, S, E); xcd_barrier(bar); }
    if (IN(1)) P1_BODY SEAM(1);
    if (PROBE_REPEAT == 2) { p2_phase(F, args); xcd_barrier(bar); }
    if (IN(2)) { p2_phase(F, args); } SEAM(2);
    if (PROBE_REPEAT == 3) { p4_phase(F, args); xcd_barrier(bar); }
    if (IN(3)) { p4_phase(F, args); } SEAM(3);
    if (IN(4)) {
        { pg8::Gemm g{(const pg8::bf16_t*)(ws + WS_OR), (const pg8::bf16_t*)(ws + WS_WRO), 8192, 2048, 2048}; pg8::StaticOrder S; S.init(8192, 2048, F.G, (int)blockIdx.x);
          pg8::EpiGate<0> E{(const pg8::bf16_t*)(ws + WS_GA), (float*)(ws + WS_YT), (pg8::bf16_t*)(ws + WS_MG)};
          pg8::gemm_phase<pg8::EpiGate<0>, pg8::StaticOrder, true, true>(F.lds, g, S, E); }
        { pg8::Gemm g{(const pg8::bf16_t*)(ws + WS_OH), (const pg8::bf16_t*)(ws + WS_WHO), 8192, 2048, 1024}; pg8::StaticOrder S; S.init(8192, 2048, F.G, (int)blockIdx.x);
          pg8::EpiGate<1> E{(const pg8::bf16_t*)(ws + WS_GB), (float*)(ws + WS_YT), (pg8::bf16_t*)(ws + WS_MG)};
          pg8::gemm_phase<pg8::EpiGate<1>, pg8::StaticOrder, true, true>(F.lds, g, S, E); }
        mini::outproj(F);
    } SEAM(4);
    if (IN(5)) {
        pg8::Gemm g{(const pg8::bf16_t*)(ws + WS_MG), (const pg8::bf16_t*)(ws + WS_WOUT), 8192, 2048, 2048}; pg8::StaticOrder S; S.init(8192, 2048, F.G, (int)blockIdx.x);
        pg8::EpiResid E{args.in[0], args.in[1], args.out, (pg8::bf16_t*)(ws + WS_X1B), (float*)(F.ctl + CW_SS1)};
        pg8::gemm_phase<pg8::EpiResid, pg8::StaticOrder, true, true>(F.lds, g, S, E);
        mini::resid(F, (const pg8::bf16_t*)(ws + WS_MG) + 8192ull * 2048, (const pg8::bf16_t*)(ws + WS_WOUT), 2048, args.in[1], args.out + OUT_YS, (pg8::bf16_t*)(ws + WS_X1B) + 8192ull * 2048, (float*)(F.ctl + CW_SS1) + 8192);
    } SEAM(5);
    if (IN(6)) {
        { const int nu = (8192 / 256) * (2 * DFF / 256), rem = nu % F.G;
          if (rem && (int)blockIdx.x >= rem) { mini::swiglu(F, (int)blockIdx.x - rem, F.G - rem); __syncthreads(); } else if (!rem) { mini::swiglu(F, F.vcu, F.G); __syncthreads(); } }
        pg8::Gemm g{(const pg8::bf16_t*)(ws + WS_X1B), (const pg8::bf16_t*)(ws + WS_WFI), 8192, 2 * DFF, 2048}; pg8::StaticOrder S; S.init(8192, 2 * DFF, F.G, (int)blockIdx.x);
        pg8::EpiSwiglu E{(const float*)(F.ctl + CW_SS1), (pg8::bf16_t*)(ws + WS_ACT)};
        pg8::gemm_phase<pg8::EpiSwiglu, pg8::StaticOrder, true, true>(F.lds, g, S, E);
    } SEAM(6);
    if (IN(7)) {
        pg8::Gemm g{(const pg8::bf16_t*)(ws + WS_ACT), (const pg8::bf16_t*)(ws + WS_WFO), 8192, 2048, DFF}; pg8::StaticOrder S; S.init(8192, 2048, F.G, (int)blockIdx.x);
        pg8::EpiResid E{args.out, args.out + OUT_YS, args.out, nullptr, (float*)(F.ctl + CW_SS2)};
        pg8::gemm_phase<pg8::EpiResid, pg8::StaticOrder, true, true>(F.lds, g, S, E);
        mini::resid(F, (const pg8::bf16_t*)(ws + WS_ACT) + 8192ull * DFF, (const pg8::bf16_t*)(ws + WS_WFO), DFF, args.out + OUT_YS, args.out + OUT_YS, nullptr, (float*)(F.ctl + CW_SS2) + 8192);
    } SEAM(7);
    if (IN(8)) {
        const int gw = F.vcu * NWAVES + F.wave, NGW = F.G * NWAVES; const float* SS2 = (const float*)(F.ctl + CW_SS2);
        for (int m = gw; m < MROWS; m += NGW) { f32x4* xr = (f32x4*)(args.out + (size_t)m * 2048) + F.lane; const f32x4* gn = (const f32x4*)args.in[14] + F.lane;
            const float rr = 1.0f / sqrtf(SS2[m] * (1.0f / 2048.0f) + EPS);
#pragma unroll
            for (int j = 0; j < 8; ++j) xr[64 * j] = xr[64 * j] * rr * gn[64 * j]; }
    }
#undef IN
#undef SEAM
}
extern "C" void kernel_launch(void* const* d_in, const int* in_sizes, int n_in, void* d_out, int out_size, void* d_ws, size_t ws_size, hipStream_t stream) {
    static int grid = 0;
    if (grid == 0) {
        int dev = 0, cus = 0;
        if (ws_size < WS_END || n_in != 15) { fprintf(stderr, "kernel_launch: unexpected sizes (ws %zu, n_in %d)\n", ws_size, n_in); grid = -1; return; }
        if (hipGetDevice(&dev) != hipSuccess || hipDeviceGetAttribute(&cus, hipDeviceAttributeMultiprocessorCount, dev) != hipSuccess) { grid = -1; return; }
        if (hipFuncSetAttribute((const void*)mk_fwd, hipFuncAttributeMaxDynamicSharedMemorySize, LDS_BYTES) != hipSuccess) { fprintf(stderr, "kernel_launch: hipFuncSetAttribute failed\n"); grid = -1; return; }
        int per_cu = 0; (void)hipOccupancyMaxActiveBlocksPerMultiprocessor(&per_cu, (const void*)mk_fwd, NWAVES * 64, LDS_BYTES); (void)hipGetLastError();
        if (per_cu < 1) { fprintf(stderr, "kernel_launch: occupancy query says %d blocks per CU; nothing launched\n", per_cu); grid = -1; return; }
        grid = cus;
    }
    if (grid < 0) return;
    (void)hipMemsetAsync((char*)d_ws + WS_CTL, 0, CTL_ZERO_BYTES, stream);
    Args a{};
    for (int i = 0; i < 15; ++i) a.in[i] = (const float*)d_in[i];
    a.out = (float*)d_out; a.ws = (unsigned char*)d_ws; a.use_bar = 1; a.ph_lo = 0; a.ph_hi = 9;
    hipLaunchKernelGGL(mk_fwd, dim3(grid), dim3(NWAVES * 64), LDS_BYTES, stream, a);
}
```

```cpp
#include <hip/hip_runtime.h>
#include <cstdio>
#include <cstdint>
constexpr int DMODEL = 2048, MROWS = 8320, MPAD = 8448, NIN = 14336, DFF = 5632, NWAVES = 8;
constexpr float EPS = 1e-6f;
constexpr size_t MiB = 1u << 20;
constexpr size_t WS_CTL = 0, CTL_ZERO_BYTES = 1 * MiB;
constexpr size_t WS_WRO = 1 * MiB, WS_WHO = 9 * MiB, WS_WOUT = 13 * MiB, WS_WFI = 21 * MiB, WS_WFO = 65 * MiB, WS_WIN = 87 * MiB;
constexpr size_t WS_XB = 143 * MiB;
constexpr size_t WS_Q = 176 * MiB, WS_K = WS_Q + 8448ull * 1024 * 2, WS_V = 209 * MiB, WS_RG = 242 * MiB, WS_HQ = 275 * MiB, WS_LOGF = WS_HQ + 8448ull * 1024 * 2;
constexpr size_t WS_HI = WS_LOGF + 8448ull * 1024 * 4, WS_HG = WS_HI + 8448ull * 1024 * 2, WS_GA = WS_HG + 8448ull * 1024 * 2, WS_GB = WS_GA + 8448ull * 2048 * 2;
constexpr size_t WS_KVLOC = WS_GB + 8448ull * 2048 * 2;
constexpr size_t WS_HSLOC = WS_KVLOC + 64 * MiB;
constexpr size_t WS_OH = WS_HSLOC + 32 * MiB;
constexpr size_t WS_MISC = WS_OH + 8448ull * 1024 * 2;
constexpr size_t WS_RR1 = WS_MISC, WS_COS = WS_RR1 + 64 * 1024, WS_SIN = WS_COS + 2049 * 64 * 4 + 256, WS_LB = WS_SIN + 2049 * 64 * 4 + 256, WS_BTOT = WS_LB + 4096, WS_END = WS_BTOT + 512 * 128 * 4;
constexpr size_t WS_OR = WS_XB;
constexpr size_t WS_SRT = WS_WIN, WS_SHT = WS_WIN + 32 * MiB;
constexpr size_t WS_YT = WS_KVLOC;
constexpr size_t WS_MG = WS_Q;
constexpr size_t WS_X1B = WS_V;
constexpr size_t WS_ACT = WS_RG;
static_assert(WS_GB + 8448ull * 2048 * 2 == WS_KVLOC && WS_K + 8448ull * 1024 * 2 == WS_V && WS_V + 8448ull * 2048 * 2 == WS_RG && WS_RG + 8448ull * 2048 * 2 == WS_HQ, "map");
static_assert(WS_YT + 8448ull * 2048 * 4 <= WS_OH && WS_ACT + 8448ull * 5632 * 2 <= WS_GA && WS_END <= 541 * MiB, "map2");
constexpr int CW_BAR = 4096;
constexpr int CW_SS1 = 16384, CW_SS2 = 16384 + 8448;
static_assert((CW_SS2 + 8448) * 4 <= (int)CTL_ZERO_BYTES, "ctl");
constexpr int RING_BYTES = 131072, LDSCTL_OFF = RING_BYTES, MISC_OFF = LDSCTL_OFF + 320, LDS_BYTES = 147456;

#define GAS __attribute__((address_space(1)))
#define LAS __attribute__((address_space(3)))
typedef unsigned short bf16;
typedef unsigned v4u __attribute__((ext_vector_type(4)));
typedef unsigned v2u __attribute__((ext_vector_type(2)));
typedef float f32x4 __attribute__((ext_vector_type(4)));
typedef short bf16x8 __attribute__((ext_vector_type(8)));
typedef GAS unsigned gu32;
#define RLX_AGENT __ATOMIC_RELAXED, __HIP_MEMORY_SCOPE_AGENT
#define LDS_WAIT() asm volatile("s_waitcnt lgkmcnt(0)" ::: "memory")
#define VM_WAIT() asm volatile("s_waitcnt vmcnt(0)" ::: "memory")
__device__ __forceinline__ unsigned f2bf(float f) { unsigned u = __builtin_bit_cast(unsigned, f); return (u + 0x7fffu + ((u >> 16) & 1u)) >> 16; }
__device__ __forceinline__ unsigned pk2(float lo, float hi) { return f2bf(lo) | (f2bf(hi) << 16); }
__device__ __forceinline__ float bf2f(unsigned short b) { return __uint_as_float(((unsigned)b) << 16); }
namespace pg8 {
#define PG8_LAS __attribute__((address_space(3)))
typedef unsigned short bf16_t;
typedef short bf16x8 __attribute__((ext_vector_type(8)));
typedef float f32x4 __attribute__((ext_vector_type(4)));
typedef unsigned u32x4 __attribute__((ext_vector_type(4)));
constexpr int BM = 256, BK = 64, HALF = 128, HTB = HALF * BK * 2  , STAGE_BYTES = 8 * HTB, NXCD = 8, WGM = 8;

__host__ __device__ __forceinline__ int lds_byte(int r, int c) { const int st = (r >> 4) * 2 + (c >> 5), rr = r & 15, cc = c & 31, ob = rr * 64 + cc * 2; return st * 1024 + (ob ^ (((ob >> 9) & 1) << 5)); }
__host__ __device__ __forceinline__ void stage_rc(int b, int& R, int& C) { const int st = b / 1024, sb = b % 1024, swz = sb ^ (((sb >> 9) & 1) << 5); R = (st >> 1) * 16 + swz / 64; C = (st & 1) * 32 + (swz % 64) / 2; }
__host__ __device__ __forceinline__ int perm32(int rho) { const int n = rho >> 4, i = rho & 15; return 8 * (i >> 2) + 4 * n + (i & 3); }

struct Unit { int pm, pn; };
struct Gemm { const bf16_t* A; const bf16_t* Bt; int M, N, K; };

struct StaticOrder {
    int nM, nN, nwg, G, c;
    __host__ __device__ void init(int M, int N, int G_, int c_) { nM = M / BM; nN = N / BM; nwg = nM * nN; G = G_; c = c_; }
    __host__ __device__ bool next(int i, Unit& u) const {
        const long L = (long)i * G + c; if (L >= nwg) return false;
        int wgid = (int)L; { const int q = nwg / NXCD, r = nwg % NXCD, xcd = wgid % NXCD, off = wgid / NXCD; wgid = (xcd < r ? xcd * (q + 1) : r * (q + 1) + (xcd - r) * q) + off; }
        const int nig = WGM * nN, gid = wgid / nig, fm = gid * WGM, gsz = (nM - fm) < WGM ? (nM - fm) : WGM;
        u.pm = fm + ((wgid % nig) % gsz); u.pn = (wgid % nig) / gsz; return true;
    }
    __device__ __forceinline__ void a_ready(const Unit&) const {}
    __device__ __forceinline__ void done(const Unit&) const {}
};

__device__ __forceinline__ unsigned cvt_pk_bf16(float lo, float hi) { unsigned r; asm volatile("v_cvt_pk_bf16_f32 %0, %1, %2" : "=v"(r) : "v"(lo), "v"(hi)); return r; }
typedef float f32x2 __attribute__((ext_vector_type(2)));
typedef unsigned u32x2 __attribute__((ext_vector_type(2)));
__device__ __forceinline__ float sigm(float x) { return __builtin_amdgcn_rcpf(1.0f + __expf(-x)); }
__device__ __forceinline__ f32x4 silu4(f32x4 v) { f32x4 o; o[0] = v[0] * sigm(v[0]); o[1] = v[1] * sigm(v[1]); o[2] = v[2] * sigm(v[2]); o[3] = v[3] * sigm(v[3]); return o; }
__device__ __forceinline__ f32x4 sigm4(f32x4 v) { f32x4 o; o[0] = sigm(v[0]); o[1] = sigm(v[1]); o[2] = sigm(v[2]); o[3] = sigm(v[3]); return o; }
__device__ __forceinline__ u32x4 pack8(f32x4 v0, f32x4 v1) { u32x4 w; w.x = cvt_pk_bf16(v0[0], v0[1]); w.y = cvt_pk_bf16(v0[2], v0[3]); w.z = cvt_pk_bf16(v1[0], v1[1]); w.w = cvt_pk_bf16(v1[2], v1[3]); return w; }
__device__ __forceinline__ u32x2 pack4(f32x4 v) { u32x2 w; w.x = cvt_pk_bf16(v[0], v[1]); w.y = cvt_pk_bf16(v[2], v[3]); return w; }
__device__ __forceinline__ f32x4 unpack4(u32x2 w) { f32x4 o; o[0] = __uint_as_float(w.x << 16); o[1] = __uint_as_float(w.x & 0xffff0000u); o[2] = __uint_as_float(w.y << 16); o[3] = __uint_as_float(w.y & 0xffff0000u); return o; }

struct EpiInProj {
    static constexpr bool PERM = true, AFTER_DRAIN = false;
    unsigned char* ws;
    __device__ __forceinline__ void operator()(const f32x4 (&acc)[2][2][4][2], const Unit& u, int wr, int wc, int fr, int fq) const {
        const int pn = u.pn, row0 = u.pm * BM + wr * 64 + fr;
        if (pn >= 28 && pn < 32) {
            float* Z = (float*)(ws + WS_LOGF); const int cs = (pn - 28) * 256 + wc * 32 + 8 * fq;
#pragma unroll
            for (int ai = 0; ai < 2; ++ai)
#pragma unroll
                for (int m = 0; m < 4; ++m) { const int r = row0 + ai * HALF + m * 16;
#pragma unroll
                    for (int bj = 0; bj < 2; ++bj)
#pragma unroll
                        for (int n = 0; n < 2; ++n) *(f32x4*)(Z + (size_t)r * 1024 + cs + bj * HALF + 4 * n) = acc[ai][bj][m][n]; }
        } else {
            size_t od; int pitch, p0, act; float sc = 1.0f;
            if (pn < 4) { od = WS_Q; pitch = 1024; p0 = 0; act = 0; } else if (pn < 8) { od = WS_K; pitch = 1024; p0 = 4; act = 0; sc = 0.08838834764831845f; }
            else if (pn < 16) { od = WS_V; pitch = 2048; p0 = 8; act = 0; } else if (pn < 24) { od = WS_RG; pitch = 2048; p0 = 16; act = 1; } else if (pn < 28) { od = WS_HQ; pitch = 1024; p0 = 24; act = 1; }
            else if (pn < 36) { od = WS_HI; pitch = 1024; p0 = 32; act = 0; } else if (pn < 40) { od = WS_HG; pitch = 1024; p0 = 36; act = 1; } else if (pn < 48) { od = WS_GA; pitch = 2048; p0 = 40; act = 2; } else { od = WS_GB; pitch = 2048; p0 = 48; act = 2; }
            bf16_t* dst = (bf16_t*)(ws + od);
            const int cs = (pn - p0) * 256 + wc * 32 + 8 * fq;
#pragma unroll
            for (int ai = 0; ai < 2; ++ai)
#pragma unroll
                for (int m = 0; m < 4; ++m) { const int r = row0 + ai * HALF + m * 16; bf16_t* rowp = dst + (size_t)r * pitch + cs;
#pragma unroll
                    for (int bj = 0; bj < 2; ++bj) { f32x4 v0 = acc[ai][bj][m][0] * sc, v1 = acc[ai][bj][m][1] * sc;
                        if (act == 1) { v0 = silu4(v0); v1 = silu4(v1); } else if (act == 2) { v0 = sigm4(v0); v1 = sigm4(v1); }
                        *(u32x4*)(rowp + bj * HALF) = pack8(v0, v1); } }
        }
    }
};
struct EpiNull {
    static constexpr bool PERM = true, AFTER_DRAIN = false;
    __device__ __forceinline__ void operator()(const f32x4 (&acc)[2][2][4][2], const Unit& u, int wr, int wc, int fr, int fq) const {
#pragma unroll
        for (int ai = 0; ai < 2; ++ai)
#pragma unroll
            for (int m = 0; m < 4; ++m)
#pragma unroll
                for (int bj = 0; bj < 2; ++bj) { asm volatile("" :: "v"(acc[ai][bj][m][0]), "v"(acc[ai][bj][m][1])); }
    }
};
template <int SECOND> struct EpiGate {
    static constexpr bool PERM = true, AFTER_DRAIN = false;
    const bf16_t* G; float* YT; bf16_t* MG;
    __device__ __forceinline__ void operator()(const f32x4 (&acc)[2][2][4][2], const Unit& u, int wr, int wc, int fr, int fq) const {
        const int row0 = u.pm * BM + wr * 64 + fr, col0 = u.pn * BM + wc * 32 + 8 * fq;
#pragma unroll
        for (int ai = 0; ai < 2; ++ai)
#pragma unroll
            for (int m = 0; m < 4; ++m) { const size_t off = (size_t)(row0 + ai * HALF + m * 16) * 2048 + col0;
#pragma unroll
                for (int bj = 0; bj < 2; ++bj) { const u32x4 gw = *(const u32x4*)(G + off + bj * HALF);
                    f32x4 v0 = acc[ai][bj][m][0] * unpack4((u32x2){gw.x, gw.y}), v1 = acc[ai][bj][m][1] * unpack4((u32x2){gw.z, gw.w});
                    float* yp = YT + off + bj * HALF;
                    if (SECOND) { v0 += *(const f32x4*)yp; v1 += *(const f32x4*)(yp + 4); *(u32x4*)(MG + off + bj * HALF) = pack8(v0, v1); }
                    else { *(f32x4*)yp = v0; *(f32x4*)(yp + 4) = v1; } } }
        __builtin_amdgcn_s_waitcnt(0x0F70);
    }
};
struct EpiResid {
    static constexpr bool PERM = true, AFTER_DRAIN = false;
    const float* XP; const float* XS; float* OUT; bf16_t* XB; float* SS;
    __device__ __forceinline__ void operator()(const f32x4 (&acc)[2][2][4][2], const Unit& u, int wr, int wc, int fr, int fq) const {
        const int row0 = u.pm * BM + wr * 64 + fr, col0 = u.pn * BM + wc * 32 + 8 * fq;
#pragma unroll
        for (int ai = 0; ai < 2; ++ai)
#pragma unroll
            for (int m = 0; m < 4; ++m) { const int r = row0 + ai * HALF + m * 16; const bool live = r < 8320;
                const float* xi = (r < 8192 ? XP + (size_t)r * 2048 : XS + (size_t)(r - 8192) * 2048) + col0; float ss = 0.f;
#pragma unroll
                for (int bj = 0; bj < 2; ++bj) { f32x4 v0 = acc[ai][bj][m][0], v1 = acc[ai][bj][m][1];
                    if (live) { v0 += *(const f32x4*)(xi + bj * HALF); v1 += *(const f32x4*)(xi + bj * HALF + 4);
                        float* op = OUT + (size_t)r * 2048 + col0 + bj * HALF; *(f32x4*)op = v0; *(f32x4*)(op + 4) = v1; }
                    if (XB) *(u32x4*)(XB + (size_t)r * 2048 + col0 + bj * HALF) = pack8(v0, v1);
                    ss += (v0[0] * v0[0] + v0[1] * v0[1]) + (v0[2] * v0[2] + v0[3] * v0[3]) + (v1[0] * v1[0] + v1[1] * v1[1]) + (v1[2] * v1[2] + v1[3] * v1[3]); }
                ss += __shfl_xor(ss, 16); ss += __shfl_xor(ss, 32);
                if (fq == 0) atomicAdd(SS + r, ss); }
        __builtin_amdgcn_s_waitcnt(0x0F70);
    }
};
struct EpiSwiglu {
    static constexpr bool PERM = true, AFTER_DRAIN = false;
    const float* SS; bf16_t* ACT;
    __device__ __forceinline__ void operator()(const f32x4 (&acc)[2][2][4][2], const Unit& u, int wr, int wc, int fr, int fq) const {
        const int row0 = u.pm * BM + wr * 64 + fr, col0 = u.pn * HALF + wc * 32 + 8 * fq;
        float ssv[2][4];
#pragma unroll
        for (int ai = 0; ai < 2; ++ai)
#pragma unroll
            for (int m = 0; m < 4; ++m) ssv[ai][m] = SS[row0 + ai * HALF + m * 16];
        __builtin_amdgcn_s_waitcnt(0x0F70);
#pragma unroll
        for (int ai = 0; ai < 2; ++ai)
#pragma unroll
            for (int m = 0; m < 4; ++m) { const int r = row0 + ai * HALF + m * 16; const float r2 = 1.0f / sqrtf(ssv[ai][m] * (1.0f / 2048.0f) + 1e-6f);
                const f32x4 g0 = acc[ai][0][m][0] * r2, g1 = acc[ai][0][m][1] * r2, u0 = acc[ai][1][m][0] * r2, u1 = acc[ai][1][m][1] * r2;
                *(u32x4*)(ACT + (size_t)r * 5632 + col0) = pack8(silu4(g0) * u0, silu4(g1) * u1); }
    }
};
template <class Epi, class Sched, bool ALIGN_EPI = false, bool SP2 = false>
__device__ __forceinline__ void gemm_phase(PG8_LAS unsigned char* lds, const Gemm g, const Sched& S, const Epi& E) {
    int tid_ = threadIdx.x; asm volatile("" : "+v"(tid_));
    const int tid = tid_, wid = __builtin_amdgcn_readfirstlane(tid >> 6), lane = tid & 63, wr = wid >> 2, wc = wid & 3, fr = lane & 15, fq = lane >> 4;
    const int K = g.K, nt = K / BK;
    unsigned voffA[2], voffB[2];
#pragma unroll
    for (int i = 0; i < 2; ++i) { int R, C; stage_rc(tid * 16 + i * 8192, R, C); const int Rb = Epi::PERM ? ((R & ~31) + perm32(R & 31)) : R;
        voffA[i] = (unsigned)(R * K + C) * 2u; voffB[i] = (unsigned)(Rb * K + C) * 2u; }
    const size_t kstep = (size_t)(BK * 2);
    const size_t hstep = (size_t)HALF * K * 2;
    const size_t tstep = 2 * hstep;
    const unsigned ldsw = (unsigned)wid * 1024u;
    const int aoff = lds_byte(wr * 64 + fr, fq * 8), boff = lds_byte(wc * 32 + fr, fq * 8);
#define PG8_SA(b, h) (((b) * 2 + (h)) * HTB)
#define PG8_SB(b, h) ((4 + (b) * 2 + (h)) * HTB)
#define PG8_STAGE(bufoff, gbase, voff) do { _Pragma("unroll") for (int _i = 0; _i < 2; ++_i) \
        __builtin_amdgcn_global_load_lds((const unsigned*)((const char*)(gbase) + (voff)[_i]), (PG8_LAS unsigned*)(lds + (bufoff) + ldsw + _i * 8192), 16, 0, 0); } while (0)
#define PG8_LDA(dst, b, h) do { _Pragma("unroll") for (int m = 0; m < 4; ++m) _Pragma("unroll") for (int k = 0; k < 2; ++k) dst[m][k] = *(const PG8_LAS bf16x8*)(lds + PG8_SA(b, h) + aoff + m * 2048 + k * 1024); } while (0)
#define PG8_LDB(dst, b, h) do { _Pragma("unroll") for (int n = 0; n < 2; ++n) _Pragma("unroll") for (int k = 0; k < 2; ++k) dst[n][k] = *(const PG8_LAS bf16x8*)(lds + PG8_SB(b, h) + boff + n * 2048 + k * 1024); } while (0)
#define PG8_MMA(ai, bj, At, Bt) do { __builtin_amdgcn_s_setprio(1); _Pragma("unroll") for (int m = 0; m < 4; ++m) _Pragma("unroll") for (int n = 0; n < 2; ++n) _Pragma("unroll") for (int k = 0; k < 2; ++k) \
        acc[ai][bj][m][n] = __builtin_amdgcn_mfma_f32_16x16x32_bf16(Bt[n][k], At[m][k], acc[ai][bj][m][n], 0, 0, 0); __builtin_amdgcn_s_setprio(0); } while (0)
#define PG8_WAIT_V(n) asm volatile("s_waitcnt vmcnt(" #n ")" ::: "memory")
#define PG8_WAIT_L(n) asm volatile("s_waitcnt lgkmcnt(" #n ")" ::: "memory")
#define PG8_BAR __builtin_amdgcn_s_barrier()
#define PG8_SCHED __builtin_amdgcn_sched_barrier(0)
    Unit cur, nxt; int ui = 0;
    if (!S.next(0, cur)) return;
    f32x4 acc[2][2][4][2];
#pragma unroll
    for (int a = 0; a < 2; ++a)
#pragma unroll
        for (int b = 0; b < 2; ++b)
#pragma unroll
            for (int m = 0; m < 4; ++m)
#pragma unroll
                for (int n = 0; n < 2; ++n) acc[a][b][m][n] = (f32x4){0.f, 0.f, 0.f, 0.f};
    bf16x8 At[4][2], B0[2][2], B1[2][2];
    const char* cA = (const char*)g.A + (size_t)cur.pm * tstep; const char* cB = (const char*)g.Bt + (size_t)cur.pn * tstep;
    S.a_ready(cur);
    if constexpr (SP2) {
        PG8_STAGE(PG8_SB(0, 0), cB, voffB); PG8_STAGE(PG8_SB(0, 1), cB + hstep, voffB); PG8_STAGE(PG8_SA(0, 0), cA, voffA); PG8_STAGE(PG8_SA(0, 1), cA + hstep, voffA);
        if (wr == 1) PG8_BAR;
        PG8_WAIT_V(2); PG8_BAR;
        PG8_STAGE(PG8_SB(1, 0), cB + kstep, voffB); PG8_STAGE(PG8_SA(1, 0), cA + kstep, voffA); PG8_STAGE(PG8_SB(1, 1), cB + hstep + kstep, voffB);
        PG8_WAIT_V(6); PG8_BAR;
    } else {
        PG8_STAGE(PG8_SB(0, 0), cB, voffB); PG8_STAGE(PG8_SA(0, 0), cA, voffA); PG8_STAGE(PG8_SB(0, 1), cB + hstep, voffB); PG8_STAGE(PG8_SA(0, 1), cA + hstep, voffA);
        if (wr == 1) PG8_BAR;
        PG8_WAIT_V(4); PG8_BAR;
        PG8_STAGE(PG8_SB(1, 0), cB + kstep, voffB); PG8_STAGE(PG8_SA(1, 0), cA + kstep, voffA); PG8_STAGE(PG8_SB(1, 1), cB + hstep + kstep, voffB);
        PG8_WAIT_V(6); PG8_BAR;
    }
    for (;;) {
        const bool has_next = S.next(ui + 1, nxt);
        const char* nA = has_next ? (const char*)g.A + (size_t)nxt.pm * tstep : cA; const char* nB = has_next ? (const char*)g.Bt + (size_t)nxt.pn * tstep : cB;
        for (int t = 0; t < nt; t += 2) {
            const bool last = (t == nt - 2);
            const char* a1 = cA + (size_t)(t + 1) * kstep;
            const char* a2 = last ? nA : cA + (size_t)(t + 2) * kstep; const char* b2 = last ? nB : cB + (size_t)(t + 2) * kstep;
            const char* a3 = a2 + kstep; const char* b3 = b2 + kstep;
            if (last && has_next) S.a_ready(nxt);
            if constexpr (SP2) {
            PG8_LDB(B0, 0, 0); PG8_LDB(B1, 0, 1); PG8_SCHED; PG8_LDA(At, 0, 0); PG8_STAGE(PG8_SA(1, 1), a1 + hstep, voffA);
            PG8_WAIT_V(8); PG8_WAIT_L(0); PG8_BAR; PG8_MMA(0, 0, At, B0); PG8_MMA(0, 1, At, B1); PG8_BAR; PG8_SCHED;
            PG8_LDA(At, 0, 1); PG8_STAGE(PG8_SB(0, 0), b2, voffB); PG8_STAGE(PG8_SB(0, 1), b2 + hstep, voffB); PG8_STAGE(PG8_SA(0, 0), a2, voffA);
            PG8_WAIT_V(8); PG8_WAIT_L(0); PG8_BAR; PG8_MMA(1, 0, At, B0); PG8_MMA(1, 1, At, B1); PG8_BAR; PG8_SCHED;
            PG8_LDB(B0, 1, 0); PG8_LDB(B1, 1, 1); PG8_SCHED; PG8_LDA(At, 1, 0); PG8_STAGE(PG8_SA(0, 1), a2 + hstep, voffA);
            PG8_WAIT_V(8); PG8_WAIT_L(0); PG8_BAR; PG8_MMA(0, 0, At, B0); PG8_MMA(0, 1, At, B1); PG8_BAR; PG8_SCHED;
            PG8_LDA(At, 1, 1); PG8_STAGE(PG8_SB(1, 0), b3, voffB); PG8_STAGE(PG8_SB(1, 1), b3 + hstep, voffB); PG8_STAGE(PG8_SA(1, 0), a3, voffA);
            PG8_WAIT_V(8); PG8_WAIT_L(0); PG8_BAR; PG8_MMA(1, 0, At, B0); PG8_MMA(1, 1, At, B1); PG8_BAR; PG8_SCHED;
            } else {
            PG8_LDB(B0, 0, 0); PG8_SCHED; PG8_LDA(At, 0, 0); PG8_STAGE(PG8_SA(1, 1), a1 + hstep, voffA);
            PG8_WAIT_L(8); PG8_BAR; PG8_WAIT_L(0); PG8_MMA(0, 0, At, B0); PG8_BAR; PG8_SCHED;
            PG8_LDB(B1, 0, 1); PG8_STAGE(PG8_SB(0, 0), b2, voffB);
            PG8_BAR; PG8_WAIT_L(0); PG8_MMA(0, 1, At, B1); PG8_BAR;
            PG8_LDA(At, 0, 1); PG8_STAGE(PG8_SA(0, 0), a2, voffA);
            PG8_BAR; PG8_WAIT_L(0); PG8_MMA(1, 0, At, B0); PG8_BAR; PG8_SCHED;
            PG8_STAGE(PG8_SB(0, 1), b2 + hstep, voffB);
            PG8_WAIT_V(6); PG8_BAR; PG8_MMA(1, 1, At, B1); PG8_BAR;
            PG8_LDB(B0, 1, 0); PG8_SCHED; PG8_LDA(At, 1, 0); PG8_STAGE(PG8_SA(0, 1), a2 + hstep, voffA);
            PG8_WAIT_L(8); PG8_BAR; PG8_WAIT_L(0); PG8_MMA(0, 0, At, B0); PG8_BAR; PG8_SCHED;
            PG8_LDB(B1, 1, 1); PG8_STAGE(PG8_SB(1, 0), b3, voffB);
            PG8_BAR; PG8_WAIT_L(0); PG8_MMA(0, 1, At, B1); PG8_BAR;
            PG8_LDA(At, 1, 1); PG8_STAGE(PG8_SA(1, 0), a3, voffA);
            PG8_BAR; PG8_WAIT_L(0); PG8_MMA(1, 0, At, B0); PG8_BAR; PG8_SCHED;
            PG8_STAGE(PG8_SB(1, 1), b3 + hstep, voffB);
            PG8_WAIT_V(6); PG8_BAR; PG8_MMA(1, 1, At, B1); PG8_BAR;
            }
        }
        if constexpr (ALIGN_EPI) { if (wr == 0) PG8_BAR; }
        if constexpr (!Epi::AFTER_DRAIN) { E(acc, cur, wr, wc, fr, fq); S.done(cur); }
        if (!has_next) break;
#pragma unroll
        for (int a = 0; a < 2; ++a)
#pragma unroll
            for (int b = 0; b < 2; ++b)
#pragma unroll
                for (int m = 0; m < 4; ++m)
#pragma unroll
                    for (int n = 0; n < 2; ++n) acc[a][b][m][n] = (f32x4){0.f, 0.f, 0.f, 0.f};
        cur = nxt; cA = nA; cB = nB; ++ui;
        if constexpr (ALIGN_EPI) { if (wr == 1) PG8_BAR; }
    }
    PG8_WAIT_V(0);
    if constexpr (!ALIGN_EPI) { if (wr == 0) PG8_BAR; }
    PG8_BAR;
    if constexpr (Epi::AFTER_DRAIN) { E.fused(acc, cur, wr, wc, fr, fq, lds, wid, lane); S.done(cur); }
#undef PG8_SA
#undef PG8_SB
#undef PG8_STAGE
#undef PG8_LDA
#undef PG8_LDB
#undef PG8_MMA
#undef PG8_WAIT_V
#undef PG8_WAIT_L
#undef PG8_BAR
#undef PG8_SCHED
}
}
#define XB_TMO      128
#define XB_XCNT(j)  (256  + 64 * (j))
#define XB_XSUB(j)  (1280 + 64 * (j))
#define XB_XGEN(j)  (2304 + 64 * (j))
#define XB_TOP      3328
#define XB_TOPGEN   3392
#define XCD_BAR_WORDS 3456
#define XB_SPIN_CAP (1u << 18)

__device__ __forceinline__ unsigned xb_ld(unsigned* p)              { return __hip_atomic_load(p, __ATOMIC_RELAXED, __HIP_MEMORY_SCOPE_AGENT); }
__device__ __forceinline__ unsigned xb_add(unsigned* p, unsigned v) { return __hip_atomic_fetch_add(p, v, __ATOMIC_RELAXED, __HIP_MEMORY_SCOPE_AGENT); }
__device__ __forceinline__ unsigned xb_xcc_id() { return (unsigned)__builtin_amdgcn_s_getreg((3 << 11) | 20) & 0xFu; }
#define XB_SPIN(cond, bar) do { unsigned _sp = 0; while (cond) { __builtin_amdgcn_s_sleep(1); \
    if ((++_sp & 255u) == 0u) { if (xb_ld(&(bar)[XB_TMO])) break; if (_sp > XB_SPIN_CAP) { atomicAdd(&(bar)[XB_TMO], 1u); break; } } } } while (0)

struct XcdBarrier {
    unsigned* bar; unsigned x;
    volatile LAS unsigned* st;
};

__device__ __forceinline__ XcdBarrier xcd_barrier_post(unsigned* bar, volatile LAS unsigned* st) {
    XcdBarrier b; b.bar = bar; b.x = xb_xcc_id(); b.st = st;
    if (threadIdx.x == 0) (void)xb_add(&bar[XB_XCNT(b.x)], 1u);
    return b;
}
__device__ __forceinline__ void xcd_barrier_complete(unsigned* bar, unsigned x, unsigned& nloc, unsigned& nx) {
    const unsigned G = gridDim.x * gridDim.y * gridDim.z;
    unsigned sum, cnt, mine, sp = 0u;
    for (;;) {
        sum = 0u; cnt = 0u; mine = 0u;
#pragma unroll
        for (unsigned j = 0; j < 16; ++j) { const unsigned c = xb_ld(&bar[XB_XCNT(j)]); sum += c; cnt += (c > 0u) ? 1u : 0u; mine = (j == x) ? c : mine; }
        if (sum == G) break;
        __builtin_amdgcn_s_sleep(1);
        if ((++sp & 255u) == 0u) { if (xb_ld(&bar[XB_TMO])) break; if (sp > XB_SPIN_CAP) { atomicAdd(&bar[XB_TMO], 1u); break; } }
    }
    nloc = mine > 0u ? mine : 1u; nx = cnt > 0u ? cnt : 1u;
}

__device__ __forceinline__ void xcd_barrier(const XcdBarrier& b) {
    asm volatile("s_waitcnt vmcnt(0)" ::: "memory");
    __syncthreads();
    if (threadIdx.x == 0) {
        unsigned* bar = b.bar;
        __builtin_amdgcn_s_waitcnt(0);
        unsigned nloc = b.st[0], nx = b.st[1];
        if (nloc == 0u) { xcd_barrier_complete(bar, b.x, nloc, nx); b.st[0] = nloc; b.st[1] = nx; }
        const unsigned old = xb_add(&bar[XB_XSUB(b.x)], 1u);
        const unsigned gen = old / nloc;
        if (old + 1u == (gen + 1u) * nloc) {
            __builtin_amdgcn_fence(__ATOMIC_RELEASE, "agent");
            asm volatile("s_waitcnt vmcnt(0)" ::: "memory");
            const unsigned og = xb_add(&bar[XB_TOP], 1u);
            const unsigned tg = og / nx;
            if (og + 1u == (tg + 1u) * nx) xb_add(&bar[XB_TOPGEN], 1u);
            else XB_SPIN(xb_ld(&bar[XB_TOPGEN]) == tg, bar);
            __builtin_amdgcn_fence(__ATOMIC_ACQUIRE, "agent");
            xb_add(&bar[XB_XGEN(b.x)], 1u);
            asm volatile("s_waitcnt vmcnt(0)" ::: "memory");
        } else {
            XB_SPIN(xb_ld(&bar[XB_XGEN(b.x)]) == gen, bar);
            __builtin_amdgcn_fence(__ATOMIC_ACQUIRE, "agent");
            asm volatile("s_waitcnt vmcnt(0)" ::: "memory");
        }
    }
    __syncthreads();
}
struct Frame {
    LAS unsigned char* lds; volatile LAS unsigned* MISC; gu32* ctl;
    int tid, lane, wave, vcu, G;
    float* out; unsigned char* ws;
};
__device__ __forceinline__ void delay_us(int us) { const unsigned long long t0 = __builtin_amdgcn_s_memrealtime(); while (__builtin_amdgcn_s_memrealtime() - t0 < (unsigned long long)us * 100ull) __builtin_amdgcn_s_sleep(8); }
__device__ __forceinline__ float wave_sum(float v) {
#pragma unroll
    for (int o = 1; o < 64; o <<= 1) v += __shfl_xor(v, o);
    return v;
}
template <int MODE> __device__ __forceinline__ int rowmap(int n) {
    if (MODE == 1) { if (n >= 2048) return n; const int j = n & 127, hb = n & ~127; return hb + (j < 64 ? 8 * (j >> 2) + (j & 3) : 8 * ((j - 64) >> 2) + 4 + (j & 3)); }
    if (MODE == 2) { return n < DFF ? (n >> 7) * 256 + (n & 127) : ((n - DFF) >> 7) * 256 + 128 + ((n - DFF) & 127); }
    return n;
}
template <int MODE> __device__ __forceinline__ void p0_transpose_item(const float* W, int K, int N, bf16* WT, const float* g, LAS unsigned* T, int item, int lane) {
    const int nblk = N / 64, kb = item / nblk, nb = item % nblk, k0 = 64 * kb, n0 = 64 * nb;
    const int l15 = lane & 15, lg = lane >> 4;
    f32x4 v[16];
#pragma unroll
    for (int i = 0; i < 16; ++i) { const int row = 8 * (i >> 1) + 2 * lg + (i & 1); v[i] = *(const f32x4*)(W + (size_t)(k0 + row) * N + n0 + 4 * l15); }
    if (g) {
#pragma unroll
        for (int i = 0; i < 16; ++i) { const int row = 8 * (i >> 1) + 2 * lg + (i & 1); v[i] = v[i] * g[k0 + row]; } }
#pragma unroll
    for (int p = 0; p < 8; ++p)
#pragma unroll
        for (int j = 0; j < 4; ++j) T[(4 * l15 + j) * 33 + 4 * p + lg] = pk2(v[2 * p][j], v[2 * p + 1][j]);
    LDS_WAIT(); asm volatile("" ::: "memory");
    const int c = lane & 7;
#pragma unroll
    for (int i = 0; i < 8; ++i) { const int n = (lane >> 3) + 8 * i; const LAS unsigned* s = T + n * 33 + 4 * c;
        v4u o; o.x = s[0]; o.y = s[1]; o.z = s[2]; o.w = s[3];
        *(GAS v4u*)(WT + (size_t)rowmap<MODE>(n0 + n) * K + k0 + 8 * c) = o; }
    LDS_WAIT(); asm volatile("" ::: "memory");
}
struct Args { const float* in[15]; float* out; unsigned char* ws; int ph_lo, ph_hi, use_bar, pad; };
__device__ __forceinline__ void p0_prologue(Frame& F, const Args& A) {
    LAS unsigned* scr = (LAS unsigned*)(F.lds + F.wave * 16384);
    const int gw = F.vcu * NWAVES + F.wave, NGW = F.G * NWAVES;
    unsigned char* ws = F.ws;
    constexpr int I_IN = 32 * (NIN / 64), I_RO = 32 * 32, I_HO = 16 * 32, I_OUT = 32 * 32, I_FI = 32 * (2 * DFF / 64), I_FO = (DFF / 64) * 32;
    constexpr int NITEMS = I_IN + I_RO + I_HO + I_OUT + I_FI + I_FO;
    for (int it = gw; it < NITEMS; it += NGW) {
        int r = it;
        if (r < I_IN) { p0_transpose_item<0>(A.in[4], 2048, NIN, (bf16*)(ws + WS_WIN), A.in[8], scr, r, F.lane); continue; } r -= I_IN;
        if (r < I_RO) { p0_transpose_item<0>(A.in[5], 2048, 2048, (bf16*)(ws + WS_WRO), nullptr, scr, r, F.lane); continue; } r -= I_RO;
        if (r < I_HO) { p0_transpose_item<0>(A.in[6], 1024, 2048, (bf16*)(ws + WS_WHO), nullptr, scr, r, F.lane); continue; } r -= I_HO;
        if (r < I_OUT) { p0_transpose_item<0>(A.in[7], 2048, 2048, (bf16*)(ws + WS_WOUT), nullptr, scr, r, F.lane); continue; } r -= I_OUT;
        if (r < I_FI) { p0_transpose_item<2>(A.in[12], 2048, 2 * DFF, (bf16*)(ws + WS_WFI), A.in[9], scr, r, F.lane); continue; } r -= I_FI;
        p0_transpose_item<0>(A.in[13], DFF, 2048, (bf16*)(ws + WS_WFO), nullptr, scr, r, F.lane);
    }
    bf16* XB = (bf16*)(ws + WS_XB);
    for (int m = gw; m < MPAD; m += NGW) {
        GAS unsigned long long* o8 = (GAS unsigned long long*)(XB + (size_t)m * 2048) + F.lane;
        if (m < MROWS) {
            const float* xrow = m < 8192 ? A.in[0] + (size_t)m * 2048 : A.in[1] + (size_t)(m - 8192) * 2048;
            const GAS f32x4* xr = (const GAS f32x4*)xrow + F.lane;
            f32x4 v[8]; float s = 0.f;
#pragma unroll
            for (int j = 0; j < 8; ++j) { v[j] = xr[64 * j]; s += (v[j].x * v[j].x + v[j].y * v[j].y) + (v[j].z * v[j].z + v[j].w * v[j].w); }
            const float rr = 1.0f / sqrtf(wave_sum(s) * (1.0f / 2048.0f) + EPS);
#pragma unroll
            for (int j = 0; j < 8; ++j) o8[64 * j] = (unsigned long long)pk2(v[j].x * rr, v[j].y * rr) | ((unsigned long long)pk2(v[j].z * rr, v[j].w * rr) << 32);
        } else {
#pragma unroll
            for (int j = 0; j < 8; ++j) o8[64 * j] = 0ull;
        }
    }
    { float* COS = (float*)(ws + WS_COS); float* SIN = (float*)(ws + WS_SIN);
      for (int i = (F.vcu * NWAVES + F.wave) * 64 + F.lane; i < 2049 * 64; i += F.G * NWAVES * 64) { const int p = i >> 6, j = i & 63; const int pos = p < 2048 ? p : 16384;
          const float inv = powf(10000.0f, -(float)j / 64.0f); const float ang = (float)pos * inv; float sn, cs; sincosf(ang, &sn, &cs); COS[i] = cs; SIN[i] = sn; } }
    { float* LB = (float*)(ws + WS_LB); const int i = (F.vcu * NWAVES + F.wave) * 64 + F.lane; if (i < 1024) { const float l0 = A.in[11][i], l1 = A.in[11][1024 + i]; LB[i] = 1.0f / (1.0f + expf(l1 - l0)); } }
}
typedef short bf16x4v __attribute__((ext_vector_type(4)));
#define MFMA16(a, b, c) __builtin_amdgcn_mfma_f32_16x16x32_bf16((a), (b), (c), 0, 0, 0)
constexpr int TP = 136;
constexpr size_t OUT_YS = 8192ull * 2048, OUT_SRP = 8320ull * 2048, OUT_SHP = OUT_SRP + 4ull * 8 * 128 * 256, OUT_SRS = OUT_SHP + 4ull * 8 * 128 * 128, OUT_SHS = OUT_SRS + 128ull * 8 * 128 * 256;
__device__ __forceinline__ int tsw(int r, int m) { return r * TP + ((r >> 3) << 3) + m; }
__device__ __forceinline__ int tsw64(int r, int m) { return r * 72 + ((r >> 3) << 3) + m; }
constexpr int TSZ128 = 128 * TP + 128, TSZ64R = 64 * TP + 64, TSZ32R = 32 * TP + 32, TSZ256 = 256 * TP + 256, TSZ64T = 128 * 72 + 128;
__device__ __forceinline__ float lg2gamma(int h) { return log2f(1.0f - exp2f(-5.0f - (float)h)); }
__device__ __forceinline__ float bfe(const v4u& w, int j) { const unsigned x = w[j >> 1]; return __uint_as_float((j & 1) ? (x & 0xffff0000u) : (x << 16)); }
__device__ __forceinline__ bf16x8 pack_f8(const float* v) { v4u w; w.x = pk2(v[0], v[1]); w.y = pk2(v[2], v[3]); w.z = pk2(v[4], v[5]); w.w = pk2(v[6], v[7]); return __builtin_bit_cast(bf16x8, w); }

__device__ __forceinline__ void p2_ret_unit(Frame& F, int u) {
    unsigned char* ws = F.ws;
    const int es = u & 1, h = (u >> 1) & 7, b = u >> 4;
    const int w = F.wave, l15 = F.lane & 15, g = F.lane >> 4;
    LAS bf16* KT = (LAS bf16*)F.lds; LAS bf16* VT = KT + TSZ128;
    const bf16* Kg = (const bf16*)(ws + WS_K); const bf16* Vg = (const bf16*)(ws + WS_V);
    const float* COS = (const float*)(ws + WS_COS); const float* SIN = (const float*)(ws + WS_SIN);
    const float lg = lg2gamma(h), cd = exp2f(128.0f * lg);
    const int dc = F.tid & 7, m0 = F.tid >> 3;
    const int vc = F.tid & 15, vm0 = F.tid >> 4;
    v4u ka[2], kb[2], va[4]; f32x4 cc[2][2], sn[2][2];
#define P2R_LOAD(c) do { _Pragma("unroll") for (int _i = 0; _i < 2; ++_i) { const int _m = m0 + 64 * _i, _r = b * 2048 + (c) * 128 + _m, _pos = (c) * 128 + _m, _d0 = 8 * dc; \
        const bf16* _kp = Kg + (size_t)_r * 1024 + h * 128 + _d0; ka[_i] = *(const v4u*)_kp; kb[_i] = *(const v4u*)(_kp + 64); \
        cc[_i][0] = *(const f32x4*)(COS + _pos * 64 + _d0); cc[_i][1] = *(const f32x4*)(COS + _pos * 64 + _d0 + 4); sn[_i][0] = *(const f32x4*)(SIN + _pos * 64 + _d0); sn[_i][1] = *(const f32x4*)(SIN + _pos * 64 + _d0 + 4); } \
        _Pragma("unroll") for (int _i = 0; _i < 4; ++_i) va[_i] = *(const v4u*)(Vg + (size_t)(b * 2048 + (c) * 128 + vm0 + 32 * _i) * 2048 + h * 256 + 128 * es + 8 * vc); } while (0)
    f32x4 S[8];
#pragma unroll
    for (int j = 0; j < 8; ++j) S[j] = (f32x4){0.f, 0.f, 0.f, 0.f};
    const float dec2[2] = {exp2f((float)(127 - m0) * lg), exp2f((float)(63 - m0) * lg)};
    P2R_LOAD(0);
    for (int c = 0; c < 16; ++c) {
        __syncthreads();
#pragma unroll
        for (int i = 0; i < 2; ++i) { const int m = m0 + 64 * i; const float dec = dec2[i];
            LAS bf16* k1 = KT + tsw(8 * dc, m); LAS bf16* k2 = KT + tsw(64 + 8 * dc, m);
#pragma unroll
            for (int j = 0; j < 8; ++j) { const float x1 = bfe(ka[i], j), x2 = bfe(kb[i], j), cj = cc[i][j >> 2][j & 3], sj = sn[i][j >> 2][j & 3];
                k1[j * TP] = (bf16)f2bf((x1 * cj - x2 * sj) * dec); k2[j * TP] = (bf16)f2bf((x2 * cj + x1 * sj) * dec); } }
#pragma unroll
        for (int i = 0; i < 4; ++i) { LAS bf16* vt = VT + tsw(8 * vc, vm0 + 32 * i);
#pragma unroll
            for (int j = 0; j < 8; ++j) vt[j * TP] = (bf16)((va[i][j >> 1] >> (16 * (j & 1))) & 0xffffu); }
        if (c + 1 < 16) P2R_LOAD(c + 1);
        __syncthreads();
        f32x4 kv[8];
#pragma unroll
        for (int j = 0; j < 8; ++j) kv[j] = (f32x4){0.f, 0.f, 0.f, 0.f};
#pragma unroll
        for (int ks = 0; ks < 4; ++ks) { const bf16x8 bfr = *(const LAS bf16x8*)&VT[tsw(16 * w + l15, 32 * ks + 8 * g)];
#pragma unroll
            for (int j = 0; j < 8; ++j) { const bf16x8 af = *(const LAS bf16x8*)&KT[tsw(16 * j + l15, 32 * ks + 8 * g)]; kv[j] = MFMA16(af, bfr, kv[j]); } }
        bf16* st = (bf16*)(ws + WS_SRT) + ((size_t)((b * 8 + h) * 16 + c) * 256 + 128 * es + 16 * w + l15) * 128 + 4 * g;
#pragma unroll
        for (int j = 0; j < 8; ++j) { v2u p; p.x = pk2(S[j][0], S[j][1]); p.y = pk2(S[j][2], S[j][3]); *(v2u*)(st + 16 * j) = p; S[j] = S[j] * cd + kv[j]; }
    }
#undef P2R_LOAD
    float* fo = F.out + OUT_SRP + ((size_t)(b * 8 + h) * 128 + 4 * g) * 256 + 128 * es + 16 * w + l15;
#pragma unroll
    for (int j = 0; j < 8; ++j)
#pragma unroll
        for (int reg = 0; reg < 4; ++reg) fo[(size_t)(16 * j + reg) * 256] = S[j][reg];
}
__device__ __forceinline__ void p2_hg_unit(Frame& F, int u) {
    unsigned char* ws = F.ws;
    const int es = u & 1, h = (u >> 1) & 7, b = u >> 4;
    const int w = F.wave, l15 = F.lane & 15, g = F.lane >> 4, et = w & 3, dh = w >> 2;
    LAS bf16* KT = (LAS bf16*)F.lds; LAS bf16* VT = KT + TSZ128; LAS float* LQ = (LAS float*)(VT + TSZ64R); LAS float* BT = LQ + 4 * 128;
    const float* Z = (const float*)(ws + WS_LOGF); const bf16* HI = (const bf16*)(ws + WS_HI);
    const int d = F.tid & 127, q = F.tid >> 7; const float oml = 1.0f - ((const float*)(ws + WS_LB))[h * 128 + d];
    const int vc = F.tid & 7, vm0 = F.tid >> 3;
    float z[32]; v4u va[2];
#define P2H_LOAD(sc) do { const int _r0 = b * 2048 + (sc) * 128; _Pragma("unroll") for (int _i = 0; _i < 32; ++_i) z[_i] = Z[(size_t)(_r0 + 32 * q + _i) * 1024 + h * 128 + d]; \
        _Pragma("unroll") for (int _i = 0; _i < 2; ++_i) va[_i] = *(const v4u*)(HI + (size_t)(_r0 + vm0 + 64 * _i) * 1024 + h * 128 + 64 * es + 8 * vc); } while (0)
    f32x4 S[4];
#pragma unroll
    for (int j = 0; j < 4; ++j) S[j] = (f32x4){0.f, 0.f, 0.f, 0.f};
    P2H_LOAD(0);
    for (int sc = 0; sc < 16; ++sc) {
        float lf[32], kin[32]; float L = 0.f;
#pragma unroll
        for (int i = 0; i < 32; ++i) { kin[i] = oml * __builtin_amdgcn_rcpf(1.0f + __expf(z[i])); lf[i] = __logf(1.0f - kin[i]); L += lf[i]; }
        __syncthreads();
        LQ[q * 128 + d] = L;
#pragma unroll
        for (int i = 0; i < 2; ++i) { LAS bf16* vt = VT + tsw(8 * vc, vm0 + 64 * i);
#pragma unroll
            for (int j = 0; j < 8; ++j) vt[j * TP] = (bf16)((va[i][j >> 1] >> (16 * (j & 1))) & 0xffffu); }
        if (sc + 1 < 16) P2H_LOAD(sc + 1);
        __syncthreads();
        float run = 0.f;
#pragma unroll
        for (int q2 = 1; q2 < 4; ++q2) if (q2 > q) run += LQ[q2 * 128 + d];
#pragma unroll
        for (int blk = 3; blk >= 0; --blk) { float v[8];
#pragma unroll
            for (int jj = 7; jj >= 0; --jj) { const int i = 8 * blk + jj; v[jj] = kin[i] * __expf(run); run += lf[i]; }
            *(LAS bf16x8*)&KT[tsw(d, 32 * q + 8 * blk)] = pack_f8(v); }
        if (q == 0) BT[d] = run;
        __syncthreads();
        f32x4 hs[4];
#pragma unroll
        for (int j = 0; j < 4; ++j) hs[j] = (f32x4){0.f, 0.f, 0.f, 0.f};
#pragma unroll
        for (int ks = 0; ks < 4; ++ks) { const bf16x8 bfr = *(const LAS bf16x8*)&VT[tsw(16 * et + l15, 32 * ks + 8 * g)];
#pragma unroll
            for (int j = 0; j < 4; ++j) { const bf16x8 af = *(const LAS bf16x8*)&KT[tsw(16 * (4 * dh + j) + l15, 32 * ks + 8 * g)]; hs[j] = MFMA16(af, bfr, hs[j]); } }
        bf16* st = (bf16*)(ws + WS_SHT) + ((size_t)((b * 8 + h) * 16 + sc) * 128 + 64 * es + 16 * et + l15) * 128 + 64 * dh + 4 * g;
#pragma unroll
        for (int j = 0; j < 4; ++j) { v2u p; p.x = pk2(S[j][0], S[j][1]); p.y = pk2(S[j][2], S[j][3]); *(v2u*)(st + 16 * j) = p;
            const f32x4 bt = *(const LAS f32x4*)&BT[16 * (4 * dh + j) + 4 * g];
#pragma unroll
            for (int reg = 0; reg < 4; ++reg) S[j][reg] = S[j][reg] * __expf(bt[reg]) + hs[j][reg]; }
    }
#undef P2H_LOAD
    float* fo = F.out + OUT_SHP + ((size_t)(b * 8 + h) * 128 + 64 * dh + 4 * g) * 128 + 64 * es + 16 * et + l15;
#pragma unroll
    for (int j = 0; j < 4; ++j)
#pragma unroll
        for (int reg = 0; reg < 4; ++reg) fo[(size_t)(16 * j + reg) * 128] = S[j][reg];
}
__device__ __forceinline__ void p2_sret_all(Frame& F, const Args& A, unsigned* ctr) {
    unsigned char* ws = F.ws;
    LAS float* qs = (LAS float*)F.lds; LAS float* ks = qs + 128; LAS float* vs = ks + 128; LAS float* ored = vs + 256;
    const bf16* Q = (const bf16*)(ws + WS_Q); const bf16* K = (const bf16*)(ws + WS_K); const bf16* V = (const bf16*)(ws + WS_V);
    const int e4 = F.tid & 63, dq = F.tid >> 6;
    __syncthreads();
    if (F.tid == 0) F.MISC[16] = atomicAdd(ctr, 1u);
    __syncthreads();
    int it = (int)F.MISC[16]; if (it >= 1024) return;
    f32x4 s[16];
    { const float* Sin = A.in[2] + (size_t)it * 128 * 256;
#pragma unroll
      for (int i = 0; i < 16; ++i) s[i] = *(const f32x4*)(Sin + (size_t)(16 * dq + i) * 256 + 4 * e4); }
    for (;;) {
        const int h = it & 7, b = it >> 3, r = 8192 + b;
        __syncthreads();
        if (F.tid == 0) F.MISC[16] = atomicAdd(ctr, 1u);
        if (F.tid < 64) { const int d = F.tid; const float cs = ((const float*)(ws + WS_COS))[2048 * 64 + d], sn = ((const float*)(ws + WS_SIN))[2048 * 64 + d];
            const float q1 = bf2f(Q[(size_t)r * 1024 + h * 128 + d]), q2 = bf2f(Q[(size_t)r * 1024 + h * 128 + 64 + d]), k1 = bf2f(K[(size_t)r * 1024 + h * 128 + d]), k2 = bf2f(K[(size_t)r * 1024 + h * 128 + 64 + d]);
            qs[d] = q1 * cs - q2 * sn; qs[d + 64] = q2 * cs + q1 * sn; ks[d] = k1 * cs - k2 * sn; ks[d + 64] = k2 * cs + k1 * sn; }
        else if (F.tid >= 256) { const int e = F.tid - 256; vs[e] = bf2f(V[(size_t)r * 2048 + h * 256 + e]); }
        __syncthreads();
        const int nx = (int)F.MISC[16];
        const float gam = 1.0f - exp2f(-5.0f - (float)h);
        float* Sout = F.out + OUT_SRS + (size_t)it * 128 * 256;
        const f32x4 v4 = *(const LAS f32x4*)&vs[4 * e4]; f32x4 o = (f32x4){0.f, 0.f, 0.f, 0.f};
#pragma unroll
        for (int i = 0; i < 16; ++i) { const int d = 16 * dq + i; s[i] = s[i] * gam + v4 * ks[d]; *(f32x4*)(Sout + (size_t)d * 256 + 4 * e4) = s[i]; o += s[i] * qs[d]; }
        *(LAS f32x4*)&ored[dq * 256 + 4 * e4] = o;
        if (nx < 1024) { const float* Sin = A.in[2] + (size_t)nx * 128 * 256;
#pragma unroll
            for (int i = 0; i < 16; ++i) s[i] = *(const f32x4*)(Sin + (size_t)(16 * dq + i) * 256 + 4 * e4); }
        __syncthreads();
        if (F.wave == 0) { float oo[4]; float ss = 0.f;
#pragma unroll
            for (int k = 0; k < 4; ++k) { const int e = F.lane + 64 * k; float t = 0.f;
#pragma unroll
                for (int j = 0; j < 8; ++j) t += ored[j * 256 + e];
                oo[k] = t; ss += t * t; }
            const float rr = 1.0f / sqrtf(wave_sum(ss) * (1.0f / 256.0f) + EPS);
            const bf16* RG = (const bf16*)(ws + WS_RG); bf16* OR = (bf16*)(ws + WS_OR);
#pragma unroll
            for (int k = 0; k < 4; ++k) { const size_t ix = (size_t)r * 2048 + h * 256 + F.lane + 64 * k; OR[ix] = (bf16)f2bf(oo[k] * rr * bf2f(RG[ix])); } }
        it = nx; if (it >= 1024) break;
    }
}
__device__ __forceinline__ void p2_shg_all(Frame& F, const Args& A, unsigned* ctr) {
    unsigned char* ws = F.ws;
    LAS float* qs = (LAS float*)F.lds; LAS float* fs = qs + 128; LAS float* kn = fs + 128; LAS float* vs = kn + 128; LAS float* ored = vs + 128;
    const int e4 = F.tid & 31, dq = F.tid >> 5;
    __syncthreads();
    if (F.tid == 0) F.MISC[16] = atomicAdd(ctr, 1u);
    __syncthreads();
    int it = (int)F.MISC[16]; if (it >= 1024) return;
    f32x4 s[8];
    { const float* Sin = A.in[3] + (size_t)it * 128 * 128;
#pragma unroll
      for (int i = 0; i < 8; ++i) s[i] = *(const f32x4*)(Sin + (size_t)(8 * dq + i) * 128 + 4 * e4); }
    for (;;) {
        const int h = it & 7, b = it >> 3, r = 8192 + b;
        __syncthreads();
        if (F.tid == 0) F.MISC[16] = atomicAdd(ctr, 1u);
        if (F.tid < 128) { const int d = F.tid; const size_t ix = (size_t)r * 1024 + h * 128 + d; const float z = ((const float*)(ws + WS_LOGF))[ix]; const float lb = ((const float*)(ws + WS_LB))[h * 128 + d];
            const float kin = (1.0f - lb) / (1.0f + __expf(z)); kn[d] = kin; fs[d] = 1.0f - kin; qs[d] = bf2f(((const bf16*)(ws + WS_HQ))[ix]); vs[d] = bf2f(((const bf16*)(ws + WS_HI))[ix]); }
        __syncthreads();
        const int nx = (int)F.MISC[16];
        float* Sout = F.out + OUT_SHS + (size_t)it * 128 * 128;
        const f32x4 v4 = *(const LAS f32x4*)&vs[4 * e4]; f32x4 o = (f32x4){0.f, 0.f, 0.f, 0.f};
#pragma unroll
        for (int i = 0; i < 8; ++i) { const int d = 8 * dq + i; s[i] = s[i] * fs[d] + v4 * kn[d]; *(f32x4*)(Sout + (size_t)d * 128 + 4 * e4) = s[i]; o += s[i] * qs[d]; }
        *(LAS f32x4*)&ored[dq * 128 + 4 * e4] = o;
        if (nx < 1024) { const float* Sin = A.in[3] + (size_t)nx * 128 * 128;
#pragma unroll
            for (int i = 0; i < 8; ++i) s[i] = *(const f32x4*)(Sin + (size_t)(8 * dq + i) * 128 + 4 * e4); }
        __syncthreads();
        if (F.wave == 0) { float oo[2]; float ss = 0.f;
#pragma unroll
            for (int k = 0; k < 2; ++k) { const int e = F.lane + 64 * k; float t = 0.f;
#pragma unroll
                for (int j = 0; j < 16; ++j) t += ored[j * 128 + e];
                oo[k] = t; ss += t * t; }
            const float rr = 1.0f / sqrtf(wave_sum(ss) * (1.0f / 128.0f) + EPS);
            const bf16* HG = (const bf16*)(ws + WS_HG); bf16* OH = (bf16*)(ws + WS_OH);
#pragma unroll
            for (int k = 0; k < 2; ++k) { const int e = F.lane + 64 * k; const size_t ix = (size_t)r * 1024 + h * 128 + e; OH[ix] = (bf16)f2bf(oo[k] * rr * A.in[10][e] * bf2f(HG[ix])); } }
        it = nx; if (it >= 1024) break;
    }
}
#ifndef PROBE_SUB
#define PROBE_SUB -1
#endif
__device__ __forceinline__ void p2_phase(Frame& F, const Args& A) {
    const int half = F.G >> 1;
    if (half == 0 || (F.vcu & 1) == 0) { const int stride = half ? half : 1;
        for (int u = F.vcu >> 1; u < 64; u += stride) p2_ret_unit(F, u);
        asm volatile("" : "+v"(F.tid), "+v"(F.lane));
        for (int u = (F.vcu >> 1) - 64; u < 64; u += stride) if (u >= 0) p2_hg_unit(F, u); }
    asm volatile("" : "+v"(F.tid), "+v"(F.lane));
    p2_sret_all(F, A, (unsigned*)(F.ctl + 64));
    asm volatile("" : "+v"(F.tid), "+v"(F.lane));
    p2_shg_all(F, A, (unsigned*)(F.ctl + 128));
}
__device__ __forceinline__ void p4_ret_item(Frame& F, int item) {
    unsigned char* ws = F.ws;
    const int c = item & 15, h = (item >> 4) & 7, b = item >> 7, r0 = b * 2048 + c * 128;
    const int w = F.wave, l15 = F.lane & 15, g = F.lane >> 4;
    LAS bf16* KS = (LAS bf16*)F.lds; LAS bf16* VT = KS + 128 * TP; LAS bf16* ST = VT + TSZ128;
    LAS bf16* OT = (LAS bf16*)F.lds;
    const bf16* Qg = (const bf16*)(ws + WS_Q); const bf16* Kg = (const bf16*)(ws + WS_K); const bf16* Vg = (const bf16*)(ws + WS_V);
    const bf16* Sg = (const bf16*)(ws + WS_SRT) + (size_t)item * 256 * 128;
    const float* COS = (const float*)(ws + WS_COS); const float* SIN = (const float*)(ws + WS_SIN);
    const float lg = lg2gamma(h);
    const int vc = F.tid & 15, vm0 = F.tid >> 4;
    v4u vp[4], sp[4];
#define P4R_LOAD(hh) do { _Pragma("unroll") for (int _i = 0; _i < 4; ++_i) { vp[_i] = *(const v4u*)(Vg + (size_t)(r0 + vm0 + 32 * _i) * 2048 + h * 256 + 128 * (hh) + 8 * vc); \
        sp[_i] = *(const v4u*)(Sg + (size_t)(128 * (hh) + vm0 + 32 * _i) * 128 + 8 * vc); } } while (0)
#define P4R_WRITE() do { _Pragma("unroll") for (int _i = 0; _i < 4; ++_i) { LAS bf16* _vt = VT + tsw(8 * vc, vm0 + 32 * _i); \
        _Pragma("unroll") for (int _j = 0; _j < 8; ++_j) _vt[_j * TP] = (bf16)((vp[_i][_j >> 1] >> (16 * (_j & 1))) & 0xffffu); \
        *(LAS v4u*)&ST[(vm0 + 32 * _i) * TP + 8 * vc] = sp[_i]; } } while (0)
    P4R_LOAD(0);
    __syncthreads();
#pragma unroll
    for (int i = 0; i < 2; ++i) { const int u = F.tid + 512 * i, d0 = (u & 7) * 8, m = u >> 3;
        const bf16* kp = Kg + (size_t)(r0 + m) * 1024 + h * 128 + d0; const v4u a = *(const v4u*)kp, bb = *(const v4u*)(kp + 64);
        const int pos = c * 128 + m; const f32x4 c0 = *(const f32x4*)(COS + pos * 64 + d0), c1 = *(const f32x4*)(COS + pos * 64 + d0 + 4), s0 = *(const f32x4*)(SIN + pos * 64 + d0), s1 = *(const f32x4*)(SIN + pos * 64 + d0 + 4);
        float o1[8], o2[8];
#pragma unroll
        for (int j = 0; j < 8; ++j) { const float x1 = bfe(a, j), x2 = bfe(bb, j), cj = j < 4 ? c0[j & 3] : c1[j & 3], sj = j < 4 ? s0[j & 3] : s1[j & 3]; o1[j] = x1 * cj - x2 * sj; o2[j] = x2 * cj + x1 * sj; }
        *(LAS bf16x8*)&KS[m * TP + d0] = pack_f8(o1); *(LAS bf16x8*)&KS[m * TP + 64 + d0] = pack_f8(o2); }
    P4R_WRITE();
    P4R_LOAD(1);
    bf16x8 qf[4];
    { const int n = 16 * w + l15, pos = c * 128 + n; const bf16* qp = Qg + (size_t)(r0 + n) * 1024 + h * 128 + 8 * g;
      const v4u a0 = *(const v4u*)qp, a1 = *(const v4u*)(qp + 32), a2 = *(const v4u*)(qp + 64), a3 = *(const v4u*)(qp + 96);
      float r0v[8], r1v[8], r2v[8], r3v[8];
#pragma unroll
      for (int hlf = 0; hlf < 2; ++hlf) { const int dd = 32 * hlf + 8 * g;
          const f32x4 c0 = *(const f32x4*)(COS + pos * 64 + dd), c1 = *(const f32x4*)(COS + pos * 64 + dd + 4), s0 = *(const f32x4*)(SIN + pos * 64 + dd), s1 = *(const f32x4*)(SIN + pos * 64 + dd + 4);
#pragma unroll
          for (int j = 0; j < 8; ++j) { const float cj = j < 4 ? c0[j & 3] : c1[j & 3], sj = j < 4 ? s0[j & 3] : s1[j & 3];
              const float x1 = hlf == 0 ? bfe(a0, j) : bfe(a1, j), x2 = hlf == 0 ? bfe(a2, j) : bfe(a3, j);
              if (hlf == 0) { r0v[j] = x1 * cj - x2 * sj; r2v[j] = x2 * cj + x1 * sj; } else { r1v[j] = x1 * cj - x2 * sj; r3v[j] = x2 * cj + x1 * sj; } } }
      qf[0] = pack_f8(r0v); qf[1] = pack_f8(r1v); qf[2] = pack_f8(r2v); qf[3] = pack_f8(r3v); }
    __syncthreads();
    bf16x8 pf[4];
#pragma unroll
    for (int s = 0; s < 4; ++s) { float pv[8];
#pragma unroll
        for (int hf = 0; hf < 2; ++hf) { const int mt = 2 * s + hf; f32x4 dd = (f32x4){0.f, 0.f, 0.f, 0.f};
            if (mt <= w) {
#pragma unroll
                for (int ks = 0; ks < 4; ++ks) { const bf16x8 kf = *(const LAS bf16x8*)&KS[(16 * mt + l15) * TP + 32 * ks + 8 * g]; dd = MFMA16(kf, qf[ks], dd); }
#pragma unroll
                for (int reg = 0; reg < 4; ++reg) { const int m = 16 * mt + 4 * g + reg, n = 16 * w + l15; dd[reg] = n >= m ? dd[reg] * exp2f((float)(n - m) * lg) : 0.f; } }
#pragma unroll
            for (int reg = 0; reg < 4; ++reg) pv[4 * hf + reg] = dd[reg]; }
        pf[s] = pack_f8(pv); }
    float rs[4];
#pragma unroll
    for (int reg = 0; reg < 4; ++reg) rs[reg] = exp2f((float)(16 * w + 4 * g + reg + 1) * lg);
    f32x4 O[16];
#pragma unroll
    for (int hh = 0; hh < 2; ++hh) {
        if (hh == 1) { __syncthreads(); P4R_WRITE(); __syncthreads(); }
#pragma unroll
        for (int et = 0; et < 8; ++et) { f32x4 t = (f32x4){0.f, 0.f, 0.f, 0.f};
#pragma unroll
            for (int ks = 0; ks < 4; ++ks) { const bf16x8 sf = *(const LAS bf16x8*)&ST[(16 * et + l15) * TP + 32 * ks + 8 * g]; t = MFMA16(qf[ks], sf, t); }
#pragma unroll
            for (int reg = 0; reg < 4; ++reg) t[reg] *= rs[reg];
#pragma unroll
            for (int s = 0; s < 4; ++s) if (2 * s <= w) { const bf16x4v lo = *(const LAS bf16x4v*)&VT[tsw(16 * et + l15, 32 * s + 4 * g)], hi = *(const LAS bf16x4v*)&VT[tsw(16 * et + l15, 32 * s + 16 + 4 * g)];
                const bf16x8 vf = __builtin_shufflevector(lo, hi, 0, 1, 2, 3, 4, 5, 6, 7); t = MFMA16(pf[s], vf, t); }
            O[8 * hh + et] = t; }
    }
#undef P4R_LOAD
#undef P4R_WRITE
    float ss[4] = {0.f, 0.f, 0.f, 0.f};
#pragma unroll
    for (int et = 0; et < 16; ++et)
#pragma unroll
        for (int reg = 0; reg < 4; ++reg) ss[reg] += O[et][reg] * O[et][reg];
#pragma unroll
    for (int reg = 0; reg < 4; ++reg) { float v = ss[reg]; v += __shfl_xor(v, 1); v += __shfl_xor(v, 2); v += __shfl_xor(v, 4); v += __shfl_xor(v, 8); ss[reg] = 1.0f / sqrtf(v * (1.0f / 256.0f) + EPS); }
    __syncthreads();
#pragma unroll
    for (int reg = 0; reg < 4; ++reg) { LAS bf16* op = OT + (16 * w + 4 * g + reg) * 264 + l15;
#pragma unroll
        for (int et = 0; et < 16; ++et) op[16 * et] = (bf16)f2bf(O[et][reg] * ss[reg]); }
    LDS_WAIT();
    const bf16* RG = (const bf16*)(ws + WS_RG); bf16* OR = (bf16*)(ws + WS_OR);
#pragma unroll
    for (int i = 0; i < 8; ++i) { const int p = F.lane + 64 * i, row = 16 * w + (p >> 5), c16 = p & 31; const size_t gx = (size_t)(r0 + row) * 2048 + h * 256 + 8 * c16;
        const v4u o8 = *(const LAS v4u*)&OT[row * 264 + 8 * c16]; const v4u g8 = *(const v4u*)(RG + gx); float v[8];
#pragma unroll
        for (int j = 0; j < 8; ++j) v[j] = bfe(o8, j) * bfe(g8, j);
        *(v4u*)(OR + gx) = __builtin_bit_cast(v4u, pack_f8(v)); }
}
__device__ __forceinline__ void p4_hg_item(Frame& F, const Args& A, int item) {
    unsigned char* ws = F.ws;
    const int sc = item & 15, h = (item >> 4) & 7, b = item >> 7, r0 = b * 2048 + sc * 128;
    const int w = F.wave, l15 = F.lane & 15, g = F.lane >> 4;
    LAS bf16* QP = (LAS bf16*)F.lds;
    LAS bf16* KP = QP + 64 * TP;
    LAS bf16* KU = KP + 64 * TP;
    LAS bf16* VT = KU + 128 * 72;
    LAS float* E15 = (LAS float*)(VT + TSZ64T);
    LAS float* OB = E15 + 4 * 128;
    const float* Z = (const float*)(ws + WS_LOGF); const bf16* HQ = (const bf16*)(ws + WS_HQ); const bf16* HI = (const bf16*)(ws + WS_HI); const float* LB = (const float*)(ws + WS_LB);
    f32x4 S[8];
    { const bf16* st = (const bf16*)(ws + WS_SHT) + (size_t)item * 128 * 128 + (size_t)(16 * w + l15) * 128 + 4 * g;
#pragma unroll
      for (int dt = 0; dt < 8; ++dt) { const v2u p = *(const v2u*)(st + 16 * dt); S[dt][0] = __uint_as_float(p.x << 16); S[dt][1] = __uint_as_float(p.x & 0xffff0000u); S[dt][2] = __uint_as_float(p.y << 16); S[dt][3] = __uint_as_float(p.y & 0xffff0000u); } }
    for (int hf = 0; hf < 2; ++hf) {
        const int rh = r0 + 64 * hf;
        __syncthreads();
        { const int d = F.tid & 127, sq = F.tid >> 7; const float oml = 1.0f - LB[h * 128 + d];
          float kin[16], bcum[16]; float bb = 0.f;
#pragma unroll
          for (int t = 0; t < 16; ++t) { const size_t ix = (size_t)(rh + 16 * sq + t) * 1024 + h * 128 + d; const float z = Z[ix]; const float q = bf2f(HQ[ix]);
              kin[t] = oml * __builtin_amdgcn_rcpf(1.0f + __expf(z)); bb += __logf(1.0f - kin[t]); bcum[t] = bb;
              QP[(16 * sq + t) * TP + d] = (bf16)f2bf(q * __expf(bb)); KP[(16 * sq + t) * TP + d] = (bf16)f2bf(kin[t] * __expf(fminf(-bb, 80.0f))); }
          E15[sq * 128 + d] = __expf(bb);
          float v[8];
#pragma unroll
          for (int t = 0; t < 8; ++t) v[t] = kin[t] * __expf(bb - bcum[t]);
          *(LAS bf16x8*)&KU[d * 72 + 16 * sq] = pack_f8(v);
#pragma unroll
          for (int t = 0; t < 8; ++t) v[t] = kin[8 + t] * __expf(bb - bcum[8 + t]);
          *(LAS bf16x8*)&KU[d * 72 + 16 * sq + 8] = pack_f8(v); }
#pragma unroll
        for (int i = 0; i < 2; ++i) { const int u = F.tid + 512 * i, e0 = (u & 15) * 8, m = u >> 4;
            const v4u a = *(const v4u*)(HI + (size_t)(rh + m) * 1024 + h * 128 + e0);
            LAS bf16* vt = VT + tsw64(e0, m);
#pragma unroll
            for (int j = 0; j < 8; ++j) vt[j * 72] = (bf16)((a[j >> 1] >> (16 * (j & 1))) & 0xffffu); }
        __syncthreads();
        const bf16x8 zero8 = (bf16x8){0, 0, 0, 0, 0, 0, 0, 0};
#pragma unroll
        for (int sq = 0; sq < 4; ++sq) {
            f32x4 at = (f32x4){0.f, 0.f, 0.f, 0.f};
#pragma unroll
            for (int ks = 0; ks < 4; ++ks) { const bf16x8 kf = *(const LAS bf16x8*)&KP[(16 * sq + l15) * TP + 32 * ks + 8 * g], qf = *(const LAS bf16x8*)&QP[(16 * sq + l15) * TP + 32 * ks + 8 * g]; at = MFMA16(kf, qf, at); }
            float pv[8];
#pragma unroll
            for (int reg = 0; reg < 4; ++reg) { pv[reg] = (4 * g + reg) <= l15 ? at[reg] : 0.f; pv[4 + reg] = 0.f; }
            const bf16x8 pfr = pack_f8(pv);
            f32x4 o;
            { const bf16x4v lo = *(const LAS bf16x4v*)&VT[tsw64(16 * w + l15, 16 * sq + 4 * g)]; const bf16x8 vf = __builtin_shufflevector(lo, (bf16x4v){0, 0, 0, 0}, 0, 1, 2, 3, 4, 5, 6, 7);
              const f32x4 z4 = {0.f, 0.f, 0.f, 0.f}; o = MFMA16(pfr, vf, z4); }
#pragma unroll
            for (int ks = 0; ks < 4; ++ks) { float sv[8];
#pragma unroll
                for (int jj = 0; jj < 8; ++jj) sv[jj] = S[2 * ks + (jj >> 2)][jj & 3];
                const bf16x8 sf = pack_f8(sv);
                const LAS bf16* qp = &QP[(16 * sq + l15) * TP + 32 * ks + 4 * g]; const bf16x4v lo = *(const LAS bf16x4v*)qp, hi = *(const LAS bf16x4v*)(qp + 16);
                const bf16x8 qf = __builtin_shufflevector(lo, hi, 0, 1, 2, 3, 4, 5, 6, 7); o = MFMA16(qf, sf, o); }
#pragma unroll
            for (int reg = 0; reg < 4; ++reg) OB[(16 * sq + 4 * g + reg) * 132 + 16 * w + l15] = o[reg];
            const bf16x8 vu = g < 2 ? *(const LAS bf16x8*)&VT[tsw64(16 * w + l15, 16 * sq + 8 * g)] : zero8;
#pragma unroll
            for (int dt = 0; dt < 8; ++dt) { const f32x4 ed = *(const LAS f32x4*)&E15[sq * 128 + 16 * dt + 4 * g];
                const bf16x8 kf = g < 2 ? *(const LAS bf16x8*)&KU[(16 * dt + l15) * 72 + 16 * sq + 8 * g] : zero8;
                S[dt] = MFMA16(kf, vu, S[dt] * ed); }
        }
        __syncthreads();
        { const bf16* HG = (const bf16*)(ws + WS_HG); bf16* OH = (bf16*)(ws + WS_OH);
#pragma unroll
          for (int i = 0; i < 8; ++i) { const int t = 8 * w + i; const float v0 = OB[t * 132 + F.lane], v1 = OB[t * 132 + 64 + F.lane];
              const float rr = 1.0f / sqrtf(wave_sum(v0 * v0 + v1 * v1) * (1.0f / 128.0f) + EPS); const size_t ix = (size_t)(rh + t) * 1024 + h * 128 + F.lane;
              OH[ix] = (bf16)f2bf(v0 * rr * A.in[10][F.lane] * bf2f(HG[ix])); OH[ix + 64] = (bf16)f2bf(v1 * rr * A.in[10][64 + F.lane] * bf2f(HG[ix + 64])); } }
    }
}
__device__ __forceinline__ void p4_phase(Frame& F, const Args& A) {
    for (int rep = 0; rep < (PROBE_SUB == 40 ? 2 : 1); ++rep) for (int it = F.vcu; it < 512; it += F.G) p4_ret_item(F, it);
    asm volatile("" : "+v"(F.tid), "+v"(F.lane));
    for (int rep = 0; rep < (PROBE_SUB == 41 ? 2 : 1); ++rep) for (int it = F.vcu; it < 512; it += F.G) p4_hg_item(F, A, it);
}
namespace mini {
using pg8::bf16_t; using pg8::u32x2; using pg8::silu4; using pg8::sigm4; using pg8::pack4; using pg8::unpack4;
constexpr int AP = 136;
template <bool TWO> __device__ __forceinline__ void core(Frame& F, const bf16_t* A, int lda, int K, const bf16_t* bp0, const bf16_t* bp1, f32x4 (&acc0)[8], f32x4 (&acc1)[8]) {
    LAS bf16* AS = (LAS bf16*)F.lds; const int l15 = F.lane & 15, g = F.lane >> 4; const int nch = K >> 7; int cc = F.vcu % nch;
    v4u pre[4]; bf16x8 b0[4], b1[4];
    const int prow = F.tid >> 4, pc = (F.tid & 15) * 8;
#pragma unroll
    for (int i = 0; i < 4; ++i) pre[i] = *(const v4u*)(A + (size_t)(prow + 32 * i) * lda + cc * 128 + pc);
    if (bp0) {
#pragma unroll
        for (int u = 0; u < 4; ++u) { b0[u] = *(const bf16x8*)(bp0 + cc * 128 + 32 * u); if (TWO) b1[u] = *(const bf16x8*)(bp1 + cc * 128 + 32 * u); } }
    __syncthreads();
    for (int c = 0; c < nch; ++c) {
        LAS bf16* buf = AS + (c & 1) * (128 * AP);
#pragma unroll
        for (int i = 0; i < 4; ++i) *(LAS v4u*)&buf[(prow + 32 * i) * AP + pc] = pre[i];
        bf16x8 c0[4], c1[4];
#pragma unroll
        for (int u = 0; u < 4; ++u) { c0[u] = b0[u]; if (TWO) c1[u] = b1[u]; }
        cc = cc + 1 == nch ? 0 : cc + 1;
        if (c + 1 < nch) {
#pragma unroll
            for (int i = 0; i < 4; ++i) pre[i] = *(const v4u*)(A + (size_t)(prow + 32 * i) * lda + cc * 128 + pc);
            if (bp0) {
#pragma unroll
                for (int u = 0; u < 4; ++u) { b0[u] = *(const bf16x8*)(bp0 + cc * 128 + 32 * u); if (TWO) b1[u] = *(const bf16x8*)(bp1 + cc * 128 + 32 * u); } } }
        __syncthreads();
        if (bp0) {
#pragma unroll
            for (int u = 0; u < 4; ++u)
#pragma unroll
                for (int rt = 0; rt < 8; ++rt) { const bf16x8 a = *(const LAS bf16x8*)&buf[(16 * rt + l15) * AP + 32 * u + 8 * g];
                    acc0[rt] = __builtin_amdgcn_mfma_f32_16x16x32_bf16(c0[u], a, acc0[rt], 0, 0, 0); if (TWO) acc1[rt] = __builtin_amdgcn_mfma_f32_16x16x32_bf16(c1[u], a, acc1[rt], 0, 0, 0); } }
    }
}
#define MINI_ZERO(acc) _Pragma("unroll") for (int _i = 0; _i < 8; ++_i) acc[_i] = (f32x4){0.f, 0.f, 0.f, 0.f}
__device__ __forceinline__ void inproj(Frame& F, int j, int nj) {
    unsigned char* ws = F.ws; const int l15 = F.lane & 15, g = F.lane >> 4;
    if (j >= NIN / 16) return;
    const int t = j + nj * F.wave; const bool has = t < NIN / 16; const int n0 = 16 * t;
    f32x4 acc[8]; MINI_ZERO(acc);
    core<false>(F, (const bf16_t*)(ws + WS_XB) + 8192ull * 2048, 2048, 2048, has ? (const bf16_t*)(ws + WS_WIN) + (size_t)(n0 + l15) * 2048 + 8 * g : nullptr, nullptr, acc, acc);
    if (!has) return;
    const int c = n0 + 4 * g;
    if (c >= 7168 && c < 8192) {
#pragma unroll
        for (int rt = 0; rt < 8; ++rt) *(f32x4*)((float*)(ws + WS_LOGF) + (size_t)(8192 + 16 * rt + l15) * 1024 + (c - 7168)) = acc[rt];
        return; }
    size_t od; int pitch, c0, act; float sc = 1.0f;
    if (c < 1024) { od = WS_Q; pitch = 1024; c0 = 0; act = 0; } else if (c < 2048) { od = WS_K; pitch = 1024; c0 = 1024; act = 0; sc = 0.08838834764831845f; }
    else if (c < 4096) { od = WS_V; pitch = 2048; c0 = 2048; act = 0; } else if (c < 6144) { od = WS_RG; pitch = 2048; c0 = 4096; act = 1; } else if (c < 7168) { od = WS_HQ; pitch = 1024; c0 = 6144; act = 1; }
    else if (c < 9216) { od = WS_HI; pitch = 1024; c0 = 8192; act = 0; } else if (c < 10240) { od = WS_HG; pitch = 1024; c0 = 9216; act = 1; } else if (c < 12288) { od = WS_GA; pitch = 2048; c0 = 10240; act = 2; } else { od = WS_GB; pitch = 2048; c0 = 12288; act = 2; }
#pragma unroll
    for (int rt = 0; rt < 8; ++rt) { f32x4 v = acc[rt] * sc; if (act == 1) v = silu4(v); else if (act == 2) v = sigm4(v);
        *(u32x2*)((bf16_t*)(ws + od) + (size_t)(8192 + 16 * rt + l15) * pitch + (c - c0)) = pack4(v); }
}
__device__ __forceinline__ void outproj(Frame& F) {
    unsigned char* ws = F.ws; const int l15 = F.lane & 15, g = F.lane >> 4;
    if (F.vcu >= 128) return;
    const int t = F.vcu + F.G * F.wave; const bool has = t < 128; const int n0 = 16 * t;
    f32x4 ya[8], yb[8]; MINI_ZERO(ya); MINI_ZERO(yb);
    core<false>(F, (const bf16_t*)(ws + WS_OR) + 8192ull * 2048, 2048, 2048, has ? (const bf16_t*)(ws + WS_WRO) + (size_t)(n0 + l15) * 2048 + 8 * g : nullptr, nullptr, ya, ya);
    core<false>(F, (const bf16_t*)(ws + WS_OH) + 8192ull * 1024, 1024, 1024, has ? (const bf16_t*)(ws + WS_WHO) + (size_t)(n0 + l15) * 1024 + 8 * g : nullptr, nullptr, yb, yb);
    if (!has) return;
#pragma unroll
    for (int rt = 0; rt < 8; ++rt) { const size_t ix = (size_t)(8192 + 16 * rt + l15) * 2048 + n0 + 4 * g;
        const f32x4 ga = unpack4(*(const u32x2*)((const bf16_t*)(ws + WS_GA) + ix)), gb = unpack4(*(const u32x2*)((const bf16_t*)(ws + WS_GB) + ix));
        *(u32x2*)((bf16_t*)(ws + WS_MG) + ix) = pack4(ga * ya[rt] + gb * yb[rt]); }
}
__device__ __forceinline__ void resid(Frame& F, const bf16_t* Arows  , const bf16_t* Bt, int K, const float* XI  , float* XO  , bf16_t* XBo  , float* SS  ) {
    const int l15 = F.lane & 15, g = F.lane >> 4;
    if (F.vcu >= 128) return;
    const int t = F.vcu + F.G * F.wave; const bool has = t < 128; const int n0 = 16 * t;
    f32x4 acc[8]; MINI_ZERO(acc);
    core<false>(F, Arows, K, K, has ? Bt + (size_t)(n0 + l15) * K + 8 * g : nullptr, nullptr, acc, acc);
    if (!has) return;
#pragma unroll
    for (int rt = 0; rt < 8; ++rt) { const int rl = 16 * rt + l15; const size_t ix = (size_t)rl * 2048 + n0 + 4 * g;
        f32x4 v = acc[rt] + *(const f32x4*)(XI + ix); *(f32x4*)(XO + ix) = v;
        if (XBo) *(u32x2*)(XBo + ix) = pack4(v);
        float ss = (v[0] * v[0] + v[1] * v[1]) + (v[2] * v[2] + v[3] * v[3]); ss += __shfl_xor(ss, 16); ss += __shfl_xor(ss, 32);
        if (g == 0) atomicAdd(SS + rl, ss); }
}
__device__ __forceinline__ void swiglu(Frame& F, int j, int nj) {
    unsigned char* ws = F.ws; const int l15 = F.lane & 15, g = F.lane >> 4;
    if (j >= DFF / 16) return;
    const int t = j + nj * F.wave; const bool has = t < DFF / 16; const int ng = ((16 * t) >> 7) * 256 + ((16 * t) & 127);
    f32x4 ag[8], au[8]; MINI_ZERO(ag); MINI_ZERO(au);
    const bf16_t* A = (const bf16_t*)(ws + WS_X1B) + 8192ull * 2048;
    const bf16_t* bg = has ? (const bf16_t*)(ws + WS_WFI) + (size_t)(ng + l15) * 2048 + 8 * g : nullptr;
    core<true>(F, A, 2048, 2048, bg, has ? bg + 128 * 2048 : nullptr, ag, au);
    if (!has) return;
    const float* SS1 = (const float*)(F.ctl + CW_SS1);
#pragma unroll
    for (int rt = 0; rt < 8; ++rt) { const int r = 8192 + 16 * rt + l15; const float r2 = 1.0f / sqrtf(SS1[r] * (1.0f / 2048.0f) + EPS);
        *(u32x2*)((bf16_t*)(ws + WS_ACT) + (size_t)r * DFF + 16 * t + 4 * g) = pack4(silu4(ag[rt] * r2) * (au[rt] * r2)); }
}
}
__global__ void __launch_bounds__(NWAVES * 64, 2) mk_fwd(Args args) {
    extern __shared__ __attribute__((aligned(16))) unsigned char lds[];
    Frame F;
    F.lds = (LAS unsigned char*)lds; F.MISC = (volatile LAS unsigned*)(F.lds + MISC_OFF);
    F.tid = threadIdx.x; F.lane = F.tid & 63; F.wave = __builtin_amdgcn_readfirstlane(F.tid >> 6);
    F.G = gridDim.x; { const int bx = blockIdx.x; F.vcu = (F.G % 8 == 0) ? (bx % 8) * (F.G / 8) + bx / 8 : bx; }
    F.ws = args.ws; F.out = args.out; F.ctl = (gu32*)(args.ws + WS_CTL);
    for (int u = F.tid; u < (LDS_BYTES - LDSCTL_OFF) / 4; u += NWAVES * 64) ((LAS unsigned*)(F.lds + LDSCTL_OFF))[u] = 0u;
    __syncthreads();
    XcdBarrier bar; bar.bar = (unsigned*)(F.ctl + CW_BAR); bar.x = 0; bar.st = nullptr;
    if (args.use_bar) bar = xcd_barrier_post((unsigned*)(F.ctl + CW_BAR), F.MISC + 8);
    const int lo = args.ph_lo, hi = args.ph_hi;
#define IN(k) (lo <= (k) && (k) < hi)
#define SEAM(k) do { if (IN(k) && IN((k) + 1)) xcd_barrier(bar); } while (0)
#ifndef PROBE_REPEAT
#define PROBE_REPEAT -1
#endif
#define NREP(k) ((PROBE_REPEAT == (k)) ? 2 : 1)
    unsigned char* ws = args.ws;
    if (PROBE_REPEAT == 0) { p0_prologue(F, args); xcd_barrier(bar); }
    if (IN(0)) { p0_prologue(F, args); } SEAM(0);
#define P1_BODY { \
          \
        if (F.G >= 2 && (F.vcu & 1)) { mini::inproj(F, F.vcu >> 1, F.G >> 1); __syncthreads(); } else if (F.G < 2) { mini::inproj(F, F.vcu, F.G); __syncthreads(); } \
        pg8::Gemm g{(const pg8::bf16_t*)(ws + WS_XB), (const pg8::bf16_t*)(ws + WS_WIN), 8192, NIN, 2048}; pg8::StaticOrder S; S.init(8192, NIN, F.G, (int)blockIdx.x); \
        pg8::EpiInProj E{ws}; \
        pg8::gemm_phase<pg8::EpiInProj, pg8::StaticOrder, true, true>(F.lds, g, S, E); }
    if (PROBE_REPEAT == 1) { P1_BODY xcd_barrier(bar); }
    if (PROBE_REPEAT == 101) { pg8::Gemm g{(const pg8::bf16_t*)(ws + WS_XB), (const pg8::bf16_t*)(ws + WS_WIN), 8192, NIN, 2048}; pg8::StaticOrder S; S.init(8192, NIN, F.G, (int)blockIdx.x);
        pg8::EpiNull E{}; pg8::gemm_phase<pg8::EpiNull, pg8::StaticOrder, true, true>(F.lds, g, S, E); xcd_barrier(bar); }
    if (PROBE_REPEAT == 102) { pg8::Gemm g{(const pg8::bf16_t*)(ws + WS_XB), (const pg8::bf16_t*)(ws + WS_WIN), 8192, 2048, 2048}; pg8::StaticOrder S; S.init(8192, 2048, F.G, (int)blockIdx.x);
        pg8::EpiNull E{}; pg8::gemm_phase<pg8::EpiNull, pg8::StaticOrder, true, true>(F.lds, g, S, E); xcd_barrier(bar); }
    if (IN(1)) P1_BODY SEAM(1);
    if (PROBE_REPEAT == 2) { p2_phase(F, args); xcd_barrier(bar); }
    if (IN(2)) { p2_phase(F, args); } SEAM(2);
    if (PROBE_REPEAT == 3) { p4_phase(F, args); xcd_barrier(bar); }
    if (IN(3)) { p4_phase(F, args); } SEAM(3);
    if (IN(4)) {
        { pg8::Gemm g{(const pg8::bf16_t*)(ws + WS_OR), (const pg8::bf16_t*)(ws + WS_WRO), 8192, 2048, 2048}; pg8::StaticOrder S; S.init(8192, 2048, F.G, (int)blockIdx.x);
          pg8::EpiGate<0> E{(const pg8::bf16_t*)(ws + WS_GA), (float*)(ws + WS_YT), (pg8::bf16_t*)(ws + WS_MG)};
          pg8::gemm_phase<pg8::EpiGate<0>, pg8::StaticOrder, true, true>(F.lds, g, S, E); }
        { pg8::Gemm g{(const pg8::bf16_t*)(ws + WS_OH), (const pg8::bf16_t*)(ws + WS_WHO), 8192, 2048, 1024}; pg8::StaticOrder S; S.init(8192, 2048, F.G, (int)blockIdx.x);
          pg8::EpiGate<1> E{(const pg8::bf16_t*)(ws + WS_GB), (float*)(ws + WS_YT), (pg8::bf16_t*)(ws + WS_MG)};
          pg8::gemm_phase<pg8::EpiGate<1>, pg8::StaticOrder, true, true>(F.lds, g, S, E); }
        mini::outproj(F);
    } SEAM(4);
    if (IN(5)) {
        pg8::Gemm g{(const pg8::bf16_t*)(ws + WS_MG), (const pg8::bf16_t*)(ws + WS_WOUT), 8192, 2048, 2048}; pg8::StaticOrder S; S.init(8192, 2048, F.G, (int)blockIdx.x);
        pg8::EpiResid E{args.in[0], args.in[1], args.out, (pg8::bf16_t*)(ws + WS_X1B), (float*)(F.ctl + CW_SS1)};
        pg8::gemm_phase<pg8::EpiResid, pg8::StaticOrder, true, true>(F.lds, g, S, E);
        mini::resid(F, (const pg8::bf16_t*)(ws + WS_MG) + 8192ull * 2048, (const pg8::bf16_t*)(ws + WS_WOUT), 2048, args.in[1], args.out + OUT_YS, (pg8::bf16_t*)(ws + WS_X1B) + 8192ull * 2048, (float*)(F.ctl + CW_SS1) + 8192);
    } SEAM(5);
    if (IN(6)) {
        { const int nu = (8192 / 256) * (2 * DFF / 256), rem = nu % F.G;
          if (rem && (int)blockIdx.x >= rem) { mini::swiglu(F, (int)blockIdx.x - rem, F.G - rem); __syncthreads(); } else if (!rem) { mini::swiglu(F, F.vcu, F.G); __syncthreads(); } }
        pg8::Gemm g{(const pg8::bf16_t*)(ws + WS_X1B), (const pg8::bf16_t*)(ws + WS_WFI), 8192, 2 * DFF, 2048}; pg8::StaticOrder S; S.init(8192, 2 * DFF, F.G, (int)blockIdx.x);
        pg8::EpiSwiglu E{(const float*)(F.ctl + CW_SS1), (pg8::bf16_t*)(ws + WS_ACT)};
        pg8::gemm_phase<pg8::EpiSwiglu, pg8::StaticOrder, true, true>(F.lds, g, S, E);
    } SEAM(6);
    if (IN(7)) {
        pg8::Gemm g{(const pg8::bf16_t*)(ws + WS_ACT), (const pg8::bf16_t*)(ws + WS_WFO), 8192, 2048, DFF}; pg8::StaticOrder S; S.init(8192, 2048, F.G, (int)blockIdx.x);
        pg8::EpiResid E{args.out, args.out + OUT_YS, args.out, nullptr, (float*)(F.ctl + CW_SS2)};
        pg8::gemm_phase<pg8::EpiResid, pg8::StaticOrder, true, true>(F.lds, g, S, E);
        mini::resid(F, (const pg8::bf16_t*)(ws + WS_ACT) + 8192ull * DFF, (const pg8::bf16_t*)(ws + WS_WFO), DFF, args.out + OUT_YS, args.out + OUT_YS, nullptr, (float*)(F.ctl + CW_SS2) + 8192);
    } SEAM(7);
    if (IN(8)) {
        const int gw = F.vcu * NWAVES + F.wave, NGW = F.G * NWAVES; const float* SS2 = (const float*)(F.ctl + CW_SS2);
        for (int m = gw; m < MROWS; m += NGW) { f32x4* xr = (f32x4*)(args.out + (size_t)m * 2048) + F.lane; const f32x4* gn = (const f32x4*)args.in[14] + F.lane;
            const float rr = 1.0f / sqrtf(SS2[m] * (1.0f / 2048.0f) + EPS);
#pragma unroll
            for (int j = 0; j < 8; ++j) xr[64 * j] = xr[64 * j] * rr * gn[64 * j]; }
    }
#undef IN
#undef SEAM
}
extern "C" void kernel_launch(void* const* d_in, const int* in_sizes, int n_in, void* d_out, int out_size, void* d_ws, size_t ws_size, hipStream_t stream) {
    static int grid = 0;
    if (grid == 0) {
        int dev = 0, cus = 0;
        if (ws_size < WS_END || n_in != 15) { fprintf(stderr, "kernel_launch: unexpected sizes (ws %zu, n_in %d)\n", ws_size, n_in); grid = -1; return; }
        if (hipGetDevice(&dev) != hipSuccess || hipDeviceGetAttribute(&cus, hipDeviceAttributeMultiprocessorCount, dev) != hipSuccess) { grid = -1; return; }
        if (hipFuncSetAttribute((const void*)mk_fwd, hipFuncAttributeMaxDynamicSharedMemorySize, LDS_BYTES) != hipSuccess) { fprintf(stderr, "kernel_launch: hipFuncSetAttribute failed\n"); grid = -1; return; }
        int per_cu = 0; (void)hipOccupancyMaxActiveBlocksPerMultiprocessor(&per_cu, (const void*)mk_fwd, NWAVES * 64, LDS_BYTES); (void)hipGetLastError();
        if (per_cu < 1) { fprintf(stderr, "kernel_launch: occupancy query says %d blocks per CU; nothing launched\n", per_cu); grid = -1; return; }
        grid = cus;
    }
    if (grid < 0) return;
    (void)hipMemsetAsync((char*)d_ws + WS_CTL, 0, CTL_ZERO_BYTES, stream);
    Args a{};
    for (int i = 0; i < 15; ++i) a.in[i] = (const float*)d_in[i];
    a.out = (float*)d_out; a.ws = (unsigned char*)d_ws; a.use_bar = 1; a.ph_lo = 0; a.ph_hi = 9;
    hipLaunchKernelGGL(mk_fwd, dim3(grid), dim3(NWAVES * 64), LDS_BYTES, stream, a);
}
```

```cpp
#include <hip/hip_runtime.h>
#include <cstdio>
#include <cstdint>
constexpr int DMODEL = 2048, MROWS = 8320, MPAD = 8448, NIN = 14336, DFF = 5632, NWAVES = 8;
constexpr float EPS = 1e-6f;
constexpr size_t MiB = 1u << 20;
constexpr size_t WS_CTL = 0, CTL_ZERO_BYTES = 1 * MiB;
constexpr size_t WS_WRO = 1 * MiB, WS_WHO = 9 * MiB, WS_WOUT = 13 * MiB, WS_WFI = 21 * MiB, WS_WFO = 65 * MiB, WS_WIN = 87 * MiB;
constexpr size_t WS_XB = 143 * MiB;
constexpr size_t WS_Q = 176 * MiB, WS_K = WS_Q + 8448ull * 1024 * 2, WS_V = 209 * MiB, WS_RG = 242 * MiB, WS_HQ = 275 * MiB, WS_LOGF = WS_HQ + 8448ull * 1024 * 2;
constexpr size_t WS_HI = WS_LOGF + 8448ull * 1024 * 4, WS_HG = WS_HI + 8448ull * 1024 * 2, WS_GA = WS_HG + 8448ull * 1024 * 2, WS_GB = WS_GA + 8448ull * 2048 * 2;
constexpr size_t WS_KVLOC = WS_GB + 8448ull * 2048 * 2;
constexpr size_t WS_HSLOC = WS_KVLOC + 64 * MiB;
constexpr size_t WS_OH = WS_HSLOC + 32 * MiB;
constexpr size_t WS_MISC = WS_OH + 8448ull * 1024 * 2;
constexpr size_t WS_RR1 = WS_MISC, WS_COS = WS_RR1 + 64 * 1024, WS_SIN = WS_COS + 2049 * 64 * 4 + 256, WS_LB = WS_SIN + 2049 * 64 * 4 + 256, WS_BTOT = WS_LB + 4096, WS_END = WS_BTOT + 512 * 128 * 4;
constexpr size_t WS_OR = WS_XB;
constexpr size_t WS_SRT = WS_WIN, WS_SHT = WS_WIN + 32 * MiB;
constexpr size_t WS_YT = WS_KVLOC;
constexpr size_t WS_MG = WS_Q;
constexpr size_t WS_X1B = WS_V;
constexpr size_t WS_ACT = WS_RG;
static_assert(WS_GB + 8448ull * 2048 * 2 == WS_KVLOC && WS_K + 8448ull * 1024 * 2 == WS_V && WS_V + 8448ull * 2048 * 2 == WS_RG && WS_RG + 8448ull * 2048 * 2 == WS_HQ, "map");
static_assert(WS_YT + 8448ull * 2048 * 4 <= WS_OH && WS_ACT + 8448ull * 5632 * 2 <= WS_GA && WS_END <= 541 * MiB, "map2");
constexpr int CW_BAR = 4096;
constexpr int CW_SS1 = 16384, CW_SS2 = 16384 + 8448;
static_assert((CW_SS2 + 8448) * 4 <= (int)CTL_ZERO_BYTES, "ctl");
constexpr int RING_BYTES = 131072, LDSCTL_OFF = RING_BYTES, MISC_OFF = LDSCTL_OFF + 320, LDS_BYTES = 147456;

#define GAS __attribute__((address_space(1)))
#define LAS __attribute__((address_space(3)))
typedef unsigned short bf16;
typedef unsigned v4u __attribute__((ext_vector_type(4)));
typedef unsigned v2u __attribute__((ext_vector_type(2)));
typedef float f32x4 __attribute__((ext_vector_type(4)));
typedef short bf16x8 __attribute__((ext_vector_type(8)));
typedef GAS unsigned gu32;
#define RLX_AGENT __ATOMIC_RELAXED, __HIP_MEMORY_SCOPE_AGENT
#define LDS_WAIT() asm volatile("s_waitcnt lgkmcnt(0)" ::: "memory")
#define VM_WAIT() asm volatile("s_waitcnt vmcnt(0)" ::: "memory")
typedef __bf16 hbf2 __attribute__((ext_vector_type(2)));
typedef float hf2 __attribute__((ext_vector_type(2)));
__device__ __forceinline__ unsigned f2bf(float f) { return (unsigned)__builtin_bit_cast(unsigned short, (__bf16)f); }
__device__ __forceinline__ unsigned pk2(float lo, float hi) { const hf2 v = {lo, hi}; return __builtin_bit_cast(unsigned, __builtin_convertvector(v, hbf2)); }
__device__ __forceinline__ float bf2f(unsigned short b) { return __uint_as_float(((unsigned)b) << 16); }
namespace pg8 {
#define PG8_LAS __attribute__((address_space(3)))
typedef unsigned short bf16_t;
typedef short bf16x8 __attribute__((ext_vector_type(8)));
typedef float f32x4 __attribute__((ext_vector_type(4)));
typedef unsigned u32x4 __attribute__((ext_vector_type(4)));
constexpr int BM = 256, BK = 64, HALF = 128, HTB = HALF * BK * 2  , STAGE_BYTES = 8 * HTB, NXCD = 8, WGM = 8;

__host__ __device__ __forceinline__ int lds_byte(int r, int c) { const int st = (r >> 4) * 2 + (c >> 5), rr = r & 15, cc = c & 31, ob = rr * 64 + cc * 2; return st * 1024 + (ob ^ (((ob >> 9) & 1) << 5)); }
__host__ __device__ __forceinline__ void stage_rc(int b, int& R, int& C) { const int st = b / 1024, sb = b % 1024, swz = sb ^ (((sb >> 9) & 1) << 5); R = (st >> 1) * 16 + swz / 64; C = (st & 1) * 32 + (swz % 64) / 2; }
__host__ __device__ __forceinline__ int perm32(int rho) { const int n = rho >> 4, i = rho & 15; return 8 * (i >> 2) + 4 * n + (i & 3); }

struct Unit { int pm, pn; };
struct Gemm { const bf16_t* A; const bf16_t* Bt; int M, N, K; };

struct StaticOrder {
    int nM, nN, nwg, G, c;
    __host__ __device__ void init(int M, int N, int G_, int c_) { nM = M / BM; nN = N / BM; nwg = nM * nN; G = G_; c = c_; }
    __host__ __device__ bool next(int i, Unit& u) const {
        const long L = (long)i * G + c; if (L >= nwg) return false;
        int wgid = (int)L; { const int q = nwg / NXCD, r = nwg % NXCD, xcd = wgid % NXCD, off = wgid / NXCD; wgid = (xcd < r ? xcd * (q + 1) : r * (q + 1) + (xcd - r) * q) + off; }
        const int nig = WGM * nN, gid = wgid / nig, fm = gid * WGM, gsz = (nM - fm) < WGM ? (nM - fm) : WGM;
        u.pm = fm + ((wgid % nig) % gsz); u.pn = (wgid % nig) / gsz; return true;
    }
    __device__ __forceinline__ void a_ready(const Unit&) const {}
    __device__ __forceinline__ void done(const Unit&) const {}
};

__device__ __forceinline__ unsigned cvt_pk_bf16(float lo, float hi) { unsigned r; asm volatile("v_cvt_pk_bf16_f32 %0, %1, %2" : "=v"(r) : "v"(lo), "v"(hi)); return r; }
typedef float f32x2 __attribute__((ext_vector_type(2)));
typedef unsigned u32x2 __attribute__((ext_vector_type(2)));
__device__ __forceinline__ float sigm(float x) { return __builtin_amdgcn_rcpf(1.0f + __expf(-x)); }
__device__ __forceinline__ f32x4 silu4(f32x4 v) { f32x4 o; o[0] = v[0] * sigm(v[0]); o[1] = v[1] * sigm(v[1]); o[2] = v[2] * sigm(v[2]); o[3] = v[3] * sigm(v[3]); return o; }
__device__ __forceinline__ f32x4 sigm4(f32x4 v) { f32x4 o; o[0] = sigm(v[0]); o[1] = sigm(v[1]); o[2] = sigm(v[2]); o[3] = sigm(v[3]); return o; }
__device__ __forceinline__ u32x4 pack8(f32x4 v0, f32x4 v1) { u32x4 w; w.x = cvt_pk_bf16(v0[0], v0[1]); w.y = cvt_pk_bf16(v0[2], v0[3]); w.z = cvt_pk_bf16(v1[0], v1[1]); w.w = cvt_pk_bf16(v1[2], v1[3]); return w; }
__device__ __forceinline__ u32x2 pack4(f32x4 v) { u32x2 w; w.x = cvt_pk_bf16(v[0], v[1]); w.y = cvt_pk_bf16(v[2], v[3]); return w; }
__device__ __forceinline__ f32x4 unpack4(u32x2 w) { f32x4 o; o[0] = __uint_as_float(w.x << 16); o[1] = __uint_as_float(w.x & 0xffff0000u); o[2] = __uint_as_float(w.y << 16); o[3] = __uint_as_float(w.y & 0xffff0000u); return o; }

struct EpiInProj {
    static constexpr bool PERM = true, AFTER_DRAIN = false;
    unsigned char* ws;
    __device__ __forceinline__ void operator()(const f32x4 (&acc)[2][2][4][2], const Unit& u, int wr, int wc, int fr, int fq) const {
        const int pn = u.pn, row0 = u.pm * BM + wr * 64 + fr;
        if (pn >= 28 && pn < 32) {
            float* Z = (float*)(ws + WS_LOGF); const int cs = (pn - 28) * 256 + wc * 32 + 8 * fq;
#pragma unroll
            for (int ai = 0; ai < 2; ++ai)
#pragma unroll
                for (int m = 0; m < 4; ++m) { const int r = row0 + ai * HALF + m * 16;
#pragma unroll
                    for (int bj = 0; bj < 2; ++bj)
#pragma unroll
                        for (int n = 0; n < 2; ++n) *(f32x4*)(Z + (size_t)r * 1024 + cs + bj * HALF + 4 * n) = acc[ai][bj][m][n]; }
        } else {
            size_t od; int pitch, p0, act; float sc = 1.0f;
            if (pn < 4) { od = WS_Q; pitch = 1024; p0 = 0; act = 0; } else if (pn < 8) { od = WS_K; pitch = 1024; p0 = 4; act = 0; sc = 0.08838834764831845f; }
            else if (pn < 16) { od = WS_V; pitch = 2048; p0 = 8; act = 0; } else if (pn < 24) { od = WS_RG; pitch = 2048; p0 = 16; act = 1; } else if (pn < 28) { od = WS_HQ; pitch = 1024; p0 = 24; act = 1; }
            else if (pn < 36) { od = WS_HI; pitch = 1024; p0 = 32; act = 0; } else if (pn < 40) { od = WS_HG; pitch = 1024; p0 = 36; act = 1; } else if (pn < 48) { od = WS_GA; pitch = 2048; p0 = 40; act = 2; } else { od = WS_GB; pitch = 2048; p0 = 48; act = 2; }
            bf16_t* dst = (bf16_t*)(ws + od);
            const int cs = (pn - p0) * 256 + wc * 32 + 8 * fq;
#pragma unroll
            for (int ai = 0; ai < 2; ++ai)
#pragma unroll
                for (int m = 0; m < 4; ++m) { const int r = row0 + ai * HALF + m * 16; bf16_t* rowp = dst + (size_t)r * pitch + cs;
#pragma unroll
                    for (int bj = 0; bj < 2; ++bj) { f32x4 v0 = acc[ai][bj][m][0] * sc, v1 = acc[ai][bj][m][1] * sc;
                        if (act == 1) { v0 = silu4(v0); v1 = silu4(v1); } else if (act == 2) { v0 = sigm4(v0); v1 = sigm4(v1); }
                        *(u32x4*)(rowp + bj * HALF) = pack8(v0, v1); } }
        }
    }
};
struct EpiNull {
    static constexpr bool PERM = true, AFTER_DRAIN = false;
    __device__ __forceinline__ void operator()(const f32x4 (&acc)[2][2][4][2], const Unit& u, int wr, int wc, int fr, int fq) const {
#pragma unroll
        for (int ai = 0; ai < 2; ++ai)
#pragma unroll
            for (int m = 0; m < 4; ++m)
#pragma unroll
                for (int bj = 0; bj < 2; ++bj) { asm volatile("" :: "v"(acc[ai][bj][m][0]), "v"(acc[ai][bj][m][1])); }
    }
};
template <int SECOND> struct EpiGate {
    static constexpr bool PERM = true, AFTER_DRAIN = false;
    const bf16_t* G; float* YT; bf16_t* MG;
    __device__ __forceinline__ void operator()(const f32x4 (&acc)[2][2][4][2], const Unit& u, int wr, int wc, int fr, int fq) const {
        const int row0 = u.pm * BM + wr * 64 + fr, col0 = u.pn * BM + wc * 32 + 8 * fq;
#pragma unroll
        for (int ai = 0; ai < 2; ++ai)
#pragma unroll
            for (int m = 0; m < 4; ++m) { const size_t off = (size_t)(row0 + ai * HALF + m * 16) * 2048 + col0;
#pragma unroll
                for (int bj = 0; bj < 2; ++bj) { const u32x4 gw = *(const u32x4*)(G + off + bj * HALF);
                    f32x4 v0 = acc[ai][bj][m][0] * unpack4((u32x2){gw.x, gw.y}), v1 = acc[ai][bj][m][1] * unpack4((u32x2){gw.z, gw.w});
                    float* yp = YT + off + bj * HALF;
                    if (SECOND) { v0 += *(const f32x4*)yp; v1 += *(const f32x4*)(yp + 4); *(u32x4*)(MG + off + bj * HALF) = pack8(v0, v1); }
                    else { *(f32x4*)yp = v0; *(f32x4*)(yp + 4) = v1; } } }
        __builtin_amdgcn_s_waitcnt(0x0F70);
    }
};
struct EpiResid {
    static constexpr bool PERM = true, AFTER_DRAIN = false;
    const float* XP; const float* XS; float* OUT; bf16_t* XB; float* SS;
    __device__ __forceinline__ void operator()(const f32x4 (&acc)[2][2][4][2], const Unit& u, int wr, int wc, int fr, int fq) const {
        const int row0 = u.pm * BM + wr * 64 + fr, col0 = u.pn * BM + wc * 32 + 8 * fq;
#pragma unroll
        for (int ai = 0; ai < 2; ++ai)
#pragma unroll
            for (int m = 0; m < 4; ++m) { const int r = row0 + ai * HALF + m * 16; const bool live = r < 8320;
                const float* xi = (r < 8192 ? XP + (size_t)r * 2048 : XS + (size_t)(r - 8192) * 2048) + col0; float ss = 0.f;
#pragma unroll
                for (int bj = 0; bj < 2; ++bj) { f32x4 v0 = acc[ai][bj][m][0], v1 = acc[ai][bj][m][1];
                    if (live) { v0 += *(const f32x4*)(xi + bj * HALF); v1 += *(const f32x4*)(xi + bj * HALF + 4);
                        float* op = OUT + (size_t)r * 2048 + col0 + bj * HALF; *(f32x4*)op = v0; *(f32x4*)(op + 4) = v1; }
                    if (XB) *(u32x4*)(XB + (size_t)r * 2048 + col0 + bj * HALF) = pack8(v0, v1);
                    ss += (v0[0] * v0[0] + v0[1] * v0[1]) + (v0[2] * v0[2] + v0[3] * v0[3]) + (v1[0] * v1[0] + v1[1] * v1[1]) + (v1[2] * v1[2] + v1[3] * v1[3]); }
                ss += __shfl_xor(ss, 16); ss += __shfl_xor(ss, 32);
                if (fq == 0) atomicAdd(SS + r, ss); }
        __builtin_amdgcn_s_waitcnt(0x0F70);
    }
};
struct EpiSwiglu {
    static constexpr bool PERM = true, AFTER_DRAIN = false;
    const float* SS; bf16_t* ACT;
    __device__ __forceinline__ void operator()(const f32x4 (&acc)[2][2][4][2], const Unit& u, int wr, int wc, int fr, int fq) const {
        const int row0 = u.pm * BM + wr * 64 + fr, col0 = u.pn * HALF + wc * 32 + 8 * fq;
        float ssv[2][4];
#pragma unroll
        for (int ai = 0; ai < 2; ++ai)
#pragma unroll
            for (int m = 0; m < 4; ++m) ssv[ai][m] = SS[row0 + ai * HALF + m * 16];
        __builtin_amdgcn_s_waitcnt(0x0F70);
#pragma unroll
        for (int ai = 0; ai < 2; ++ai)
#pragma unroll
            for (int m = 0; m < 4; ++m) { const int r = row0 + ai * HALF + m * 16; const float r2 = 1.0f / sqrtf(ssv[ai][m] * (1.0f / 2048.0f) + 1e-6f);
                const f32x4 g0 = acc[ai][0][m][0] * r2, g1 = acc[ai][0][m][1] * r2, u0 = acc[ai][1][m][0] * r2, u1 = acc[ai][1][m][1] * r2;
                *(u32x4*)(ACT + (size_t)r * 5632 + col0) = pack8(silu4(g0) * u0, silu4(g1) * u1); }
    }
};
template <class Epi, class Sched, bool ALIGN_EPI = false, bool SP2 = false>
__device__ __forceinline__ void gemm_phase(PG8_LAS unsigned char* lds, const Gemm g, const Sched& S, const Epi& E) {
    int tid_ = threadIdx.x; asm volatile("" : "+v"(tid_));
    const int tid = tid_, wid = __builtin_amdgcn_readfirstlane(tid >> 6), lane = tid & 63, wr = wid >> 2, wc = wid & 3, fr = lane & 15, fq = lane >> 4;
    const int K = g.K, nt = K / BK;
    unsigned voffA[2], voffB[2];
#pragma unroll
    for (int i = 0; i < 2; ++i) { int R, C; stage_rc(tid * 16 + i * 8192, R, C); const int Rb = Epi::PERM ? ((R & ~31) + perm32(R & 31)) : R;
        voffA[i] = (unsigned)(R * K + C) * 2u; voffB[i] = (unsigned)(Rb * K + C) * 2u; }
    const size_t kstep = (size_t)(BK * 2);
    const size_t hstep = (size_t)HALF * K * 2;
    const size_t tstep = 2 * hstep;
    const unsigned ldsw = (unsigned)wid * 1024u;
    const int aoff = lds_byte(wr * 64 + fr, fq * 8), boff = lds_byte(wc * 32 + fr, fq * 8);
#define PG8_SA(b, h) (((b) * 2 + (h)) * HTB)
#define PG8_SB(b, h) ((4 + (b) * 2 + (h)) * HTB)
#define PG8_STAGE(bufoff, gbase, voff) do { _Pragma("unroll") for (int _i = 0; _i < 2; ++_i) \
        __builtin_amdgcn_global_load_lds((const unsigned*)((const char*)(gbase) + (voff)[_i]), (PG8_LAS unsigned*)(lds + (bufoff) + ldsw + _i * 8192), 16, 0, 0); } while (0)
#define PG8_LDA(dst, b, h) do { _Pragma("unroll") for (int m = 0; m < 4; ++m) _Pragma("unroll") for (int k = 0; k < 2; ++k) dst[m][k] = *(const PG8_LAS bf16x8*)(lds + PG8_SA(b, h) + aoff + m * 2048 + k * 1024); } while (0)
#define PG8_LDB(dst, b, h) do { _Pragma("unroll") for (int n = 0; n < 2; ++n) _Pragma("unroll") for (int k = 0; k < 2; ++k) dst[n][k] = *(const PG8_LAS bf16x8*)(lds + PG8_SB(b, h) + boff + n * 2048 + k * 1024); } while (0)
#define PG8_MMA(ai, bj, At, Bt) do { __builtin_amdgcn_s_setprio(1); _Pragma("unroll") for (int m = 0; m < 4; ++m) _Pragma("unroll") for (int n = 0; n < 2; ++n) _Pragma("unroll") for (int k = 0; k < 2; ++k) \
        acc[ai][bj][m][n] = __builtin_amdgcn_mfma_f32_16x16x32_bf16(Bt[n][k], At[m][k], acc[ai][bj][m][n], 0, 0, 0); __builtin_amdgcn_s_setprio(0); } while (0)
#define PG8_WAIT_V(n) asm volatile("s_waitcnt vmcnt(" #n ")" ::: "memory")
#define PG8_WAIT_L(n) asm volatile("s_waitcnt lgkmcnt(" #n ")" ::: "memory")
#define PG8_BAR __builtin_amdgcn_s_barrier()
#define PG8_SCHED __builtin_amdgcn_sched_barrier(0)
    Unit cur, nxt; int ui = 0;
    if (!S.next(0, cur)) return;
    f32x4 acc[2][2][4][2];
#pragma unroll
    for (int a = 0; a < 2; ++a)
#pragma unroll
        for (int b = 0; b < 2; ++b)
#pragma unroll
            for (int m = 0; m < 4; ++m)
#pragma unroll
                for (int n = 0; n < 2; ++n) acc[a][b][m][n] = (f32x4){0.f, 0.f, 0.f, 0.f};
    bf16x8 At[4][2], B0[2][2], B1[2][2];
    const char* cA = (const char*)g.A + (size_t)cur.pm * tstep; const char* cB = (const char*)g.Bt + (size_t)cur.pn * tstep;
    S.a_ready(cur);
    if constexpr (SP2) {
        PG8_STAGE(PG8_SB(0, 0), cB, voffB); PG8_STAGE(PG8_SB(0, 1), cB + hstep, voffB); PG8_STAGE(PG8_SA(0, 0), cA, voffA); PG8_STAGE(PG8_SA(0, 1), cA + hstep, voffA);
        if (wr == 1) PG8_BAR;
        PG8_WAIT_V(2); PG8_BAR;
        PG8_STAGE(PG8_SB(1, 0), cB + kstep, voffB); PG8_STAGE(PG8_SA(1, 0), cA + kstep, voffA); PG8_STAGE(PG8_SB(1, 1), cB + hstep + kstep, voffB);
        PG8_WAIT_V(6); PG8_BAR;
    } else {
        PG8_STAGE(PG8_SB(0, 0), cB, voffB); PG8_STAGE(PG8_SA(0, 0), cA, voffA); PG8_STAGE(PG8_SB(0, 1), cB + hstep, voffB); PG8_STAGE(PG8_SA(0, 1), cA + hstep, voffA);
        if (wr == 1) PG8_BAR;
        PG8_WAIT_V(4); PG8_BAR;
        PG8_STAGE(PG8_SB(1, 0), cB + kstep, voffB); PG8_STAGE(PG8_SA(1, 0), cA + kstep, voffA); PG8_STAGE(PG8_SB(1, 1), cB + hstep + kstep, voffB);
        PG8_WAIT_V(6); PG8_BAR;
    }
    for (;;) {
        const bool has_next = S.next(ui + 1, nxt);
        const char* nA = has_next ? (const char*)g.A + (size_t)nxt.pm * tstep : cA; const char* nB = has_next ? (const char*)g.Bt + (size_t)nxt.pn * tstep : cB;
        for (int t = 0; t < nt; t += 2) {
            const bool last = (t == nt - 2);
            const char* a1 = cA + (size_t)(t + 1) * kstep;
            const char* a2 = last ? nA : cA + (size_t)(t + 2) * kstep; const char* b2 = last ? nB : cB + (size_t)(t + 2) * kstep;
            const char* a3 = a2 + kstep; const char* b3 = b2 + kstep;
            if (last && has_next) S.a_ready(nxt);
            if constexpr (SP2) {
            PG8_LDB(B0, 0, 0); PG8_LDB(B1, 0, 1); PG8_SCHED; PG8_LDA(At, 0, 0); PG8_STAGE(PG8_SA(1, 1), a1 + hstep, voffA);
            PG8_WAIT_V(8); PG8_WAIT_L(0); PG8_BAR; PG8_MMA(0, 0, At, B0); PG8_MMA(0, 1, At, B1); PG8_BAR; PG8_SCHED;
            PG8_LDA(At, 0, 1); PG8_STAGE(PG8_SB(0, 0), b2, voffB); PG8_STAGE(PG8_SB(0, 1), b2 + hstep, voffB); PG8_STAGE(PG8_SA(0, 0), a2, voffA);
            PG8_WAIT_V(8); PG8_WAIT_L(0); PG8_BAR; PG8_MMA(1, 0, At, B0); PG8_MMA(1, 1, At, B1); PG8_BAR; PG8_SCHED;
            PG8_LDB(B0, 1, 0); PG8_LDB(B1, 1, 1); PG8_SCHED; PG8_LDA(At, 1, 0); PG8_STAGE(PG8_SA(0, 1), a2 + hstep, voffA);
            PG8_WAIT_V(8); PG8_WAIT_L(0); PG8_BAR; PG8_MMA(0, 0, At, B0); PG8_MMA(0, 1, At, B1); PG8_BAR; PG8_SCHED;
            PG8_LDA(At, 1, 1); PG8_STAGE(PG8_SB(1, 0), b3, voffB); PG8_STAGE(PG8_SB(1, 1), b3 + hstep, voffB); PG8_STAGE(PG8_SA(1, 0), a3, voffA);
            PG8_WAIT_V(8); PG8_WAIT_L(0); PG8_BAR; PG8_MMA(1, 0, At, B0); PG8_MMA(1, 1, At, B1); PG8_BAR; PG8_SCHED;
            } else {
            PG8_LDB(B0, 0, 0); PG8_SCHED; PG8_LDA(At, 0, 0); PG8_STAGE(PG8_SA(1, 1), a1 + hstep, voffA);
            PG8_WAIT_L(8); PG8_BAR; PG8_WAIT_L(0); PG8_MMA(0, 0, At, B0); PG8_BAR; PG8_SCHED;
            PG8_LDB(B1, 0, 1); PG8_STAGE(PG8_SB(0, 0), b2, voffB);
            PG8_BAR; PG8_WAIT_L(0); PG8_MMA(0, 1, At, B1); PG8_BAR;
            PG8_LDA(At, 0, 1); PG8_STAGE(PG8_SA(0, 0), a2, voffA);
            PG8_BAR; PG8_WAIT_L(0); PG8_MMA(1, 0, At, B0); PG8_BAR; PG8_SCHED;
            PG8_STAGE(PG8_SB(0, 1), b2 + hstep, voffB);
            PG8_WAIT_V(6); PG8_BAR; PG8_MMA(1, 1, At, B1); PG8_BAR;
            PG8_LDB(B0, 1, 0); PG8_SCHED; PG8_LDA(At, 1, 0); PG8_STAGE(PG8_SA(0, 1), a2 + hstep, voffA);
            PG8_WAIT_L(8); PG8_BAR; PG8_WAIT_L(0); PG8_MMA(0, 0, At, B0); PG8_BAR; PG8_SCHED;
            PG8_LDB(B1, 1, 1); PG8_STAGE(PG8_SB(1, 0), b3, voffB);
            PG8_BAR; PG8_WAIT_L(0); PG8_MMA(0, 1, At, B1); PG8_BAR;
            PG8_LDA(At, 1, 1); PG8_STAGE(PG8_SA(1, 0), a3, voffA);
            PG8_BAR; PG8_WAIT_L(0); PG8_MMA(1, 0, At, B0); PG8_BAR; PG8_SCHED;
            PG8_STAGE(PG8_SB(1, 1), b3 + hstep, voffB);
            PG8_WAIT_V(6); PG8_BAR; PG8_MMA(1, 1, At, B1); PG8_BAR;
            }
        }
        if constexpr (ALIGN_EPI) { if (wr == 0) PG8_BAR; }
        if constexpr (!Epi::AFTER_DRAIN) { E(acc, cur, wr, wc, fr, fq); S.done(cur); }
        if (!has_next) break;
#pragma unroll
        for (int a = 0; a < 2; ++a)
#pragma unroll
            for (int b = 0; b < 2; ++b)
#pragma unroll
                for (int m = 0; m < 4; ++m)
#pragma unroll
                    for (int n = 0; n < 2; ++n) acc[a][b][m][n] = (f32x4){0.f, 0.f, 0.f, 0.f};
        cur = nxt; cA = nA; cB = nB; ++ui;
        if constexpr (ALIGN_EPI) { if (wr == 1) PG8_BAR; }
    }
    PG8_WAIT_V(0);
    if constexpr (!ALIGN_EPI) { if (wr == 0) PG8_BAR; }
    PG8_BAR;
    if constexpr (Epi::AFTER_DRAIN) { E.fused(acc, cur, wr, wc, fr, fq, lds, wid, lane); S.done(cur); }
#undef PG8_SA
#undef PG8_SB
#undef PG8_STAGE
#undef PG8_LDA
#undef PG8_LDB
#undef PG8_MMA
#undef PG8_WAIT_V
#undef PG8_WAIT_L
#undef PG8_BAR
#undef PG8_SCHED
}
}
#define XB_TMO      128
#define XB_XCNT(j)  (256  + 64 * (j))
#define XB_XSUB(j)  (1280 + 64 * (j))
#define XB_XGEN(j)  (2304 + 64 * (j))
#define XB_TOP      3328
#define XB_TOPGEN   3392
#define XCD_BAR_WORDS 3456
#define XB_SPIN_CAP (1u << 18)

__device__ __forceinline__ unsigned xb_ld(unsigned* p)              { return __hip_atomic_load(p, __ATOMIC_RELAXED, __HIP_MEMORY_SCOPE_AGENT); }
__device__ __forceinline__ unsigned xb_add(unsigned* p, unsigned v) { return __hip_atomic_fetch_add(p, v, __ATOMIC_RELAXED, __HIP_MEMORY_SCOPE_AGENT); }
__device__ __forceinline__ unsigned xb_xcc_id() { return (unsigned)__builtin_amdgcn_s_getreg((3 << 11) | 20) & 0xFu; }
#define XB_SPIN(cond, bar) do { unsigned _sp = 0; while (cond) { __builtin_amdgcn_s_sleep(1); \
    if ((++_sp & 255u) == 0u) { if (xb_ld(&(bar)[XB_TMO])) break; if (_sp > XB_SPIN_CAP) { atomicAdd(&(bar)[XB_TMO], 1u); break; } } } } while (0)

struct XcdBarrier {
    unsigned* bar; unsigned x;
    volatile LAS unsigned* st;
};

__device__ __forceinline__ XcdBarrier xcd_barrier_post(unsigned* bar, volatile LAS unsigned* st) {
    XcdBarrier b; b.bar = bar; b.x = xb_xcc_id(); b.st = st;
    if (threadIdx.x == 0) (void)xb_add(&bar[XB_XCNT(b.x)], 1u);
    return b;
}
__device__ __forceinline__ void xcd_barrier_complete(unsigned* bar, unsigned x, unsigned& nloc, unsigned& nx) {
    const unsigned G = gridDim.x * gridDim.y * gridDim.z;
    unsigned sum, cnt, mine, sp = 0u;
    for (;;) {
        sum = 0u; cnt = 0u; mine = 0u;
#pragma unroll
        for (unsigned j = 0; j < 16; ++j) { const unsigned c = xb_ld(&bar[XB_XCNT(j)]); sum += c; cnt += (c > 0u) ? 1u : 0u; mine = (j == x) ? c : mine; }
        if (sum == G) break;
        __builtin_amdgcn_s_sleep(1);
        if ((++sp & 255u) == 0u) { if (xb_ld(&bar[XB_TMO])) break; if (sp > XB_SPIN_CAP) { atomicAdd(&bar[XB_TMO], 1u); break; } }
    }
    nloc = mine > 0u ? mine : 1u; nx = cnt > 0u ? cnt : 1u;
}

__device__ __forceinline__ void xcd_barrier(const XcdBarrier& b) {
    asm volatile("s_waitcnt vmcnt(0)" ::: "memory");
    __syncthreads();
    if (threadIdx.x == 0) {
        unsigned* bar = b.bar;
        __builtin_amdgcn_s_waitcnt(0);
        unsigned nloc = b.st[0], nx = b.st[1];
        if (nloc == 0u) { xcd_barrier_complete(bar, b.x, nloc, nx); b.st[0] = nloc; b.st[1] = nx; }
        const unsigned old = xb_add(&bar[XB_XSUB(b.x)], 1u);
        const unsigned gen = old / nloc;
        if (old + 1u == (gen + 1u) * nloc) {
            __builtin_amdgcn_fence(__ATOMIC_RELEASE, "agent");
            asm volatile("s_waitcnt vmcnt(0)" ::: "memory");
            const unsigned og = xb_add(&bar[XB_TOP], 1u);
            const unsigned tg = og / nx;
            if (og + 1u == (tg + 1u) * nx) xb_add(&bar[XB_TOPGEN], 1u);
            else XB_SPIN(xb_ld(&bar[XB_TOPGEN]) == tg, bar);
            __builtin_amdgcn_fence(__ATOMIC_ACQUIRE, "agent");
            xb_add(&bar[XB_XGEN(b.x)], 1u);
            asm volatile("s_waitcnt vmcnt(0)" ::: "memory");
        } else {
            XB_SPIN(xb_ld(&bar[XB_XGEN(b.x)]) == gen, bar);
            __builtin_amdgcn_fence(__ATOMIC_ACQUIRE, "agent");
            asm volatile("s_waitcnt vmcnt(0)" ::: "memory");
        }
    }
    __syncthreads();
}
struct Frame {
    LAS unsigned char* lds; volatile LAS unsigned* MISC; gu32* ctl;
    int tid, lane, wave, vcu, G;
    float* out; unsigned char* ws;
};
__device__ __forceinline__ void delay_us(int us) { const unsigned long long t0 = __builtin_amdgcn_s_memrealtime(); while (__builtin_amdgcn_s_memrealtime() - t0 < (unsigned long long)us * 100ull) __builtin_amdgcn_s_sleep(8); }
__device__ __forceinline__ float wave_sum(float v) {
#pragma unroll
    for (int o = 1; o < 64; o <<= 1) v += __shfl_xor(v, o);
    return v;
}
template <int MODE> __device__ __forceinline__ int rowmap(int n) {
    if (MODE == 1) { if (n >= 2048) return n; const int j = n & 127, hb = n & ~127; return hb + (j < 64 ? 8 * (j >> 2) + (j & 3) : 8 * ((j - 64) >> 2) + 4 + (j & 3)); }
    if (MODE == 2) { return n < DFF ? (n >> 7) * 256 + (n & 127) : ((n - DFF) >> 7) * 256 + 128 + ((n - DFF) & 127); }
    return n;
}
template <int MODE> __device__ __forceinline__ void p0_transpose_item(const float* W, int K, int N, bf16* WT, const float* g, LAS unsigned* T, int item, int lane) {
    const int nblk = N / 64, kb = item / nblk, nb = item % nblk, k0 = 64 * kb, n0 = 64 * nb;
    const int l15 = lane & 15, lg = lane >> 4;
    f32x4 v[16];
#pragma unroll
    for (int i = 0; i < 16; ++i) { const int row = 8 * (i >> 1) + 2 * lg + (i & 1); v[i] = *(const f32x4*)(W + (size_t)(k0 + row) * N + n0 + 4 * l15); }
    if (g) {
#pragma unroll
        for (int i = 0; i < 16; ++i) { const int row = 8 * (i >> 1) + 2 * lg + (i & 1); v[i] = v[i] * g[k0 + row]; } }
#pragma unroll
    for (int p = 0; p < 8; ++p)
#pragma unroll
        for (int j = 0; j < 4; ++j) T[(4 * l15 + j) * 33 + 4 * p + lg] = pk2(v[2 * p][j], v[2 * p + 1][j]);
    LDS_WAIT(); asm volatile("" ::: "memory");
    const int c = lane & 7;
#pragma unroll
    for (int i = 0; i < 8; ++i) { const int n = (lane >> 3) + 8 * i; const LAS unsigned* s = T + n * 33 + 4 * c;
        v4u o; o.x = s[0]; o.y = s[1]; o.z = s[2]; o.w = s[3];
        *(GAS v4u*)(WT + (size_t)rowmap<MODE>(n0 + n) * K + k0 + 8 * c) = o; }
    LDS_WAIT(); asm volatile("" ::: "memory");
}
struct Args { const float* in[15]; float* out; unsigned char* ws; int ph_lo, ph_hi, use_bar, pad; };
__device__ __forceinline__ void p0_prologue(Frame& F, const Args& A) {
    LAS unsigned* scr = (LAS unsigned*)(F.lds + F.wave * 16384);
    const int gw = F.vcu * NWAVES + F.wave, NGW = F.G * NWAVES;
    unsigned char* ws = F.ws;
    constexpr int I_IN = 32 * (NIN / 64), I_RO = 32 * 32, I_HO = 16 * 32, I_OUT = 32 * 32, I_FI = 32 * (2 * DFF / 64), I_FO = (DFF / 64) * 32;
    constexpr int NITEMS = I_IN + I_RO + I_HO + I_OUT + I_FI + I_FO;
    for (int it = gw; it < NITEMS; it += NGW) {
        int r = it;
        if (r < I_IN) { p0_transpose_item<0>(A.in[4], 2048, NIN, (bf16*)(ws + WS_WIN), A.in[8], scr, r, F.lane); continue; } r -= I_IN;
        if (r < I_RO) { p0_transpose_item<0>(A.in[5], 2048, 2048, (bf16*)(ws + WS_WRO), nullptr, scr, r, F.lane); continue; } r -= I_RO;
        if (r < I_HO) { p0_transpose_item<0>(A.in[6], 1024, 2048, (bf16*)(ws + WS_WHO), nullptr, scr, r, F.lane); continue; } r -= I_HO;
        if (r < I_OUT) { p0_transpose_item<0>(A.in[7], 2048, 2048, (bf16*)(ws + WS_WOUT), nullptr, scr, r, F.lane); continue; } r -= I_OUT;
        if (r < I_FI) { p0_transpose_item<2>(A.in[12], 2048, 2 * DFF, (bf16*)(ws + WS_WFI), A.in[9], scr, r, F.lane); continue; } r -= I_FI;
        p0_transpose_item<0>(A.in[13], DFF, 2048, (bf16*)(ws + WS_WFO), nullptr, scr, r, F.lane);
    }
    bf16* XB = (bf16*)(ws + WS_XB);
    for (int m = gw; m < MPAD; m += NGW) {
        GAS unsigned long long* o8 = (GAS unsigned long long*)(XB + (size_t)m * 2048) + F.lane;
        if (m < MROWS) {
            const float* xrow = m < 8192 ? A.in[0] + (size_t)m * 2048 : A.in[1] + (size_t)(m - 8192) * 2048;
            const GAS f32x4* xr = (const GAS f32x4*)xrow + F.lane;
            f32x4 v[8]; float s = 0.f;
#pragma unroll
            for (int j = 0; j < 8; ++j) { v[j] = xr[64 * j]; s += (v[j].x * v[j].x + v[j].y * v[j].y) + (v[j].z * v[j].z + v[j].w * v[j].w); }
            const float rr = 1.0f / sqrtf(wave_sum(s) * (1.0f / 2048.0f) + EPS);
#pragma unroll
            for (int j = 0; j < 8; ++j) o8[64 * j] = (unsigned long long)pk2(v[j].x * rr, v[j].y * rr) | ((unsigned long long)pk2(v[j].z * rr, v[j].w * rr) << 32);
        } else {
#pragma unroll
            for (int j = 0; j < 8; ++j) o8[64 * j] = 0ull;
        }
    }
    { float* COS = (float*)(ws + WS_COS); float* SIN = (float*)(ws + WS_SIN);
      for (int i = (F.vcu * NWAVES + F.wave) * 64 + F.lane; i < 2049 * 64; i += F.G * NWAVES * 64) { const int p = i >> 6, j = i & 63; const int pos = p < 2048 ? p : 16384;
          const float inv = powf(10000.0f, -(float)j / 64.0f); const float ang = (float)pos * inv; float sn, cs; sincosf(ang, &sn, &cs); COS[i] = cs; SIN[i] = sn; } }
    { float* LB = (float*)(ws + WS_LB); const int i = (F.vcu * NWAVES + F.wave) * 64 + F.lane; if (i < 1024) { const float l0 = A.in[11][i], l1 = A.in[11][1024 + i]; LB[i] = 1.0f / (1.0f + expf(l1 - l0)); } }
}
typedef short bf16x4v __attribute__((ext_vector_type(4)));
#define MFMA16(a, b, c) __builtin_amdgcn_mfma_f32_16x16x32_bf16((a), (b), (c), 0, 0, 0)
constexpr int TP = 136;
constexpr size_t OUT_YS = 8192ull * 2048, OUT_SRP = 8320ull * 2048, OUT_SHP = OUT_SRP + 4ull * 8 * 128 * 256, OUT_SRS = OUT_SHP + 4ull * 8 * 128 * 128, OUT_SHS = OUT_SRS + 128ull * 8 * 128 * 256;
__device__ __forceinline__ int tsw(int r, int m) { return r * TP + ((r >> 3) << 3) + m; }
__device__ __forceinline__ int tsw64(int r, int m) { return r * 72 + ((r >> 3) << 3) + m; }
constexpr int TSZ128 = 128 * TP + 128, TSZ64R = 64 * TP + 64, TSZ32R = 32 * TP + 32, TSZ256 = 256 * TP + 256, TSZ64T = 128 * 72 + 128;
__device__ __forceinline__ float lg2gamma(int h) { return log2f(1.0f - exp2f(-5.0f - (float)h)); }
__device__ __forceinline__ float bfe(const v4u& w, int j) { const unsigned x = w[j >> 1]; return __uint_as_float((j & 1) ? (x & 0xffff0000u) : (x << 16)); }
__device__ __forceinline__ bf16x8 pack_f8(const float* v) { v4u w; w.x = pk2(v[0], v[1]); w.y = pk2(v[2], v[3]); w.z = pk2(v[4], v[5]); w.w = pk2(v[6], v[7]); return __builtin_bit_cast(bf16x8, w); }

__device__ __forceinline__ void p2_ret_unit(Frame& F, int u) {
    unsigned char* ws = F.ws;
    const int es = u & 1, h = (u >> 1) & 7, b = u >> 4;
    const int w = F.wave, l15 = F.lane & 15, g = F.lane >> 4;
    LAS bf16* KT = (LAS bf16*)F.lds; LAS bf16* VT = KT + TSZ128;
    const bf16* Kg = (const bf16*)(ws + WS_K); const bf16* Vg = (const bf16*)(ws + WS_V);
    const float* COS = (const float*)(ws + WS_COS); const float* SIN = (const float*)(ws + WS_SIN);
    const float lg = lg2gamma(h), cd = exp2f(128.0f * lg);
    const int dc = F.tid & 7, m0 = F.tid >> 3;
    const int vc = F.tid & 15, vm0 = F.tid >> 4;
    v4u ka[2], kb[2], va[4]; f32x4 cc[2][2], sn[2][2];
#define P2R_LOAD(c) do { _Pragma("unroll") for (int _i = 0; _i < 2; ++_i) { const int _m = m0 + 64 * _i, _r = b * 2048 + (c) * 128 + _m, _pos = (c) * 128 + _m, _d0 = 8 * dc; \
        const bf16* _kp = Kg + (size_t)_r * 1024 + h * 128 + _d0; ka[_i] = *(const v4u*)_kp; kb[_i] = *(const v4u*)(_kp + 64); \
        cc[_i][0] = *(const f32x4*)(COS + _pos * 64 + _d0); cc[_i][1] = *(const f32x4*)(COS + _pos * 64 + _d0 + 4); sn[_i][0] = *(const f32x4*)(SIN + _pos * 64 + _d0); sn[_i][1] = *(const f32x4*)(SIN + _pos * 64 + _d0 + 4); } \
        _Pragma("unroll") for (int _i = 0; _i < 4; ++_i) va[_i] = *(const v4u*)(Vg + (size_t)(b * 2048 + (c) * 128 + vm0 + 32 * _i) * 2048 + h * 256 + 128 * es + 8 * vc); } while (0)
    f32x4 S[8];
#pragma unroll
    for (int j = 0; j < 8; ++j) S[j] = (f32x4){0.f, 0.f, 0.f, 0.f};
    const float dec2[2] = {exp2f((float)(127 - m0) * lg), exp2f((float)(63 - m0) * lg)};
    P2R_LOAD(0);
    for (int c = 0; c < 16; ++c) {
        __syncthreads();
#pragma unroll
        for (int i = 0; i < 2; ++i) { const int m = m0 + 64 * i; const float dec = dec2[i];
            LAS bf16* k1 = KT + tsw(8 * dc, m); LAS bf16* k2 = KT + tsw(64 + 8 * dc, m);
#pragma unroll
            for (int j = 0; j < 8; ++j) { const float x1 = bfe(ka[i], j), x2 = bfe(kb[i], j), cj = cc[i][j >> 2][j & 3], sj = sn[i][j >> 2][j & 3];
                k1[j * TP] = (bf16)f2bf((x1 * cj - x2 * sj) * dec); k2[j * TP] = (bf16)f2bf((x2 * cj + x1 * sj) * dec); } }
#pragma unroll
        for (int i = 0; i < 4; ++i) { LAS bf16* vt = VT + tsw(8 * vc, vm0 + 32 * i);
#pragma unroll
            for (int j = 0; j < 8; ++j) vt[j * TP] = (bf16)((va[i][j >> 1] >> (16 * (j & 1))) & 0xffffu); }
        if (c + 1 < 16) P2R_LOAD(c + 1);
        __syncthreads();
        f32x4 kv[8];
#pragma unroll
        for (int j = 0; j < 8; ++j) kv[j] = (f32x4){0.f, 0.f, 0.f, 0.f};
#pragma unroll
        for (int ks = 0; ks < 4; ++ks) { const bf16x8 bfr = *(const LAS bf16x8*)&VT[tsw(16 * w + l15, 32 * ks + 8 * g)];
#pragma unroll
            for (int j = 0; j < 8; ++j) { const bf16x8 af = *(const LAS bf16x8*)&KT[tsw(16 * j + l15, 32 * ks + 8 * g)]; kv[j] = MFMA16(af, bfr, kv[j]); } }
        bf16* st = (bf16*)(ws + WS_SRT) + ((size_t)((b * 8 + h) * 16 + c) * 256 + 128 * es + 16 * w + l15) * 128 + 4 * g;
#pragma unroll
        for (int j = 0; j < 8; ++j) { v2u p; p.x = pk2(S[j][0], S[j][1]); p.y = pk2(S[j][2], S[j][3]); *(v2u*)(st + 16 * j) = p; S[j] = S[j] * cd + kv[j]; }
    }
#undef P2R_LOAD
    float* fo = F.out + OUT_SRP + ((size_t)(b * 8 + h) * 128 + 4 * g) * 256 + 128 * es + 16 * w + l15;
#pragma unroll
    for (int j = 0; j < 8; ++j)
#pragma unroll
        for (int reg = 0; reg < 4; ++reg) fo[(size_t)(16 * j + reg) * 256] = S[j][reg];
}
__device__ __forceinline__ void p2_hg_unit(Frame& F, int u) {
    unsigned char* ws = F.ws;
    const int es = u & 1, h = (u >> 1) & 7, b = u >> 4;
    const int w = F.wave, l15 = F.lane & 15, g = F.lane >> 4, et = w & 3, dh = w >> 2;
    LAS bf16* KT = (LAS bf16*)F.lds; LAS bf16* VT = KT + TSZ128; LAS float* LQ = (LAS float*)(VT + TSZ64R); LAS float* BT = LQ + 4 * 128;
    const float* Z = (const float*)(ws + WS_LOGF); const bf16* HI = (const bf16*)(ws + WS_HI);
    const int d = F.tid & 127, q = F.tid >> 7; const float oml = 1.0f - ((const float*)(ws + WS_LB))[h * 128 + d];
    const int vc = F.tid & 7, vm0 = F.tid >> 3;
    float z[32]; v4u va[2];
#define P2H_LOAD(sc) do { const int _r0 = b * 2048 + (sc) * 128; _Pragma("unroll") for (int _i = 0; _i < 32; ++_i) z[_i] = Z[(size_t)(_r0 + 32 * q + _i) * 1024 + h * 128 + d]; \
        _Pragma("unroll") for (int _i = 0; _i < 2; ++_i) va[_i] = *(const v4u*)(HI + (size_t)(_r0 + vm0 + 64 * _i) * 1024 + h * 128 + 64 * es + 8 * vc); } while (0)
    f32x4 S[4];
#pragma unroll
    for (int j = 0; j < 4; ++j) S[j] = (f32x4){0.f, 0.f, 0.f, 0.f};
    P2H_LOAD(0);
    for (int sc = 0; sc < 16; ++sc) {
        float lf[32], kin[32]; float L = 0.f;
#pragma unroll
        for (int i = 0; i < 32; ++i) { kin[i] = oml * __builtin_amdgcn_rcpf(1.0f + __expf(z[i])); lf[i] = __logf(1.0f - kin[i]); L += lf[i]; }
        __syncthreads();
        LQ[q * 128 + d] = L;
#pragma unroll
        for (int i = 0; i < 2; ++i) { LAS bf16* vt = VT + tsw(8 * vc, vm0 + 64 * i);
#pragma unroll
            for (int j = 0; j < 8; ++j) vt[j * TP] = (bf16)((va[i][j >> 1] >> (16 * (j & 1))) & 0xffffu); }
        if (sc + 1 < 16) P2H_LOAD(sc + 1);
        __syncthreads();
        float run = 0.f;
#pragma unroll
        for (int q2 = 1; q2 < 4; ++q2) if (q2 > q) run += LQ[q2 * 128 + d];
#pragma unroll
        for (int blk = 3; blk >= 0; --blk) { float v[8];
#pragma unroll
            for (int jj = 7; jj >= 0; --jj) { const int i = 8 * blk + jj; v[jj] = kin[i] * __expf(run); run += lf[i]; }
            *(LAS bf16x8*)&KT[tsw(d, 32 * q + 8 * blk)] = pack_f8(v); }
        if (q == 0) BT[d] = run;
        __syncthreads();
        f32x4 hs[4];
#pragma unroll
        for (int j = 0; j < 4; ++j) hs[j] = (f32x4){0.f, 0.f, 0.f, 0.f};
#pragma unroll
        for (int ks = 0; ks < 4; ++ks) { const bf16x8 bfr = *(const LAS bf16x8*)&VT[tsw(16 * et + l15, 32 * ks + 8 * g)];
#pragma unroll
            for (int j = 0; j < 4; ++j) { const bf16x8 af = *(const LAS bf16x8*)&KT[tsw(16 * (4 * dh + j) + l15, 32 * ks + 8 * g)]; hs[j] = MFMA16(af, bfr, hs[j]); } }
        bf16* st = (bf16*)(ws + WS_SHT) + ((size_t)((b * 8 + h) * 16 + sc) * 128 + 64 * es + 16 * et + l15) * 128 + 64 * dh + 4 * g;
#pragma unroll
        for (int j = 0; j < 4; ++j) { v2u p; p.x = pk2(S[j][0], S[j][1]); p.y = pk2(S[j][2], S[j][3]); *(v2u*)(st + 16 * j) = p;
            const f32x4 bt = *(const LAS f32x4*)&BT[16 * (4 * dh + j) + 4 * g];
#pragma unroll
            for (int reg = 0; reg < 4; ++reg) S[j][reg] = S[j][reg] * __expf(bt[reg]) + hs[j][reg]; }
    }
#undef P2H_LOAD
    float* fo = F.out + OUT_SHP + ((size_t)(b * 8 + h) * 128 + 64 * dh + 4 * g) * 128 + 64 * es + 16 * et + l15;
#pragma unroll
    for (int j = 0; j < 4; ++j)
#pragma unroll
        for (int reg = 0; reg < 4; ++reg) fo[(size_t)(16 * j + reg) * 128] = S[j][reg];
}
__device__ __forceinline__ void p2_sret_all(Frame& F, const Args& A, unsigned* ctr) {
    unsigned char* ws = F.ws;
    LAS float* qs = (LAS float*)F.lds; LAS float* ks = qs + 128; LAS float* vs = ks + 128; LAS float* ored = vs + 256;
    const bf16* Q = (const bf16*)(ws + WS_Q); const bf16* K = (const bf16*)(ws + WS_K); const bf16* V = (const bf16*)(ws + WS_V);
    const int e4 = F.tid & 63, dq = F.tid >> 6;
    __syncthreads();
    if (F.tid == 0) F.MISC[16] = atomicAdd(ctr, 1u);
    __syncthreads();
    int it = (int)F.MISC[16]; if (it >= 1024) return;
    f32x4 s[16];
    { const float* Sin = A.in[2] + (size_t)it * 128 * 256;
#pragma unroll
      for (int i = 0; i < 16; ++i) s[i] = *(const f32x4*)(Sin + (size_t)(16 * dq + i) * 256 + 4 * e4); }
    for (;;) {
        const int h = it & 7, b = it >> 3, r = 8192 + b;
        __syncthreads();
        if (F.tid == 0) F.MISC[16] = atomicAdd(ctr, 1u);
        if (F.tid < 64) { const int d = F.tid; const float cs = ((const float*)(ws + WS_COS))[2048 * 64 + d], sn = ((const float*)(ws + WS_SIN))[2048 * 64 + d];
            const float q1 = bf2f(Q[(size_t)r * 1024 + h * 128 + d]), q2 = bf2f(Q[(size_t)r * 1024 + h * 128 + 64 + d]), k1 = bf2f(K[(size_t)r * 1024 + h * 128 + d]), k2 = bf2f(K[(size_t)r * 1024 + h * 128 + 64 + d]);
            qs[d] = q1 * cs - q2 * sn; qs[d + 64] = q2 * cs + q1 * sn; ks[d] = k1 * cs - k2 * sn; ks[d + 64] = k2 * cs + k1 * sn; }
        else if (F.tid >= 256) { const int e = F.tid - 256; vs[e] = bf2f(V[(size_t)r * 2048 + h * 256 + e]); }
        __syncthreads();
        const int nx = (int)F.MISC[16];
        const float gam = 1.0f - exp2f(-5.0f - (float)h);
        float* Sout = F.out + OUT_SRS + (size_t)it * 128 * 256;
        const f32x4 v4 = *(const LAS f32x4*)&vs[4 * e4]; f32x4 o = (f32x4){0.f, 0.f, 0.f, 0.f};
#pragma unroll
        for (int i = 0; i < 16; ++i) { const int d = 16 * dq + i; s[i] = s[i] * gam + v4 * ks[d]; *(f32x4*)(Sout + (size_t)d * 256 + 4 * e4) = s[i]; o += s[i] * qs[d]; }
        *(LAS f32x4*)&ored[dq * 256 + 4 * e4] = o;
        if (nx < 1024) { const float* Sin = A.in[2] + (size_t)nx * 128 * 256;
#pragma unroll
            for (int i = 0; i < 16; ++i) s[i] = *(const f32x4*)(Sin + (size_t)(16 * dq + i) * 256 + 4 * e4); }
        __syncthreads();
        if (F.wave == 0) { float oo[4]; float ss = 0.f;
#pragma unroll
            for (int k = 0; k < 4; ++k) { const int e = F.lane + 64 * k; float t = 0.f;
#pragma unroll
                for (int j = 0; j < 8; ++j) t += ored[j * 256 + e];
                oo[k] = t; ss += t * t; }
            const float rr = 1.0f / sqrtf(wave_sum(ss) * (1.0f / 256.0f) + EPS);
            const bf16* RG = (const bf16*)(ws + WS_RG); bf16* OR = (bf16*)(ws + WS_OR);
#pragma unroll
            for (int k = 0; k < 4; ++k) { const size_t ix = (size_t)r * 2048 + h * 256 + F.lane + 64 * k; OR[ix] = (bf16)f2bf(oo[k] * rr * bf2f(RG[ix])); } }
        it = nx; if (it >= 1024) break;
    }
}
__device__ __forceinline__ void p2_shg_all(Frame& F, const Args& A, unsigned* ctr) {
    unsigned char* ws = F.ws;
    LAS float* qs = (LAS float*)F.lds; LAS float* fs = qs + 128; LAS float* kn = fs + 128; LAS float* vs = kn + 128; LAS float* ored = vs + 128;
    const int e4 = F.tid & 31, dq = F.tid >> 5;
    __syncthreads();
    if (F.tid == 0) F.MISC[16] = atomicAdd(ctr, 1u);
    __syncthreads();
    int it = (int)F.MISC[16]; if (it >= 1024) return;
    f32x4 s[8];
    { const float* Sin = A.in[3] + (size_t)it * 128 * 128;
#pragma unroll
      for (int i = 0; i < 8; ++i) s[i] = *(const f32x4*)(Sin + (size_t)(8 * dq + i) * 128 + 4 * e4); }
    for (;;) {
        const int h = it & 7, b = it >> 3, r = 8192 + b;
        __syncthreads();
        if (F.tid == 0) F.MISC[16] = atomicAdd(ctr, 1u);
        if (F.tid < 128) { const int d = F.tid; const size_t ix = (size_t)r * 1024 + h * 128 + d; const float z = ((const float*)(ws + WS_LOGF))[ix]; const float lb = ((const float*)(ws + WS_LB))[h * 128 + d];
            const float kin = (1.0f - lb) / (1.0f + __expf(z)); kn[d] = kin; fs[d] = 1.0f - kin; qs[d] = bf2f(((const bf16*)(ws + WS_HQ))[ix]); vs[d] = bf2f(((const bf16*)(ws + WS_HI))[ix]); }
        __syncthreads();
        const int nx = (int)F.MISC[16];
        float* Sout = F.out + OUT_SHS + (size_t)it * 128 * 128;
        const f32x4 v4 = *(const LAS f32x4*)&vs[4 * e4]; f32x4 o = (f32x4){0.f, 0.f, 0.f, 0.f};
#pragma unroll
        for (int i = 0; i < 8; ++i) { const int d = 8 * dq + i; s[i] = s[i] * fs[d] + v4 * kn[d]; *(f32x4*)(Sout + (size_t)d * 128 + 4 * e4) = s[i]; o += s[i] * qs[d]; }
        *(LAS f32x4*)&ored[dq * 128 + 4 * e4] = o;
        if (nx < 1024) { const float* Sin = A.in[3] + (size_t)nx * 128 * 128;
#pragma unroll
            for (int i = 0; i < 8; ++i) s[i] = *(const f32x4*)(Sin + (size_t)(8 * dq + i) * 128 + 4 * e4); }
        __syncthreads();
        if (F.wave == 0) { float oo[2]; float ss = 0.f;
#pragma unroll
            for (int k = 0; k < 2; ++k) { const int e = F.lane + 64 * k; float t = 0.f;
#pragma unroll
                for (int j = 0; j < 16; ++j) t += ored[j * 128 + e];
                oo[k] = t; ss += t * t; }
            const float rr = 1.0f / sqrtf(wave_sum(ss) * (1.0f / 128.0f) + EPS);
            const bf16* HG = (const bf16*)(ws + WS_HG); bf16* OH = (bf16*)(ws + WS_OH);
#pragma unroll
            for (int k = 0; k < 2; ++k) { const int e = F.lane + 64 * k; const size_t ix = (size_t)r * 1024 + h * 128 + e; OH[ix] = (bf16)f2bf(oo[k] * rr * A.in[10][e] * bf2f(HG[ix])); } }
        it = nx; if (it >= 1024) break;
    }
}
#ifndef PROBE_SUB
#define PROBE_SUB -1
#endif
__device__ __forceinline__ void p2_phase(Frame& F, const Args& A) {
    const int half = F.G >> 1;
    if (half == 0 || (F.vcu & 1) == 0) { const int stride = half ? half : 1;
        for (int u = F.vcu >> 1; u < 64; u += stride) p2_ret_unit(F, u);
        asm volatile("" : "+v"(F.tid), "+v"(F.lane));
        for (int u = (F.vcu >> 1) - 64; u < 64; u += stride) if (u >= 0) p2_hg_unit(F, u); }
    asm volatile("" : "+v"(F.tid), "+v"(F.lane));
    p2_sret_all(F, A, (unsigned*)(F.ctl + 64));
    asm volatile("" : "+v"(F.tid), "+v"(F.lane));
    p2_shg_all(F, A, (unsigned*)(F.ctl + 128));
}
__device__ __forceinline__ void p4_ret_item(Frame& F, int item) {
    unsigned char* ws = F.ws;
    const int c = item & 15, h = (item >> 4) & 7, b = item >> 7, r0 = b * 2048 + c * 128;
    const int w = F.wave, l15 = F.lane & 15, g = F.lane >> 4;
    LAS bf16* KS = (LAS bf16*)F.lds; LAS bf16* VT = KS + 128 * TP; LAS bf16* ST = VT + TSZ128;
    LAS bf16* OT = (LAS bf16*)F.lds;
    const bf16* Qg = (const bf16*)(ws + WS_Q); const bf16* Kg = (const bf16*)(ws + WS_K); const bf16* Vg = (const bf16*)(ws + WS_V);
    const bf16* Sg = (const bf16*)(ws + WS_SRT) + (size_t)item * 256 * 128;
    const float* COS = (const float*)(ws + WS_COS); const float* SIN = (const float*)(ws + WS_SIN);
    const float lg = lg2gamma(h);
    const int vc = F.tid & 15, vm0 = F.tid >> 4;
    v4u vp[4], sp[4];
#define P4R_LOAD(hh) do { _Pragma("unroll") for (int _i = 0; _i < 4; ++_i) { vp[_i] = *(const v4u*)(Vg + (size_t)(r0 + vm0 + 32 * _i) * 2048 + h * 256 + 128 * (hh) + 8 * vc); \
        sp[_i] = *(const v4u*)(Sg + (size_t)(128 * (hh) + vm0 + 32 * _i) * 128 + 8 * vc); } } while (0)
#define P4R_WRITE() do { _Pragma("unroll") for (int _i = 0; _i < 4; ++_i) { LAS bf16* _vt = VT + tsw(8 * vc, vm0 + 32 * _i); \
        _Pragma("unroll") for (int _j = 0; _j < 8; ++_j) _vt[_j * TP] = (bf16)((vp[_i][_j >> 1] >> (16 * (_j & 1))) & 0xffffu); \
        *(LAS v4u*)&ST[(vm0 + 32 * _i) * TP + 8 * vc] = sp[_i]; } } while (0)
    P4R_LOAD(0);
    __syncthreads();
#pragma unroll
    for (int i = 0; i < 2; ++i) { const int u = F.tid + 512 * i, d0 = (u & 7) * 8, m = u >> 3;
        const bf16* kp = Kg + (size_t)(r0 + m) * 1024 + h * 128 + d0; const v4u a = *(const v4u*)kp, bb = *(const v4u*)(kp + 64);
        const int pos = c * 128 + m; const f32x4 c0 = *(const f32x4*)(COS + pos * 64 + d0), c1 = *(const f32x4*)(COS + pos * 64 + d0 + 4), s0 = *(const f32x4*)(SIN + pos * 64 + d0), s1 = *(const f32x4*)(SIN + pos * 64 + d0 + 4);
        float o1[8], o2[8];
#pragma unroll
        for (int j = 0; j < 8; ++j) { const float x1 = bfe(a, j), x2 = bfe(bb, j), cj = j < 4 ? c0[j & 3] : c1[j & 3], sj = j < 4 ? s0[j & 3] : s1[j & 3]; o1[j] = x1 * cj - x2 * sj; o2[j] = x2 * cj + x1 * sj; }
        *(LAS bf16x8*)&KS[m * TP + d0] = pack_f8(o1); *(LAS bf16x8*)&KS[m * TP + 64 + d0] = pack_f8(o2); }
    P4R_WRITE();
    P4R_LOAD(1);
    bf16x8 qf[4];
    { const int n = 16 * w + l15, pos = c * 128 + n; const bf16* qp = Qg + (size_t)(r0 + n) * 1024 + h * 128 + 8 * g;
      const v4u a0 = *(const v4u*)qp, a1 = *(const v4u*)(qp + 32), a2 = *(const v4u*)(qp + 64), a3 = *(const v4u*)(qp + 96);
      float r0v[8], r1v[8], r2v[8], r3v[8];
#pragma unroll
      for (int hlf = 0; hlf < 2; ++hlf) { const int dd = 32 * hlf + 8 * g;
          const f32x4 c0 = *(const f32x4*)(COS + pos * 64 + dd), c1 = *(const f32x4*)(COS + pos * 64 + dd + 4), s0 = *(const f32x4*)(SIN + pos * 64 + dd), s1 = *(const f32x4*)(SIN + pos * 64 + dd + 4);
#pragma unroll
          for (int j = 0; j < 8; ++j) { const float cj = j < 4 ? c0[j & 3] : c1[j & 3], sj = j < 4 ? s0[j & 3] : s1[j & 3];
              const float x1 = hlf == 0 ? bfe(a0, j) : bfe(a1, j), x2 = hlf == 0 ? bfe(a2, j) : bfe(a3, j);
              if (hlf == 0) { r0v[j] = x1 * cj - x2 * sj; r2v[j] = x2 * cj + x1 * sj; } else { r1v[j] = x1 * cj - x2 * sj; r3v[j] = x2 * cj + x1 * sj; } } }
      qf[0] = pack_f8(r0v); qf[1] = pack_f8(r1v); qf[2] = pack_f8(r2v); qf[3] = pack_f8(r3v); }
    __syncthreads();
    bf16x8 pf[4];
#pragma unroll
    for (int s = 0; s < 4; ++s) { float pv[8];
#pragma unroll
        for (int hf = 0; hf < 2; ++hf) { const int mt = 2 * s + hf; f32x4 dd = (f32x4){0.f, 0.f, 0.f, 0.f};
            if (mt <= w) {
#pragma unroll
                for (int ks = 0; ks < 4; ++ks) { const bf16x8 kf = *(const LAS bf16x8*)&KS[(16 * mt + l15) * TP + 32 * ks + 8 * g]; dd = MFMA16(kf, qf[ks], dd); }
#pragma unroll
                for (int reg = 0; reg < 4; ++reg) { const int m = 16 * mt + 4 * g + reg, n = 16 * w + l15; dd[reg] = n >= m ? dd[reg] * exp2f((float)(n - m) * lg) : 0.f; } }
#pragma unroll
            for (int reg = 0; reg < 4; ++reg) pv[4 * hf + reg] = dd[reg]; }
        pf[s] = pack_f8(pv); }
    float rs[4];
#pragma unroll
    for (int reg = 0; reg < 4; ++reg) rs[reg] = exp2f((float)(16 * w + 4 * g + reg + 1) * lg);
    f32x4 O[16];
#pragma unroll
    for (int hh = 0; hh < 2; ++hh) {
        if (hh == 1) { __syncthreads(); P4R_WRITE(); __syncthreads(); }
#pragma unroll
        for (int et = 0; et < 8; ++et) { f32x4 t = (f32x4){0.f, 0.f, 0.f, 0.f};
#pragma unroll
            for (int ks = 0; ks < 4; ++ks) { const bf16x8 sf = *(const LAS bf16x8*)&ST[(16 * et + l15) * TP + 32 * ks + 8 * g]; t = MFMA16(qf[ks], sf, t); }
#pragma unroll
            for (int reg = 0; reg < 4; ++reg) t[reg] *= rs[reg];
#pragma unroll
            for (int s = 0; s < 4; ++s) if (2 * s <= w) { const bf16x4v lo = *(const LAS bf16x4v*)&VT[tsw(16 * et + l15, 32 * s + 4 * g)], hi = *(const LAS bf16x4v*)&VT[tsw(16 * et + l15, 32 * s + 16 + 4 * g)];
                const bf16x8 vf = __builtin_shufflevector(lo, hi, 0, 1, 2, 3, 4, 5, 6, 7); t = MFMA16(pf[s], vf, t); }
            O[8 * hh + et] = t; }
    }
#undef P4R_LOAD
#undef P4R_WRITE
    float ss[4] = {0.f, 0.f, 0.f, 0.f};
#pragma unroll
    for (int et = 0; et < 16; ++et)
#pragma unroll
        for (int reg = 0; reg < 4; ++reg) ss[reg] += O[et][reg] * O[et][reg];
#pragma unroll
    for (int reg = 0; reg < 4; ++reg) { float v = ss[reg]; v += __shfl_xor(v, 1); v += __shfl_xor(v, 2); v += __shfl_xor(v, 4); v += __shfl_xor(v, 8); ss[reg] = 1.0f / sqrtf(v * (1.0f / 256.0f) + EPS); }
    __syncthreads();
#pragma unroll
    for (int reg = 0; reg < 4; ++reg) { LAS bf16* op = OT + (16 * w + 4 * g + reg) * 264 + l15;
#pragma unroll
        for (int et = 0; et < 16; ++et) op[16 * et] = (bf16)f2bf(O[et][reg] * ss[reg]); }
    LDS_WAIT();
    const bf16* RG = (const bf16*)(ws + WS_RG); bf16* OR = (bf16*)(ws + WS_OR);
#pragma unroll
    for (int i = 0; i < 8; ++i) { const int p = F.lane + 64 * i, row = 16 * w + (p >> 5), c16 = p & 31; const size_t gx = (size_t)(r0 + row) * 2048 + h * 256 + 8 * c16;
        const v4u o8 = *(const LAS v4u*)&OT[row * 264 + 8 * c16]; const v4u g8 = *(const v4u*)(RG + gx); float v[8];
#pragma unroll
        for (int j = 0; j < 8; ++j) v[j] = bfe(o8, j) * bfe(g8, j);
        *(v4u*)(OR + gx) = __builtin_bit_cast(v4u, pack_f8(v)); }
}
__device__ __forceinline__ void p4_hg_all(Frame& F, const Args& A) {
    unsigned char* ws = F.ws;
    const int w = F.wave, l15 = F.lane & 15, g = F.lane >> 4;
    LAS bf16* QP = (LAS bf16*)F.lds;
    LAS bf16* KP = QP + 64 * TP;
    LAS bf16* KU = KP + 64 * TP;
    LAS bf16* VT = KU + 128 * 72;
    LAS float* E15 = (LAS float*)(VT + TSZ64T);
    LAS float* OB = E15 + 4 * 128;
    const float* Z = (const float*)(ws + WS_LOGF); const bf16* HQ = (const bf16*)(ws + WS_HQ); const bf16* HI = (const bf16*)(ws + WS_HI); const float* LB = (const float*)(ws + WS_LB);
    const int d = F.tid & 127, sq = F.tid >> 7;
    const int vc = F.tid & 15, vm0 = F.tid >> 4;
    if (F.vcu >= 512) return;
    const int nst = 2 * ((511 - F.vcu) / F.G + 1);
    float zr[16]; unsigned short qr[16]; v4u vr[2]; v2u sr[8];
#define P4H_LOAD(st) do { const int _it = F.vcu + ((st) >> 1) * F.G, _h = (_it >> 4) & 7, _rh = (_it >> 7) * 2048 + (_it & 15) * 128 + 64 * ((st) & 1); \
        _Pragma("unroll") for (int _t = 0; _t < 16; ++_t) { const size_t _ix = (size_t)(_rh + 16 * sq + _t) * 1024 + _h * 128 + d; zr[_t] = Z[_ix]; qr[_t] = HQ[_ix]; } \
        _Pragma("unroll") for (int _i = 0; _i < 2; ++_i) vr[_i] = *(const v4u*)(HI + (size_t)(_rh + vm0 + 32 * _i) * 1024 + _h * 128 + 8 * vc); \
        if (((st) & 1) == 0) { const bf16* _s = (const bf16*)(ws + WS_SHT) + (size_t)_it * 128 * 128 + (size_t)(16 * w + l15) * 128 + 4 * g; _Pragma("unroll") for (int _dt = 0; _dt < 8; ++_dt) sr[_dt] = *(const v2u*)(_s + 16 * _dt); } } while (0)
    f32x4 S[8];
    P4H_LOAD(0);
    for (int st = 0; st < nst; ++st) {
        const int item = F.vcu + (st >> 1) * F.G, hf = st & 1, h = (item >> 4) & 7, rh = (item >> 7) * 2048 + (item & 15) * 128 + 64 * hf;
        if (hf == 0) {
#pragma unroll
            for (int dt = 0; dt < 8; ++dt) { S[dt][0] = __uint_as_float(sr[dt].x << 16); S[dt][1] = __uint_as_float(sr[dt].x & 0xffff0000u); S[dt][2] = __uint_as_float(sr[dt].y << 16); S[dt][3] = __uint_as_float(sr[dt].y & 0xffff0000u); } }
        __syncthreads();
        { const float oml = 1.0f - LB[h * 128 + d];
          float kin[16], bcum[16]; float bb = 0.f;
#pragma unroll
          for (int t = 0; t < 16; ++t) { const float z = zr[t]; const float q = bf2f(qr[t]);
              kin[t] = oml * __builtin_amdgcn_rcpf(1.0f + __expf(z)); bb += __logf(1.0f - kin[t]); bcum[t] = bb;
              QP[(16 * sq + t) * TP + d] = (bf16)f2bf(q * __expf(bb)); KP[(16 * sq + t) * TP + d] = (bf16)f2bf(kin[t] * __expf(fminf(-bb, 80.0f))); }
          E15[sq * 128 + d] = __expf(bb);
          float v[8];
#pragma unroll
          for (int t = 0; t < 8; ++t) v[t] = kin[t] * __expf(bb - bcum[t]);
          *(LAS bf16x8*)&KU[d * 72 + 16 * sq] = pack_f8(v);
#pragma unroll
          for (int t = 0; t < 8; ++t) v[t] = kin[8 + t] * __expf(bb - bcum[8 + t]);
          *(LAS bf16x8*)&KU[d * 72 + 16 * sq + 8] = pack_f8(v); }
#pragma unroll
        for (int i = 0; i < 2; ++i) { LAS bf16* vt = VT + tsw64(8 * vc, vm0 + 32 * i);
#pragma unroll
            for (int j = 0; j < 8; ++j) vt[j * 72] = (bf16)((vr[i][j >> 1] >> (16 * (j & 1))) & 0xffffu); }
        if (st + 1 < nst) P4H_LOAD(st + 1);
        __syncthreads();
        const bf16x8 zero8 = (bf16x8){0, 0, 0, 0, 0, 0, 0, 0};
#pragma unroll
        for (int sc4 = 0; sc4 < 4; ++sc4) {
            f32x4 at = (f32x4){0.f, 0.f, 0.f, 0.f};
#pragma unroll
            for (int ks = 0; ks < 4; ++ks) { const bf16x8 kf = *(const LAS bf16x8*)&KP[(16 * sc4 + l15) * TP + 32 * ks + 8 * g], qf = *(const LAS bf16x8*)&QP[(16 * sc4 + l15) * TP + 32 * ks + 8 * g]; at = MFMA16(kf, qf, at); }
            float pv[8];
#pragma unroll
            for (int reg = 0; reg < 4; ++reg) { pv[reg] = (4 * g + reg) <= l15 ? at[reg] : 0.f; pv[4 + reg] = 0.f; }
            const bf16x8 pfr = pack_f8(pv);
            f32x4 o;
            { const bf16x4v lo = *(const LAS bf16x4v*)&VT[tsw64(16 * w + l15, 16 * sc4 + 4 * g)]; const bf16x8 vf = __builtin_shufflevector(lo, (bf16x4v){0, 0, 0, 0}, 0, 1, 2, 3, 4, 5, 6, 7);
              const f32x4 z4 = {0.f, 0.f, 0.f, 0.f}; o = MFMA16(pfr, vf, z4); }
#pragma unroll
            for (int ks = 0; ks < 4; ++ks) { float sv[8];
#pragma unroll
                for (int jj = 0; jj < 8; ++jj) sv[jj] = S[2 * ks + (jj >> 2)][jj & 3];
                const bf16x8 sf = pack_f8(sv);
                const LAS bf16* qp = &QP[(16 * sc4 + l15) * TP + 32 * ks + 4 * g]; const bf16x4v lo = *(const LAS bf16x4v*)qp, hi = *(const LAS bf16x4v*)(qp + 16);
                const bf16x8 qf = __builtin_shufflevector(lo, hi, 0, 1, 2, 3, 4, 5, 6, 7); o = MFMA16(qf, sf, o); }
#pragma unroll
            for (int reg = 0; reg < 4; ++reg) OB[(16 * sc4 + 4 * g + reg) * 132 + 16 * w + l15] = o[reg];
            const bf16x8 vu = g < 2 ? *(const LAS bf16x8*)&VT[tsw64(16 * w + l15, 16 * sc4 + 8 * g)] : zero8;
#pragma unroll
            for (int dt = 0; dt < 8; ++dt) { const f32x4 ed = *(const LAS f32x4*)&E15[sc4 * 128 + 16 * dt + 4 * g];
                const bf16x8 kf = g < 2 ? *(const LAS bf16x8*)&KU[(16 * dt + l15) * 72 + 16 * sc4 + 8 * g] : zero8;
                S[dt] = MFMA16(kf, vu, S[dt] * ed); }
        }
        __syncthreads();
        { const bf16* HG = (const bf16*)(ws + WS_HG); bf16* OH = (bf16*)(ws + WS_OH);
#pragma unroll
          for (int i = 0; i < 8; ++i) { const int t = 8 * w + i; const float v0 = OB[t * 132 + F.lane], v1 = OB[t * 132 + 64 + F.lane];
              const float rr = 1.0f / sqrtf(wave_sum(v0 * v0 + v1 * v1) * (1.0f / 128.0f) + EPS); const size_t ix = (size_t)(rh + t) * 1024 + h * 128 + F.lane;
              OH[ix] = (bf16)f2bf(v0 * rr * A.in[10][F.lane] * bf2f(HG[ix])); OH[ix + 64] = (bf16)f2bf(v1 * rr * A.in[10][64 + F.lane] * bf2f(HG[ix + 64])); } }
    }
#undef P4H_LOAD
}
__device__ __forceinline__ void p4_phase(Frame& F, const Args& A) {
    for (int rep = 0; rep < (PROBE_SUB == 40 ? 2 : 1); ++rep) for (int it = F.vcu; it < 512; it += F.G) p4_ret_item(F, it);
    asm volatile("" : "+v"(F.tid), "+v"(F.lane));
    for (int rep = 0; rep < (PROBE_SUB == 41 ? 2 : 1); ++rep) p4_hg_all(F, A);
}
namespace mini {
using pg8::bf16_t; using pg8::u32x2; using pg8::silu4; using pg8::sigm4; using pg8::pack4; using pg8::unpack4;
constexpr int AP = 136;
template <bool TWO> __device__ __forceinline__ void core(Frame& F, const bf16_t* A, int lda, int K, const bf16_t* bp0, const bf16_t* bp1, f32x4 (&acc0)[8], f32x4 (&acc1)[8]) {
    LAS bf16* AS = (LAS bf16*)F.lds; const int l15 = F.lane & 15, g = F.lane >> 4; const int nch = K >> 7; int cc = F.vcu % nch;
    v4u pre[4]; bf16x8 b0[4], b1[4];
    const int prow = F.tid >> 4, pc = (F.tid & 15) * 8;
#pragma unroll
    for (int i = 0; i < 4; ++i) pre[i] = *(const v4u*)(A + (size_t)(prow + 32 * i) * lda + cc * 128 + pc);
    if (bp0) {
#pragma unroll
        for (int u = 0; u < 4; ++u) { b0[u] = *(const bf16x8*)(bp0 + cc * 128 + 32 * u); if (TWO) b1[u] = *(const bf16x8*)(bp1 + cc * 128 + 32 * u); } }
    __syncthreads();
    for (int c = 0; c < nch; ++c) {
        LAS bf16* buf = AS + (c & 1) * (128 * AP);
#pragma unroll
        for (int i = 0; i < 4; ++i) *(LAS v4u*)&buf[(prow + 32 * i) * AP + pc] = pre[i];
        bf16x8 c0[4], c1[4];
#pragma unroll
        for (int u = 0; u < 4; ++u) { c0[u] = b0[u]; if (TWO) c1[u] = b1[u]; }
        cc = cc + 1 == nch ? 0 : cc + 1;
        if (c + 1 < nch) {
#pragma unroll
            for (int i = 0; i < 4; ++i) pre[i] = *(const v4u*)(A + (size_t)(prow + 32 * i) * lda + cc * 128 + pc);
            if (bp0) {
#pragma unroll
                for (int u = 0; u < 4; ++u) { b0[u] = *(const bf16x8*)(bp0 + cc * 128 + 32 * u); if (TWO) b1[u] = *(const bf16x8*)(bp1 + cc * 128 + 32 * u); } } }
        __syncthreads();
        if (bp0) {
#pragma unroll
            for (int u = 0; u < 4; ++u)
#pragma unroll
                for (int rt = 0; rt < 8; ++rt) { const bf16x8 a = *(const LAS bf16x8*)&buf[(16 * rt + l15) * AP + 32 * u + 8 * g];
                    acc0[rt] = __builtin_amdgcn_mfma_f32_16x16x32_bf16(c0[u], a, acc0[rt], 0, 0, 0); if (TWO) acc1[rt] = __builtin_amdgcn_mfma_f32_16x16x32_bf16(c1[u], a, acc1[rt], 0, 0, 0); } }
    }
}
#define MINI_ZERO(acc) _Pragma("unroll") for (int _i = 0; _i < 8; ++_i) acc[_i] = (f32x4){0.f, 0.f, 0.f, 0.f}
__device__ __forceinline__ void inproj(Frame& F, int j, int nj) {
    unsigned char* ws = F.ws; const int l15 = F.lane & 15, g = F.lane >> 4;
    if (j >= NIN / 16) return;
    const int t = j + nj * F.wave; const bool has = t < NIN / 16; const int n0 = 16 * t;
    f32x4 acc[8]; MINI_ZERO(acc);
    core<false>(F, (const bf16_t*)(ws + WS_XB) + 8192ull * 2048, 2048, 2048, has ? (const bf16_t*)(ws + WS_WIN) + (size_t)(n0 + l15) * 2048 + 8 * g : nullptr, nullptr, acc, acc);
    if (!has) return;
    const int c = n0 + 4 * g;
    if (c >= 7168 && c < 8192) {
#pragma unroll
        for (int rt = 0; rt < 8; ++rt) *(f32x4*)((float*)(ws + WS_LOGF) + (size_t)(8192 + 16 * rt + l15) * 1024 + (c - 7168)) = acc[rt];
        return; }
    size_t od; int pitch, c0, act; float sc = 1.0f;
    if (c < 1024) { od = WS_Q; pitch = 1024; c0 = 0; act = 0; } else if (c < 2048) { od = WS_K; pitch = 1024; c0 = 1024; act = 0; sc = 0.08838834764831845f; }
    else if (c < 4096) { od = WS_V; pitch = 2048; c0 = 2048; act = 0; } else if (c < 6144) { od = WS_RG; pitch = 2048; c0 = 4096; act = 1; } else if (c < 7168) { od = WS_HQ; pitch = 1024; c0 = 6144; act = 1; }
    else if (c < 9216) { od = WS_HI; pitch = 1024; c0 = 8192; act = 0; } else if (c < 10240) { od = WS_HG; pitch = 1024; c0 = 9216; act = 1; } else if (c < 12288) { od = WS_GA; pitch = 2048; c0 = 10240; act = 2; } else { od = WS_GB; pitch = 2048; c0 = 12288; act = 2; }
#pragma unroll
    for (int rt = 0; rt < 8; ++rt) { f32x4 v = acc[rt] * sc; if (act == 1) v = silu4(v); else if (act == 2) v = sigm4(v);
        *(u32x2*)((bf16_t*)(ws + od) + (size_t)(8192 + 16 * rt + l15) * pitch + (c - c0)) = pack4(v); }
}
__device__ __forceinline__ void outproj(Frame& F) {
    unsigned char* ws = F.ws; const int l15 = F.lane & 15, g = F.lane >> 4;
    if (F.vcu >= 128) return;
    const int t = F.vcu + F.G * F.wave; const bool has = t < 128; const int n0 = 16 * t;
    f32x4 ya[8], yb[8]; MINI_ZERO(ya); MINI_ZERO(yb);
    core<false>(F, (const bf16_t*)(ws + WS_OR) + 8192ull * 2048, 2048, 2048, has ? (const bf16_t*)(ws + WS_WRO) + (size_t)(n0 + l15) * 2048 + 8 * g : nullptr, nullptr, ya, ya);
    core<false>(F, (const bf16_t*)(ws + WS_OH) + 8192ull * 1024, 1024, 1024, has ? (const bf16_t*)(ws + WS_WHO) + (size_t)(n0 + l15) * 1024 + 8 * g : nullptr, nullptr, yb, yb);
    if (!has) return;
#pragma unroll
    for (int rt = 0; rt < 8; ++rt) { const size_t ix = (size_t)(8192 + 16 * rt + l15) * 2048 + n0 + 4 * g;
        const f32x4 ga = unpack4(*(const u32x2*)((const bf16_t*)(ws + WS_GA) + ix)), gb = unpack4(*(const u32x2*)((const bf16_t*)(ws + WS_GB) + ix));
        *(u32x2*)((bf16_t*)(ws + WS_MG) + ix) = pack4(ga * ya[rt] + gb * yb[rt]); }
}
__device__ __forceinline__ void resid(Frame& F, const bf16_t* Arows  , const bf16_t* Bt, int K, const float* XI  , float* XO  , bf16_t* XBo  , float* SS  ) {
    const int l15 = F.lane & 15, g = F.lane >> 4;
    if (F.vcu >= 128) return;
    const int t = F.vcu + F.G * F.wave; const bool has = t < 128; const int n0 = 16 * t;
    f32x4 acc[8]; MINI_ZERO(acc);
    core<false>(F, Arows, K, K, has ? Bt + (size_t)(n0 + l15) * K + 8 * g : nullptr, nullptr, acc, acc);
    if (!has) return;
#pragma unroll
    for (int rt = 0; rt < 8; ++rt) { const int rl = 16 * rt + l15; const size_t ix = (size_t)rl * 2048 + n0 + 4 * g;
        f32x4 v = acc[rt] + *(const f32x4*)(XI + ix); *(f32x4*)(XO + ix) = v;
        if (XBo) *(u32x2*)(XBo + ix) = pack4(v);
        float ss = (v[0] * v[0] + v[1] * v[1]) + (v[2] * v[2] + v[3] * v[3]); ss += __shfl_xor(ss, 16); ss += __shfl_xor(ss, 32);
        if (g == 0) atomicAdd(SS + rl, ss); }
}
__device__ __forceinline__ void swiglu(Frame& F, int j, int nj) {
    unsigned char* ws = F.ws; const int l15 = F.lane & 15, g = F.lane >> 4;
    if (j >= DFF / 16) return;
    const int t = j + nj * F.wave; const bool has = t < DFF / 16; const int ng = ((16 * t) >> 7) * 256 + ((16 * t) & 127);
    f32x4 ag[8], au[8]; MINI_ZERO(ag); MINI_ZERO(au);
    const bf16_t* A = (const bf16_t*)(ws + WS_X1B) + 8192ull * 2048;
    const bf16_t* bg = has ? (const bf16_t*)(ws + WS_WFI) + (size_t)(ng + l15) * 2048 + 8 * g : nullptr;
    core<true>(F, A, 2048, 2048, bg, has ? bg + 128 * 2048 : nullptr, ag, au);
    if (!has) return;
    const float* SS1 = (const float*)(F.ctl + CW_SS1);
#pragma unroll
    for (int rt = 0; rt < 8; ++rt) { const int r = 8192 + 16 * rt + l15; const float r2 = 1.0f / sqrtf(SS1[r] * (1.0f / 2048.0f) + EPS);
        *(u32x2*)((bf16_t*)(ws + WS_ACT) + (size_t)r * DFF + 16 * t + 4 * g) = pack4(silu4(ag[rt] * r2) * (au[rt] * r2)); }
}
}
__global__ void __launch_bounds__(NWAVES * 64, 2) mk_fwd(Args args) {
    extern __shared__ __attribute__((aligned(16))) unsigned char lds[];
    Frame F;
    F.lds = (LAS unsigned char*)lds; F.MISC = (volatile LAS unsigned*)(F.lds + MISC_OFF);
    F.tid = threadIdx.x; F.lane = F.tid & 63; F.wave = __builtin_amdgcn_readfirstlane(F.tid >> 6);
    F.G = gridDim.x; { const int bx = blockIdx.x; F.vcu = (F.G % 8 == 0) ? (bx % 8) * (F.G / 8) + bx / 8 : bx; }
    F.ws = args.ws; F.out = args.out; F.ctl = (gu32*)(args.ws + WS_CTL);
    for (int u = F.tid; u < (LDS_BYTES - LDSCTL_OFF) / 4; u += NWAVES * 64) ((LAS unsigned*)(F.lds + LDSCTL_OFF))[u] = 0u;
    __syncthreads();
    XcdBarrier bar; bar.bar = (unsigned*)(F.ctl + CW_BAR); bar.x = 0; bar.st = nullptr;
    if (args.use_bar) bar = xcd_barrier_post((unsigned*)(F.ctl + CW_BAR), F.MISC + 8);
    const int lo = args.ph_lo, hi = args.ph_hi;
#define IN(k) (lo <= (k) && (k) < hi)
#define SEAM(k) do { if (IN(k) && IN((k) + 1)) xcd_barrier(bar); } while (0)
#ifndef PROBE_REPEAT
#define PROBE_REPEAT -1
#endif
#define NREP(k) ((PROBE_REPEAT == (k)) ? 2 : 1)
    unsigned char* ws = args.ws;
    if (PROBE_REPEAT == 0) { p0_prologue(F, args); xcd_barrier(bar); }
    if (IN(0)) { p0_prologue(F, args); } SEAM(0);
#define P1_BODY { \
          \
        if (F.G >= 2 && (F.vcu & 1)) { mini::inproj(F, F.vcu >> 1, F.G >> 1); __syncthreads(); } else if (F.G < 2) { mini::inproj(F, F.vcu, F.G); __syncthreads(); } \
        pg8::Gemm g{(const pg8::bf16_t*)(ws + WS_XB), (const pg8::bf16_t*)(ws + WS_WIN), 8192, NIN, 2048}; pg8::StaticOrder S; S.init(8192, NIN, F.G, (int)blockIdx.x); \
        pg8::EpiInProj E{ws}; \
        pg8::gemm_phase<pg8::EpiInProj, pg8::StaticOrder, true, true>(F.lds, g, S, E); }
    if (PROBE_REPEAT == 1) { P1_BODY xcd_barrier(bar); }
    if (PROBE_REPEAT == 101) { pg8::Gemm g{(const pg8::bf16_t*)(ws + WS_XB), (const pg8::bf16_t*)(ws + WS_WIN), 8192, NIN, 2048}; pg8::StaticOrder S; S.init(8192, NIN, F.G, (int)blockIdx.x);
        pg8::EpiNull E{}; pg8::gemm_phase<pg8::EpiNull, pg8::StaticOrder, true, true>(F.lds, g, S, E); xcd_barrier(bar); }
    if (PROBE_REPEAT == 102) { pg8::Gemm g{(const pg8::bf16_t*)(ws + WS_XB), (const pg8::bf16_t*)(ws + WS_WIN), 8192, 2048, 2048}; pg8::StaticOrder S; S.init(8192, 2048, F.G, (int)blockIdx.x);
        pg8::EpiNull E{}; pg8::gemm_phase<pg8::EpiNull, pg8::StaticOrder, true, true>(F.lds, g, S, E); xcd_barrier(bar); }
    if (IN(1)) P1_BODY SEAM(1);
    if (PROBE_REPEAT == 2) { p2_phase(F, args); xcd_barrier(bar); }
    if (IN(2)) { p2_phase(F, args); } SEAM(2);
    if (PROBE_REPEAT == 3) { p4_phase(F, args); xcd_barrier(bar); }
    if (IN(3)) { p4_phase(F, args); } SEAM(3);
    if (IN(4)) {
        { pg8::Gemm g{(const pg8::bf16_t*)(ws + WS_OR), (const pg8::bf16_t*)(ws + WS_WRO), 8192, 2048, 2048}; pg8::StaticOrder S; S.init(8192, 2048, F.G, (int)blockIdx.x);
          pg8::EpiGate<0> E{(const pg8::bf16_t*)(ws + WS_GA), (float*)(ws + WS_YT), (pg8::bf16_t*)(ws + WS_MG)};
          pg8::gemm_phase<pg8::EpiGate<0>, pg8::StaticOrder, true, true>(F.lds, g, S, E); }
        { pg8::Gemm g{(const pg8::bf16_t*)(ws + WS_OH), (const pg8::bf16_t*)(ws + WS_WHO), 8192, 2048, 1024}; pg8::StaticOrder S; S.init(8192, 2048, F.G, (int)blockIdx.x);
          pg8::EpiGate<1> E{(const pg8::bf16_t*)(ws + WS_GB), (float*)(ws + WS_YT), (pg8::bf16_t*)(ws + WS_MG)};
          pg8::gemm_phase<pg8::EpiGate<1>, pg8::StaticOrder, true, true>(F.lds, g, S, E); }
        mini::outproj(F);
    } SEAM(4);
    if (IN(5)) {
        pg8::Gemm g{(const pg8::bf16_t*)(ws + WS_MG), (const pg8::bf16_t*)(ws + WS_WOUT), 8192, 2048, 2048}; pg8::StaticOrder S; S.init(8192, 2048, F.G, (int)blockIdx.x);
        pg8::EpiResid E{args.in[0], args.in[1], args.out, (pg8::bf16_t*)(ws + WS_X1B), (float*)(F.ctl + CW_SS1)};
        pg8::gemm_phase<pg8::EpiResid, pg8::StaticOrder, true, true>(F.lds, g, S, E);
        mini::resid(F, (const pg8::bf16_t*)(ws + WS_MG) + 8192ull * 2048, (const pg8::bf16_t*)(ws + WS_WOUT), 2048, args.in[1], args.out + OUT_YS, (pg8::bf16_t*)(ws + WS_X1B) + 8192ull * 2048, (float*)(F.ctl + CW_SS1) + 8192);
    } SEAM(5);
    if (IN(6)) {
        { const int nu = (8192 / 256) * (2 * DFF / 256), rem = nu % F.G;
          if (rem && (int)blockIdx.x >= rem) { mini::swiglu(F, (int)blockIdx.x - rem, F.G - rem); __syncthreads(); } else if (!rem) { mini::swiglu(F, F.vcu, F.G); __syncthreads(); } }
        pg8::Gemm g{(const pg8::bf16_t*)(ws + WS_X1B), (const pg8::bf16_t*)(ws + WS_WFI), 8192, 2 * DFF, 2048}; pg8::StaticOrder S; S.init(8192, 2 * DFF, F.G, (int)blockIdx.x);
        pg8::EpiSwiglu E{(const float*)(F.ctl + CW_SS1), (pg8::bf16_t*)(ws + WS_ACT)};
        pg8::gemm_phase<pg8::EpiSwiglu, pg8::StaticOrder, true, true>(F.lds, g, S, E);
    } SEAM(6);
    if (IN(7)) {
        pg8::Gemm g{(const pg8::bf16_t*)(ws + WS_ACT), (const pg8::bf16_t*)(ws + WS_WFO), 8192, 2048, DFF}; pg8::StaticOrder S; S.init(8192, 2048, F.G, (int)blockIdx.x);
        pg8::EpiResid E{args.out, args.out + OUT_YS, args.out, nullptr, (float*)(F.ctl + CW_SS2)};
        pg8::gemm_phase<pg8::EpiResid, pg8::StaticOrder, true, true>(F.lds, g, S, E);
        mini::resid(F, (const pg8::bf16_t*)(ws + WS_ACT) + 8192ull * DFF, (const pg8::bf16_t*)(ws + WS_WFO), DFF, args.out + OUT_YS, args.out + OUT_YS, nullptr, (float*)(F.ctl + CW_SS2) + 8192);
    } SEAM(7);
    if (IN(8)) {
        const int gw = F.vcu * NWAVES + F.wave, NGW = F.G * NWAVES; const float* SS2 = (const float*)(F.ctl + CW_SS2);
        for (int m = gw; m < MROWS; m += NGW) { f32x4* xr = (f32x4*)(args.out + (size_t)m * 2048) + F.lane; const f32x4* gn = (const f32x4*)args.in[14] + F.lane;
            const float rr = 1.0f / sqrtf(SS2[m] * (1.0f / 2048.0f) + EPS);
#pragma unroll
            for (int j = 0; j < 8; ++j) xr[64 * j] = xr[64 * j] * rr * gn[64 * j]; }
    }
#undef IN
#undef SEAM
}
extern "C" void kernel_launch(void* const* d_in, const int* in_sizes, int n_in, void* d_out, int out_size, void* d_ws, size_t ws_size, hipStream_t stream) {
    static int grid = 0;
    if (grid == 0) {
        int dev = 0, cus = 0;
        if (ws_size < WS_END || n_in != 15) { fprintf(stderr, "kernel_launch: unexpected sizes (ws %zu, n_in %d)\n", ws_size, n_in); grid = -1; return; }
        if (hipGetDevice(&dev) != hipSuccess || hipDeviceGetAttribute(&cus, hipDeviceAttributeMultiprocessorCount, dev) != hipSuccess) { grid = -1; return; }
        if (hipFuncSetAttribute((const void*)mk_fwd, hipFuncAttributeMaxDynamicSharedMemorySize, LDS_BYTES) != hipSuccess) { fprintf(stderr, "kernel_launch: hipFuncSetAttribute failed\n"); grid = -1; return; }
        int per_cu = 0; (void)hipOccupancyMaxActiveBlocksPerMultiprocessor(&per_cu, (const void*)mk_fwd, NWAVES * 64, LDS_BYTES); (void)hipGetLastError();
        if (per_cu < 1) { fprintf(stderr, "kernel_launch: occupancy query says %d blocks per CU; nothing launched\n", per_cu); grid = -1; return; }
        grid = cus;
    }
    if (grid < 0) return;
    (void)hipMemsetAsync((char*)d_ws + WS_CTL, 0, CTL_ZERO_BYTES, stream);
    Args a{};
    for (int i = 0; i < 15; ++i) a.in[i] = (const float*)d_in[i];
    a.out = (float*)d_out; a.ws = (unsigned char*)d_ws; a.use_bar = 1; a.ph_lo = 0; a.ph_hi = 9;
    hipLaunchKernelGGL(mk_fwd, dim3(grid), dim3(NWAVES * 64), LDS_BYTES, stream, a);
}
```

```cpp
#include <hip/hip_runtime.h>
#include <cstdio>
#include <cstdint>
constexpr int DMODEL = 2048, MROWS = 8320, MPAD = 8448, NIN = 14336, DFF = 5632, NWAVES = 8;
constexpr float EPS = 1e-6f;
constexpr size_t MiB = 1u << 20;
constexpr size_t WS_CTL = 0, CTL_ZERO_BYTES = 1 * MiB;
constexpr size_t WS_WRO = 1 * MiB, WS_WHO = 9 * MiB, WS_WOUT = 13 * MiB, WS_WFI = 21 * MiB, WS_WFO = 65 * MiB, WS_WIN = 87 * MiB;
constexpr size_t WS_XB = 143 * MiB;
constexpr size_t WS_Q = 176 * MiB, WS_K = WS_Q + 8448ull * 1024 * 2, WS_V = 209 * MiB, WS_RG = 242 * MiB, WS_HQ = 275 * MiB, WS_LOGF = WS_HQ + 8448ull * 1024 * 2;
constexpr size_t WS_HI = WS_LOGF + 8448ull * 1024 * 4, WS_HG = WS_HI + 8448ull * 1024 * 2, WS_GA = WS_HG + 8448ull * 1024 * 2, WS_GB = WS_GA + 8448ull * 2048 * 2;
constexpr size_t WS_KVLOC = WS_GB + 8448ull * 2048 * 2;
constexpr size_t WS_HSLOC = WS_KVLOC + 64 * MiB;
constexpr size_t WS_OH = WS_HSLOC + 32 * MiB;
constexpr size_t WS_MISC = WS_OH + 8448ull * 1024 * 2;
constexpr size_t WS_RR1 = WS_MISC, WS_COS = WS_RR1 + 64 * 1024, WS_SIN = WS_COS + 2049 * 64 * 4 + 256, WS_LB = WS_SIN + 2049 * 64 * 4 + 256, WS_BTOT = WS_LB + 4096, WS_END = WS_BTOT + 512 * 128 * 4;
constexpr size_t WS_OR = WS_XB;
constexpr size_t WS_SRT = WS_WIN, WS_SHT = WS_WIN + 32 * MiB;
constexpr size_t WS_YT = WS_KVLOC;
constexpr size_t WS_MG = WS_Q;
constexpr size_t WS_X1B = WS_V;
constexpr size_t WS_ACT = WS_RG;
static_assert(WS_GB + 8448ull * 2048 * 2 == WS_KVLOC && WS_K + 8448ull * 1024 * 2 == WS_V && WS_V + 8448ull * 2048 * 2 == WS_RG && WS_RG + 8448ull * 2048 * 2 == WS_HQ, "map");
static_assert(WS_YT + 8448ull * 2048 * 4 <= WS_OH && WS_ACT + 8448ull * 5632 * 2 <= WS_GA && WS_END <= 541 * MiB, "map2");
constexpr int CW_BAR = 4096;
constexpr int CW_SS1 = 16384, CW_SS2 = 16384 + 8448;
static_assert((CW_SS2 + 8448) * 4 <= (int)CTL_ZERO_BYTES, "ctl");
constexpr int RING_BYTES = 131072, LDSCTL_OFF = RING_BYTES, MISC_OFF = LDSCTL_OFF + 320, LDS_BYTES = 147456;

#define GAS __attribute__((address_space(1)))
#define LAS __attribute__((address_space(3)))
typedef unsigned short bf16;
typedef unsigned v4u __attribute__((ext_vector_type(4)));
typedef unsigned v2u __attribute__((ext_vector_type(2)));
typedef float f32x4 __attribute__((ext_vector_type(4)));
typedef short bf16x8 __attribute__((ext_vector_type(8)));
typedef GAS unsigned gu32;
#define RLX_AGENT __ATOMIC_RELAXED, __HIP_MEMORY_SCOPE_AGENT
#define LDS_WAIT() asm volatile("s_waitcnt lgkmcnt(0)" ::: "memory")
#define VM_WAIT() asm volatile("s_waitcnt vmcnt(0)" ::: "memory")
typedef __bf16 hbf2 __attribute__((ext_vector_type(2)));
typedef float hf2 __attribute__((ext_vector_type(2)));
__device__ __forceinline__ unsigned f2bf(float f) { return (unsigned)__builtin_bit_cast(unsigned short, (__bf16)f); }
__device__ __forceinline__ unsigned pk2(float lo, float hi) { const hf2 v = {lo, hi}; return __builtin_bit_cast(unsigned, __builtin_convertvector(v, hbf2)); }
__device__ __forceinline__ float bf2f(unsigned short b) { return __uint_as_float(((unsigned)b) << 16); }
namespace pg8 {
#define PG8_LAS __attribute__((address_space(3)))
typedef unsigned short bf16_t;
typedef short bf16x8 __attribute__((ext_vector_type(8)));
typedef float f32x4 __attribute__((ext_vector_type(4)));
typedef unsigned u32x4 __attribute__((ext_vector_type(4)));
constexpr int BM = 256, BK = 64, HALF = 128, HTB = HALF * BK * 2  , STAGE_BYTES = 8 * HTB, NXCD = 8, WGM = 8;

__host__ __device__ __forceinline__ int lds_byte(int r, int c) { const int st = (r >> 4) * 2 + (c >> 5), rr = r & 15, cc = c & 31, ob = rr * 64 + cc * 2; return st * 1024 + (ob ^ (((ob >> 9) & 1) << 5)); }
__host__ __device__ __forceinline__ void stage_rc(int b, int& R, int& C) { const int st = b / 1024, sb = b % 1024, swz = sb ^ (((sb >> 9) & 1) << 5); R = (st >> 1) * 16 + swz / 64; C = (st & 1) * 32 + (swz % 64) / 2; }
__host__ __device__ __forceinline__ int perm32(int rho) { const int n = rho >> 4, i = rho & 15; return 8 * (i >> 2) + 4 * n + (i & 3); }

struct Unit { int pm, pn; };
struct Gemm { const bf16_t* A; const bf16_t* Bt; int M, N, K; };

struct StaticOrder {
    int nM, nN, nwg, G, c;
    __host__ __device__ void init(int M, int N, int G_, int c_) { nM = M / BM; nN = N / BM; nwg = nM * nN; G = G_; c = c_; }
    __host__ __device__ bool next(int i, Unit& u) const {
        const long L = (long)i * G + c; if (L >= nwg) return false;
        int wgid = (int)L; { const int q = nwg / NXCD, r = nwg % NXCD, xcd = wgid % NXCD, off = wgid / NXCD; wgid = (xcd < r ? xcd * (q + 1) : r * (q + 1) + (xcd - r) * q) + off; }
        const int nig = WGM * nN, gid = wgid / nig, fm = gid * WGM, gsz = (nM - fm) < WGM ? (nM - fm) : WGM;
        u.pm = fm + ((wgid % nig) % gsz); u.pn = (wgid % nig) / gsz; return true;
    }
    __device__ __forceinline__ void a_ready(const Unit&) const {}
    __device__ __forceinline__ void done(const Unit&) const {}
};

__device__ __forceinline__ unsigned cvt_pk_bf16(float lo, float hi) { unsigned r; asm volatile("v_cvt_pk_bf16_f32 %0, %1, %2" : "=v"(r) : "v"(lo), "v"(hi)); return r; }
typedef float f32x2 __attribute__((ext_vector_type(2)));
typedef unsigned u32x2 __attribute__((ext_vector_type(2)));
__device__ __forceinline__ float sigm(float x) { return __builtin_amdgcn_rcpf(1.0f + __expf(-x)); }
__device__ __forceinline__ f32x4 silu4(f32x4 v) { f32x4 o; o[0] = v[0] * sigm(v[0]); o[1] = v[1] * sigm(v[1]); o[2] = v[2] * sigm(v[2]); o[3] = v[3] * sigm(v[3]); return o; }
__device__ __forceinline__ f32x4 sigm4(f32x4 v) { f32x4 o; o[0] = sigm(v[0]); o[1] = sigm(v[1]); o[2] = sigm(v[2]); o[3] = sigm(v[3]); return o; }
__device__ __forceinline__ u32x4 pack8(f32x4 v0, f32x4 v1) { u32x4 w; w.x = cvt_pk_bf16(v0[0], v0[1]); w.y = cvt_pk_bf16(v0[2], v0[3]); w.z = cvt_pk_bf16(v1[0], v1[1]); w.w = cvt_pk_bf16(v1[2], v1[3]); return w; }
__device__ __forceinline__ u32x2 pack4(f32x4 v) { u32x2 w; w.x = cvt_pk_bf16(v[0], v[1]); w.y = cvt_pk_bf16(v[2], v[3]); return w; }
__device__ __forceinline__ f32x4 unpack4(u32x2 w) { f32x4 o; o[0] = __uint_as_float(w.x << 16); o[1] = __uint_as_float(w.x & 0xffff0000u); o[2] = __uint_as_float(w.y << 16); o[3] = __uint_as_float(w.y & 0xffff0000u); return o; }

struct EpiInProj {
    static constexpr bool PERM = true, AFTER_DRAIN = false;
    unsigned char* ws;
    __device__ __forceinline__ void operator()(const f32x4 (&acc)[2][2][4][2], const Unit& u, int wr, int wc, int fr, int fq) const {
        const int pn = u.pn, row0 = u.pm * BM + wr * 64 + fr;
        if (pn >= 28 && pn < 32) {
            float* Z = (float*)(ws + WS_LOGF); const int cs = (pn - 28) * 256 + wc * 32 + 8 * fq;
#pragma unroll
            for (int ai = 0; ai < 2; ++ai)
#pragma unroll
                for (int m = 0; m < 4; ++m) { const int r = row0 + ai * HALF + m * 16;
#pragma unroll
                    for (int bj = 0; bj < 2; ++bj)
#pragma unroll
                        for (int n = 0; n < 2; ++n) *(f32x4*)(Z + (size_t)r * 1024 + cs + bj * HALF + 4 * n) = acc[ai][bj][m][n]; }
        } else {
            size_t od; int pitch, p0, act; float sc = 1.0f;
            if (pn < 4) { od = WS_Q; pitch = 1024; p0 = 0; act = 0; } else if (pn < 8) { od = WS_K; pitch = 1024; p0 = 4; act = 0; sc = 0.08838834764831845f; }
            else if (pn < 16) { od = WS_V; pitch = 2048; p0 = 8; act = 0; } else if (pn < 24) { od = WS_RG; pitch = 2048; p0 = 16; act = 1; } else if (pn < 28) { od = WS_HQ; pitch = 1024; p0 = 24; act = 1; }
            else if (pn < 36) { od = WS_HI; pitch = 1024; p0 = 32; act = 0; } else if (pn < 40) { od = WS_HG; pitch = 1024; p0 = 36; act = 1; } else if (pn < 48) { od = WS_GA; pitch = 2048; p0 = 40; act = 2; } else { od = WS_GB; pitch = 2048; p0 = 48; act = 2; }
            bf16_t* dst = (bf16_t*)(ws + od);
            const int cs = (pn - p0) * 256 + wc * 32 + 8 * fq;
#pragma unroll
            for (int ai = 0; ai < 2; ++ai)
#pragma unroll
                for (int m = 0; m < 4; ++m) { const int r = row0 + ai * HALF + m * 16; bf16_t* rowp = dst + (size_t)r * pitch + cs;
#pragma unroll
                    for (int bj = 0; bj < 2; ++bj) { f32x4 v0 = acc[ai][bj][m][0] * sc, v1 = acc[ai][bj][m][1] * sc;
                        if (act == 1) { v0 = silu4(v0); v1 = silu4(v1); } else if (act == 2) { v0 = sigm4(v0); v1 = sigm4(v1); }
                        *(u32x4*)(rowp + bj * HALF) = pack8(v0, v1); } }
        }
    }
};
struct EpiNull {
    static constexpr bool PERM = true, AFTER_DRAIN = false;
    __device__ __forceinline__ void operator()(const f32x4 (&acc)[2][2][4][2], const Unit& u, int wr, int wc, int fr, int fq) const {
#pragma unroll
        for (int ai = 0; ai < 2; ++ai)
#pragma unroll
            for (int m = 0; m < 4; ++m)
#pragma unroll
                for (int bj = 0; bj < 2; ++bj) { asm volatile("" :: "v"(acc[ai][bj][m][0]), "v"(acc[ai][bj][m][1])); }
    }
};
template <int SECOND> struct EpiGate {
    static constexpr bool PERM = true, AFTER_DRAIN = false;
    const bf16_t* G; bf16_t* YT; bf16_t* MG;
    __device__ __forceinline__ void operator()(const f32x4 (&acc)[2][2][4][2], const Unit& u, int wr, int wc, int fr, int fq) const {
        const int row0 = u.pm * BM + wr * 64 + fr, col0 = u.pn * BM + wc * 32 + 8 * fq;
#pragma unroll
        for (int ai = 0; ai < 2; ++ai)
#pragma unroll
            for (int m = 0; m < 4; ++m) { const size_t off = (size_t)(row0 + ai * HALF + m * 16) * 2048 + col0;
#pragma unroll
                for (int bj = 0; bj < 2; ++bj) { const u32x4 gw = *(const u32x4*)(G + off + bj * HALF);
                    f32x4 v0 = acc[ai][bj][m][0] * unpack4((u32x2){gw.x, gw.y}), v1 = acc[ai][bj][m][1] * unpack4((u32x2){gw.z, gw.w});
                    if (SECOND) { const u32x4 yw = *(const u32x4*)(YT + off + bj * HALF); v0 += unpack4((u32x2){yw.x, yw.y}); v1 += unpack4((u32x2){yw.z, yw.w}); *(u32x4*)(MG + off + bj * HALF) = pack8(v0, v1); }
                    else *(u32x4*)(YT + off + bj * HALF) = pack8(v0, v1); } }
        __builtin_amdgcn_s_waitcnt(0x0F70);
    }
};
template <int MODE> struct EpiResid {
    static constexpr bool PERM = true, AFTER_DRAIN = false;
    const float* XP; const float* XS; bf16_t* X1; float* OUT; float* SS;
    __device__ __forceinline__ void operator()(const f32x4 (&acc)[2][2][4][2], const Unit& u, int wr, int wc, int fr, int fq) const {
        const int row0 = u.pm * BM + wr * 64 + fr, col0 = u.pn * BM + wc * 32 + 8 * fq;
#pragma unroll
        for (int ai = 0; ai < 2; ++ai)
#pragma unroll
            for (int m = 0; m < 4; ++m) { const int r = row0 + ai * HALF + m * 16; float ss = 0.f;
#pragma unroll
                for (int bj = 0; bj < 2; ++bj) { f32x4 v0 = acc[ai][bj][m][0], v1 = acc[ai][bj][m][1]; const size_t off = (size_t)r * 2048 + col0 + bj * HALF;
                    if (MODE == 0) { const float* xi = (r < 8192 ? XP + (size_t)r * 2048 : XS + (size_t)(r - 8192) * 2048) + col0 + bj * HALF; v0 += *(const f32x4*)xi; v1 += *(const f32x4*)(xi + 4); *(u32x4*)(X1 + off) = pack8(v0, v1); }
                    else { const u32x4 xw = *(const u32x4*)(X1 + off); v0 += unpack4((u32x2){xw.x, xw.y}); v1 += unpack4((u32x2){xw.z, xw.w}); *(f32x4*)(OUT + off) = v0; *(f32x4*)(OUT + off + 4) = v1; }
                    ss += (v0[0] * v0[0] + v0[1] * v0[1]) + (v0[2] * v0[2] + v0[3] * v0[3]) + (v1[0] * v1[0] + v1[1] * v1[1]) + (v1[2] * v1[2] + v1[3] * v1[3]); }
                ss += __shfl_xor(ss, 16); ss += __shfl_xor(ss, 32);
                if (fq == 0) atomicAdd(SS + r, ss); }
        __builtin_amdgcn_s_waitcnt(0x0F70);
    }
};
struct EpiSwiglu {
    static constexpr bool PERM = true, AFTER_DRAIN = false;
    const float* SS; bf16_t* ACT;
    __device__ __forceinline__ void operator()(const f32x4 (&acc)[2][2][4][2], const Unit& u, int wr, int wc, int fr, int fq) const {
        const int row0 = u.pm * BM + wr * 64 + fr, col0 = u.pn * HALF + wc * 32 + 8 * fq;
        float ssv[2][4];
#pragma unroll
        for (int ai = 0; ai < 2; ++ai)
#pragma unroll
            for (int m = 0; m < 4; ++m) ssv[ai][m] = SS[row0 + ai * HALF + m * 16];
        __builtin_amdgcn_s_waitcnt(0x0F70);
#pragma unroll
        for (int ai = 0; ai < 2; ++ai)
#pragma unroll
            for (int m = 0; m < 4; ++m) { const int r = row0 + ai * HALF + m * 16; const float r2 = 1.0f / sqrtf(ssv[ai][m] * (1.0f / 2048.0f) + 1e-6f);
                const f32x4 g0 = acc[ai][0][m][0] * r2, g1 = acc[ai][0][m][1] * r2, u0 = acc[ai][1][m][0] * r2, u1 = acc[ai][1][m][1] * r2;
                *(u32x4*)(ACT + (size_t)r * 5632 + col0) = pack8(silu4(g0) * u0, silu4(g1) * u1); }
    }
};
template <class Epi, class Sched, bool ALIGN_EPI = false, bool SP2 = false>
__device__ __forceinline__ void gemm_phase(PG8_LAS unsigned char* lds, const Gemm g, const Sched& S, const Epi& E) {
    int tid_ = threadIdx.x; asm volatile("" : "+v"(tid_));
    const int tid = tid_, wid = __builtin_amdgcn_readfirstlane(tid >> 6), lane = tid & 63, wr = wid >> 2, wc = wid & 3, fr = lane & 15, fq = lane >> 4;
    const int K = g.K, nt = K / BK;
    unsigned voffA[2], voffB[2];
#pragma unroll
    for (int i = 0; i < 2; ++i) { int R, C; stage_rc(tid * 16 + i * 8192, R, C); const int Rb = Epi::PERM ? ((R & ~31) + perm32(R & 31)) : R;
        voffA[i] = (unsigned)(R * K + C) * 2u; voffB[i] = (unsigned)(Rb * K + C) * 2u; }
    const size_t kstep = (size_t)(BK * 2);
    const size_t hstep = (size_t)HALF * K * 2;
    const size_t tstep = 2 * hstep;
    const unsigned ldsw = (unsigned)wid * 1024u;
    const int aoff = lds_byte(wr * 64 + fr, fq * 8), boff = lds_byte(wc * 32 + fr, fq * 8);
#define PG8_SA(b, h) (((b) * 2 + (h)) * HTB)
#define PG8_SB(b, h) ((4 + (b) * 2 + (h)) * HTB)
#define PG8_STAGE(bufoff, gbase, voff) do { _Pragma("unroll") for (int _i = 0; _i < 2; ++_i) \
        __builtin_amdgcn_global_load_lds((const unsigned*)((const char*)(gbase) + (voff)[_i]), (PG8_LAS unsigned*)(lds + (bufoff) + ldsw + _i * 8192), 16, 0, 0); } while (0)
#define PG8_LDA(dst, b, h) do { _Pragma("unroll") for (int m = 0; m < 4; ++m) _Pragma("unroll") for (int k = 0; k < 2; ++k) dst[m][k] = *(const PG8_LAS bf16x8*)(lds + PG8_SA(b, h) + aoff + m * 2048 + k * 1024); } while (0)
#define PG8_LDB(dst, b, h) do { _Pragma("unroll") for (int n = 0; n < 2; ++n) _Pragma("unroll") for (int k = 0; k < 2; ++k) dst[n][k] = *(const PG8_LAS bf16x8*)(lds + PG8_SB(b, h) + boff + n * 2048 + k * 1024); } while (0)
#define PG8_MMA(ai, bj, At, Bt) do { __builtin_amdgcn_s_setprio(1); _Pragma("unroll") for (int m = 0; m < 4; ++m) _Pragma("unroll") for (int n = 0; n < 2; ++n) _Pragma("unroll") for (int k = 0; k < 2; ++k) \
        acc[ai][bj][m][n] = __builtin_amdgcn_mfma_f32_16x16x32_bf16(Bt[n][k], At[m][k], acc[ai][bj][m][n], 0, 0, 0); __builtin_amdgcn_s_setprio(0); } while (0)
#define PG8_WAIT_V(n) asm volatile("s_waitcnt vmcnt(" #n ")" ::: "memory")
#define PG8_WAIT_L(n) asm volatile("s_waitcnt lgkmcnt(" #n ")" ::: "memory")
#define PG8_BAR __builtin_amdgcn_s_barrier()
#define PG8_SCHED __builtin_amdgcn_sched_barrier(0)
    Unit cur, nxt; int ui = 0;
    if (!S.next(0, cur)) return;
    f32x4 acc[2][2][4][2];
#pragma unroll
    for (int a = 0; a < 2; ++a)
#pragma unroll
        for (int b = 0; b < 2; ++b)
#pragma unroll
            for (int m = 0; m < 4; ++m)
#pragma unroll
                for (int n = 0; n < 2; ++n) acc[a][b][m][n] = (f32x4){0.f, 0.f, 0.f, 0.f};
    bf16x8 At[4][2], B0[2][2], B1[2][2];
    const char* cA = (const char*)g.A + (size_t)cur.pm * tstep; const char* cB = (const char*)g.Bt + (size_t)cur.pn * tstep;
    S.a_ready(cur);
    if constexpr (SP2) {
        PG8_STAGE(PG8_SB(0, 0), cB, voffB); PG8_STAGE(PG8_SB(0, 1), cB + hstep, voffB); PG8_STAGE(PG8_SA(0, 0), cA, voffA); PG8_STAGE(PG8_SA(0, 1), cA + hstep, voffA);
        if (wr == 1) PG8_BAR;
        PG8_WAIT_V(2); PG8_BAR;
        PG8_STAGE(PG8_SB(1, 0), cB + kstep, voffB); PG8_STAGE(PG8_SA(1, 0), cA + kstep, voffA); PG8_STAGE(PG8_SB(1, 1), cB + hstep + kstep, voffB);
        PG8_WAIT_V(6); PG8_BAR;
    } else {
        PG8_STAGE(PG8_SB(0, 0), cB, voffB); PG8_STAGE(PG8_SA(0, 0), cA, voffA); PG8_STAGE(PG8_SB(0, 1), cB + hstep, voffB); PG8_STAGE(PG8_SA(0, 1), cA + hstep, voffA);
        if (wr == 1) PG8_BAR;
        PG8_WAIT_V(4); PG8_BAR;
        PG8_STAGE(PG8_SB(1, 0), cB + kstep, voffB); PG8_STAGE(PG8_SA(1, 0), cA + kstep, voffA); PG8_STAGE(PG8_SB(1, 1), cB + hstep + kstep, voffB);
        PG8_WAIT_V(6); PG8_BAR;
    }
    for (;;) {
        const bool has_next = S.next(ui + 1, nxt);
        const char* nA = has_next ? (const char*)g.A + (size_t)nxt.pm * tstep : cA; const char* nB = has_next ? (const char*)g.Bt + (size_t)nxt.pn * tstep : cB;
        for (int t = 0; t < nt; t += 2) {
            const bool last = (t == nt - 2);
            const char* a1 = cA + (size_t)(t + 1) * kstep;
            const char* a2 = last ? nA : cA + (size_t)(t + 2) * kstep; const char* b2 = last ? nB : cB + (size_t)(t + 2) * kstep;
            const char* a3 = a2 + kstep; const char* b3 = b2 + kstep;
            if (last && has_next) S.a_ready(nxt);
            if constexpr (SP2) {
            PG8_LDB(B0, 0, 0); PG8_LDB(B1, 0, 1); PG8_SCHED; PG8_LDA(At, 0, 0); PG8_STAGE(PG8_SA(1, 1), a1 + hstep, voffA);
            PG8_WAIT_V(8); PG8_WAIT_L(0); PG8_BAR; PG8_MMA(0, 0, At, B0); PG8_MMA(0, 1, At, B1); PG8_BAR; PG8_SCHED;
            PG8_LDA(At, 0, 1); PG8_STAGE(PG8_SB(0, 0), b2, voffB); PG8_STAGE(PG8_SB(0, 1), b2 + hstep, voffB); PG8_STAGE(PG8_SA(0, 0), a2, voffA);
            PG8_WAIT_V(8); PG8_WAIT_L(0); PG8_BAR; PG8_MMA(1, 0, At, B0); PG8_MMA(1, 1, At, B1); PG8_BAR; PG8_SCHED;
            PG8_LDB(B0, 1, 0); PG8_LDB(B1, 1, 1); PG8_SCHED; PG8_LDA(At, 1, 0); PG8_STAGE(PG8_SA(0, 1), a2 + hstep, voffA);
            PG8_WAIT_V(8); PG8_WAIT_L(0); PG8_BAR; PG8_MMA(0, 0, At, B0); PG8_MMA(0, 1, At, B1); PG8_BAR; PG8_SCHED;
            PG8_LDA(At, 1, 1); PG8_STAGE(PG8_SB(1, 0), b3, voffB); PG8_STAGE(PG8_SB(1, 1), b3 + hstep, voffB); PG8_STAGE(PG8_SA(1, 0), a3, voffA);
            PG8_WAIT_V(8); PG8_WAIT_L(0); PG8_BAR; PG8_MMA(1, 0, At, B0); PG8_MMA(1, 1, At, B1); PG8_BAR; PG8_SCHED;
            } else {
            PG8_LDB(B0, 0, 0); PG8_SCHED; PG8_LDA(At, 0, 0); PG8_STAGE(PG8_SA(1, 1), a1 + hstep, voffA);
            PG8_WAIT_L(8); PG8_BAR; PG8_WAIT_L(0); PG8_MMA(0, 0, At, B0); PG8_BAR; PG8_SCHED;
            PG8_LDB(B1, 0, 1); PG8_STAGE(PG8_SB(0, 0), b2, voffB);
            PG8_BAR; PG8_WAIT_L(0); PG8_MMA(0, 1, At, B1); PG8_BAR;
            PG8_LDA(At, 0, 1); PG8_STAGE(PG8_SA(0, 0), a2, voffA);
            PG8_BAR; PG8_WAIT_L(0); PG8_MMA(1, 0, At, B0); PG8_BAR; PG8_SCHED;
            PG8_STAGE(PG8_SB(0, 1), b2 + hstep, voffB);
            PG8_WAIT_V(6); PG8_BAR; PG8_MMA(1, 1, At, B1); PG8_BAR;
            PG8_LDB(B0, 1, 0); PG8_SCHED; PG8_LDA(At, 1, 0); PG8_STAGE(PG8_SA(0, 1), a2 + hstep, voffA);
            PG8_WAIT_L(8); PG8_BAR; PG8_WAIT_L(0); PG8_MMA(0, 0, At, B0); PG8_BAR; PG8_SCHED;
            PG8_LDB(B1, 1, 1); PG8_STAGE(PG8_SB(1, 0), b3, voffB);
            PG8_BAR; PG8_WAIT_L(0); PG8_MMA(0, 1, At, B1); PG8_BAR;
            PG8_LDA(At, 1, 1); PG8_STAGE(PG8_SA(1, 0), a3, voffA);
            PG8_BAR; PG8_WAIT_L(0); PG8_MMA(1, 0, At, B0); PG8_BAR; PG8_SCHED;
            PG8_STAGE(PG8_SB(1, 1), b3 + hstep, voffB);
            PG8_WAIT_V(6); PG8_BAR; PG8_MMA(1, 1, At, B1); PG8_BAR;
            }
        }
        if constexpr (ALIGN_EPI) { if (wr == 0) PG8_BAR; }
        if constexpr (!Epi::AFTER_DRAIN) { E(acc, cur, wr, wc, fr, fq); S.done(cur); }
        if (!has_next) break;
#pragma unroll
        for (int a = 0; a < 2; ++a)
#pragma unroll
            for (int b = 0; b < 2; ++b)
#pragma unroll
                for (int m = 0; m < 4; ++m)
#pragma unroll
                    for (int n = 0; n < 2; ++n) acc[a][b][m][n] = (f32x4){0.f, 0.f, 0.f, 0.f};
        cur = nxt; cA = nA; cB = nB; ++ui;
        if constexpr (ALIGN_EPI) { if (wr == 1) PG8_BAR; }
    }
    PG8_WAIT_V(0);
    if constexpr (!ALIGN_EPI) { if (wr == 0) PG8_BAR; }
    PG8_BAR;
    if constexpr (Epi::AFTER_DRAIN) { E.fused(acc, cur, wr, wc, fr, fq, lds, wid, lane); S.done(cur); }
#undef PG8_SA
#undef PG8_SB
#undef PG8_STAGE
#undef PG8_LDA
#undef PG8_LDB
#undef PG8_MMA
#undef PG8_WAIT_V
#undef PG8_WAIT_L
#undef PG8_BAR
#undef PG8_SCHED
}
}
#define XB_TMO      128
#define XB_XCNT(j)  (256  + 64 * (j))
#define XB_XSUB(j)  (1280 + 64 * (j))
#define XB_XGEN(j)  (2304 + 64 * (j))
#define XB_TOP      3328
#define XB_TOPGEN   3392
#define XCD_BAR_WORDS 3456
#define XB_SPIN_CAP (1u << 18)

__device__ __forceinline__ unsigned xb_ld(unsigned* p)              { return __hip_atomic_load(p, __ATOMIC_RELAXED, __HIP_MEMORY_SCOPE_AGENT); }
__device__ __forceinline__ unsigned xb_add(unsigned* p, unsigned v) { return __hip_atomic_fetch_add(p, v, __ATOMIC_RELAXED, __HIP_MEMORY_SCOPE_AGENT); }
__device__ __forceinline__ unsigned xb_xcc_id() { return (unsigned)__builtin_amdgcn_s_getreg((3 << 11) | 20) & 0xFu; }
#define XB_SPIN(cond, bar) do { unsigned _sp = 0; while (cond) { __builtin_amdgcn_s_sleep(1); \
    if ((++_sp & 255u) == 0u) { if (xb_ld(&(bar)[XB_TMO])) break; if (_sp > XB_SPIN_CAP) { atomicAdd(&(bar)[XB_TMO], 1u); break; } } } } while (0)

struct XcdBarrier {
    unsigned* bar; unsigned x;
    volatile LAS unsigned* st;
};

__device__ __forceinline__ XcdBarrier xcd_barrier_post(unsigned* bar, volatile LAS unsigned* st) {
    XcdBarrier b; b.bar = bar; b.x = xb_xcc_id(); b.st = st;
    if (threadIdx.x == 0) (void)xb_add(&bar[XB_XCNT(b.x)], 1u);
    return b;
}
__device__ __forceinline__ void xcd_barrier_complete(unsigned* bar, unsigned x, unsigned& nloc, unsigned& nx) {
    const unsigned G = gridDim.x * gridDim.y * gridDim.z;
    unsigned sum, cnt, mine, sp = 0u;
    for (;;) {
        sum = 0u; cnt = 0u; mine = 0u;
#pragma unroll
        for (unsigned j = 0; j < 16; ++j) { const unsigned c = xb_ld(&bar[XB_XCNT(j)]); sum += c; cnt += (c > 0u) ? 1u : 0u; mine = (j == x) ? c : mine; }
        if (sum == G) break;
        __builtin_amdgcn_s_sleep(1);
        if ((++sp & 255u) == 0u) { if (xb_ld(&bar[XB_TMO])) break; if (sp > XB_SPIN_CAP) { atomicAdd(&bar[XB_TMO], 1u); break; } }
    }
    nloc = mine > 0u ? mine : 1u; nx = cnt > 0u ? cnt : 1u;
}

__device__ __forceinline__ void xcd_barrier(const XcdBarrier& b) {
    asm volatile("s_waitcnt vmcnt(0)" ::: "memory");
    __syncthreads();
    if (threadIdx.x == 0) {
        unsigned* bar = b.bar;
        __builtin_amdgcn_s_waitcnt(0);
        unsigned nloc = b.st[0], nx = b.st[1];
        if (nloc == 0u) { xcd_barrier_complete(bar, b.x, nloc, nx); b.st[0] = nloc; b.st[1] = nx; }
        const unsigned old = xb_add(&bar[XB_XSUB(b.x)], 1u);
        const unsigned gen = old / nloc;
        if (old + 1u == (gen + 1u) * nloc) {
            __builtin_amdgcn_fence(__ATOMIC_RELEASE, "agent");
            asm volatile("s_waitcnt vmcnt(0)" ::: "memory");
            const unsigned og = xb_add(&bar[XB_TOP], 1u);
            const unsigned tg = og / nx;
            if (og + 1u == (tg + 1u) * nx) xb_add(&bar[XB_TOPGEN], 1u);
            else XB_SPIN(xb_ld(&bar[XB_TOPGEN]) == tg, bar);
            __builtin_amdgcn_fence(__ATOMIC_ACQUIRE, "agent");
            xb_add(&bar[XB_XGEN(b.x)], 1u);
            asm volatile("s_waitcnt vmcnt(0)" ::: "memory");
        } else {
            XB_SPIN(xb_ld(&bar[XB_XGEN(b.x)]) == gen, bar);
            __builtin_amdgcn_fence(__ATOMIC_ACQUIRE, "agent");
            asm volatile("s_waitcnt vmcnt(0)" ::: "memory");
        }
    }
    __syncthreads();
}
struct Frame {
    LAS unsigned char* lds; volatile LAS unsigned* MISC; gu32* ctl;
    int tid, lane, wave, vcu, G;
    float* out; unsigned char* ws;
};
__device__ __forceinline__ void delay_us(int us) { const unsigned long long t0 = __builtin_amdgcn_s_memrealtime(); while (__builtin_amdgcn_s_memrealtime() - t0 < (unsigned long long)us * 100ull) __builtin_amdgcn_s_sleep(8); }
__device__ __forceinline__ float wave_sum(float v) {
#pragma unroll
    for (int o = 1; o < 64; o <<= 1) v += __shfl_xor(v, o);
    return v;
}
template <int MODE> __device__ __forceinline__ int rowmap(int n) {
    if (MODE == 1) { if (n >= 2048) return n; const int j = n & 127, hb = n & ~127; return hb + (j < 64 ? 8 * (j >> 2) + (j & 3) : 8 * ((j - 64) >> 2) + 4 + (j & 3)); }
    if (MODE == 2) { return n < DFF ? (n >> 7) * 256 + (n & 127) : ((n - DFF) >> 7) * 256 + 128 + ((n - DFF) & 127); }
    return n;
}
template <int MODE> __device__ __forceinline__ void p0_transpose_item(const float* W, int K, int N, bf16* WT, const float* g, LAS unsigned* T, int item, int lane) {
    const int nblk = N / 64, kb = item / nblk, nb = item % nblk, k0 = 64 * kb, n0 = 64 * nb;
    const int l15 = lane & 15, lg = lane >> 4;
    f32x4 v[16];
#pragma unroll
    for (int i = 0; i < 16; ++i) { const int row = 8 * (i >> 1) + 2 * lg + (i & 1); v[i] = *(const f32x4*)(W + (size_t)(k0 + row) * N + n0 + 4 * l15); }
    if (g) {
#pragma unroll
        for (int i = 0; i < 16; ++i) { const int row = 8 * (i >> 1) + 2 * lg + (i & 1); v[i] = v[i] * g[k0 + row]; } }
#pragma unroll
    for (int p = 0; p < 8; ++p)
#pragma unroll
        for (int j = 0; j < 4; ++j) T[(4 * l15 + j) * 33 + 4 * p + lg] = pk2(v[2 * p][j], v[2 * p + 1][j]);
    LDS_WAIT(); asm volatile("" ::: "memory");
    const int c = lane & 7;
#pragma unroll
    for (int i = 0; i < 8; ++i) { const int n = (lane >> 3) + 8 * i; const LAS unsigned* s = T + n * 33 + 4 * c;
        v4u o; o.x = s[0]; o.y = s[1]; o.z = s[2]; o.w = s[3];
        *(GAS v4u*)(WT + (size_t)rowmap<MODE>(n0 + n) * K + k0 + 8 * c) = o; }
    LDS_WAIT(); asm volatile("" ::: "memory");
}
struct Args { const float* in[15]; float* out; unsigned char* ws; int ph_lo, ph_hi, use_bar, pad; };
__device__ __forceinline__ void p0_prologue(Frame& F, const Args& A) {
    LAS unsigned* scr = (LAS unsigned*)(F.lds + F.wave * 16384);
    const int gw = F.vcu * NWAVES + F.wave, NGW = F.G * NWAVES;
    unsigned char* ws = F.ws;
    constexpr int I_IN = 32 * (NIN / 64), I_RO = 32 * 32, I_HO = 16 * 32, I_OUT = 32 * 32, I_FI = 32 * (2 * DFF / 64), I_FO = (DFF / 64) * 32;
    constexpr int NITEMS = I_IN + I_RO + I_HO + I_OUT + I_FI + I_FO;
    for (int it = gw; it < NITEMS; it += NGW) {
        int r = it;
        if (r < I_IN) { p0_transpose_item<0>(A.in[4], 2048, NIN, (bf16*)(ws + WS_WIN), A.in[8], scr, r, F.lane); continue; } r -= I_IN;
        if (r < I_RO) { p0_transpose_item<0>(A.in[5], 2048, 2048, (bf16*)(ws + WS_WRO), nullptr, scr, r, F.lane); continue; } r -= I_RO;
        if (r < I_HO) { p0_transpose_item<0>(A.in[6], 1024, 2048, (bf16*)(ws + WS_WHO), nullptr, scr, r, F.lane); continue; } r -= I_HO;
        if (r < I_OUT) { p0_transpose_item<0>(A.in[7], 2048, 2048, (bf16*)(ws + WS_WOUT), nullptr, scr, r, F.lane); continue; } r -= I_OUT;
        if (r < I_FI) { p0_transpose_item<2>(A.in[12], 2048, 2 * DFF, (bf16*)(ws + WS_WFI), A.in[9], scr, r, F.lane); continue; } r -= I_FI;
        p0_transpose_item<0>(A.in[13], DFF, 2048, (bf16*)(ws + WS_WFO), nullptr, scr, r, F.lane);
    }
    bf16* XB = (bf16*)(ws + WS_XB);
    for (int m = gw; m < MPAD; m += NGW) {
        GAS unsigned long long* o8 = (GAS unsigned long long*)(XB + (size_t)m * 2048) + F.lane;
        if (m < MROWS) {
            const float* xrow = m < 8192 ? A.in[0] + (size_t)m * 2048 : A.in[1] + (size_t)(m - 8192) * 2048;
            const GAS f32x4* xr = (const GAS f32x4*)xrow + F.lane;
            f32x4 v[8]; float s = 0.f;
#pragma unroll
            for (int j = 0; j < 8; ++j) { v[j] = xr[64 * j]; s += (v[j].x * v[j].x + v[j].y * v[j].y) + (v[j].z * v[j].z + v[j].w * v[j].w); }
            const float rr = 1.0f / sqrtf(wave_sum(s) * (1.0f / 2048.0f) + EPS);
#pragma unroll
            for (int j = 0; j < 8; ++j) o8[64 * j] = (unsigned long long)pk2(v[j].x * rr, v[j].y * rr) | ((unsigned long long)pk2(v[j].z * rr, v[j].w * rr) << 32);
        } else {
#pragma unroll
            for (int j = 0; j < 8; ++j) o8[64 * j] = 0ull;
        }
    }
    { float* COS = (float*)(ws + WS_COS); float* SIN = (float*)(ws + WS_SIN);
      for (int i = (F.vcu * NWAVES + F.wave) * 64 + F.lane; i < 2049 * 64; i += F.G * NWAVES * 64) { const int p = i >> 6, j = i & 63; const int pos = p < 2048 ? p : 16384;
          const float inv = powf(10000.0f, -(float)j / 64.0f); const float ang = (float)pos * inv; float sn, cs; sincosf(ang, &sn, &cs); COS[i] = cs; SIN[i] = sn; } }
    { float* LB = (float*)(ws + WS_LB); const int i = (F.vcu * NWAVES + F.wave) * 64 + F.lane; if (i < 1024) { const float l0 = A.in[11][i], l1 = A.in[11][1024 + i]; LB[i] = 1.0f / (1.0f + expf(l1 - l0)); } }
}
typedef short bf16x4v __attribute__((ext_vector_type(4)));
#define MFMA16(a, b, c) __builtin_amdgcn_mfma_f32_16x16x32_bf16((a), (b), (c), 0, 0, 0)
constexpr int TP = 136;
constexpr size_t OUT_YS = 8192ull * 2048, OUT_SRP = 8320ull * 2048, OUT_SHP = OUT_SRP + 4ull * 8 * 128 * 256, OUT_SRS = OUT_SHP + 4ull * 8 * 128 * 128, OUT_SHS = OUT_SRS + 128ull * 8 * 128 * 256;
__device__ __forceinline__ int tsw(int r, int m) { return r * TP + ((r >> 3) << 3) + m; }
__device__ __forceinline__ int tsw64(int r, int m) { return r * 72 + ((r >> 3) << 3) + m; }
constexpr int TSZ128 = 128 * TP + 128, TSZ64R = 64 * TP + 64, TSZ32R = 32 * TP + 32, TSZ256 = 256 * TP + 256, TSZ64T = 128 * 72 + 128;
__device__ __forceinline__ float lg2gamma(int h) { return log2f(1.0f - exp2f(-5.0f - (float)h)); }
__device__ __forceinline__ float bfe(const v4u& w, int j) { const unsigned x = w[j >> 1]; return __uint_as_float((j & 1) ? (x & 0xffff0000u) : (x << 16)); }
__device__ __forceinline__ bf16x8 pack_f8(const float* v) { v4u w; w.x = pk2(v[0], v[1]); w.y = pk2(v[2], v[3]); w.z = pk2(v[4], v[5]); w.w = pk2(v[6], v[7]); return __builtin_bit_cast(bf16x8, w); }

__device__ __forceinline__ void p2_ret_unit(Frame& F, int u) {
    unsigned char* ws = F.ws;
    const int es = u & 1, h = (u >> 1) & 7, b = u >> 4;
    const int w = F.wave, l15 = F.lane & 15, g = F.lane >> 4;
    LAS bf16* KT = (LAS bf16*)F.lds; LAS bf16* VT = KT + TSZ128;
    const bf16* Kg = (const bf16*)(ws + WS_K); const bf16* Vg = (const bf16*)(ws + WS_V);
    const float* COS = (const float*)(ws + WS_COS); const float* SIN = (const float*)(ws + WS_SIN);
    const float lg = lg2gamma(h), cd = exp2f(128.0f * lg);
    const int dc = F.tid & 7, m0 = F.tid >> 3;
    const int vc = F.tid & 15, vm0 = F.tid >> 4;
    v4u ka[2], kb[2], va[4]; f32x4 cc[2][2], sn[2][2];
#define P2R_LOAD(c) do { _Pragma("unroll") for (int _i = 0; _i < 2; ++_i) { const int _m = m0 + 64 * _i, _r = b * 2048 + (c) * 128 + _m, _pos = (c) * 128 + _m, _d0 = 8 * dc; \
        const bf16* _kp = Kg + (size_t)_r * 1024 + h * 128 + _d0; ka[_i] = *(const v4u*)_kp; kb[_i] = *(const v4u*)(_kp + 64); \
        cc[_i][0] = *(const f32x4*)(COS + _pos * 64 + _d0); cc[_i][1] = *(const f32x4*)(COS + _pos * 64 + _d0 + 4); sn[_i][0] = *(const f32x4*)(SIN + _pos * 64 + _d0); sn[_i][1] = *(const f32x4*)(SIN + _pos * 64 + _d0 + 4); } \
        _Pragma("unroll") for (int _i = 0; _i < 4; ++_i) va[_i] = *(const v4u*)(Vg + (size_t)(b * 2048 + (c) * 128 + vm0 + 32 * _i) * 2048 + h * 256 + 128 * es + 8 * vc); } while (0)
    f32x4 S[8];
#pragma unroll
    for (int j = 0; j < 8; ++j) S[j] = (f32x4){0.f, 0.f, 0.f, 0.f};
    const float dec2[2] = {exp2f((float)(127 - m0) * lg), exp2f((float)(63 - m0) * lg)};
    P2R_LOAD(0);
    for (int c = 0; c < 16; ++c) {
        __syncthreads();
#pragma unroll
        for (int i = 0; i < 2; ++i) { const int m = m0 + 64 * i; const float dec = dec2[i];
            LAS bf16* k1 = KT + tsw(8 * dc, m); LAS bf16* k2 = KT + tsw(64 + 8 * dc, m);
#pragma unroll
            for (int j = 0; j < 8; ++j) { const float x1 = bfe(ka[i], j), x2 = bfe(kb[i], j), cj = cc[i][j >> 2][j & 3], sj = sn[i][j >> 2][j & 3];
                k1[j * TP] = (bf16)f2bf((x1 * cj - x2 * sj) * dec); k2[j * TP] = (bf16)f2bf((x2 * cj + x1 * sj) * dec); } }
#pragma unroll
        for (int i = 0; i < 4; ++i) { LAS bf16* vt = VT + tsw(8 * vc, vm0 + 32 * i);
#pragma unroll
            for (int j = 0; j < 8; ++j) vt[j * TP] = (bf16)((va[i][j >> 1] >> (16 * (j & 1))) & 0xffffu); }
        if (c + 1 < 16) P2R_LOAD(c + 1);
        __syncthreads();
        f32x4 kv[8];
#pragma unroll
        for (int j = 0; j < 8; ++j) kv[j] = (f32x4){0.f, 0.f, 0.f, 0.f};
#pragma unroll
        for (int ks = 0; ks < 4; ++ks) { const bf16x8 bfr = *(const LAS bf16x8*)&VT[tsw(16 * w + l15, 32 * ks + 8 * g)];
#pragma unroll
            for (int j = 0; j < 8; ++j) { const bf16x8 af = *(const LAS bf16x8*)&KT[tsw(16 * j + l15, 32 * ks + 8 * g)]; kv[j] = MFMA16(af, bfr, kv[j]); } }
        bf16* st = (bf16*)(ws + WS_SRT) + ((size_t)((b * 8 + h) * 16 + c) * 256 + 128 * es + 16 * w + l15) * 128 + 4 * g;
#pragma unroll
        for (int j = 0; j < 8; ++j) { v2u p; p.x = pk2(S[j][0], S[j][1]); p.y = pk2(S[j][2], S[j][3]); *(v2u*)(st + 16 * j) = p; S[j] = S[j] * cd + kv[j]; }
    }
#undef P2R_LOAD
    float* fo = F.out + OUT_SRP + ((size_t)(b * 8 + h) * 128 + 4 * g) * 256 + 128 * es + 16 * w + l15;
#pragma unroll
    for (int j = 0; j < 8; ++j)
#pragma unroll
        for (int reg = 0; reg < 4; ++reg) fo[(size_t)(16 * j + reg) * 256] = S[j][reg];
}
__device__ __forceinline__ void p2_hg_unit(Frame& F, int u) {
    unsigned char* ws = F.ws;
    const int es = u & 1, h = (u >> 1) & 7, b = u >> 4;
    const int w = F.wave, l15 = F.lane & 15, g = F.lane >> 4, et = w & 3, dh = w >> 2;
    LAS bf16* KT = (LAS bf16*)F.lds; LAS bf16* VT = KT + TSZ128; LAS float* LQ = (LAS float*)(VT + TSZ64R); LAS float* BT = LQ + 4 * 128;
    const float* Z = (const float*)(ws + WS_LOGF); const bf16* HI = (const bf16*)(ws + WS_HI);
    const int d = F.tid & 127, q = F.tid >> 7; const float oml = 1.0f - ((const float*)(ws + WS_LB))[h * 128 + d];
    const int vc = F.tid & 7, vm0 = F.tid >> 3;
    float z[32]; v4u va[2];
#define P2H_LOAD(sc) do { const int _r0 = b * 2048 + (sc) * 128; _Pragma("unroll") for (int _i = 0; _i < 32; ++_i) z[_i] = Z[(size_t)(_r0 + 32 * q + _i) * 1024 + h * 128 + d]; \
        _Pragma("unroll") for (int _i = 0; _i < 2; ++_i) va[_i] = *(const v4u*)(HI + (size_t)(_r0 + vm0 + 64 * _i) * 1024 + h * 128 + 64 * es + 8 * vc); } while (0)
    f32x4 S[4];
#pragma unroll
    for (int j = 0; j < 4; ++j) S[j] = (f32x4){0.f, 0.f, 0.f, 0.f};
    P2H_LOAD(0);
    for (int sc = 0; sc < 16; ++sc) {
        float lf[32], kin[32]; float L = 0.f;
#pragma unroll
        for (int i = 0; i < 32; ++i) { kin[i] = oml * __builtin_amdgcn_rcpf(1.0f + __expf(z[i])); lf[i] = __logf(1.0f - kin[i]); L += lf[i]; }
        __syncthreads();
        LQ[q * 128 + d] = L;
#pragma unroll
        for (int i = 0; i < 2; ++i) { LAS bf16* vt = VT + tsw(8 * vc, vm0 + 64 * i);
#pragma unroll
            for (int j = 0; j < 8; ++j) vt[j * TP] = (bf16)((va[i][j >> 1] >> (16 * (j & 1))) & 0xffffu); }
        if (sc + 1 < 16) P2H_LOAD(sc + 1);
        __syncthreads();
        float run = 0.f;
#pragma unroll
        for (int q2 = 1; q2 < 4; ++q2) if (q2 > q) run += LQ[q2 * 128 + d];
#pragma unroll
        for (int blk = 3; blk >= 0; --blk) { float v[8];
#pragma unroll
            for (int jj = 7; jj >= 0; --jj) { const int i = 8 * blk + jj; v[jj] = kin[i] * __expf(run); run += lf[i]; }
            *(LAS bf16x8*)&KT[tsw(d, 32 * q + 8 * blk)] = pack_f8(v); }
        if (q == 0) BT[d] = run;
        __syncthreads();
        f32x4 hs[4];
#pragma unroll
        for (int j = 0; j < 4; ++j) hs[j] = (f32x4){0.f, 0.f, 0.f, 0.f};
#pragma unroll
        for (int ks = 0; ks < 4; ++ks) { const bf16x8 bfr = *(const LAS bf16x8*)&VT[tsw(16 * et + l15, 32 * ks + 8 * g)];
#pragma unroll
            for (int j = 0; j < 4; ++j) { const bf16x8 af = *(const LAS bf16x8*)&KT[tsw(16 * (4 * dh + j) + l15, 32 * ks + 8 * g)]; hs[j] = MFMA16(af, bfr, hs[j]); } }
        bf16* st = (bf16*)(ws + WS_SHT) + ((size_t)((b * 8 + h) * 16 + sc) * 128 + 64 * es + 16 * et + l15) * 128 + 64 * dh + 4 * g;
#pragma unroll
        for (int j = 0; j < 4; ++j) { v2u p; p.x = pk2(S[j][0], S[j][1]); p.y = pk2(S[j][2], S[j][3]); *(v2u*)(st + 16 * j) = p;
            const f32x4 bt = *(const LAS f32x4*)&BT[16 * (4 * dh + j) + 4 * g];
#pragma unroll
            for (int reg = 0; reg < 4; ++reg) S[j][reg] = S[j][reg] * __expf(bt[reg]) + hs[j][reg]; }
    }
#undef P2H_LOAD
    float* fo = F.out + OUT_SHP + ((size_t)(b * 8 + h) * 128 + 64 * dh + 4 * g) * 128 + 64 * es + 16 * et + l15;
#pragma unroll
    for (int j = 0; j < 4; ++j)
#pragma unroll
        for (int reg = 0; reg < 4; ++reg) fo[(size_t)(16 * j + reg) * 128] = S[j][reg];
}
__device__ __forceinline__ void p2_sret_all(Frame& F, const Args& A, unsigned* ctr) {
    unsigned char* ws = F.ws;
    LAS float* qs = (LAS float*)F.lds; LAS float* ks = qs + 128; LAS float* vs = ks + 128; LAS float* ored = vs + 256;
    const bf16* Q = (const bf16*)(ws + WS_Q); const bf16* K = (const bf16*)(ws + WS_K); const bf16* V = (const bf16*)(ws + WS_V);
    const int e4 = F.tid & 63, dq = F.tid >> 6;
    __syncthreads();
    if (F.tid == 0) F.MISC[16] = atomicAdd(ctr, 1u);
    __syncthreads();
    int it = (int)F.MISC[16]; if (it >= 1024) return;
    f32x4 s[16];
    { const float* Sin = A.in[2] + (size_t)it * 128 * 256;
#pragma unroll
      for (int i = 0; i < 16; ++i) s[i] = *(const f32x4*)(Sin + (size_t)(16 * dq + i) * 256 + 4 * e4); }
    for (;;) {
        const int h = it & 7, b = it >> 3, r = 8192 + b;
        __syncthreads();
        if (F.tid == 0) F.MISC[16] = atomicAdd(ctr, 1u);
        if (F.tid < 64) { const int d = F.tid; const float cs = ((const float*)(ws + WS_COS))[2048 * 64 + d], sn = ((const float*)(ws + WS_SIN))[2048 * 64 + d];
            const float q1 = bf2f(Q[(size_t)r * 1024 + h * 128 + d]), q2 = bf2f(Q[(size_t)r * 1024 + h * 128 + 64 + d]), k1 = bf2f(K[(size_t)r * 1024 + h * 128 + d]), k2 = bf2f(K[(size_t)r * 1024 + h * 128 + 64 + d]);
            qs[d] = q1 * cs - q2 * sn; qs[d + 64] = q2 * cs + q1 * sn; ks[d] = k1 * cs - k2 * sn; ks[d + 64] = k2 * cs + k1 * sn; }
        else if (F.tid >= 256) { const int e = F.tid - 256; vs[e] = bf2f(V[(size_t)r * 2048 + h * 256 + e]); }
        __syncthreads();
        const int nx = (int)F.MISC[16];
        const float gam = 1.0f - exp2f(-5.0f - (float)h);
        float* Sout = F.out + OUT_SRS + (size_t)it * 128 * 256;
        const f32x4 v4 = *(const LAS f32x4*)&vs[4 * e4]; f32x4 o = (f32x4){0.f, 0.f, 0.f, 0.f};
#pragma unroll
        for (int i = 0; i < 16; ++i) { const int d = 16 * dq + i; s[i] = s[i] * gam + v4 * ks[d]; *(f32x4*)(Sout + (size_t)d * 256 + 4 * e4) = s[i]; o += s[i] * qs[d]; }
        *(LAS f32x4*)&ored[dq * 256 + 4 * e4] = o;
        if (nx < 1024) { const float* Sin = A.in[2] + (size_t)nx * 128 * 256;
#pragma unroll
            for (int i = 0; i < 16; ++i) s[i] = *(const f32x4*)(Sin + (size_t)(16 * dq + i) * 256 + 4 * e4); }
        __syncthreads();
        if (F.wave == 0) { float oo[4]; float ss = 0.f;
#pragma unroll
            for (int k = 0; k < 4; ++k) { const int e = F.lane + 64 * k; float t = 0.f;
#pragma unroll
                for (int j = 0; j < 8; ++j) t += ored[j * 256 + e];
                oo[k] = t; ss += t * t; }
            const float rr = 1.0f / sqrtf(wave_sum(ss) * (1.0f / 256.0f) + EPS);
            const bf16* RG = (const bf16*)(ws + WS_RG); bf16* OR = (bf16*)(ws + WS_OR);
#pragma unroll
            for (int k = 0; k < 4; ++k) { const size_t ix = (size_t)r * 2048 + h * 256 + F.lane + 64 * k; OR[ix] = (bf16)f2bf(oo[k] * rr * bf2f(RG[ix])); } }
        it = nx; if (it >= 1024) break;
    }
}
__device__ __forceinline__ void p2_shg_all(Frame& F, const Args& A, unsigned* ctr) {
    unsigned char* ws = F.ws;
    LAS float* qs = (LAS float*)F.lds; LAS float* fs = qs + 128; LAS float* kn = fs + 128; LAS float* vs = kn + 128; LAS float* ored = vs + 128;
    const int e4 = F.tid & 31, dq = F.tid >> 5;
    __syncthreads();
    if (F.tid == 0) F.MISC[16] = atomicAdd(ctr, 1u);
    __syncthreads();
    int it = (int)F.MISC[16]; if (it >= 1024) return;
    f32x4 s[8];
    { const float* Sin = A.in[3] + (size_t)it * 128 * 128;
#pragma unroll
      for (int i = 0; i < 8; ++i) s[i] = *(const f32x4*)(Sin + (size_t)(8 * dq + i) * 128 + 4 * e4); }
    for (;;) {
        const int h = it & 7, b = it >> 3, r = 8192 + b;
        __syncthreads();
        if (F.tid == 0) F.MISC[16] = atomicAdd(ctr, 1u);
        if (F.tid < 128) { const int d = F.tid; const size_t ix = (size_t)r * 1024 + h * 128 + d; const float z = ((const float*)(ws + WS_LOGF))[ix]; const float lb = ((const float*)(ws + WS_LB))[h * 128 + d];
            const float kin = (1.0f - lb) / (1.0f + __expf(z)); kn[d] = kin; fs[d] = 1.0f - kin; qs[d] = bf2f(((const bf16*)(ws + WS_HQ))[ix]); vs[d] = bf2f(((const bf16*)(ws + WS_HI))[ix]); }
        __syncthreads();
        const int nx = (int)F.MISC[16];
        float* Sout = F.out + OUT_SHS + (size_t)it * 128 * 128;
        const f32x4 v4 = *(const LAS f32x4*)&vs[4 * e4]; f32x4 o = (f32x4){0.f, 0.f, 0.f, 0.f};
#pragma unroll
        for (int i = 0; i < 8; ++i) { const int d = 8 * dq + i; s[i] = s[i] * fs[d] + v4 * kn[d]; *(f32x4*)(Sout + (size_t)d * 128 + 4 * e4) = s[i]; o += s[i] * qs[d]; }
        *(LAS f32x4*)&ored[dq * 128 + 4 * e4] = o;
        if (nx < 1024) { const float* Sin = A.in[3] + (size_t)nx * 128 * 128;
#pragma unroll
            for (int i = 0; i < 8; ++i) s[i] = *(const f32x4*)(Sin + (size_t)(8 * dq + i) * 128 + 4 * e4); }
        __syncthreads();
        if (F.wave == 0) { float oo[2]; float ss = 0.f;
#pragma unroll
            for (int k = 0; k < 2; ++k) { const int e = F.lane + 64 * k; float t = 0.f;
#pragma unroll
                for (int j = 0; j < 16; ++j) t += ored[j * 128 + e];
                oo[k] = t; ss += t * t; }
            const float rr = 1.0f / sqrtf(wave_sum(ss) * (1.0f / 128.0f) + EPS);
            const bf16* HG = (const bf16*)(ws + WS_HG); bf16* OH = (bf16*)(ws + WS_OH);
#pragma unroll
            for (int k = 0; k < 2; ++k) { const int e = F.lane + 64 * k; const size_t ix = (size_t)r * 1024 + h * 128 + e; OH[ix] = (bf16)f2bf(oo[k] * rr * A.in[10][e] * bf2f(HG[ix])); } }
        it = nx; if (it >= 1024) break;
    }
}
#ifndef PROBE_SUB
#define PROBE_SUB -1
#endif
__device__ __forceinline__ void p2_phase(Frame& F, const Args& A) {
    const int half = F.G >> 1;
    if (half == 0 || (F.vcu & 1) == 0) { const int stride = half ? half : 1;
        for (int u = F.vcu >> 1; u < 64; u += stride) p2_ret_unit(F, u);
        asm volatile("" : "+v"(F.tid), "+v"(F.lane));
        for (int u = (F.vcu >> 1) - 64; u < 64; u += stride) if (u >= 0) p2_hg_unit(F, u); }
    asm volatile("" : "+v"(F.tid), "+v"(F.lane));
    p2_sret_all(F, A, (unsigned*)(F.ctl + 64));
    asm volatile("" : "+v"(F.tid), "+v"(F.lane));
    p2_shg_all(F, A, (unsigned*)(F.ctl + 128));
}
__device__ __forceinline__ void p4_ret_item(Frame& F, int item) {
    unsigned char* ws = F.ws;
    const int c = item & 15, h = (item >> 4) & 7, b = item >> 7, r0 = b * 2048 + c * 128;
    const int w = F.wave, l15 = F.lane & 15, g = F.lane >> 4;
    LAS bf16* KS = (LAS bf16*)F.lds; LAS bf16* VT = KS + 128 * TP; LAS bf16* ST = VT + TSZ128;
    LAS bf16* OT = (LAS bf16*)F.lds;
    const bf16* Qg = (const bf16*)(ws + WS_Q); const bf16* Kg = (const bf16*)(ws + WS_K); const bf16* Vg = (const bf16*)(ws + WS_V);
    const bf16* Sg = (const bf16*)(ws + WS_SRT) + (size_t)item * 256 * 128;
    const float* COS = (const float*)(ws + WS_COS); const float* SIN = (const float*)(ws + WS_SIN);
    const float lg = lg2gamma(h);
    const int vc = F.tid & 15, vm0 = F.tid >> 4;
    v4u vp[4], sp[4];
#define P4R_LOAD(hh) do { _Pragma("unroll") for (int _i = 0; _i < 4; ++_i) { vp[_i] = *(const v4u*)(Vg + (size_t)(r0 + vm0 + 32 * _i) * 2048 + h * 256 + 128 * (hh) + 8 * vc); \
        sp[_i] = *(const v4u*)(Sg + (size_t)(128 * (hh) + vm0 + 32 * _i) * 128 + 8 * vc); } } while (0)
#define P4R_WRITE() do { _Pragma("unroll") for (int _i = 0; _i < 4; ++_i) { LAS bf16* _vt = VT + tsw(8 * vc, vm0 + 32 * _i); \
        _Pragma("unroll") for (int _j = 0; _j < 8; ++_j) _vt[_j * TP] = (bf16)((vp[_i][_j >> 1] >> (16 * (_j & 1))) & 0xffffu); \
        *(LAS v4u*)&ST[(vm0 + 32 * _i) * TP + 8 * vc] = sp[_i]; } } while (0)
    P4R_LOAD(0);
    __syncthreads();
#pragma unroll
    for (int i = 0; i < 2; ++i) { const int u = F.tid + 512 * i, d0 = (u & 7) * 8, m = u >> 3;
        const bf16* kp = Kg + (size_t)(r0 + m) * 1024 + h * 128 + d0; const v4u a = *(const v4u*)kp, bb = *(const v4u*)(kp + 64);
        const int pos = c * 128 + m; const f32x4 c0 = *(const f32x4*)(COS + pos * 64 + d0), c1 = *(const f32x4*)(COS + pos * 64 + d0 + 4), s0 = *(const f32x4*)(SIN + pos * 64 + d0), s1 = *(const f32x4*)(SIN + pos * 64 + d0 + 4);
        float o1[8], o2[8];
#pragma unroll
        for (int j = 0; j < 8; ++j) { const float x1 = bfe(a, j), x2 = bfe(bb, j), cj = j < 4 ? c0[j & 3] : c1[j & 3], sj = j < 4 ? s0[j & 3] : s1[j & 3]; o1[j] = x1 * cj - x2 * sj; o2[j] = x2 * cj + x1 * sj; }
        *(LAS bf16x8*)&KS[m * TP + d0] = pack_f8(o1); *(LAS bf16x8*)&KS[m * TP + 64 + d0] = pack_f8(o2); }
    P4R_WRITE();
    P4R_LOAD(1);
    bf16x8 qf[4];
    { const int n = 16 * w + l15, pos = c * 128 + n; const bf16* qp = Qg + (size_t)(r0 + n) * 1024 + h * 128 + 8 * g;
      const v4u a0 = *(const v4u*)qp, a1 = *(const v4u*)(qp + 32), a2 = *(const v4u*)(qp + 64), a3 = *(const v4u*)(qp + 96);
      float r0v[8], r1v[8], r2v[8], r3v[8];
#pragma unroll
      for (int hlf = 0; hlf < 2; ++hlf) { const int dd = 32 * hlf + 8 * g;
          const f32x4 c0 = *(const f32x4*)(COS + pos * 64 + dd), c1 = *(const f32x4*)(COS + pos * 64 + dd + 4), s0 = *(const f32x4*)(SIN + pos * 64 + dd), s1 = *(const f32x4*)(SIN + pos * 64 + dd + 4);
#pragma unroll
          for (int j = 0; j < 8; ++j) { const float cj = j < 4 ? c0[j & 3] : c1[j & 3], sj = j < 4 ? s0[j & 3] : s1[j & 3];
              const float x1 = hlf == 0 ? bfe(a0, j) : bfe(a1, j), x2 = hlf == 0 ? bfe(a2, j) : bfe(a3, j);
              if (hlf == 0) { r0v[j] = x1 * cj - x2 * sj; r2v[j] = x2 * cj + x1 * sj; } else { r1v[j] = x1 * cj - x2 * sj; r3v[j] = x2 * cj + x1 * sj; } } }
      qf[0] = pack_f8(r0v); qf[1] = pack_f8(r1v); qf[2] = pack_f8(r2v); qf[3] = pack_f8(r3v); }
    __syncthreads();
    bf16x8 pf[4];
#pragma unroll
    for (int s = 0; s < 4; ++s) { float pv[8];
#pragma unroll
        for (int hf = 0; hf < 2; ++hf) { const int mt = 2 * s + hf; f32x4 dd = (f32x4){0.f, 0.f, 0.f, 0.f};
            if (mt <= w) {
#pragma unroll
                for (int ks = 0; ks < 4; ++ks) { const bf16x8 kf = *(const LAS bf16x8*)&KS[(16 * mt + l15) * TP + 32 * ks + 8 * g]; dd = MFMA16(kf, qf[ks], dd); }
#pragma unroll
                for (int reg = 0; reg < 4; ++reg) { const int m = 16 * mt + 4 * g + reg, n = 16 * w + l15; dd[reg] = n >= m ? dd[reg] * exp2f((float)(n - m) * lg) : 0.f; } }
#pragma unroll
            for (int reg = 0; reg < 4; ++reg) pv[4 * hf + reg] = dd[reg]; }
        pf[s] = pack_f8(pv); }
    float rs[4];
#pragma unroll
    for (int reg = 0; reg < 4; ++reg) rs[reg] = exp2f((float)(16 * w + 4 * g + reg + 1) * lg);
    f32x4 O[16];
#pragma unroll
    for (int hh = 0; hh < 2; ++hh) {
        if (hh == 1) { __syncthreads(); P4R_WRITE(); __syncthreads(); }
#pragma unroll
        for (int et = 0; et < 8; ++et) { f32x4 t = (f32x4){0.f, 0.f, 0.f, 0.f};
#pragma unroll
            for (int ks = 0; ks < 4; ++ks) { const bf16x8 sf = *(const LAS bf16x8*)&ST[(16 * et + l15) * TP + 32 * ks + 8 * g]; t = MFMA16(qf[ks], sf, t); }
#pragma unroll
            for (int reg = 0; reg < 4; ++reg) t[reg] *= rs[reg];
#pragma unroll
            for (int s = 0; s < 4; ++s) if (2 * s <= w) { const bf16x4v lo = *(const LAS bf16x4v*)&VT[tsw(16 * et + l15, 32 * s + 4 * g)], hi = *(const LAS bf16x4v*)&VT[tsw(16 * et + l15, 32 * s + 16 + 4 * g)];
                const bf16x8 vf = __builtin_shufflevector(lo, hi, 0, 1, 2, 3, 4, 5, 6, 7); t = MFMA16(pf[s], vf, t); }
            O[8 * hh + et] = t; }
    }
#undef P4R_LOAD
#undef P4R_WRITE
    float ss[4] = {0.f, 0.f, 0.f, 0.f};
#pragma unroll
    for (int et = 0; et < 16; ++et)
#pragma unroll
        for (int reg = 0; reg < 4; ++reg) ss[reg] += O[et][reg] * O[et][reg];
#pragma unroll
    for (int reg = 0; reg < 4; ++reg) { float v = ss[reg]; v += __shfl_xor(v, 1); v += __shfl_xor(v, 2); v += __shfl_xor(v, 4); v += __shfl_xor(v, 8); ss[reg] = 1.0f / sqrtf(v * (1.0f / 256.0f) + EPS); }
    __syncthreads();
#pragma unroll
    for (int reg = 0; reg < 4; ++reg) { LAS bf16* op = OT + (16 * w + 4 * g + reg) * 264 + l15;
#pragma unroll
        for (int et = 0; et < 16; ++et) op[16 * et] = (bf16)f2bf(O[et][reg] * ss[reg]); }
    LDS_WAIT();
    const bf16* RG = (const bf16*)(ws + WS_RG); bf16* OR = (bf16*)(ws + WS_OR);
#pragma unroll
    for (int i = 0; i < 8; ++i) { const int p = F.lane + 64 * i, row = 16 * w + (p >> 5), c16 = p & 31; const size_t gx = (size_t)(r0 + row) * 2048 + h * 256 + 8 * c16;
        const v4u o8 = *(const LAS v4u*)&OT[row * 264 + 8 * c16]; const v4u g8 = *(const v4u*)(RG + gx); float v[8];
#pragma unroll
        for (int j = 0; j < 8; ++j) v[j] = bfe(o8, j) * bfe(g8, j);
        *(v4u*)(OR + gx) = __builtin_bit_cast(v4u, pack_f8(v)); }
}
__device__ __forceinline__ void p4_hg_all(Frame& F, const Args& A) {
    unsigned char* ws = F.ws;
    const int w = F.wave, l15 = F.lane & 15, g = F.lane >> 4;
    LAS bf16* QP = (LAS bf16*)F.lds;
    LAS bf16* KP = QP + 64 * TP;
    LAS bf16* KU = KP + 64 * TP;
    LAS bf16* VT = KU + 128 * 72;
    LAS float* E15 = (LAS float*)(VT + TSZ64T);
    LAS float* OB = E15 + 4 * 128;
    const float* Z = (const float*)(ws + WS_LOGF); const bf16* HQ = (const bf16*)(ws + WS_HQ); const bf16* HI = (const bf16*)(ws + WS_HI); const float* LB = (const float*)(ws + WS_LB);
    const int d = F.tid & 127, sq = F.tid >> 7;
    const int vc = F.tid & 15, vm0 = F.tid >> 4;
    if (F.vcu >= 512) return;
    const int nst = 2 * ((511 - F.vcu) / F.G + 1);
    float zr[16]; unsigned short qr[16]; v4u vr[2]; v2u sr[8];
#define P4H_LOAD(st) do { const int _it = F.vcu + ((st) >> 1) * F.G, _h = (_it >> 4) & 7, _rh = (_it >> 7) * 2048 + (_it & 15) * 128 + 64 * ((st) & 1); \
        _Pragma("unroll") for (int _t = 0; _t < 16; ++_t) { const size_t _ix = (size_t)(_rh + 16 * sq + _t) * 1024 + _h * 128 + d; zr[_t] = Z[_ix]; qr[_t] = HQ[_ix]; } \
        _Pragma("unroll") for (int _i = 0; _i < 2; ++_i) vr[_i] = *(const v4u*)(HI + (size_t)(_rh + vm0 + 32 * _i) * 1024 + _h * 128 + 8 * vc); \
        if (((st) & 1) == 0) { const bf16* _s = (const bf16*)(ws + WS_SHT) + (size_t)_it * 128 * 128 + (size_t)(16 * w + l15) * 128 + 4 * g; _Pragma("unroll") for (int _dt = 0; _dt < 8; ++_dt) sr[_dt] = *(const v2u*)(_s + 16 * _dt); } } while (0)
    f32x4 S[8];
    P4H_LOAD(0);
    for (int st = 0; st < nst; ++st) {
        const int item = F.vcu + (st >> 1) * F.G, hf = st & 1, h = (item >> 4) & 7, rh = (item >> 7) * 2048 + (item & 15) * 128 + 64 * hf;
        if (hf == 0) {
#pragma unroll
            for (int dt = 0; dt < 8; ++dt) { S[dt][0] = __uint_as_float(sr[dt].x << 16); S[dt][1] = __uint_as_float(sr[dt].x & 0xffff0000u); S[dt][2] = __uint_as_float(sr[dt].y << 16); S[dt][3] = __uint_as_float(sr[dt].y & 0xffff0000u); } }
        __syncthreads();
        { const float oml = 1.0f - LB[h * 128 + d];
          float kin[16], bcum[16]; float bb = 0.f;
#pragma unroll
          for (int t = 0; t < 16; ++t) { const float z = zr[t]; const float q = bf2f(qr[t]);
              kin[t] = oml * __builtin_amdgcn_rcpf(1.0f + __expf(z)); bb += __logf(1.0f - kin[t]); bcum[t] = bb;
              QP[(16 * sq + t) * TP + d] = (bf16)f2bf(q * __expf(bb)); KP[(16 * sq + t) * TP + d] = (bf16)f2bf(kin[t] * __expf(fminf(-bb, 80.0f))); }
          E15[sq * 128 + d] = __expf(bb);
          float v[8];
#pragma unroll
          for (int t = 0; t < 8; ++t) v[t] = kin[t] * __expf(bb - bcum[t]);
          *(LAS bf16x8*)&KU[d * 72 + 16 * sq] = pack_f8(v);
#pragma unroll
          for (int t = 0; t < 8; ++t) v[t] = kin[8 + t] * __expf(bb - bcum[8 + t]);
          *(LAS bf16x8*)&KU[d * 72 + 16 * sq + 8] = pack_f8(v); }
#pragma unroll
        for (int i = 0; i < 2; ++i) { LAS bf16* vt = VT + tsw64(8 * vc, vm0 + 32 * i);
#pragma unroll
            for (int j = 0; j < 8; ++j) vt[j * 72] = (bf16)((vr[i][j >> 1] >> (16 * (j & 1))) & 0xffffu); }
        if (st + 1 < nst) P4H_LOAD(st + 1);
        __syncthreads();
        const bf16x8 zero8 = (bf16x8){0, 0, 0, 0, 0, 0, 0, 0};
#pragma unroll
        for (int sc4 = 0; sc4 < 4; ++sc4) {
            f32x4 at = (f32x4){0.f, 0.f, 0.f, 0.f};
#pragma unroll
            for (int ks = 0; ks < 4; ++ks) { const bf16x8 kf = *(const LAS bf16x8*)&KP[(16 * sc4 + l15) * TP + 32 * ks + 8 * g], qf = *(const LAS bf16x8*)&QP[(16 * sc4 + l15) * TP + 32 * ks + 8 * g]; at = MFMA16(kf, qf, at); }
            float pv[8];
#pragma unroll
            for (int reg = 0; reg < 4; ++reg) { pv[reg] = (4 * g + reg) <= l15 ? at[reg] : 0.f; pv[4 + reg] = 0.f; }
            const bf16x8 pfr = pack_f8(pv);
            f32x4 o;
            { const bf16x4v lo = *(const LAS bf16x4v*)&VT[tsw64(16 * w + l15, 16 * sc4 + 4 * g)]; const bf16x8 vf = __builtin_shufflevector(lo, (bf16x4v){0, 0, 0, 0}, 0, 1, 2, 3, 4, 5, 6, 7);
              const f32x4 z4 = {0.f, 0.f, 0.f, 0.f}; o = MFMA16(pfr, vf, z4); }
#pragma unroll
            for (int ks = 0; ks < 4; ++ks) { float sv[8];
#pragma unroll
                for (int jj = 0; jj < 8; ++jj) sv[jj] = S[2 * ks + (jj >> 2)][jj & 3];
                const bf16x8 sf = pack_f8(sv);
                const LAS bf16* qp = &QP[(16 * sc4 + l15) * TP + 32 * ks + 4 * g]; const bf16x4v lo = *(const LAS bf16x4v*)qp, hi = *(const LAS bf16x4v*)(qp + 16);
                const bf16x8 qf = __builtin_shufflevector(lo, hi, 0, 1, 2, 3, 4, 5, 6, 7); o = MFMA16(qf, sf, o); }
#pragma unroll
            for (int reg = 0; reg < 4; ++reg) OB[(16 * sc4 + 4 * g + reg) * 132 + 16 * w + l15] = o[reg];
            const bf16x8 vu = g < 2 ? *(const LAS bf16x8*)&VT[tsw64(16 * w + l15, 16 * sc4 + 8 * g)] : zero8;
#pragma unroll
            for (int dt = 0; dt < 8; ++dt) { const f32x4 ed = *(const LAS f32x4*)&E15[sc4 * 128 + 16 * dt + 4 * g];
                const bf16x8 kf = g < 2 ? *(const LAS bf16x8*)&KU[(16 * dt + l15) * 72 + 16 * sc4 + 8 * g] : zero8;
                S[dt] = MFMA16(kf, vu, S[dt] * ed); }
        }
        __syncthreads();
        { const bf16* HG = (const bf16*)(ws + WS_HG); bf16* OH = (bf16*)(ws + WS_OH);
#pragma unroll
          for (int i = 0; i < 8; ++i) { const int t = 8 * w + i; const float v0 = OB[t * 132 + F.lane], v1 = OB[t * 132 + 64 + F.lane];
              const float rr = 1.0f / sqrtf(wave_sum(v0 * v0 + v1 * v1) * (1.0f / 128.0f) + EPS); const size_t ix = (size_t)(rh + t) * 1024 + h * 128 + F.lane;
              OH[ix] = (bf16)f2bf(v0 * rr * A.in[10][F.lane] * bf2f(HG[ix])); OH[ix + 64] = (bf16)f2bf(v1 * rr * A.in[10][64 + F.lane] * bf2f(HG[ix + 64])); } }
    }
#undef P4H_LOAD
}
__device__ __forceinline__ void p4_phase(Frame& F, const Args& A) {
    for (int rep = 0; rep < (PROBE_SUB == 40 ? 2 : 1); ++rep) for (int it = F.vcu; it < 512; it += F.G) p4_ret_item(F, it);
    asm volatile("" : "+v"(F.tid), "+v"(F.lane));
    for (int rep = 0; rep < (PROBE_SUB == 41 ? 2 : 1); ++rep) p4_hg_all(F, A);
}
namespace mini {
using pg8::bf16_t; using pg8::u32x2; using pg8::silu4; using pg8::sigm4; using pg8::pack4; using pg8::unpack4;
constexpr int AP = 136;
template <bool TWO> __device__ __forceinline__ void core(Frame& F, const bf16_t* A, int lda, int K, const bf16_t* bp0, const bf16_t* bp1, f32x4 (&acc0)[8], f32x4 (&acc1)[8]) {
    LAS bf16* AS = (LAS bf16*)F.lds; const int l15 = F.lane & 15, g = F.lane >> 4; const int nch = K >> 7; int cc = F.vcu % nch;
    v4u pre[4]; bf16x8 b0[4], b1[4];
    const int prow = F.tid >> 4, pc = (F.tid & 15) * 8;
#pragma unroll
    for (int i = 0; i < 4; ++i) pre[i] = *(const v4u*)(A + (size_t)(prow + 32 * i) * lda + cc * 128 + pc);
    if (bp0) {
#pragma unroll
        for (int u = 0; u < 4; ++u) { b0[u] = *(const bf16x8*)(bp0 + cc * 128 + 32 * u); if (TWO) b1[u] = *(const bf16x8*)(bp1 + cc * 128 + 32 * u); } }
    __syncthreads();
    for (int c = 0; c < nch; ++c) {
        LAS bf16* buf = AS + (c & 1) * (128 * AP);
#pragma unroll
        for (int i = 0; i < 4; ++i) *(LAS v4u*)&buf[(prow + 32 * i) * AP + pc] = pre[i];
        bf16x8 c0[4], c1[4];
#pragma unroll
        for (int u = 0; u < 4; ++u) { c0[u] = b0[u]; if (TWO) c1[u] = b1[u]; }
        cc = cc + 1 == nch ? 0 : cc + 1;
        if (c + 1 < nch) {
#pragma unroll
            for (int i = 0; i < 4; ++i) pre[i] = *(const v4u*)(A + (size_t)(prow + 32 * i) * lda + cc * 128 + pc);
            if (bp0) {
#pragma unroll
                for (int u = 0; u < 4; ++u) { b0[u] = *(const bf16x8*)(bp0 + cc * 128 + 32 * u); if (TWO) b1[u] = *(const bf16x8*)(bp1 + cc * 128 + 32 * u); } } }
        __syncthreads();
        if (bp0) {
#pragma unroll
            for (int u = 0; u < 4; ++u)
#pragma unroll
                for (int rt = 0; rt < 8; ++rt) { const bf16x8 a = *(const LAS bf16x8*)&buf[(16 * rt + l15) * AP + 32 * u + 8 * g];
                    acc0[rt] = __builtin_amdgcn_mfma_f32_16x16x32_bf16(c0[u], a, acc0[rt], 0, 0, 0); if (TWO) acc1[rt] = __builtin_amdgcn_mfma_f32_16x16x32_bf16(c1[u], a, acc1[rt], 0, 0, 0); } }
    }
}
#define MINI_ZERO(acc) _Pragma("unroll") for (int _i = 0; _i < 8; ++_i) acc[_i] = (f32x4){0.f, 0.f, 0.f, 0.f}
__device__ __forceinline__ void inproj(Frame& F, int j, int nj) {
    unsigned char* ws = F.ws; const int l15 = F.lane & 15, g = F.lane >> 4;
    if (j >= NIN / 16) return;
    const int t = j + nj * F.wave; const bool has = t < NIN / 16; const int n0 = 16 * t;
    f32x4 acc[8]; MINI_ZERO(acc);
    core<false>(F, (const bf16_t*)(ws + WS_XB) + 8192ull * 2048, 2048, 2048, has ? (const bf16_t*)(ws + WS_WIN) + (size_t)(n0 + l15) * 2048 + 8 * g : nullptr, nullptr, acc, acc);
    if (!has) return;
    const int c = n0 + 4 * g;
    if (c >= 7168 && c < 8192) {
#pragma unroll
        for (int rt = 0; rt < 8; ++rt) *(f32x4*)((float*)(ws + WS_LOGF) + (size_t)(8192 + 16 * rt + l15) * 1024 + (c - 7168)) = acc[rt];
        return; }
    size_t od; int pitch, c0, act; float sc = 1.0f;
    if (c < 1024) { od = WS_Q; pitch = 1024; c0 = 0; act = 0; } else if (c < 2048) { od = WS_K; pitch = 1024; c0 = 1024; act = 0; sc = 0.08838834764831845f; }
    else if (c < 4096) { od = WS_V; pitch = 2048; c0 = 2048; act = 0; } else if (c < 6144) { od = WS_RG; pitch = 2048; c0 = 4096; act = 1; } else if (c < 7168) { od = WS_HQ; pitch = 1024; c0 = 6144; act = 1; }
    else if (c < 9216) { od = WS_HI; pitch = 1024; c0 = 8192; act = 0; } else if (c < 10240) { od = WS_HG; pitch = 1024; c0 = 9216; act = 1; } else if (c < 12288) { od = WS_GA; pitch = 2048; c0 = 10240; act = 2; } else { od = WS_GB; pitch = 2048; c0 = 12288; act = 2; }
#pragma unroll
    for (int rt = 0; rt < 8; ++rt) { f32x4 v = acc[rt] * sc; if (act == 1) v = silu4(v); else if (act == 2) v = sigm4(v);
        *(u32x2*)((bf16_t*)(ws + od) + (size_t)(8192 + 16 * rt + l15) * pitch + (c - c0)) = pack4(v); }
}
__device__ __forceinline__ void outproj(Frame& F) {
    unsigned char* ws = F.ws; const int l15 = F.lane & 15, g = F.lane >> 4;
    if (F.vcu >= 128) return;
    const int t = F.vcu + F.G * F.wave; const bool has = t < 128; const int n0 = 16 * t;
    f32x4 ya[8], yb[8]; MINI_ZERO(ya); MINI_ZERO(yb);
    core<false>(F, (const bf16_t*)(ws + WS_OR) + 8192ull * 2048, 2048, 2048, has ? (const bf16_t*)(ws + WS_WRO) + (size_t)(n0 + l15) * 2048 + 8 * g : nullptr, nullptr, ya, ya);
    core<false>(F, (const bf16_t*)(ws + WS_OH) + 8192ull * 1024, 1024, 1024, has ? (const bf16_t*)(ws + WS_WHO) + (size_t)(n0 + l15) * 1024 + 8 * g : nullptr, nullptr, yb, yb);
    if (!has) return;
#pragma unroll
    for (int rt = 0; rt < 8; ++rt) { const size_t ix = (size_t)(8192 + 16 * rt + l15) * 2048 + n0 + 4 * g;
        const f32x4 ga = unpack4(*(const u32x2*)((const bf16_t*)(ws + WS_GA) + ix)), gb = unpack4(*(const u32x2*)((const bf16_t*)(ws + WS_GB) + ix));
        *(u32x2*)((bf16_t*)(ws + WS_MG) + ix) = pack4(ga * ya[rt] + gb * yb[rt]); }
}
template <int MODE> __device__ __forceinline__ void resid(Frame& F, const bf16_t* Arows  , const bf16_t* Bt, int K, const float* XI  , float* XO  , bf16_t* X1  , float* SS  ) {
    const int l15 = F.lane & 15, g = F.lane >> 4;
    if (F.vcu >= 128) return;
    const int t = F.vcu + F.G * F.wave; const bool has = t < 128; const int n0 = 16 * t;
    f32x4 acc[8]; MINI_ZERO(acc);
    core<false>(F, Arows, K, K, has ? Bt + (size_t)(n0 + l15) * K + 8 * g : nullptr, nullptr, acc, acc);
    if (!has) return;
#pragma unroll
    for (int rt = 0; rt < 8; ++rt) { const int rl = 16 * rt + l15; const size_t ix = (size_t)rl * 2048 + n0 + 4 * g; f32x4 v = acc[rt];
        if (MODE == 0) { v += *(const f32x4*)(XI + ix); *(u32x2*)(X1 + ix) = pack4(v); }
        else { v += unpack4(*(const u32x2*)(X1 + ix)); *(f32x4*)(XO + ix) = v; }
        float ss = (v[0] * v[0] + v[1] * v[1]) + (v[2] * v[2] + v[3] * v[3]); ss += __shfl_xor(ss, 16); ss += __shfl_xor(ss, 32);
        if (g == 0) atomicAdd(SS + rl, ss); }
}
__device__ __forceinline__ void swiglu(Frame& F, int j, int nj) {
    unsigned char* ws = F.ws; const int l15 = F.lane & 15, g = F.lane >> 4;
    if (j >= DFF / 16) return;
    const int t = j + nj * F.wave; const bool has = t < DFF / 16; const int ng = ((16 * t) >> 7) * 256 + ((16 * t) & 127);
    f32x4 ag[8], au[8]; MINI_ZERO(ag); MINI_ZERO(au);
    const bf16_t* A = (const bf16_t*)(ws + WS_X1B) + 8192ull * 2048;
    const bf16_t* bg = has ? (const bf16_t*)(ws + WS_WFI) + (size_t)(ng + l15) * 2048 + 8 * g : nullptr;
    core<true>(F, A, 2048, 2048, bg, has ? bg + 128 * 2048 : nullptr, ag, au);
    if (!has) return;
    const float* SS1 = (const float*)(F.ctl + CW_SS1);
#pragma unroll
    for (int rt = 0; rt < 8; ++rt) { const int r = 8192 + 16 * rt + l15; const float r2 = 1.0f / sqrtf(SS1[r] * (1.0f / 2048.0f) + EPS);
        *(u32x2*)((bf16_t*)(ws + WS_ACT) + (size_t)r * DFF + 16 * t + 4 * g) = pack4(silu4(ag[rt] * r2) * (au[rt] * r2)); }
}
}
__global__ void __launch_bounds__(NWAVES * 64, 2) mk_fwd(Args args) {
    extern __shared__ __attribute__((aligned(16))) unsigned char lds[];
    Frame F;
    F.lds = (LAS unsigned char*)lds; F.MISC = (volatile LAS unsigned*)(F.lds + MISC_OFF);
    F.tid = threadIdx.x; F.lane = F.tid & 63; F.wave = __builtin_amdgcn_readfirstlane(F.tid >> 6);
    F.G = gridDim.x; { const int bx = blockIdx.x; F.vcu = (F.G % 8 == 0) ? (bx % 8) * (F.G / 8) + bx / 8 : bx; }
    F.ws = args.ws; F.out = args.out; F.ctl = (gu32*)(args.ws + WS_CTL);
    for (int u = F.tid; u < (LDS_BYTES - LDSCTL_OFF) / 4; u += NWAVES * 64) ((LAS unsigned*)(F.lds + LDSCTL_OFF))[u] = 0u;
    __syncthreads();
    XcdBarrier bar; bar.bar = (unsigned*)(F.ctl + CW_BAR); bar.x = 0; bar.st = nullptr;
    if (args.use_bar) bar = xcd_barrier_post((unsigned*)(F.ctl + CW_BAR), F.MISC + 8);
    const int lo = args.ph_lo, hi = args.ph_hi;
#define IN(k) (lo <= (k) && (k) < hi)
#define SEAM(k) do { if (IN(k) && IN((k) + 1)) xcd_barrier(bar); } while (0)
#ifndef PROBE_REPEAT
#define PROBE_REPEAT -1
#endif
#define NREP(k) ((PROBE_REPEAT == (k)) ? 2 : 1)
    unsigned char* ws = args.ws;
    if (PROBE_REPEAT == 0) { p0_prologue(F, args); xcd_barrier(bar); }
    if (IN(0)) { p0_prologue(F, args); } SEAM(0);
#define P1_BODY { \
          \
        if (F.G >= 2 && (F.vcu & 1)) { mini::inproj(F, F.vcu >> 1, F.G >> 1); __syncthreads(); } else if (F.G < 2) { mini::inproj(F, F.vcu, F.G); __syncthreads(); } \
        pg8::Gemm g{(const pg8::bf16_t*)(ws + WS_XB), (const pg8::bf16_t*)(ws + WS_WIN), 8192, NIN, 2048}; pg8::StaticOrder S; S.init(8192, NIN, F.G, (int)blockIdx.x); \
        pg8::EpiInProj E{ws}; \
        pg8::gemm_phase<pg8::EpiInProj, pg8::StaticOrder, true, true>(F.lds, g, S, E); }
    if (PROBE_REPEAT == 1) { P1_BODY xcd_barrier(bar); }
    if (PROBE_REPEAT == 101) { pg8::Gemm g{(const pg8::bf16_t*)(ws + WS_XB), (const pg8::bf16_t*)(ws + WS_WIN), 8192, NIN, 2048}; pg8::StaticOrder S; S.init(8192, NIN, F.G, (int)blockIdx.x);
        pg8::EpiNull E{}; pg8::gemm_phase<pg8::EpiNull, pg8::StaticOrder, true, true>(F.lds, g, S, E); xcd_barrier(bar); }
    if (PROBE_REPEAT == 102) { pg8::Gemm g{(const pg8::bf16_t*)(ws + WS_XB), (const pg8::bf16_t*)(ws + WS_WIN), 8192, 2048, 2048}; pg8::StaticOrder S; S.init(8192, 2048, F.G, (int)blockIdx.x);
        pg8::EpiNull E{}; pg8::gemm_phase<pg8::EpiNull, pg8::StaticOrder, true, true>(F.lds, g, S, E); xcd_barrier(bar); }
    if (IN(1)) P1_BODY SEAM(1);
    if (PROBE_REPEAT == 2) { p2_phase(F, args); xcd_barrier(bar); }
    if (IN(2)) { p2_phase(F, args); } SEAM(2);
    if (PROBE_REPEAT == 3) { p4_phase(F, args); xcd_barrier(bar); }
    if (IN(3)) { p4_phase(F, args); } SEAM(3);
    if (IN(4)) {
        { pg8::Gemm g{(const pg8::bf16_t*)(ws + WS_OR), (const pg8::bf16_t*)(ws + WS_WRO), 8192, 2048, 2048}; pg8::StaticOrder S; S.init(8192, 2048, F.G, (int)blockIdx.x);
          pg8::EpiGate<0> E{(const pg8::bf16_t*)(ws + WS_GA), (pg8::bf16_t*)(ws + WS_YT), (pg8::bf16_t*)(ws + WS_MG)};
          pg8::gemm_phase<pg8::EpiGate<0>, pg8::StaticOrder, true, true>(F.lds, g, S, E); }
        { pg8::Gemm g{(const pg8::bf16_t*)(ws + WS_OH), (const pg8::bf16_t*)(ws + WS_WHO), 8192, 2048, 1024}; pg8::StaticOrder S; S.init(8192, 2048, F.G, (int)blockIdx.x);
          pg8::EpiGate<1> E{(const pg8::bf16_t*)(ws + WS_GB), (pg8::bf16_t*)(ws + WS_YT), (pg8::bf16_t*)(ws + WS_MG)};
          pg8::gemm_phase<pg8::EpiGate<1>, pg8::StaticOrder, true, true>(F.lds, g, S, E); }
        mini::outproj(F);
    } SEAM(4);
    if (IN(5)) {
        pg8::Gemm g{(const pg8::bf16_t*)(ws + WS_MG), (const pg8::bf16_t*)(ws + WS_WOUT), 8192, 2048, 2048}; pg8::StaticOrder S; S.init(8192, 2048, F.G, (int)blockIdx.x);
        pg8::EpiResid<0> E{args.in[0], args.in[1], (pg8::bf16_t*)(ws + WS_X1B), nullptr, (float*)(F.ctl + CW_SS1)};
        pg8::gemm_phase<pg8::EpiResid<0>, pg8::StaticOrder, true, true>(F.lds, g, S, E);
        mini::resid<0>(F, (const pg8::bf16_t*)(ws + WS_MG) + 8192ull * 2048, (const pg8::bf16_t*)(ws + WS_WOUT), 2048, args.in[1], nullptr, (pg8::bf16_t*)(ws + WS_X1B) + 8192ull * 2048, (float*)(F.ctl + CW_SS1) + 8192);
    } SEAM(5);
    if (IN(6)) {
        { const int nu = (8192 / 256) * (2 * DFF / 256), rem = nu % F.G;
          if (rem && (int)blockIdx.x >= rem) { mini::swiglu(F, (int)blockIdx.x - rem, F.G - rem); __syncthreads(); } else if (!rem) { mini::swiglu(F, F.vcu, F.G); __syncthreads(); } }
        pg8::Gemm g{(const pg8::bf16_t*)(ws + WS_X1B), (const pg8::bf16_t*)(ws + WS_WFI), 8192, 2 * DFF, 2048}; pg8::StaticOrder S; S.init(8192, 2 * DFF, F.G, (int)blockIdx.x);
        pg8::EpiSwiglu E{(const float*)(F.ctl + CW_SS1), (pg8::bf16_t*)(ws + WS_ACT)};
        pg8::gemm_phase<pg8::EpiSwiglu, pg8::StaticOrder, true, true>(F.lds, g, S, E);
    } SEAM(6);
    if (IN(7)) {
        pg8::Gemm g{(const pg8::bf16_t*)(ws + WS_ACT), (const pg8::bf16_t*)(ws + WS_WFO), 8192, 2048, DFF}; pg8::StaticOrder S; S.init(8192, 2048, F.G, (int)blockIdx.x);
        pg8::EpiResid<1> E{nullptr, nullptr, (pg8::bf16_t*)(ws + WS_X1B), args.out, (float*)(F.ctl + CW_SS2)};
        pg8::gemm_phase<pg8::EpiResid<1>, pg8::StaticOrder, true, true>(F.lds, g, S, E);
        mini::resid<1>(F, (const pg8::bf16_t*)(ws + WS_ACT) + 8192ull * DFF, (const pg8::bf16_t*)(ws + WS_WFO), DFF, nullptr, args.out + OUT_YS, (pg8::bf16_t*)(ws + WS_X1B) + 8192ull * 2048, (float*)(F.ctl + CW_SS2) + 8192);
    } SEAM(7);
    if (IN(8)) {
        const int gw = F.vcu * NWAVES + F.wave, NGW = F.G * NWAVES; const float* SS2 = (const float*)(F.ctl + CW_SS2);
        for (int m = gw; m < MROWS; m += NGW) { f32x4* xr = (f32x4*)(args.out + (size_t)m * 2048) + F.lane; const f32x4* gn = (const f32x4*)args.in[14] + F.lane;
            const float rr = 1.0f / sqrtf(SS2[m] * (1.0f / 2048.0f) + EPS);
#pragma unroll
            for (int j = 0; j < 8; ++j) xr[64 * j] = xr[64 * j] * rr * gn[64 * j]; }
    }
#undef IN
#undef SEAM
}
extern "C" void kernel_launch(void* const* d_in, const int* in_sizes, int n_in, void* d_out, int out_size, void* d_ws, size_t ws_size, hipStream_t stream) {
    static int grid = 0;
    if (grid == 0) {
        int dev = 0, cus = 0;
        if (ws_size < WS_END || n_in != 15) { fprintf(stderr, "kernel_launch: unexpected sizes (ws %zu, n_in %d)\n", ws_size, n_in); grid = -1; return; }
        if (hipGetDevice(&dev) != hipSuccess || hipDeviceGetAttribute(&cus, hipDeviceAttributeMultiprocessorCount, dev) != hipSuccess) { grid = -1; return; }
        if (hipFuncSetAttribute((const void*)mk_fwd, hipFuncAttributeMaxDynamicSharedMemorySize, LDS_BYTES) != hipSuccess) { fprintf(stderr, "kernel_launch: hipFuncSetAttribute failed\n"); grid = -1; return; }
        int per_cu = 0; (void)hipOccupancyMaxActiveBlocksPerMultiprocessor(&per_cu, (const void*)mk_fwd, NWAVES * 64, LDS_BYTES); (void)hipGetLastError();
        if (per_cu < 1) { fprintf(stderr, "kernel_launch: occupancy query says %d blocks per CU; nothing launched\n", per_cu); grid = -1; return; }
        grid = cus;
    }
    if (grid < 0) return;
    (void)hipMemsetAsync((char*)d_ws + WS_CTL, 0, CTL_ZERO_BYTES, stream);
    Args a{};
    for (int i = 0; i < 15; ++i) a.in[i] = (const float*)d_in[i];
    a.out = (float*)d_out; a.ws = (unsigned char*)d_ws; a.use_bar = 1; a.ph_lo = 0; a.ph_hi = 9;
    hipLaunchKernelGGL(mk_fwd, dim3(grid), dim3(NWAVES * 64), LDS_BYTES, stream, a);
}
```
